# Optimizing an MI355X kernel written in HIP

```python
import math
import jax
import jax.numpy as jnp
from jax import lax
import numpy as np

D_MODEL = 1024
BATCH = 8
SEQ = 2048
DEPTH = 4

CTX_LEN = 256
GRID_W = 64
HEAD_DIM = 64
D_MIX = D_MODEL
GROUP_W = D_MIX // 4
N_GROUP_HEADS = GROUP_W // HEAD_DIM
N_DIR = 2
NORM_EPS = 1e-6
N_MOD = 6
GDN_HEADS = N_GROUP_HEADS
GDN_CONV = 5
GDN_CHUNK = 64
SWA_Q_HEADS = N_GROUP_HEADS
SWA_KV_HEADS = 2
SWA_WINDOW = 128
SWA_BLOCK = 128
ROPE_THETA = 10000.0
GMLP_GROUPS = N_GROUP_HEADS
GMLP_CHUNK = 128
MLSTM_HEADS = N_GROUP_HEADS
MLSTM_CHUNK = 64
D_FF = 4 * D_MODEL

IN_SPLITS = (GROUP_W, GROUP_W, GROUP_W, GROUP_W, N_DIR * GDN_HEADS, N_DIR * GDN_HEADS,
             GROUP_W, SWA_KV_HEADS * HEAD_DIM, SWA_KV_HEADS * HEAD_DIM,
             GROUP_W, GROUP_W,
             GROUP_W, GROUP_W, GROUP_W, GROUP_W, N_DIR * MLSTM_HEADS, N_DIR * MLSTM_HEADS)
D_IN = sum(IN_SPLITS)

kernel_name = 'hybrid_parallel_groups_flow_block'


def rmsnorm(x, w):
    xf = x.astype(jnp.float32)
    y = xf * lax.rsqrt(jnp.mean(xf * xf, axis=-1, keepdims=True) + NORM_EPS)
    return (y * w.astype(jnp.float32)).astype(x.dtype)


def l2norm(x):
    xf = x.astype(jnp.float32)
    return xf * lax.rsqrt(jnp.sum(xf * xf, axis=-1, keepdims=True) + NORM_EPS)


def heads(t, n):
    return t.reshape(t.shape[:-1] + (n, t.shape[-1] // n))


def split_cols(z):
    out, start = [], 0
    for size in IN_SPLITS:
        out.append(z[..., start:start + size])
        start += size
    return out


def modulate(h, shift, scale):
    return h * (1 + scale) + shift


def dwconv_centred(x, w):
    k, ch = w.shape
    return lax.conv_general_dilated(x, w[:, None, :].astype(x.dtype), window_strides=(1,),
                                    padding=[(k // 2, k // 2)], dimension_numbers=('NWC', 'WIO', 'NWC'),
                                    feature_group_count=ch)


def to_chunks(t, chunk):
    bsz, length, h = t.shape[:3]
    t = t.astype(jnp.float32).reshape((bsz, length // chunk, chunk, h) + t.shape[3:])
    return jnp.moveaxis(t, (1, 3), (0, 2))


def from_chunks(t):
    t = jnp.moveaxis(t, (0, 2), (1, 3))
    return t.reshape((t.shape[0], t.shape[1] * t.shape[2]) + t.shape[3:])


def gdn_scan(q, k, v, g, beta, state):
    dk, dv = q.shape[-1], v.shape[-1]
    q = to_chunks(q, GDN_CHUNK) * dk ** -0.5
    k = to_chunks(k, GDN_CHUNK)
    v = to_chunks(v, GDN_CHUNK)
    g = to_chunks(g, GDN_CHUNK)
    beta = to_chunks(beta, GDN_CHUNK)
    idx = jnp.arange(GDN_CHUNK)
    incl = idx[:, None] >= idx[None, :]
    strict = idx[:, None] > idx[None, :]
    gcum = jnp.cumsum(g, axis=-1)
    decay = jnp.exp(jnp.where(incl, gcum[..., :, None] - gcum[..., None, :], -jnp.inf))
    kbeta = k * beta[..., None]
    a = jnp.where(strict, jnp.einsum('nbhik,nbhjk->nbhij', kbeta, k) * decay, 0.0)
    rhs = jnp.concatenate([v * beta[..., None], kbeta * jnp.exp(gcum)[..., None]], axis=-1)
    sol = lax.linalg.triangular_solve(a + jnp.eye(GDN_CHUNK, dtype=jnp.float32), rhs,
                                      left_side=True, lower=True)
    u, w = sol[..., :dv], sol[..., dv:]
    attn = jnp.einsum('nbhik,nbhjk->nbhij', q, k) * decay
    q_dec = q * jnp.exp(gcum)[..., None]
    k_dec = k * jnp.exp(gcum[..., -1:] - gcum)[..., None]
    g_last = jnp.exp(gcum[..., -1])

    def step(s, inp):
        u_c, w_c, attn_c, q_c, k_c, gl_c = inp
        v_new = u_c - jnp.einsum('bhck,bhkv->bhcv', w_c, s)
        o = jnp.einsum('bhck,bhkv->bhcv', q_c, s) + jnp.einsum('bhij,bhjv->bhiv', attn_c, v_new)
        s = s * gl_c[..., None, None] + jnp.einsum('bhck,bhcv->bhkv', k_c, v_new)
        return s, o

    state, o = lax.scan(step, state, (u, w, attn, q_dec, k_dec, g_last))
    return from_chunks(o), state


def mlstm_scan(q, k, v, ig, fg, state):
    dk = q.shape[-1]
    q = to_chunks(q, MLSTM_CHUNK) * dk ** -0.5
    k = to_chunks(k, MLSTM_CHUNK)
    v = to_chunks(v, MLSTM_CHUNK)
    ig = to_chunks(ig, MLSTM_CHUNK)
    logf = jax.nn.log_sigmoid(to_chunks(fg, MLSTM_CHUNK))
    idx = jnp.arange(MLSTM_CHUNK)
    incl = idx[:, None] >= idx[None, :]
    b = jnp.cumsum(logf, axis=-1)
    dmat = jnp.where(incl, b[..., :, None] - b[..., None, :] + ig[..., None, :], -jnp.inf)
    dmax = jnp.max(dmat, axis=-1)
    qk = jnp.einsum('nbhik,nbhjk->nbhij', q, k)
    b_last = b[..., -1]
    w_state = b[..., -1:] - b + ig
    w_state_max = jnp.max(w_state, axis=-1)

    def step(carry, inp):
        c_mem, n_vec, m = carry
        q_c, k_c, v_c, b_c, d_c, dmax_c, qk_c, ws_c, wsmax_c, bl_c = inp
        inter = b_c + m[..., None]
        m_t = jnp.maximum(inter, dmax_c)
        s = qk_c * jnp.exp(d_c - m_t[..., None])
        w_inter = jnp.exp(inter - m_t)
        num = (w_inter[..., None] * jnp.einsum('bhck,bhkv->bhcv', q_c, c_mem)
               + jnp.einsum('bhij,bhjv->bhiv', s, v_c))
        den = w_inter * jnp.einsum('bhck,bhk->bhc', q_c, n_vec) + jnp.sum(s, axis=-1)
        h = num / jnp.maximum(jnp.abs(den), jnp.exp(-m_t))[..., None]
        m_new = jnp.maximum(bl_c + m, wsmax_c)
        carry_decay = jnp.exp(bl_c + m - m_new)
        k_w = k_c * jnp.exp(ws_c - m_new[..., None])[..., None]
        c_mem = carry_decay[..., None, None] * c_mem + jnp.einsum('bhck,bhcv->bhkv', k_w, v_c)
        n_vec = carry_decay[..., None] * n_vec + jnp.sum(k_w, axis=-2)
        return (c_mem, n_vec, m_new), h

    state, h = lax.scan(step, state, (q, k, v, b, dmat, dmax, qk, w_state, w_state_max, b_last))
    return from_chunks(h), state


def bidirectional_prefixed(scan_fn, ctx_seq, ctx_gates, lat_seq, lat_gates, state0):
    out_x, out_c = 0.0, 0.0
    for d in range(N_DIR):
        flip = (lambda t: jnp.flip(t, axis=1)) if d == 1 else (lambda t: t)
        c_args = [flip(t) for t in ctx_seq] + [flip(gt[:, :, d]) for gt in ctx_gates]
        x_args = [flip(t) for t in lat_seq] + [flip(gt[:, :, d]) for gt in lat_gates]
        o_c, ctx_state = scan_fn(*c_args, state0)
        o_x, _ = scan_fn(*x_args, ctx_state)
        out_c = out_c + flip(o_c)
        out_x = out_x + flip(o_x)
    return out_x, out_c


def gdn_mixer(lat, cx, conv_w, a_log, dt_bias, norm_w):
    dtype = lat[0].dtype

    def branch(q, k, v, a, b):
        qkv = jax.nn.silu(dwconv_centred(jnp.concatenate([q, k, v], axis=-1), conv_w))
        q, k, v = jnp.split(qkv, 3, axis=-1)
        g = -jnp.exp(a_log.astype(jnp.float32)) * jax.nn.softplus(
            heads(a.astype(jnp.float32), N_DIR) + dt_bias.astype(jnp.float32))
        beta = jax.nn.sigmoid(heads(b.astype(jnp.float32), N_DIR))
        seq = (l2norm(heads(q, GDN_HEADS)), l2norm(heads(k, GDN_HEADS)), heads(v, GDN_HEADS))
        return seq, (g, beta)

    (sx, gx), (sc, gcx) = branch(*lat[:3], *lat[4:]), branch(*cx[:3], *cx[4:])
    state0 = jnp.zeros((lat[0].shape[0], GDN_HEADS, HEAD_DIM, HEAD_DIM), jnp.float32)
    ox, oc = bidirectional_prefixed(gdn_scan, sc, gcx, sx, gx, state0)

    def finish(o, z):
        o = rmsnorm(o, norm_w) * jax.nn.silu(heads(z.astype(jnp.float32), GDN_HEADS))
        return o.reshape(o.shape[:2] + (GROUP_W,)).astype(dtype)

    return finish(ox, lat[3]), finish(oc, cx[3])


def axial_rope(length, dtype):
    rows = length // GRID_W
    row = jnp.repeat(jnp.arange(rows), GRID_W).astype(jnp.float32)
    col = (jnp.arange(rows * GRID_W) % GRID_W).astype(jnp.float32)
    n_freq = HEAD_DIM // 4
    inv = jnp.power(ROPE_THETA, -jnp.arange(n_freq, dtype=jnp.float32) / n_freq)
    ang = jnp.concatenate([row[:, None] * inv, col[:, None] * inv], axis=-1)
    return jnp.cos(ang)[:, None, :].astype(dtype), jnp.sin(ang)[:, None, :].astype(dtype)


def apply_rope(t, cos, sin):
    half = t.shape[-1] // 2
    t1, t2 = t[..., :half], t[..., half:]
    return jnp.concatenate([t1 * cos - t2 * sin, t1 * sin + t2 * cos], axis=-1)


def sink_softmax(sink_logit, scores):
    sk = jnp.broadcast_to(sink_logit, scores.shape[:-1] + (1,))
    return jax.nn.softmax(jnp.concatenate([sk, scores], axis=-1), axis=-1)[..., 1:]


def banded_window_attention(q, k, v, kc, vc, sink):
    bsz, length, hq, dh = q.shape
    hkv = k.shape[2]
    grp = hq // hkv
    blk = SWA_BLOCK
    nb = length // blk
    scale = dh ** -0.5
    qb = q.reshape(bsz, nb, blk, hkv, grp, dh)

    def band(t):
        tp = jnp.pad(t, ((0, 0), (blk, blk), (0, 0), (0, 0))).reshape(bsz, nb + 2, blk, hkv, dh)
        return jnp.concatenate([tp[:, :-2], tp[:, 1:-1], tp[:, 2:]], axis=2)

    kb, vb = band(k), band(v)
    s_loc = jnp.einsum('bnqhgd,bnkhd->bnhgqk', qb, kb).astype(jnp.float32) * scale
    s_ctx = jnp.einsum('bnqhgd,bchd->bnhgqc', qb, kc).astype(jnp.float32) * scale
    qi = jnp.arange(blk)[:, None]
    kj = jnp.arange(3 * blk)[None, :]
    kpos = jnp.arange(nb)[:, None, None] * blk + kj[None] - blk
    mask = (jnp.abs(kj - blk - qi) <= SWA_WINDOW)[None] & (kpos >= 0) & (kpos < length)
    s_loc = jnp.where(mask[None, :, None, None], s_loc, -jnp.inf)
    sk = sink.astype(jnp.float32).reshape(hkv, grp)[None, None, :, :, None, None]
    p = sink_softmax(sk, jnp.concatenate([s_loc, s_ctx], axis=-1)).astype(v.dtype)
    p_loc, p_ctx = p[..., :3 * blk], p[..., 3 * blk:]
    o = (jnp.einsum('bnhgqk,bnkhd->bnqhgd', p_loc, vb)
         + jnp.einsum('bnhgqc,bchd->bnqhgd', p_ctx, vc))
    return o.reshape(bsz, length, hq * dh)


def context_attention(qc, kc, vc, sink):
    bsz, lc, hq, dh = qc.shape
    hkv = kc.shape[2]
    grp = hq // hkv
    q = qc.reshape(bsz, lc, hkv, grp, dh)
    s = jnp.einsum('bqhgd,bkhd->bhgqk', q, kc).astype(jnp.float32) * dh ** -0.5
    sk = sink.astype(jnp.float32).reshape(hkv, grp)[None, :, :, None, None]
    p = sink_softmax(sk, s).astype(vc.dtype)
    return jnp.einsum('bhgqk,bkhd->bqhgd', p, vc).reshape(bsz, lc, hq * dh)


def swa_mixer(lat, cx, sink):
    qx, kx, vx = lat
    qc, kc, vc = cx
    cos, sin = axial_rope(qx.shape[1], qx.dtype)
    qx = apply_rope(heads(qx, SWA_Q_HEADS), cos, sin)
    kx = apply_rope(heads(kx, SWA_KV_HEADS), cos, sin)
    kc, vc = heads(kc, SWA_KV_HEADS), heads(vc, SWA_KV_HEADS)
    o_x = banded_window_attention(qx, kx, heads(vx, SWA_KV_HEADS), kc, vc, sink)
    o_c = context_attention(heads(qc, SWA_Q_HEADS), kc, vc, sink)
    return o_x, o_c


def gmlp_mixer(u, v, w_s, b_s, norm_w):
    bsz, length, _ = u.shape
    n = length // GMLP_CHUNK
    u = jax.nn.gelu(u)
    v = rmsnorm(jax.nn.gelu(v), norm_w)
    vb = v.reshape(bsz, n, GMLP_CHUNK, GMLP_GROUPS, GROUP_W // GMLP_GROUPS)
    mixed = jnp.einsum('gpq,bnqgd->bnpgd', w_s, vb) + b_s.T[None, None, :, :, None]
    return u * mixed.reshape(bsz, length, GROUP_W)


def mlstm_mixer(lat, cx, ig_bias, fg_bias, norm_w):
    dtype = lat[0].dtype

    def branch(q, k, v, i, f):
        seq = (heads(q, MLSTM_HEADS), heads(k, MLSTM_HEADS), heads(v, MLSTM_HEADS))
        gates = (heads(i.astype(jnp.float32), N_DIR) + ig_bias.astype(jnp.float32),
                 heads(f.astype(jnp.float32), N_DIR) + fg_bias.astype(jnp.float32))
        return seq, gates

    (sx, gx), (sc, gcx) = branch(*lat[:3], *lat[4:]), branch(*cx[:3], *cx[4:])
    bsz = lat[0].shape[0]
    state0 = (jnp.zeros((bsz, MLSTM_HEADS, HEAD_DIM, HEAD_DIM), jnp.float32),
              jnp.zeros((bsz, MLSTM_HEADS, HEAD_DIM), jnp.float32),
              jnp.zeros((bsz, MLSTM_HEADS), jnp.float32))
    hx, hc = bidirectional_prefixed(mlstm_scan, sc, gcx, sx, gx, state0)

    def finish(h, o):
        h = rmsnorm(h, norm_w.reshape(MLSTM_HEADS, HEAD_DIM)).reshape(h.shape[:2] + (GROUP_W,))
        return (jax.nn.sigmoid(o.astype(jnp.float32)) * h).astype(dtype)

    return finish(hx, lat[3]), finish(hc, cx[3])


def token_mixing(hx, hc, w_in, gdn_conv_w, gdn_a_log, gdn_dt_bias, gdn_norm_w, swa_sink,
                 gmlp_w_s, gmlp_b_s, gmlp_norm_w, mlstm_ig_bias, mlstm_fg_bias, mlstm_norm_w):
    zx = split_cols(hx @ w_in)
    zc = split_cols(hc @ w_in)
    a_x, a_c = gdn_mixer(zx[0:6], zc[0:6], gdn_conv_w, gdn_a_log, gdn_dt_bias, gdn_norm_w)
    b_x, b_c = swa_mixer(zx[6:9], zc[6:9], swa_sink)
    c_x = gmlp_mixer(zx[9], zx[10], gmlp_w_s, gmlp_b_s, gmlp_norm_w)
    c_c = gmlp_mixer(zc[9], zc[10], gmlp_w_s, gmlp_b_s, gmlp_norm_w)
    d_x, d_c = mlstm_mixer(zx[11:17], zc[11:17], mlstm_ig_bias, mlstm_fg_bias, mlstm_norm_w)
    mix_x = jnp.concatenate([a_x, b_x, c_x, d_x], axis=-1)
    mix_c = jnp.concatenate([a_c, b_c, c_c, d_c], axis=-1)
    return mix_x, mix_c


def channel_mlp(h, w1, w2):
    return jnp.square(jax.nn.relu(h @ w1)) @ w2


def setup_inputs(seed: int = 0) -> dict:
    key = jax.random.key(seed)
    ks = iter(jax.random.split(key, 32))
    f32 = jnp.float32

    def nrm(shape, s):
        return jax.random.normal(next(ks), shape, f32) * s

    x = nrm((BATCH, SEQ, D_MODEL), 1.0)
    c = nrm((BATCH, D_MODEL), 1.0)
    ctx = nrm((BATCH, CTX_LEN, D_MODEL), 1.0)
    c_ctx = nrm((D_MODEL,), 1.0)
    ada_w = nrm((DEPTH, D_MODEL, N_MOD * D_MODEL), 0.5 * D_MODEL ** -0.5)
    ada_b = nrm((DEPTH, N_MOD * D_MODEL), 0.02)
    norm1_w = 1.0 + nrm((DEPTH, D_MODEL), 0.02)
    norm2_w = 1.0 + nrm((DEPTH, D_MODEL), 0.02)
    w_in = nrm((DEPTH, D_MODEL, D_IN), D_MODEL ** -0.5)
    w_out = nrm((DEPTH, D_MIX, D_MODEL), D_MIX ** -0.5)
    gdn_conv_w = nrm((DEPTH, GDN_CONV, 3 * GROUP_W), GDN_CONV ** -0.5)
    gdn_a_log = jnp.log(jax.random.uniform(next(ks), (DEPTH, N_DIR, GDN_HEADS), f32, 1.0, 16.0))
    dt = jnp.exp(jax.random.uniform(next(ks), (DEPTH, N_DIR, GDN_HEADS), f32,
                                    math.log(1e-3), math.log(1e-1)))
    gdn_dt_bias = dt + jnp.log(-jnp.expm1(-dt))
    gdn_norm_w = 1.0 + nrm((DEPTH, HEAD_DIM), 0.02)
    swa_sink = nrm((DEPTH, SWA_Q_HEADS), 1.0)
    gmlp_w_s = nrm((DEPTH, GMLP_GROUPS, GMLP_CHUNK, GMLP_CHUNK), GMLP_CHUNK ** -0.5)
    gmlp_b_s = 1.0 + nrm((DEPTH, GMLP_GROUPS, GMLP_CHUNK), 0.02)
    gmlp_norm_w = 1.0 + nrm((DEPTH, GROUP_W), 0.02)
    mlstm_ig_bias = nrm((DEPTH, N_DIR, MLSTM_HEADS), 0.1)
    mlstm_fg_bias = 3.0 + 3.0 * jax.random.uniform(next(ks), (DEPTH, N_DIR, MLSTM_HEADS), f32)
    mlstm_norm_w = 1.0 + nrm((DEPTH, GROUP_W), 0.02)
    mlp_w1 = nrm((DEPTH, D_MODEL, D_FF), D_MODEL ** -0.5)
    mlp_w2 = nrm((DEPTH, D_FF, D_MODEL), D_FF ** -0.5)
    final_norm_w = 1.0 + nrm((D_MODEL,), 0.02)
    return {'x': x, 'c': c, 'ctx': ctx, 'c_ctx': c_ctx, 'ada_w': ada_w, 'ada_b': ada_b,
            'norm1_w': norm1_w, 'norm2_w': norm2_w, 'w_in': w_in, 'w_out': w_out,
            'gdn_conv_w': gdn_conv_w, 'gdn_a_log': gdn_a_log, 'gdn_dt_bias': gdn_dt_bias,
            'gdn_norm_w': gdn_norm_w, 'swa_sink': swa_sink, 'gmlp_w_s': gmlp_w_s, 'gmlp_b_s': gmlp_b_s,
            'gmlp_norm_w': gmlp_norm_w, 'mlstm_ig_bias': mlstm_ig_bias, 'mlstm_fg_bias': mlstm_fg_bias,
            'mlstm_norm_w': mlstm_norm_w, 'mlp_w1': mlp_w1, 'mlp_w2': mlp_w2, 'final_norm_w': final_norm_w}


def reference(x, c, ctx, c_ctx, ada_w, ada_b, norm1_w, norm2_w, w_in, w_out, gdn_conv_w, gdn_a_log,
              gdn_dt_bias, gdn_norm_w, swa_sink, gmlp_w_s, gmlp_b_s, gmlp_norm_w, mlstm_ig_bias,
              mlstm_fg_bias, mlstm_norm_w, mlp_w1, mlp_w2, final_norm_w):
    for l in range(DEPTH):
        last = l == DEPTH - 1
        mod_x = jnp.split((jax.nn.silu(c) @ ada_w[l] + ada_b[l])[:, None, :], N_MOD, axis=-1)
        mod_c = jnp.split((jax.nn.silu(c_ctx) @ ada_w[l] + ada_b[l])[None, None, :], N_MOD, axis=-1)
        hx = modulate(rmsnorm(x, norm1_w[l]), mod_x[0], mod_x[1])
        hc = modulate(rmsnorm(ctx, norm1_w[l]), mod_c[0], mod_c[1])
        mix_x, mix_c = token_mixing(hx, hc, w_in[l], gdn_conv_w[l], gdn_a_log[l], gdn_dt_bias[l],
                                    gdn_norm_w[l], swa_sink[l], gmlp_w_s[l], gmlp_b_s[l], gmlp_norm_w[l],
                                    mlstm_ig_bias[l], mlstm_fg_bias[l], mlstm_norm_w[l])
        x = x + mod_x[2] * (mix_x @ w_out[l])
        x = x + mod_x[5] * channel_mlp(modulate(rmsnorm(x, norm2_w[l]), mod_x[3], mod_x[4]),
                                       mlp_w1[l], mlp_w2[l])
        if not last:
            ctx = ctx + mod_c[2] * (mix_c @ w_out[l])
            ctx = ctx + mod_c[5] * channel_mlp(modulate(rmsnorm(ctx, norm2_w[l]), mod_c[3], mod_c[4]),
                                               mlp_w1[l], mlp_w2[l])
    return rmsnorm(x, final_norm_w)
```

```cpp
#include <hip/hip_runtime.h>
#include <cstdio>
#include <cstdint>
#ifndef MK_PER_PHASE
#define MK_PER_PHASE 1
#endif
namespace pg8 {
#define PG8_LAS __attribute__((address_space(3)))
typedef unsigned short bf16_t;
typedef short bf16x8 __attribute__((ext_vector_type(8)));
typedef float f32x4 __attribute__((ext_vector_type(4)));
typedef unsigned u32x4 __attribute__((ext_vector_type(4)));
constexpr int BM = 256, BK = 64, HALF = 128, HTB = HALF * BK * 2  , STAGE_BYTES = 8 * HTB, NXCD = 8, WGM = 8;

__host__ __device__ __forceinline__ int lds_byte(int r, int c) { const int st = (r >> 4) * 2 + (c >> 5), rr = r & 15, cc = c & 31, ob = rr * 64 + cc * 2; return st * 1024 + (ob ^ (((ob >> 9) & 1) << 5)); }
__host__ __device__ __forceinline__ void stage_rc(int b, int& R, int& C) { const int st = b / 1024, sb = b % 1024, swz = sb ^ (((sb >> 9) & 1) << 5); R = (st >> 1) * 16 + swz / 64; C = (st & 1) * 32 + (swz % 64) / 2; }
__host__ __device__ __forceinline__ int perm32(int rho) { const int n = rho >> 4, i = rho & 15; return 8 * (i >> 2) + 4 * n + (i & 3); }

struct Unit { int pm, pn; };
struct Gemm { const bf16_t* A; const bf16_t* Bt; int M, N, K; };

struct StaticOrder {
    int nM, nN, nwg, G, c;
    __host__ __device__ void init(int M, int N, int G_, int c_) { nM = M / BM; nN = N / BM; nwg = nM * nN; G = G_; c = c_; }
    __host__ __device__ bool next(int i, Unit& u) const {
        const long L = (long)i * G + c; if (L >= nwg) return false;
        int wgid = (int)L; { const int q = nwg / NXCD, r = nwg % NXCD, xcd = wgid % NXCD, off = wgid / NXCD; wgid = (xcd < r ? xcd * (q + 1) : r * (q + 1) + (xcd - r) * q) + off; }
        const int nig = WGM * nN, gid = wgid / nig, fm = gid * WGM, gsz = (nM - fm) < WGM ? (nM - fm) : WGM;
        u.pm = fm + ((wgid % nig) % gsz); u.pn = (wgid % nig) / gsz; return true;
    }
    __device__ __forceinline__ void a_ready(const Unit&) const {}
    __device__ __forceinline__ void done(const Unit&) const {}
};

__device__ __forceinline__ unsigned cvt_pk_bf16(float lo, float hi) { unsigned r; asm volatile("v_cvt_pk_bf16_f32 %0, %1, %2" : "=v"(r) : "v"(lo), "v"(hi)); return r; }

template <int ACT  > struct EpiBf16 {
    static constexpr bool PERM = true, AFTER_DRAIN = false;
    bf16_t* O; int ldc;
    __device__ __forceinline__ void operator()(const f32x4 (&acc)[2][2][4][2], const Unit& u, int wr, int wc, int fr, int fq) const {
        const int row0 = u.pm * BM + wr * 64 + fr; const int col0 = u.pn * BM + wc * 32 + 8 * fq;
#pragma unroll
        for (int ai = 0; ai < 2; ++ai)
#pragma unroll
            for (int m = 0; m < 4; ++m) { bf16_t* rowp = O + (size_t)(row0 + ai * HALF + m * 16) * ldc + col0;
#pragma unroll
                for (int bj = 0; bj < 2; ++bj) { f32x4 v0 = acc[ai][bj][m][0], v1 = acc[ai][bj][m][1];
                    if (ACT == 1) {
#pragma unroll
                        for (int e = 0; e < 4; ++e) { float a = fmaxf(v0[e], 0.f), b = fmaxf(v1[e], 0.f); v0[e] = a * a; v1[e] = b * b; } }
                    u32x4 w; w.x = cvt_pk_bf16(v0[0], v0[1]); w.y = cvt_pk_bf16(v0[2], v0[3]); w.z = cvt_pk_bf16(v1[0], v1[1]); w.w = cvt_pk_bf16(v1[2], v1[3]);
                    *(u32x4*)(rowp + bj * HALF) = w; } }
    }
};

struct EpiResid {
    static constexpr bool PERM = false, AFTER_DRAIN = false;
    float* xlat; float* xctx; const float* gmod;
    __device__ __forceinline__ void operator()(const f32x4 (&acc)[2][2][4][2], const Unit& u, int wr, int wc, int fr, int fq) const {
        const int bm = u.pm < 64 ? (u.pm >> 3) : 8;
        float* base = u.pm < 64 ? xlat + (size_t)u.pm * BM * 1024 : xctx + (size_t)(u.pm - 64) * BM * 1024;
        const float* g = gmod + bm * 6144;
        const int col0 = u.pn * BM + wc * 32 + 4 * fq;
        f32x4 gv[2][2];
#pragma unroll
        for (int bj = 0; bj < 2; ++bj)
#pragma unroll
            for (int n = 0; n < 2; ++n) gv[bj][n] = *(const f32x4*)(g + col0 + bj * HALF + n * 16);
#pragma unroll
        for (int ai = 0; ai < 2; ++ai)
#pragma unroll
            for (int m = 0; m < 4; ++m) { float* rowp = base + (size_t)(ai * HALF + wr * 64 + m * 16 + fr) * 1024 + col0;
#pragma unroll
                for (int bj = 0; bj < 2; ++bj)
#pragma unroll
                    for (int n = 0; n < 2; ++n) { f32x4* p = (f32x4*)(rowp + bj * HALF + n * 16); const f32x4 o = *p + gv[bj][n] * acc[ai][bj][m][n]; *p = o; }
                asm volatile("" ::: "memory"); }
    }
};

template <class Epi, class Sched, bool ALIGN_EPI = false, bool SP2 = false>
__device__ __forceinline__ void gemm_phase(PG8_LAS unsigned char* lds, const Gemm g, const Sched& S, const Epi& E, int tid_in) {
    int tid_o = tid_in; asm volatile("" : "+v"(tid_o)); const int tid = tid_o, wid = __builtin_amdgcn_readfirstlane(tid >> 6), lane = tid & 63, wr = wid >> 2, wc = wid & 3, fr = lane & 15, fq = lane >> 4;
    const int K = g.K, nt = K / BK;
    unsigned voffA[2], voffB[2];
#pragma unroll
    for (int i = 0; i < 2; ++i) { int R, C; stage_rc(tid * 16 + i * 8192, R, C); const int Rb = Epi::PERM ? ((R & ~31) + perm32(R & 31)) : R;
        voffA[i] = (unsigned)(R * K + C) * 2u; voffB[i] = (unsigned)(Rb * K + C) * 2u; }
    const size_t kstep = (size_t)(BK * 2);
    const size_t hstep = (size_t)HALF * K * 2;
    const size_t tstep = 2 * hstep;
    const unsigned ldsw = (unsigned)wid * 1024u;
    const int aoff = lds_byte(wr * 64 + fr, fq * 8), boff = lds_byte(wc * 32 + fr, fq * 8);
#define PG8_SA(b, h) (((b) * 2 + (h)) * HTB)
#define PG8_SB(b, h) ((4 + (b) * 2 + (h)) * HTB)
#define PG8_STAGE(bufoff, gbase, voff) do { _Pragma("unroll") for (int _i = 0; _i < 2; ++_i) \
        __builtin_amdgcn_global_load_lds((const unsigned*)((const char*)(gbase) + (voff)[_i]), (PG8_LAS unsigned*)(lds + (bufoff) + ldsw + _i * 8192), 16, 0, 0); } while (0)
#define PG8_LDA(dst, b, h) do { _Pragma("unroll") for (int m = 0; m < 4; ++m) _Pragma("unroll") for (int k = 0; k < 2; ++k) dst[m][k] = *(const PG8_LAS bf16x8*)(lds + PG8_SA(b, h) + aoff + m * 2048 + k * 1024); } while (0)
#define PG8_LDB(dst, b, h) do { _Pragma("unroll") for (int n = 0; n < 2; ++n) _Pragma("unroll") for (int k = 0; k < 2; ++k) dst[n][k] = *(const PG8_LAS bf16x8*)(lds + PG8_SB(b, h) + boff + n * 2048 + k * 1024); } while (0)
#define PG8_MMA(ai, bj, At, Bt) do { __builtin_amdgcn_s_setprio(1); _Pragma("unroll") for (int m = 0; m < 4; ++m) _Pragma("unroll") for (int n = 0; n < 2; ++n) _Pragma("unroll") for (int k = 0; k < 2; ++k) \
        acc[ai][bj][m][n] = __builtin_amdgcn_mfma_f32_16x16x32_bf16(Bt[n][k], At[m][k], acc[ai][bj][m][n], 0, 0, 0); __builtin_amdgcn_s_setprio(0); } while (0)
#define PG8_WAIT_V(n) asm volatile("s_waitcnt vmcnt(" #n ")" ::: "memory")
#define PG8_WAIT_L(n) asm volatile("s_waitcnt lgkmcnt(" #n ")" ::: "memory")
#define PG8_BAR __builtin_amdgcn_s_barrier()
#define PG8_SCHED __builtin_amdgcn_sched_barrier(0)
    Unit cur, nxt; int ui = 0;
    if (!S.next(0, cur)) return;
    f32x4 acc[2][2][4][2];
#pragma unroll
    for (int a = 0; a < 2; ++a)
#pragma unroll
        for (int b = 0; b < 2; ++b)
#pragma unroll
            for (int m = 0; m < 4; ++m)
#pragma unroll
                for (int n = 0; n < 2; ++n) acc[a][b][m][n] = (f32x4){0.f, 0.f, 0.f, 0.f};
    bf16x8 At[4][2], B0[2][2], B1[2][2];
    const char* cA = (const char*)g.A + (size_t)cur.pm * tstep; const char* cB = (const char*)g.Bt + (size_t)cur.pn * tstep;
    S.a_ready(cur);
    if constexpr (SP2) {
        PG8_STAGE(PG8_SB(0, 0), cB, voffB); PG8_STAGE(PG8_SB(0, 1), cB + hstep, voffB); PG8_STAGE(PG8_SA(0, 0), cA, voffA); PG8_STAGE(PG8_SA(0, 1), cA + hstep, voffA);
        if (wr == 1) PG8_BAR;
        PG8_WAIT_V(2); PG8_BAR;
        PG8_STAGE(PG8_SB(1, 0), cB + kstep, voffB); PG8_STAGE(PG8_SA(1, 0), cA + kstep, voffA); PG8_STAGE(PG8_SB(1, 1), cB + hstep + kstep, voffB);
        PG8_WAIT_V(6); PG8_BAR;
    } else {
        PG8_STAGE(PG8_SB(0, 0), cB, voffB); PG8_STAGE(PG8_SA(0, 0), cA, voffA); PG8_STAGE(PG8_SB(0, 1), cB + hstep, voffB); PG8_STAGE(PG8_SA(0, 1), cA + hstep, voffA);
        if (wr == 1) PG8_BAR;
        PG8_WAIT_V(4); PG8_BAR;
        PG8_STAGE(PG8_SB(1, 0), cB + kstep, voffB); PG8_STAGE(PG8_SA(1, 0), cA + kstep, voffA); PG8_STAGE(PG8_SB(1, 1), cB + hstep + kstep, voffB);
        PG8_WAIT_V(6); PG8_BAR;
    }
    for (;;) {
        const bool has_next = S.next(ui + 1, nxt);
        const char* nA = has_next ? (const char*)g.A + (size_t)nxt.pm * tstep : cA; const char* nB = has_next ? (const char*)g.Bt + (size_t)nxt.pn * tstep : cB;
        for (int t = 0; t < nt; t += 2) {
            const bool last = (t == nt - 2);
            const char* a1 = cA + (size_t)(t + 1) * kstep;
            const char* a2 = last ? nA : cA + (size_t)(t + 2) * kstep; const char* b2 = last ? nB : cB + (size_t)(t + 2) * kstep;
            const char* a3 = a2 + kstep; const char* b3 = b2 + kstep;
            if (last && has_next) S.a_ready(nxt);
            if constexpr (SP2) {
            PG8_LDB(B0, 0, 0); PG8_LDB(B1, 0, 1); PG8_SCHED; PG8_LDA(At, 0, 0); PG8_STAGE(PG8_SA(1, 1), a1 + hstep, voffA);
            PG8_WAIT_V(8); PG8_WAIT_L(0); PG8_BAR; PG8_MMA(0, 0, At, B0); PG8_MMA(0, 1, At, B1); PG8_BAR; PG8_SCHED;
            PG8_LDA(At, 0, 1); PG8_STAGE(PG8_SB(0, 0), b2, voffB); PG8_STAGE(PG8_SB(0, 1), b2 + hstep, voffB); PG8_STAGE(PG8_SA(0, 0), a2, voffA);
            PG8_WAIT_V(8); PG8_WAIT_L(0); PG8_BAR; PG8_MMA(1, 0, At, B0); PG8_MMA(1, 1, At, B1); PG8_BAR; PG8_SCHED;
            PG8_LDB(B0, 1, 0); PG8_LDB(B1, 1, 1); PG8_SCHED; PG8_LDA(At, 1, 0); PG8_STAGE(PG8_SA(0, 1), a2 + hstep, voffA);
            PG8_WAIT_V(8); PG8_WAIT_L(0); PG8_BAR; PG8_MMA(0, 0, At, B0); PG8_MMA(0, 1, At, B1); PG8_BAR; PG8_SCHED;
            PG8_LDA(At, 1, 1); PG8_STAGE(PG8_SB(1, 0), b3, voffB); PG8_STAGE(PG8_SB(1, 1), b3 + hstep, voffB); PG8_STAGE(PG8_SA(1, 0), a3, voffA);
            PG8_WAIT_V(8); PG8_WAIT_L(0); PG8_BAR; PG8_MMA(1, 0, At, B0); PG8_MMA(1, 1, At, B1); PG8_BAR; PG8_SCHED;
            } else {
            PG8_LDB(B0, 0, 0); PG8_SCHED; PG8_LDA(At, 0, 0); PG8_STAGE(PG8_SA(1, 1), a1 + hstep, voffA);
            PG8_WAIT_L(8); PG8_BAR; PG8_WAIT_L(0); PG8_MMA(0, 0, At, B0); PG8_BAR; PG8_SCHED;
            PG8_LDB(B1, 0, 1); PG8_STAGE(PG8_SB(0, 0), b2, voffB);
            PG8_BAR; PG8_WAIT_L(0); PG8_MMA(0, 1, At, B1); PG8_BAR;
            PG8_LDA(At, 0, 1); PG8_STAGE(PG8_SA(0, 0), a2, voffA);
            PG8_BAR; PG8_WAIT_L(0); PG8_MMA(1, 0, At, B0); PG8_BAR; PG8_SCHED;
            PG8_STAGE(PG8_SB(0, 1), b2 + hstep, voffB);
            PG8_WAIT_V(6); PG8_BAR; PG8_MMA(1, 1, At, B1); PG8_BAR;
            PG8_LDB(B0, 1, 0); PG8_SCHED; PG8_LDA(At, 1, 0); PG8_STAGE(PG8_SA(0, 1), a2 + hstep, voffA);
            PG8_WAIT_L(8); PG8_BAR; PG8_WAIT_L(0); PG8_MMA(0, 0, At, B0); PG8_BAR; PG8_SCHED;
            PG8_LDB(B1, 1, 1); PG8_STAGE(PG8_SB(1, 0), b3, voffB);
            PG8_BAR; PG8_WAIT_L(0); PG8_MMA(0, 1, At, B1); PG8_BAR;
            PG8_LDA(At, 1, 1); PG8_STAGE(PG8_SA(1, 0), a3, voffA);
            PG8_BAR; PG8_WAIT_L(0); PG8_MMA(1, 0, At, B0); PG8_BAR; PG8_SCHED;
            PG8_STAGE(PG8_SB(1, 1), b3 + hstep, voffB);
            PG8_WAIT_V(6); PG8_BAR; PG8_MMA(1, 1, At, B1); PG8_BAR;
            }
        }
        if constexpr (ALIGN_EPI) { if (wr == 0) PG8_BAR; }
        if constexpr (!Epi::AFTER_DRAIN) { E(acc, cur, wr, wc, fr, fq); S.done(cur); }
        if (!has_next) break;
#pragma unroll
        for (int a = 0; a < 2; ++a)
#pragma unroll
            for (int b = 0; b < 2; ++b)
#pragma unroll
                for (int m = 0; m < 4; ++m)
#pragma unroll
                    for (int n = 0; n < 2; ++n) acc[a][b][m][n] = (f32x4){0.f, 0.f, 0.f, 0.f};
        cur = nxt; cA = nA; cB = nB; ++ui;
        if constexpr (ALIGN_EPI) { if (wr == 1) PG8_BAR; }
    }
    PG8_WAIT_V(0);
    if constexpr (!ALIGN_EPI) { if (wr == 0) PG8_BAR; }
    PG8_BAR;
    if constexpr (Epi::AFTER_DRAIN) { E.fused(acc, cur, wr, wc, fr, fq, lds, wid, lane); S.done(cur); }
#undef PG8_SA
#undef PG8_SB
#undef PG8_STAGE
#undef PG8_LDA
#undef PG8_LDB
#undef PG8_MMA
#undef PG8_WAIT_V
#undef PG8_WAIT_L
#undef PG8_BAR
#undef PG8_SCHED
}
}
constexpr int NWAVES = 8;
constexpr int NB = 8, SEQ = 2048, CTXL = 256, D = 1024, DEPTH = 4, FF = 4096;
constexpr int MLAT = NB * SEQ, MCTX = NB * CTXL, MALL = MLAT + MCTX;
constexpr int ZW = 3328;
constexpr int ZC_GQ = 0, ZC_GK = 256, ZC_GV = 512, ZC_GZ = 768, ZC_SQ = 1024, ZC_SK = 1280, ZC_SV = 1408, ZC_MU = 1536, ZC_MV = 1792,
              ZC_LQ = 2048, ZC_LK = 2304, ZC_LV = 2560, ZC_LO = 2816, ZC_GA = 3072, ZC_GB = 3080, ZC_LI = 3088, ZC_LF = 3096;
constexpr float EPS = 1e-6f;
constexpr size_t MiB = 1u << 20;
constexpr size_t WS_CTL = 0, CTL_ZERO_BYTES = 65536;
constexpr size_t WS_MOD = 1 * MiB;
constexpr size_t WS_WIN = 2 * MiB, WS_WOUT = 9 * MiB, WS_W1 = 11 * MiB, WS_W2 = 19 * MiB, WS_WSP = 27 * MiB;
constexpr size_t WS_CHS = 27 * MiB + 512 * 1024;
constexpr size_t WS_GLG = 27 * MiB + 768 * 1024;
constexpr size_t WS_XC = 29 * MiB;
constexpr size_t WS_H = 37 * MiB;
constexpr size_t WS_MIX = 73 * MiB;
constexpr size_t WS_Z = 109 * MiB;
constexpr size_t WS_PG = 226 * MiB;
constexpr size_t WS_PM = 298 * MiB;
constexpr size_t WS_HID = 109 * MiB;
constexpr size_t WS_END = 343 * MiB;
constexpr int CW_BAR = 1024;
constexpr int LDS_BYTES = 147456;
constexpr int MISC_OFF = 131072 + 8192;

#define LAS __attribute__((address_space(3)))
typedef unsigned short bf16_t;
typedef unsigned v4u __attribute__((ext_vector_type(4)));
typedef unsigned v2u __attribute__((ext_vector_type(2)));
typedef float f32x4 __attribute__((ext_vector_type(4)));
typedef short bf16x8 __attribute__((ext_vector_type(8)));
#define LDS_WAIT() asm volatile("s_waitcnt lgkmcnt(0)" ::: "memory")
#define VM_WAIT() asm volatile("s_waitcnt vmcnt(0)" ::: "memory")
__device__ __forceinline__ unsigned f2bf(float f) { unsigned u = __builtin_bit_cast(unsigned, f); return (u + 0x7fffu + ((u >> 16) & 1u)) >> 16; }
__device__ __forceinline__ unsigned pk2(float lo, float hi) { return f2bf(lo) | (f2bf(hi) << 16); }
__device__ __forceinline__ float bf2f(unsigned v) { return __builtin_bit_cast(float, v << 16); }
__device__ __forceinline__ float bflo(unsigned w) { return __builtin_bit_cast(float, w << 16); }
__device__ __forceinline__ float bfhi(unsigned w) { return __builtin_bit_cast(float, w & 0xffff0000u); }
__device__ __forceinline__ float wave_sum(float v) {
#pragma unroll
    for (int o = 1; o < 64; o <<= 1) v += __shfl_xor(v, o);
    return v;
}
__device__ __forceinline__ float sigmoidf_(float x) { return 1.f / (1.f + __expf(-x)); }
__device__ __forceinline__ float siluf_(float x) { return x / (1.f + __expf(-x)); }
__device__ __forceinline__ float softplusf_(float x) { return x > 20.f ? x : log1pf(expf(x)); }
__device__ __forceinline__ float logsigf_(float x) { return x >= 0.f ? -log1pf(expf(-x)) : x - log1pf(expf(x)); }
__device__ __forceinline__ float geluf_(float x) { const float u = 0.7978845608028654f * (x + 0.044715f * x * x * x); return 0.5f * x * (1.f + tanhf(u)); }
template <int KS> __device__ __forceinline__ f32x4 mma_ll(const LAS bf16_t* A, int lda, const LAS bf16_t* Bt, int ldb, f32x4 acc, int lane) {
    const LAS bf16_t* ap = A + (lane & 15) * lda + 8 * (lane >> 4);
    const LAS bf16_t* bp = Bt + (lane & 15) * ldb + 8 * (lane >> 4);
#pragma unroll
    for (int ks = 0; ks < KS; ++ks) {
        const bf16x8 a = *(const LAS bf16x8*)(ap + 32 * ks); const bf16x8 b = *(const LAS bf16x8*)(bp + 32 * ks);
        acc = __builtin_amdgcn_mfma_f32_16x16x32_bf16(a, b, acc, 0, 0, 0);
    }
    return acc;
}
__device__ __forceinline__ v2u pack4(const f32x4 v) { v2u r; r.x = pk2(v[0], v[1]); r.y = pk2(v[2], v[3]); return r; }
__device__ __forceinline__ f32x4 unpack4(const v2u w) { f32x4 r; r[0] = bflo(w.x); r[1] = bfhi(w.x); r[2] = bflo(w.y); r[3] = bfhi(w.y); return r; }
__device__ __forceinline__ int chunk_row0(int b, int cidx) { return cidx < 4 ? MLAT + b * CTXL + cidx * 64 : b * SEQ + (cidx - 4) * 64; }

#define XB_TMO      128
#define XB_XCNT(j)  (256  + 64 * (j))
#define XB_XSUB(j)  (1280 + 64 * (j))
#define XB_XGEN(j)  (2304 + 64 * (j))
#define XB_TOP      3328
#define XB_TOPGEN   3392
#define XCD_BAR_WORDS 3456
#define XB_SPIN_CAP (1u << 18)

__device__ __forceinline__ unsigned xb_ld(unsigned* p)              { return __hip_atomic_load(p, __ATOMIC_RELAXED, __HIP_MEMORY_SCOPE_AGENT); }
__device__ __forceinline__ unsigned xb_add(unsigned* p, unsigned v) { return __hip_atomic_fetch_add(p, v, __ATOMIC_RELAXED, __HIP_MEMORY_SCOPE_AGENT); }
__device__ __forceinline__ unsigned xb_xcc_id() { return (unsigned)__builtin_amdgcn_s_getreg((3 << 11) | 20) & 0xFu; }
#define XB_SPIN(cond, bar) do { unsigned _sp = 0; while (cond) { __builtin_amdgcn_s_sleep(1); \
    if ((++_sp & 255u) == 0u) { if (xb_ld(&(bar)[XB_TMO])) break; if (_sp > XB_SPIN_CAP) { atomicAdd(&(bar)[XB_TMO], 1u); break; } } } } while (0)

struct XcdBarrier {
    unsigned* bar; unsigned x;
    volatile LAS unsigned* st;
};

__device__ __forceinline__ XcdBarrier xcd_barrier_post(unsigned* bar, volatile LAS unsigned* st, int tid) {
    XcdBarrier b; b.bar = bar; b.x = xb_xcc_id(); b.st = st;
    if (tid == 0) (void)xb_add(&bar[XB_XCNT(b.x)], 1u);
    return b;
}
__device__ __forceinline__ void xcd_barrier_complete(unsigned* bar, unsigned x, unsigned& nloc, unsigned& nx) {
    const unsigned G = gridDim.x * gridDim.y * gridDim.z;
    unsigned sum, cnt, mine, sp = 0u;
    for (;;) {
        sum = 0u; cnt = 0u; mine = 0u;
#pragma unroll
        for (unsigned j = 0; j < 16; ++j) { const unsigned c = xb_ld(&bar[XB_XCNT(j)]); sum += c; cnt += (c > 0u) ? 1u : 0u; mine = (j == x) ? c : mine; }
        if (sum == G) break;
        __builtin_amdgcn_s_sleep(1);
        if ((++sp & 255u) == 0u) { if (xb_ld(&bar[XB_TMO])) break; if (sp > XB_SPIN_CAP) { atomicAdd(&bar[XB_TMO], 1u); break; } }
    }
    nloc = mine > 0u ? mine : 1u; nx = cnt > 0u ? cnt : 1u;
}

__device__ __forceinline__ void xcd_barrier(const XcdBarrier& b, int tid) {
    asm volatile("s_waitcnt vmcnt(0)" ::: "memory");
    __syncthreads();
    if (tid == 0) {
        unsigned* bar = b.bar;
        __builtin_amdgcn_s_waitcnt(0);
        unsigned nloc = b.st[0], nx = b.st[1];
        if (nloc == 0u) { xcd_barrier_complete(bar, b.x, nloc, nx); b.st[0] = nloc; b.st[1] = nx; }
        const unsigned old = xb_add(&bar[XB_XSUB(b.x)], 1u);
        const unsigned gen = old / nloc;
        if (old + 1u == (gen + 1u) * nloc) {
            __builtin_amdgcn_fence(__ATOMIC_RELEASE, "agent");
            asm volatile("s_waitcnt vmcnt(0)" ::: "memory");
            const unsigned og = xb_add(&bar[XB_TOP], 1u);
            const unsigned tg = og / nx;
            if (og + 1u == (tg + 1u) * nx) xb_add(&bar[XB_TOPGEN], 1u);
            else XB_SPIN(xb_ld(&bar[XB_TOPGEN]) == tg, bar);
            __builtin_amdgcn_fence(__ATOMIC_ACQUIRE, "agent");
            xb_add(&bar[XB_XGEN(b.x)], 1u);
            asm volatile("s_waitcnt vmcnt(0)" ::: "memory");
        } else {
            XB_SPIN(xb_ld(&bar[XB_XGEN(b.x)]) == gen, bar);
            __builtin_amdgcn_fence(__ATOMIC_ACQUIRE, "agent");
            asm volatile("s_waitcnt vmcnt(0)" ::: "memory");
        }
    }
    __syncthreads();
}

struct Frame {
    LAS unsigned char* lds;
    int wave, G, gw, NGW;
    const float *x, *c, *ctx, *cctx, *ada_w, *ada_b, *norm1_w, *norm2_w, *w_in, *w_out, *conv_w, *a_log, *dt_bias, *gdn_norm_w, *sink, *w_s, *b_s,
                *gmlp_norm_w, *ig_bias, *fg_bias, *mlstm_norm_w, *w1, *w2, *final_w;
    float* out; unsigned char* ws;
    float *MOD, *XC, *CHS, *GLG, *GLM, *WI, *PEND;
    bf16_t *WIN, *WOUT, *W1, *W2, *WSP, *H, *MIX, *Z, *PG, *PM, *HID;
};

__device__ __forceinline__ int fresh_lane() { int t; asm volatile("v_mbcnt_lo_u32_b32 %0, -1, 0\n\tv_mbcnt_hi_u32_b32 %0, -1, %0" : "=v"(t)); return t; }
__device__ __forceinline__ void phase_mod(const Frame& F) {
    LAS float* sact = (LAS float*)F.lds;
    const int lane0 = fresh_lane(), tid0 = F.wave * 64 + lane0;
    for (int i = tid0; i < 9 * 1024; i += NWAVES * 64) { const float v = i < 8192 ? F.c[i] : F.cctx[i - 8192]; sact[i] = v / (1.f + expf(-v)); }
    __syncthreads();
    for (int task = F.gw; task < DEPTH * 384; task += F.NGW) {
        const int lane = fresh_lane();
        const int l = task / 384, cg = task % 384, col = cg * 16 + (lane & 15), kq = lane >> 4;
        const float* w = F.ada_w + (size_t)l * 1024 * 6144 + col;
        float acc[9];
#pragma unroll
        for (int b = 0; b < 9; ++b) acc[b] = 0.f;
#pragma unroll 4
        for (int k = kq; k < 1024; k += 4) { const float wv = w[(size_t)k * 6144];
#pragma unroll
            for (int b = 0; b < 9; ++b) acc[b] += sact[b * 1024 + k] * wv; }
#pragma unroll
        for (int b = 0; b < 9; ++b) { acc[b] += __shfl_xor(acc[b], 16); acc[b] += __shfl_xor(acc[b], 32); }
        if (kq == 0) { const float bias = F.ada_b[l * 6144 + col];
#pragma unroll
            for (int b = 0; b < 9; ++b) F.MOD[(l * 9 + b) * 6144 + col] = acc[b] + bias; }
    }
    __syncthreads();
}

__device__ __forceinline__ void transpose_item(const float* W, int K, int N, int Ndst, bf16_t* WT, LAS float* scr, int item, int lane, bool remap) {
    const int nblk = Ndst / 32, kb = item / nblk, nb = item % nblk, k0 = 64 * kb, n0 = 32 * nb;
    const int n = n0 + (lane & 31);
    const int src = remap ? (n < 1024 ? n : n < 3072 ? n + 16 : n < 3088 ? n - 2048 : n < 3104 ? n : -1) : n;
#pragma unroll 8
    for (int i = 0; i < 32; ++i) { const int kk = 2 * i + (lane >> 5); scr[kk * 33 + (lane & 31)] = src >= 0 ? W[(size_t)(k0 + kk) * N + src] : 0.f; }
    LDS_WAIT(); asm volatile("" ::: "memory");
    const int c = lane & 7;
#pragma unroll
    for (int j = 0; j < 4; ++j) { const int nn = (lane >> 3) + 8 * j; const LAS float* s = scr + (8 * c) * 33 + nn;
        v4u o; o.x = pk2(s[0 * 33], s[1 * 33]); o.y = pk2(s[2 * 33], s[3 * 33]); o.z = pk2(s[4 * 33], s[5 * 33]); o.w = pk2(s[6 * 33], s[7 * 33]);
        *(v4u*)(WT + (size_t)(n0 + nn) * K + k0 + 8 * c) = o; }
    LDS_WAIT(); asm volatile("" ::: "memory");
}
__device__ __forceinline__ void convert_weights(const Frame& F, int l) {
    LAS float* scr = (LAS float*)(F.lds + F.wave * 16384);
    constexpr int I_IN = 16 * (ZW / 32), I_OUT = 16 * 32, I_1 = 16 * 128, I_2 = 64 * 32, I_S = 128;
    for (int it = F.gw; it < I_IN + I_OUT + I_1 + I_2 + I_S; it += F.NGW) {
        int r = it; const int lane = fresh_lane();
        if (r < I_IN) { transpose_item(F.w_in + (size_t)l * 1024 * 3104, 1024, 3104, ZW, F.WIN, scr, r, lane, true); continue; } r -= I_IN;
        if (r < I_OUT) { transpose_item(F.w_out + (size_t)l * 1024 * 1024, 1024, 1024, 1024, F.WOUT, scr, r, lane, false); continue; } r -= I_OUT;
        if (r < I_1) { transpose_item(F.w1 + (size_t)l * 1024 * 4096, 1024, 4096, 4096, F.W1, scr, r, lane, false); continue; } r -= I_1;
        if (r < I_2) { transpose_item(F.w2 + (size_t)l * 4096 * 1024, 4096, 1024, 1024, F.W2, scr, r, lane, false); continue; } r -= I_2;
        { const float* s = F.w_s + (size_t)l * 65536 + r * 512 + lane * 8; const f32x4 a = *(const f32x4*)s, b = *(const f32x4*)(s + 4);
          v4u o; o.x = pk2(a[0], a[1]); o.y = pk2(a[2], a[3]); o.z = pk2(b[0], b[1]); o.w = pk2(b[2], b[3]); *(v4u*)(F.WSP + r * 512 + lane * 8) = o; }
    }
}

__device__ __forceinline__ void phase_norm(const Frame& F, int l, int which, int nrows) {
    const float* nwp = (which == 0 ? F.norm1_w : F.norm2_w) + l * 1024;
    const bool init = (which == 0 && l == 0);
    for (int m = F.gw; m < nrows; m += F.NGW) {
        const int lane = fresh_lane();
        const bool lat = m < MLAT; const int bm = lat ? (m >> 11) : 8;
        float* xrow = lat ? F.out + (size_t)m * 1024 : F.XC + (size_t)(m - MLAT) * 1024;
        const float* src = init ? (lat ? F.x + (size_t)m * 1024 : F.ctx + (size_t)(m - MLAT) * 1024) : xrow;
        const float* mod = F.MOD + (l * 9 + bm) * 6144 + (which == 0 ? 0 : 3 * 1024);
        f32x4 v[4]; float s = 0.f;
#pragma unroll
        for (int j = 0; j < 4; ++j) { v[j] = *(const f32x4*)(src + 256 * j + 4 * lane); s += (v[j][0] * v[j][0] + v[j][1] * v[j][1]) + (v[j][2] * v[j][2] + v[j][3] * v[j][3]); }
        const float rstd = 1.0f / sqrtf(wave_sum(s) * (1.f / 1024.f) + EPS);
#pragma unroll
        for (int j = 0; j < 4; ++j) {
            const int col = 256 * j + 4 * lane;
            if (init) *(f32x4*)(xrow + col) = v[j];
            const f32x4 nw = *(const f32x4*)(nwp + col), sh = *(const f32x4*)(mod + col), sc = *(const f32x4*)(mod + 1024 + col);
            const f32x4 hh = (v[j] * rstd * nw) * (sc + 1.0f) + sh;
            *(v2u*)(F.H + (size_t)m * 1024 + col) = pack4(hh);
        }
    }
}
__device__ __forceinline__ void phase_final(const Frame& F, bool poison) {
    for (int m = F.gw; m < MLAT; m += F.NGW) {
        const int lane = fresh_lane();
        float* xrow = F.out + (size_t)m * 1024;
        f32x4 v[4]; float s = 0.f;
#pragma unroll
        for (int j = 0; j < 4; ++j) { v[j] = *(const f32x4*)(xrow + 256 * j + 4 * lane); s += (v[j][0] * v[j][0] + v[j][1] * v[j][1]) + (v[j][2] * v[j][2] + v[j][3] * v[j][3]); }
        float rstd = 1.0f / sqrtf(wave_sum(s) * (1.f / 1024.f) + EPS);
        if (poison) rstd = __builtin_nanf("");
#pragma unroll
        for (int j = 0; j < 4; ++j) { const int col = 256 * j + 4 * lane; const f32x4 nw = *(const f32x4*)(F.final_w + col); *(f32x4*)(xrow + col) = v[j] * rstd * nw; }
    }
}

__device__ __forceinline__ void ew_unit(const Frame& F, int l, int rg) {
    const int r0 = rg * 16;
    const int t_o = F.wave * 64 + fresh_lane();
    const int tid = t_o, lane_ = t_o & 63, wave_ = __builtin_amdgcn_readfirstlane(t_o >> 6);
#pragma unroll 1
    for (int j = 0; j < 6; ++j) {
        const int idx = tid + 512 * j, rr = idx / 192, pr = idx % 192, hd = pr >> 5, f = pr & 31, row = r0 + rr;
        const int col = (hd < 4 ? ZC_SQ + hd * 64 : ZC_SK + (hd - 4) * 64) + f;
        bf16_t* p = F.Z + (size_t)row * ZW + col;
        if (row < MLAT) {
            const int t = row & (SEQ - 1); const float pos = (float)(f < 16 ? (t >> 6) : (t & 63));
            const float inv = powf(10000.0f, -(float)(f & 15) * (1.0f / 16.0f));
            const float ang = pos * inv; const float cs = cosf(ang), sn = sinf(ang);
            const float t1 = bf2f(p[0]), t2 = bf2f(p[32]); const float sc = hd < 4 ? 0.125f : 1.0f;
            p[0] = (bf16_t)f2bf((t1 * cs - t2 * sn) * sc); p[32] = (bf16_t)f2bf((t1 * sn + t2 * cs) * sc);
        } else if (hd < 4) {
            p[0] = (bf16_t)f2bf(bf2f(p[0]) * 0.125f); p[32] = (bf16_t)f2bf(bf2f(p[32]) * 0.125f);
        }
    }
#pragma unroll 1
    for (int j = 0; j < 2; ++j) {
        const int row = r0 + 2 * wave_ + j;
        bf16_t* pu = F.Z + (size_t)row * ZW + ZC_MU + 4 * lane_; bf16_t* pv = F.Z + (size_t)row * ZW + ZC_MV + 4 * lane_;
        f32x4 u = unpack4(*(const v2u*)pu), v = unpack4(*(const v2u*)pv); float ss = 0.f;
#pragma unroll
        for (int e = 0; e < 4; ++e) { u[e] = geluf_(u[e]); v[e] = geluf_(v[e]); ss += v[e] * v[e]; }
        const float rs = 1.0f / sqrtf(wave_sum(ss) * (1.f / 256.f) + EPS);
        const f32x4 nw = *(const f32x4*)(F.gmlp_norm_w + l * 256 + 4 * lane_);
        *(v2u*)pu = pack4(u); *(v2u*)pv = pack4(v * rs * nw);
    }
    if ((rg & 3) == 0 && tid < 8) {
        const int d = tid >> 2, h = tid & 3;
        int b, cidx; if (r0 < MLAT) { b = r0 >> 11; cidx = 4 + ((r0 & (SEQ - 1)) >> 6); } else { const int j = r0 - MLAT; b = j >> 8; cidx = (j & 255) >> 6; }
        const float ib = F.ig_bias[l * 8 + d * 4 + h], fb = F.fg_bias[l * 8 + d * 4 + h];
        float bsum = 0.f, mx = -1e30f;
        for (int i = 0; i < 64; ++i) {
            const int p = d ? 63 - i : i; const bf16_t* zr = F.Z + (size_t)(r0 + p) * ZW;
            const float ig = bf2f(zr[ZC_LI + d * 4 + h]) + ib; const float lf = logsigf_(bf2f(zr[ZC_LF + d * 4 + h]) + fb);
            bsum += lf; mx = fmaxf(mx, ig - bsum);
        }
        float* o = F.CHS + ((((b * 4 + h) * 2 + d) * 36) + cidx) * 2; o[0] = bsum; o[1] = bsum + mx;
    }
}

__device__ __forceinline__ void gdn_prep_unit(const Frame& F, int l, int u) {
    const int b = u / 144, h = (u / 36) & 3, cidx = u % 36;
    const int row0 = chunk_row0(b, cidx);
    const int seg_lo = cidx < 4 ? MLAT + b * CTXL : b * SEQ, seg_hi = seg_lo + (cidx < 4 ? CTXL : SEQ);
    const int t_o = F.wave * 64 + fresh_lane();
    const int t = t_o, lane = t & 63, w = __builtin_amdgcn_readfirstlane(t >> 6), lr = lane & 15, lq = lane >> 4;
    LAS unsigned char* L = F.lds;
    LAS bf16_t* Qs = (LAS bf16_t*)(L + 0); LAS bf16_t* Ks = (LAS bf16_t*)(L + 9216); LAS bf16_t* Kt = (LAS bf16_t*)(L + 18432); LAS bf16_t* Vt = (LAS bf16_t*)(L + 27648);
    LAS float* gS = (LAS float*)(L + 36864); LAS float* bS = gS + 128; LAS float* gcS = gS + 256; LAS float* totS = gS + 384;
    LAS float* As = (LAS float*)(L + 38912);
    LAS float* CV = (LAS float*)(L + 38912);
    LAS bf16_t* UT = (LAS bf16_t*)(L + 38912); LAS bf16_t* UTd = UT + 4608; LAS bf16_t* WT = UT + 9216; LAS bf16_t* WTd = UT + 13824;
    LAS bf16_t* Tb = (LAS bf16_t*)(L + 75776);
    LAS bf16_t* At = (LAS bf16_t*)(L + 112640);
    if (t < 384) {
        const int pair = t % 96, rg = t / 96, c0 = 2 * pair, part = c0 >> 6, d0 = c0 & 63, zcol = part * 256 + h * 64 + d0;
        float cw[5][2];
#pragma unroll
        for (int j = 0; j < 5; ++j) { const float* wp = F.conv_w + (size_t)(l * 5 + j) * 768 + part * 256 + h * 64 + d0; cw[j][0] = wp[0]; cw[j][1] = wp[1]; }
        float win[20][2];
#pragma unroll
        for (int rr = 0; rr < 20; ++rr) { const int row = row0 + rg * 16 - 2 + rr; unsigned wv = 0u;
            if (row >= seg_lo && row < seg_hi) wv = *(const unsigned*)(F.Z + (size_t)row * ZW + zcol);
            win[rr][0] = bflo(wv); win[rr][1] = bfhi(wv); }
#pragma unroll
        for (int i = 0; i < 16; ++i) { float a0 = 0.f, a1 = 0.f;
#pragma unroll
            for (int j = 0; j < 5; ++j) { a0 += cw[j][0] * win[i + j][0]; a1 += cw[j][1] * win[i + j][1]; }
            CV[(rg * 16 + i) * 196 + c0] = siluf_(a0); CV[(rg * 16 + i) * 196 + c0 + 1] = siluf_(a1); }
    } else {
        const int tt = t - 384, d = tt >> 6, p = tt & 63; const bf16_t* zr = F.Z + (size_t)(row0 + p) * ZW;
        const float a = bf2f(zr[ZC_GA + d * 4 + h]), bb = bf2f(zr[ZC_GB + d * 4 + h]);
        gS[d * 64 + p] = -expf(F.a_log[l * 8 + d * 4 + h]) * softplusf_(a + F.dt_bias[l * 8 + d * 4 + h]);
        bS[d * 64 + p] = sigmoidf_(bb);
    }
    __syncthreads();
    {
        const int combo = t >> 2, sub = t & 3, row = combo & 63, part = combo >> 6;
        float v[16]; float ss = 0.f;
#pragma unroll
        for (int i = 0; i < 16; ++i) { v[i] = CV[row * 196 + part * 64 + sub * 16 + i]; ss += v[i] * v[i]; }
        ss += __shfl_xor(ss, 1); ss += __shfl_xor(ss, 2);
        const float rs = 1.0f / sqrtf(ss + EPS);
        LAS bf16_t* dst = (part == 0 ? Qs : Ks) + row * 72 + sub * 16;
        v4u o0, o1;
        o0.x = pk2(v[0] * rs, v[1] * rs); o0.y = pk2(v[2] * rs, v[3] * rs); o0.z = pk2(v[4] * rs, v[5] * rs); o0.w = pk2(v[6] * rs, v[7] * rs);
        o1.x = pk2(v[8] * rs, v[9] * rs); o1.y = pk2(v[10] * rs, v[11] * rs); o1.z = pk2(v[12] * rs, v[13] * rs); o1.w = pk2(v[14] * rs, v[15] * rs);
        *(LAS v4u*)dst = o0; *(LAS v4u*)(dst + 8) = o1;
        if (part == 1) {
#pragma unroll
            for (int i = 0; i < 16; ++i) Kt[(sub * 16 + i) * 72 + row] = (bf16_t)f2bf(v[i] * rs);
        }
        const int vrow = t & 63, dg = t >> 6;
#pragma unroll
        for (int i = 0; i < 8; ++i) Vt[(dg * 8 + i) * 72 + vrow] = (bf16_t)f2bf(CV[vrow * 196 + 128 + dg * 8 + i]);
        if (t < 128) { const int d = t >> 6, p = t & 63; float s = 0.f, tot = 0.f;
            for (int r = 0; r < 64; ++r) { const float g = gS[d * 64 + r]; tot += g; if (d == 0 ? (r <= p) : (r >= p)) s += g; }
            gcS[d * 64 + p] = s; if (p == 0) totS[d] = tot; }
    }
    __syncthreads();
#pragma unroll
    for (int k2 = 0; k2 < 2; ++k2) {
        const int tt = 2 * w + k2, mt = tt >> 2, nt = tt & 3;
        f32x4 accG = {0.f, 0.f, 0.f, 0.f}, accQ = {0.f, 0.f, 0.f, 0.f};
        accG = mma_ll<2>(Ks + mt * 16 * 72, 72, Ks + nt * 16 * 72, 72, accG, lane);
        accQ = mma_ll<2>(Ks + mt * 16 * 72, 72, Qs + nt * 16 * 72, 72, accQ, lane);
        const int n = nt * 16 + lr, m0 = mt * 16 + 4 * lq;
#pragma unroll
        for (int d = 0; d < 2; ++d) {
            const float gcn = gcS[d * 64 + n], bn = bS[d * 64 + n];
            f32x4 av, tv;
#pragma unroll
            for (int i = 0; i < 4; ++i) { const int m = m0 + i; const float gcm = gcS[d * 64 + m];
                const bool strict = d == 0 ? (m < n) : (m > n); const bool incl = d == 0 ? (m <= n) : (m >= n);
                const float e = __expf(incl ? (gcn - gcm) : 0.f);
                av[i] = strict ? bn * accG[i] * e : 0.f; tv[i] = incl ? 0.125f * accQ[i] * e : 0.f; }
            if (d == 0) *(LAS f32x4*)(As + n * 68 + m0) = av;
            else { f32x4 rv; rv[0] = av[3]; rv[1] = av[2]; rv[2] = av[1]; rv[3] = av[0]; *(LAS f32x4*)(As + 4352 + (63 - n) * 68 + 60 - m0) = rv; }
            *(LAS v2u*)(At + d * 4608 + n * 72 + m0) = pack4(tv);
        }
    }
    __syncthreads();
    if (w < 2) {
        const int d = w; const LAS float* Ad = As + d * 4352;
        float tr[64]; int lane_o = lane;
#pragma unroll
        for (int i = 0; i < 64; ++i) {
            float a0 = 0.f, a1 = 0.f, a2 = 0.f, a3 = 0.f;
#pragma unroll
            for (int j4 = 0; j4 < i; j4 += 4) {
                const f32x4 av = *(const LAS f32x4*)(Ad + i * 68 + j4);
                a0 += av[0] * tr[j4];
                if (j4 + 1 < i) a1 += av[1] * tr[j4 + 1];
                if (j4 + 2 < i) a2 += av[2] * tr[j4 + 2];
                if (j4 + 3 < i) a3 += av[3] * tr[j4 + 3];
            }
            asm volatile("" : "+v"(lane_o) :: "memory");
            tr[i] = (lane_o == i ? 1.f : 0.f) - ((a0 + a1) + (a2 + a3));
        }
        const int pb = d ? 63 - lane : lane; const float sb = bS[d * 64 + pb], sbe = sb * __expf(gcS[d * 64 + pb]);
        LAS bf16_t* T0 = Tb + d * 9216; LAS bf16_t* T1 = T0 + 4608;
#pragma unroll
        for (int i = 0; i < 64; ++i) { const int pa = d ? 63 - i : i; T0[pa * 72 + pb] = (bf16_t)f2bf(tr[i] * sb); T1[pa * 72 + pb] = (bf16_t)f2bf(tr[i] * sbe); }
    }
    __syncthreads();
#pragma unroll 1
    for (int d = 0; d < 2; ++d) {
        const int ud = u * 2 + d; const float tot = totS[d];
        const LAS bf16_t* T0 = Tb + d * 9216; const LAS bf16_t* T1 = T0 + 4608; const LAS bf16_t* Ad = At + d * 4608;
        {
            const bool isw = w >= 4; const LAS bf16_t* Aop = isw ? T1 : T0; const LAS bf16_t* Bop = isw ? Kt : Vt;
            LAS bf16_t* o0 = isw ? WT : UT; LAS bf16_t* o1 = isw ? WTd : UTd;
#pragma unroll
            for (int k4 = 0; k4 < 4; ++k4) { const int tt = (w & 3) * 4 + k4, mt = tt >> 2, nt = tt & 3;
                f32x4 acc = {0.f, 0.f, 0.f, 0.f}; acc = mma_ll<2>(Aop + mt * 16 * 72, 72, Bop + nt * 16 * 72, 72, acc, lane);
                const int n = nt * 16 + lr, m0 = mt * 16 + 4 * lq; f32x4 dv;
#pragma unroll
                for (int i = 0; i < 4; ++i) dv[i] = acc[i] * __expf(tot - gcS[d * 64 + m0 + i]);
                *(LAS v2u*)(o0 + n * 72 + m0) = pack4(acc); *(LAS v2u*)(o1 + n * 72 + m0) = pack4(dv); }
        }
        __syncthreads();
        {
            const int prod = w >> 1; bf16_t* gout = F.PG + (size_t)ud * 16384 + prod * 4096;
            const LAS bf16_t* Aop = prod == 0 ? WTd : prod == 1 ? Kt : prod == 2 ? WT : Ad;
            const LAS bf16_t* Bop = prod == 0 ? Kt : prod == 1 ? UTd : prod == 2 ? Ad : UT;
#pragma unroll
            for (int k8 = 0; k8 < 8; ++k8) { const int tt = (w & 1) * 8 + k8, mt = tt >> 2, nt = tt & 3;
                f32x4 acc = {0.f, 0.f, 0.f, 0.f}; acc = mma_ll<2>(Aop + mt * 16 * 72, 72, Bop + nt * 16 * 72, 72, acc, lane);
                const int n = nt * 16 + lr, m0 = mt * 16 + 4 * lq;
                if (prod == 2) { const f32x4 qv = unpack4(*(const LAS v2u*)(Qs + n * 72 + m0)); const float e = 0.125f * __expf(gcS[d * 64 + n]); acc = qv * e - acc; }
                *(v2u*)(gout + n * 64 + m0) = pack4(acc); }
        }
        if (t == 0) F.GLG[ud] = __expf(tot);
        __syncthreads();
    }
}

__device__ __forceinline__ void mlstm_prep_unit(const Frame& F, int l, int u) {
    const int b = u / 144, h = (u / 36) & 3, cidx = u % 36;
    const int row0 = chunk_row0(b, cidx);
    const int t_o = F.wave * 64 + fresh_lane();
    const int t = t_o, lane = t & 63, w = __builtin_amdgcn_readfirstlane(t >> 6), lr = lane & 15, lq = lane >> 4;
    LAS unsigned char* L = F.lds;
    LAS bf16_t* Qs = (LAS bf16_t*)(L + 0); LAS bf16_t* Ks = (LAS bf16_t*)(L + 9216); LAS bf16_t* Vta = (LAS bf16_t*)(L + 18432);
    LAS bf16_t* Kte = (LAS bf16_t*)(L + 29952);
    LAS bf16_t* S0 = (LAS bf16_t*)(L + 48384);
    LAS float* igS = (LAS float*)(L + 66816); LAS float* lfS = igS + 128; LAS float* bS = igS + 256; LAS float* dmS = igS + 384; LAS float* rS = igS + 512;
    LAS float* flS = igS + 640; LAS float* eS = igS + 768; LAS float* mpS = igS + 896;
    {
        const int r = t >> 3, seg = t & 7; const bf16_t* zr = F.Z + (size_t)(row0 + r) * ZW + h * 64 + seg * 8;
        const v4u q = *(const v4u*)(zr + ZC_LQ), k = *(const v4u*)(zr + ZC_LK), v = *(const v4u*)(zr + ZC_LV);
        *(LAS v4u*)(Qs + r * 72 + seg * 8) = q; *(LAS v4u*)(Ks + r * 72 + seg * 8) = k;
        Vta[(seg * 8 + 0) * 72 + r] = (bf16_t)(v.x & 0xffffu); Vta[(seg * 8 + 1) * 72 + r] = (bf16_t)(v.x >> 16);
        Vta[(seg * 8 + 2) * 72 + r] = (bf16_t)(v.y & 0xffffu); Vta[(seg * 8 + 3) * 72 + r] = (bf16_t)(v.y >> 16);
        Vta[(seg * 8 + 4) * 72 + r] = (bf16_t)(v.z & 0xffffu); Vta[(seg * 8 + 5) * 72 + r] = (bf16_t)(v.z >> 16);
        Vta[(seg * 8 + 6) * 72 + r] = (bf16_t)(v.w & 0xffffu); Vta[(seg * 8 + 7) * 72 + r] = (bf16_t)(v.w >> 16);
#pragma unroll
        for (int j = 0; j < 2; ++j) { const int idx = t + 512 * j, rr = 64 + (idx >> 6), cc = idx & 63; Vta[rr * 72 + cc] = (bf16_t)(rr == 64 ? 0x3F80u : 0u); }
        if (t < 128) { const int d = t >> 6, p = t & 63; const bf16_t* zg = F.Z + (size_t)(row0 + p) * ZW;
            igS[d * 64 + p] = bf2f(zg[ZC_LI + d * 4 + h]) + F.ig_bias[l * 8 + d * 4 + h];
            lfS[d * 64 + p] = logsigf_(bf2f(zg[ZC_LF + d * 4 + h]) + F.fg_bias[l * 8 + d * 4 + h]); }
        if (t >= 128 && t < 130) { const int d = t - 128; const int step_of = d ? (cidx < 4 ? 3 - cidx : 39 - cidx) : cidx; float m = 0.f;
            const float* ch = F.CHS + (size_t)(((b * 4 + h) * 2 + d) * 36) * 2;
            for (int s = 0; s < step_of; ++s) { const int ci = d ? (s < 4 ? 3 - s : 39 - s) : s; m = fmaxf(ch[ci * 2] + m, ch[ci * 2 + 1]); }
            mpS[d] = m; }
    }
    __syncthreads();
    if (t < 128) { const int d = t >> 6, p = t & 63; float s = 0.f;
        for (int r = 0; r < 64; ++r) if (d == 0 ? (r <= p) : (r >= p)) s += lfS[d * 64 + r];
        bS[d * 64 + p] = s; }
    __syncthreads();
    if (t < 128) { const int d = t >> 6, p = t & 63; float mxp = -1e30f, mxall = -1e30f;
        for (int j = 0; j < 64; ++j) { const float v = igS[d * 64 + j] - bS[d * 64 + j]; mxall = fmaxf(mxall, v); if (d == 0 ? (j <= p) : (j >= p)) mxp = fmaxf(mxp, v); }
        const float bp = bS[d * 64 + p], dmax = bp + mxp, bl = d == 0 ? bS[63] : bS[64], wsmax = bl + mxall, mprev = mpS[d];
        const float mnew = fmaxf(bl + mprev, wsmax), cd = expf(bl + mprev - mnew), e2 = expf(wsmax - mnew);
        const float mt = fmaxf(bp + mprev, dmax);
        dmS[d * 64 + p] = dmax; rS[d * 64 + p] = expf(dmax - mt); flS[d * 64 + p] = expf(-mt);
        eS[d * 64 + p] = expf(bl - bp + igS[d * 64 + p] - wsmax) * e2;
        const int ud = u * 2 + d; F.WI[ud * 64 + p] = 0.125f * expf(bp + mprev - mt); if (p == 0) F.GLM[ud] = cd; }
    __syncthreads();
    {
        const int d = t >> 8, tt = t & 255, p = tt & 63, dg = tt >> 6; const float e = eS[d * 64 + p];
#pragma unroll
        for (int i = 0; i < 16; ++i) Kte[d * 4608 + (dg * 16 + i) * 72 + p] = (bf16_t)f2bf(bf2f(Ks[p * 72 + dg * 16 + i]) * e);
#pragma unroll
        for (int k2 = 0; k2 < 2; ++k2) { const int tl = 2 * w + k2, mt = tl >> 2, nt = tl & 3;
            f32x4 acc = {0.f, 0.f, 0.f, 0.f}; acc = mma_ll<2>(Ks + mt * 16 * 72, 72, Qs + nt * 16 * 72, 72, acc, lane);
            const int n = nt * 16 + lr, m0 = mt * 16 + 4 * lq;
#pragma unroll
            for (int dd = 0; dd < 2; ++dd) { const float bn = bS[dd * 64 + n], dn = dmS[dd * 64 + n], rn = rS[dd * 64 + n]; f32x4 sv;
#pragma unroll
                for (int i = 0; i < 4; ++i) { const int m = m0 + i; const bool incl = dd == 0 ? (m <= n) : (m >= n);
                    const float arg = incl ? (bn - bS[dd * 64 + m] + igS[dd * 64 + m] - dn) : 0.f; sv[i] = incl ? 0.125f * acc[i] * __expf(arg) * rn : 0.f; }
                *(LAS v2u*)(S0 + dd * 4608 + n * 72 + m0) = pack4(sv); } }
    }
    __syncthreads();
    {
        const int d = w >> 2, ud = u * 2 + d; bf16_t* gO = F.PM + (size_t)ud * 10240; bf16_t* gB = gO + 5120;
#pragma unroll 2
        for (int k = 0; k < 10; ++k) { const int tl = (w & 3) * 10 + k; const bool iskv = tl >= 20; const int t2 = iskv ? tl - 20 : tl, mt = t2 / 5, nt = t2 % 5;
            const LAS bf16_t* Aop = (iskv ? Kte : S0) + d * 4608 + mt * 16 * 72;
            f32x4 acc = {0.f, 0.f, 0.f, 0.f}; acc = mma_ll<2>(Aop, 72, Vta + nt * 16 * 72, 72, acc, lane);
            const int n = nt * 16 + lr, m0 = mt * 16 + 4 * lq;
            if (!iskv && n == 65) {
#pragma unroll
                for (int i = 0; i < 4; ++i) acc[i] = flS[d * 64 + m0 + i]; }
            *(v2u*)((iskv ? gB : gO) + n * 64 + m0) = pack4(acc); }
    }
    __syncthreads();
}

template <bool GDN> __device__ __forceinline__ void scan_wg(const Frame& F, int l, int bh) {
    constexpr int NT = GDN ? 4 : 5;
    const int b = bh >> 2, h = bh & 3;
    const int lane = fresh_lane(), dir = F.wave >> 2, wq = F.wave & 3, lr = lane & 15, lq = lane >> 4;
    LAS bf16_t* St = (LAS bf16_t*)F.lds;
    f32x4 S[NT];
#pragma unroll
    for (int t = 0; t < NT; ++t) S[t] = (f32x4){0.f, 0.f, 0.f, 0.f};
    const float* nw = GDN ? F.gdn_norm_w + l * 64 : F.mlstm_norm_w + l * 256 + h * 64;
    float* PEND = F.PEND + (GDN ? (size_t)0 : (size_t)1152 * 4096);
#pragma unroll 1
    for (int s = 0; s < 36; ++s) {
        const int cidx = dir ? (s < 4 ? 3 - s : 39 - s) : s;
        const int ud = ((b * 4 + h) * 36 + cidx) * 2 + dir;
        const int row0 = chunk_row0(b, cidx);
        LAS bf16_t* Sb = St + ((dir * 2 + (s & 1)) * 80) * 72;
#pragma unroll
        for (int t = 0; t < NT; ++t) *(LAS v2u*)(Sb + (16 * t + lr) * 72 + 16 * wq + 4 * lq) = pack4(S[t]);
        VM_WAIT();
        __syncthreads();
        bf16x8 Qf[2], Mf[2];
        if (GDN) {
            const bf16_t* gM = F.PG + (size_t)ud * 16384; const bf16_t* gQ = gM + 8192;
#pragma unroll
            for (int ks = 0; ks < 2; ++ks) { Mf[ks] = *(const bf16x8*)(gM + (16 * wq + lr) * 64 + 32 * ks + 8 * lq); Qf[ks] = *(const bf16x8*)(gQ + (16 * wq + lr) * 64 + 32 * ks + 8 * lq); }
        } else {
            const bf16_t* zq = F.Z + (size_t)(row0 + 16 * wq + lr) * ZW + ZC_LQ + h * 64;
#pragma unroll
            for (int ks = 0; ks < 2; ++ks) { Qf[ks] = *(const bf16x8*)(zq + 32 * ks + 8 * lq); Mf[ks] = Qf[ks]; }
        }
        const bf16_t* gB = GDN ? F.PG + (size_t)ud * 16384 + 4096 : F.PM + (size_t)ud * 10240 + 5120;
        const bf16_t* gO = GDN ? F.PG + (size_t)ud * 16384 + 12288 : F.PM + (size_t)ud * 10240;
        const float gl = GDN ? F.GLG[ud] : F.GLM[ud];
        f32x4 wi = {1.f, 1.f, 1.f, 1.f}; if (!GDN) wi = *(const f32x4*)(F.WI + ud * 64 + 16 * wq + 4 * lq);
        f32x4 O[NT];
#pragma unroll
        for (int t = 0; t < NT; ++t) {
            const LAS bf16_t* sp = Sb + (16 * t + lr) * 72 + 8 * lq;
            const bf16x8 s0 = *(const LAS bf16x8*)sp, s1 = *(const LAS bf16x8*)(sp + 32);
            f32x4 o = {0.f, 0.f, 0.f, 0.f};
            o = __builtin_amdgcn_mfma_f32_16x16x32_bf16(Qf[0], s0, o, 0, 0, 0); o = __builtin_amdgcn_mfma_f32_16x16x32_bf16(Qf[1], s1, o, 0, 0, 0);
            const f32x4 bv = unpack4(*(const v2u*)(gB + (16 * t + lr) * 64 + 16 * wq + 4 * lq));
            const f32x4 ov = unpack4(*(const v2u*)(gO + (16 * t + lr) * 64 + 16 * wq + 4 * lq));
            if (GDN) {
                f32x4 ms = {0.f, 0.f, 0.f, 0.f};
                ms = __builtin_amdgcn_mfma_f32_16x16x32_bf16(Mf[0], s0, ms, 0, 0, 0); ms = __builtin_amdgcn_mfma_f32_16x16x32_bf16(Mf[1], s1, ms, 0, 0, 0);
                S[t] = S[t] * gl - ms + bv; O[t] = o + ov;
            } else { S[t] = S[t] * gl + bv; O[t] = o * wi + ov; }
        }
        if (!GDN) {
#pragma unroll
            for (int i = 0; i < 4; ++i) { const float den = __shfl(O[NT - 1][i], lane & 48), fl = __shfl(O[NT - 1][i], (lane & 48) + 1); const float dv = 1.0f / fmaxf(fabsf(den), fl);
#pragma unroll
                for (int t = 0; t < 4; ++t) O[t][i] *= dv; }
        }
        const bool first = s < 4 ? (s <= 1) : (s <= 19);
        float* pp = PEND + (size_t)((b * 4 + h) * 36 + cidx) * 4096 + 16 * wq + 4 * lq;
        if (first) {
#pragma unroll
            for (int t = 0; t < 4; ++t) *(f32x4*)(pp + (16 * t + lr) * 64) = O[t];
        } else {
            float ss[4] = {0.f, 0.f, 0.f, 0.f};
#pragma unroll
            for (int t = 0; t < 4; ++t) { const float* q = pp + (16 * t + lr) * 64;
#pragma unroll
                for (int i = 0; i < 4; ++i) { O[t][i] += __hip_atomic_load(q + i, __ATOMIC_RELAXED, __HIP_MEMORY_SCOPE_AGENT); ss[i] += O[t][i] * O[t][i]; } }
#pragma unroll
            for (int i = 0; i < 4; ++i) { ss[i] += __shfl_xor(ss[i], 1); ss[i] += __shfl_xor(ss[i], 2); ss[i] += __shfl_xor(ss[i], 4); ss[i] += __shfl_xor(ss[i], 8); ss[i] = 1.0f / sqrtf(ss[i] * (1.f / 64.f) + EPS); }
#pragma unroll
            for (int t = 0; t < 4; ++t) { const int dv = 16 * t + lr; const float nwv = nw[dv];
#pragma unroll
                for (int i = 0; i < 4; ++i) { const int row = row0 + 16 * wq + 4 * lq + i;
                    const float g = bf2f(F.Z[(size_t)row * ZW + (GDN ? ZC_GZ : ZC_LO) + h * 64 + dv]);
                    const float gate = GDN ? siluf_(g) : sigmoidf_(g);
                    F.MIX[(size_t)row * 1024 + (GDN ? 0 : 768) + h * 64 + dv] = (bf16_t)f2bf(O[t][i] * ss[i] * nwv * gate); } }
        }
    }
    __syncthreads();
}

__device__ __forceinline__ void swa_unit(const Frame& F, int l, int it) {
    const bool lat = it < 256; int b, kvh, qb;
    if (lat) { b = it >> 5; kvh = (it >> 4) & 1; qb = it & 15; } else { const int j = it - 256; b = j >> 2; kvh = (j >> 1) & 1; qb = j & 1; }
    const int t_o = F.wave * 64 + fresh_lane();
    const int t = t_o, lane = t & 63, w = __builtin_amdgcn_readfirstlane(t >> 6), lr = lane & 15, lq = lane >> 4;
    const int hq = kvh * 2 + (w >> 2), wrow = (w & 3) * 32;
    const int qrow = (lat ? b * SEQ : MLAT + b * CTXL) + qb * 128 + wrow;
    LAS bf16_t* Ksh = (LAS bf16_t*)F.lds; LAS bf16_t* Vt = Ksh + 4608; LAS bf16_t* Pw = Ksh + 9216 + w * 2304;
    bf16x8 Qf[2][2];
#pragma unroll
    for (int mt = 0; mt < 2; ++mt)
#pragma unroll
        for (int ks = 0; ks < 2; ++ks) Qf[mt][ks] = *(const bf16x8*)(F.Z + (size_t)(qrow + mt * 16 + lr) * ZW + ZC_SQ + hq * 64 + 32 * ks + 8 * lq);
    const float sk = F.sink[l * 4 + hq];
    float mi[2][4], li[2][4]; f32x4 O[2][4];
#pragma unroll
    for (int mt = 0; mt < 2; ++mt)
#pragma unroll
        for (int i = 0; i < 4; ++i) { mi[mt][i] = sk; li[mt][i] = 1.f; O[mt][i] = (f32x4){0.f, 0.f, 0.f, 0.f}; }
    const int ntile = lat ? 10 : 4;
#pragma unroll 1
    for (int kt = 0; kt < ntile; ++kt) {
        int krow, kpos0 = 0; bool masked = false;
        if (lat && kt < 6) { kpos0 = (qb - 1) * 128 + kt * 64; if (kpos0 < 0 || kpos0 >= SEQ) continue; krow = b * SEQ + kpos0; masked = true; }
        else { const int cj = lat ? kt - 6 : kt; krow = MLAT + b * CTXL + cj * 64; }
        __syncthreads();
        { const int r = t >> 3, seg = t & 7; const bf16_t* zr = F.Z + (size_t)(krow + r) * ZW + kvh * 64 + seg * 8;
          const v4u k = *(const v4u*)(zr + ZC_SK), v = *(const v4u*)(zr + ZC_SV);
          *(LAS v4u*)(Ksh + r * 72 + seg * 8) = k;
          Vt[(seg * 8 + 0) * 72 + r] = (bf16_t)(v.x & 0xffffu); Vt[(seg * 8 + 1) * 72 + r] = (bf16_t)(v.x >> 16);
          Vt[(seg * 8 + 2) * 72 + r] = (bf16_t)(v.y & 0xffffu); Vt[(seg * 8 + 3) * 72 + r] = (bf16_t)(v.y >> 16);
          Vt[(seg * 8 + 4) * 72 + r] = (bf16_t)(v.z & 0xffffu); Vt[(seg * 8 + 5) * 72 + r] = (bf16_t)(v.z >> 16);
          Vt[(seg * 8 + 6) * 72 + r] = (bf16_t)(v.w & 0xffffu); Vt[(seg * 8 + 7) * 72 + r] = (bf16_t)(v.w >> 16); }
        __syncthreads();
        f32x4 sc[2][4];
#pragma unroll
        for (int nt = 0; nt < 4; ++nt) { const LAS bf16_t* kp = Ksh + (nt * 16 + lr) * 72 + 8 * lq; const bf16x8 k0 = *(const LAS bf16x8*)kp, k1 = *(const LAS bf16x8*)(kp + 32);
#pragma unroll
            for (int mt = 0; mt < 2; ++mt) { f32x4 a = {0.f, 0.f, 0.f, 0.f};
                a = __builtin_amdgcn_mfma_f32_16x16x32_bf16(Qf[mt][0], k0, a, 0, 0, 0); a = __builtin_amdgcn_mfma_f32_16x16x32_bf16(Qf[mt][1], k1, a, 0, 0, 0); sc[mt][nt] = a; } }
#pragma unroll
        for (int mt = 0; mt < 2; ++mt) {
            float mx[4] = {-1e30f, -1e30f, -1e30f, -1e30f};
#pragma unroll
            for (int nt = 0; nt < 4; ++nt)
#pragma unroll
                for (int i = 0; i < 4; ++i) {
                    if (masked) { const int qpos = qb * 128 + wrow + mt * 16 + 4 * lq + i, kpos = kpos0 + nt * 16 + lr; const int dd = qpos - kpos; if (dd > 128 || dd < -128) sc[mt][nt][i] = -1e30f; }
                    mx[i] = fmaxf(mx[i], sc[mt][nt][i]); }
#pragma unroll
            for (int i = 0; i < 4; ++i) { mx[i] = fmaxf(mx[i], __shfl_xor(mx[i], 1)); mx[i] = fmaxf(mx[i], __shfl_xor(mx[i], 2)); mx[i] = fmaxf(mx[i], __shfl_xor(mx[i], 4)); mx[i] = fmaxf(mx[i], __shfl_xor(mx[i], 8)); }
            float al[4], rsum[4];
#pragma unroll
            for (int i = 0; i < 4; ++i) { const float mn = fmaxf(mi[mt][i], mx[i]); al[i] = __expf(mi[mt][i] - mn); mi[mt][i] = mn; rsum[i] = 0.f; }
#pragma unroll
            for (int nt = 0; nt < 4; ++nt)
#pragma unroll
                for (int i = 0; i < 4; ++i) { const float p = __expf(sc[mt][nt][i] - mi[mt][i]); rsum[i] += p; Pw[(mt * 16 + 4 * lq + i) * 72 + nt * 16 + lr] = (bf16_t)f2bf(p); }
#pragma unroll
            for (int i = 0; i < 4; ++i) { rsum[i] += __shfl_xor(rsum[i], 1); rsum[i] += __shfl_xor(rsum[i], 2); rsum[i] += __shfl_xor(rsum[i], 4); rsum[i] += __shfl_xor(rsum[i], 8); li[mt][i] = li[mt][i] * al[i] + rsum[i]; }
#pragma unroll
            for (int nt = 0; nt < 4; ++nt)
#pragma unroll
                for (int i = 0; i < 4; ++i) O[mt][nt][i] *= al[i];
        }
        LDS_WAIT(); asm volatile("" ::: "memory");
#pragma unroll
        for (int nt = 0; nt < 4; ++nt) { const LAS bf16_t* vp = Vt + (nt * 16 + lr) * 72 + 8 * lq; const bf16x8 v0 = *(const LAS bf16x8*)vp, v1 = *(const LAS bf16x8*)(vp + 32);
#pragma unroll
            for (int mt = 0; mt < 2; ++mt) { const LAS bf16_t* pp = Pw + (mt * 16 + lr) * 72 + 8 * lq; const bf16x8 p0 = *(const LAS bf16x8*)pp, p1 = *(const LAS bf16x8*)(pp + 32);
                O[mt][nt] = __builtin_amdgcn_mfma_f32_16x16x32_bf16(p0, v0, O[mt][nt], 0, 0, 0); O[mt][nt] = __builtin_amdgcn_mfma_f32_16x16x32_bf16(p1, v1, O[mt][nt], 0, 0, 0); } }
    }
#pragma unroll
    for (int mt = 0; mt < 2; ++mt)
#pragma unroll
        for (int i = 0; i < 4; ++i) { const float inv = 1.0f / li[mt][i]; bf16_t* orow = F.MIX + (size_t)(qrow + mt * 16 + 4 * lq + i) * 1024 + 256 + hq * 64 + lr;
#pragma unroll
            for (int nt = 0; nt < 4; ++nt) orow[nt * 16] = (bf16_t)f2bf(O[mt][nt][i] * inv); }
    __syncthreads();
}

__device__ __forceinline__ void gmlp_unit(const Frame& F, int l, int it) {
    const int b = it / 72, c = (it >> 2) % 18, g = it & 3;
    const int r0 = c < 16 ? b * SEQ + c * 128 : MLAT + b * CTXL + (c - 16) * 128;
    const int t_o = F.wave * 64 + fresh_lane();
    const int t = t_o, lane = t & 63, w = __builtin_amdgcn_readfirstlane(t >> 6), lr = lane & 15, lq = lane >> 4;
    LAS bf16_t* Vt = (LAS bf16_t*)F.lds;
#pragma unroll
    for (int j = 0; j < 2; ++j) { const int idx = t + 512 * j, q = idx >> 3, seg = idx & 7;
        const v4u v = *(const v4u*)(F.Z + (size_t)(r0 + q) * ZW + ZC_MV + g * 64 + seg * 8);
        Vt[(seg * 8 + 0) * 136 + q] = (bf16_t)(v.x & 0xffffu); Vt[(seg * 8 + 1) * 136 + q] = (bf16_t)(v.x >> 16);
        Vt[(seg * 8 + 2) * 136 + q] = (bf16_t)(v.y & 0xffffu); Vt[(seg * 8 + 3) * 136 + q] = (bf16_t)(v.y >> 16);
        Vt[(seg * 8 + 4) * 136 + q] = (bf16_t)(v.z & 0xffffu); Vt[(seg * 8 + 5) * 136 + q] = (bf16_t)(v.z >> 16);
        Vt[(seg * 8 + 6) * 136 + q] = (bf16_t)(v.w & 0xffffu); Vt[(seg * 8 + 7) * 136 + q] = (bf16_t)(v.w >> 16); }
    __syncthreads();
    bf16x8 Af[4];
#pragma unroll
    for (int ks = 0; ks < 4; ++ks) Af[ks] = *(const bf16x8*)(F.WSP + (size_t)g * 16384 + (16 * w + lr) * 128 + 32 * ks + 8 * lq);
    f32x4 bsv = *(const f32x4*)(F.b_s + (size_t)(l * 4 + g) * 128 + 16 * w + 4 * lq);
#pragma unroll
    for (int nt = 0; nt < 4; ++nt) { f32x4 acc = {0.f, 0.f, 0.f, 0.f};
#pragma unroll
        for (int ks = 0; ks < 4; ++ks) { const bf16x8 bfr = *(const LAS bf16x8*)(Vt + (nt * 16 + lr) * 136 + 32 * ks + 8 * lq); acc = __builtin_amdgcn_mfma_f32_16x16x32_bf16(Af[ks], bfr, acc, 0, 0, 0); }
#pragma unroll
        for (int i = 0; i < 4; ++i) { const int row = r0 + 16 * w + 4 * lq + i, col = g * 64 + nt * 16 + lr;
            const float uv = bf2f(F.Z[(size_t)row * ZW + ZC_MU + col]);
            F.MIX[(size_t)row * 1024 + 512 + col] = (bf16_t)f2bf(uv * (acc[i] + bsv[i])); } }
    __syncthreads();
}

#ifndef ONLY_CASE
#define ONLY_CASE -1
#endif
struct Args { const float* in[24]; float* out; unsigned char* ws; int ph_lo, ph_hi; };
constexpr int NPH = 2 + 9 * DEPTH;
__global__ void __launch_bounds__(NWAVES * 64, 2) mk_fwd(Args args) {
    extern __shared__ __attribute__((aligned(16))) unsigned char lds[];
    const int wave_s = __builtin_amdgcn_readfirstlane((int)threadIdx.x >> 6);
    const int tid_ = wave_s * 64 + fresh_lane();
    volatile LAS unsigned* MISC = (volatile LAS unsigned*)((LAS unsigned char*)lds + MISC_OFF);
    if (tid_ < 32) MISC[tid_] = 0u;
    __syncthreads();
    unsigned* barw = (unsigned*)(args.ws + WS_CTL) + CW_BAR;
    XcdBarrier bar; bar.bar = barw; bar.x = 0; bar.st = nullptr;
    const int lo = args.ph_lo, hi = args.ph_hi;
    if (hi - lo > 1) bar = xcd_barrier_post(barw, MISC + 8, tid_);

#pragma unroll 1
    for (int ph = lo; ph < hi; ++ph) {
        int zero; asm volatile("s_mov_b32 %0, 0" : "=s"(zero));
        Frame F;
        F.lds = (LAS unsigned char*)lds;
        F.wave = wave_s;
        F.G = gridDim.x; F.gw = blockIdx.x * NWAVES + F.wave; F.NGW = F.G * NWAVES;
        const float* const* inp = args.in + zero;
        F.x = inp[0]; F.c = inp[1]; F.ctx = inp[2]; F.cctx = inp[3]; F.ada_w = inp[4]; F.ada_b = inp[5]; F.norm1_w = inp[6]; F.norm2_w = inp[7];
        F.w_in = inp[8]; F.w_out = inp[9]; F.conv_w = inp[10]; F.a_log = inp[11]; F.dt_bias = inp[12]; F.gdn_norm_w = inp[13]; F.sink = inp[14];
        F.w_s = inp[15]; F.b_s = inp[16]; F.gmlp_norm_w = inp[17]; F.ig_bias = inp[18]; F.fg_bias = inp[19]; F.mlstm_norm_w = inp[20];
        F.w1 = inp[21]; F.w2 = inp[22]; F.final_w = inp[23];
        unsigned char* ws = args.ws + zero;
        F.out = args.out + zero; F.ws = ws;
        F.MOD = (float*)(ws + WS_MOD); F.XC = (float*)(ws + WS_XC); F.CHS = (float*)(ws + WS_CHS); F.GLG = (float*)(ws + WS_GLG); F.GLM = F.GLG + 2304; F.WI = F.GLG + 4608;
        F.PEND = (float*)(ws + WS_H);
        F.WIN = (bf16_t*)(ws + WS_WIN); F.WOUT = (bf16_t*)(ws + WS_WOUT); F.W1 = (bf16_t*)(ws + WS_W1); F.W2 = (bf16_t*)(ws + WS_W2); F.WSP = (bf16_t*)(ws + WS_WSP);
        F.H = (bf16_t*)(ws + WS_H); F.MIX = (bf16_t*)(ws + WS_MIX); F.Z = (bf16_t*)(ws + WS_Z); F.PG = (bf16_t*)(ws + WS_PG); F.PM = (bf16_t*)(ws + WS_PM); F.HID = (bf16_t*)(ws + WS_HID);
        int kind, l;
        if (ph == 0) { kind = 0; l = 0; } else if (ph == NPH - 1) { kind = 10; l = DEPTH - 1; } else { l = (ph - 1) / 9; kind = 1 + (ph - 1) % 9; }
        const bool last = (l == DEPTH - 1);
        const int Mrows = last ? MLAT : MALL;
        switch (kind) {
        case 0: if (ONLY_CASE >= 0 && ONLY_CASE != 0) break; phase_mod(F); break;
        case 1: if (ONLY_CASE >= 0 && ONLY_CASE != 1) break; convert_weights(F, l); phase_norm(F, l, 0, MALL); break;
        case 2: if (ONLY_CASE >= 0 && ONLY_CASE != 2) break; { pg8::Gemm g{F.H, F.WIN, MALL, ZW, D}; pg8::StaticOrder S; S.init(MALL, ZW, F.G, (int)blockIdx.x);
                  pg8::EpiBf16<0> E{F.Z, ZW}; pg8::gemm_phase<pg8::EpiBf16<0>, pg8::StaticOrder, true, true>(F.lds, g, S, E, wave_s * 64 + fresh_lane()); } break;
        case 3: if (ONLY_CASE >= 0 && ONLY_CASE != 3) break; for (int rg = blockIdx.x; rg < MALL / 16; rg += F.G) ew_unit(F, l, rg); break;
        case 4: if (ONLY_CASE >= 0 && ONLY_CASE != 4) break; for (int it = blockIdx.x; it < 2304; it += F.G) { if (it < 1152) gdn_prep_unit(F, l, it); else mlstm_prep_unit(F, l, it - 1152); } break;
        case 5: if (ONLY_CASE >= 0 && ONLY_CASE != 5) break; { const int bx = blockIdx.x;
                  if (bx < 32) scan_wg<true>(F, l, bx);
                  else if (bx < 64) scan_wg<false>(F, l, bx - 32);
                  else for (int it = bx - 64; it < 288 + 576; it += F.G - 64) { if (it < 288) swa_unit(F, l, it); else gmlp_unit(F, l, it - 288); } } break;
        case 6: case 9: { if (ONLY_CASE >= 0 && ONLY_CASE != 6) break; const bool isout = (kind == 6);
                  pg8::Gemm g{isout ? F.MIX : F.HID, isout ? F.WOUT : F.W2, Mrows, D, isout ? D : FF}; pg8::StaticOrder S; S.init(Mrows, D, F.G, (int)blockIdx.x);
                  pg8::EpiResid E{F.out, F.XC, F.MOD + (size_t)l * 9 * 6144 + (isout ? 2 : 5) * 1024};
                  pg8::gemm_phase<pg8::EpiResid, pg8::StaticOrder, true, true>(F.lds, g, S, E, wave_s * 64 + fresh_lane()); } break;
        case 7: if (ONLY_CASE >= 0 && ONLY_CASE != 7) break; phase_norm(F, l, 1, Mrows); break;
        case 8: if (ONLY_CASE >= 0 && ONLY_CASE != 8) break; { pg8::Gemm g{F.H, F.W1, Mrows, FF, D}; pg8::StaticOrder S; S.init(Mrows, FF, F.G, (int)blockIdx.x);
                  pg8::EpiBf16<1> E{F.HID, FF}; pg8::gemm_phase<pg8::EpiBf16<1>, pg8::StaticOrder, true, true>(F.lds, g, S, E, wave_s * 64 + fresh_lane()); } break;
        default: { const bool poison = (hi - lo > 1) && (__hip_atomic_load(barw + XB_TMO, __ATOMIC_RELAXED, __HIP_MEMORY_SCOPE_AGENT) != 0u); phase_final(F, poison); } break;
        }
        if (ph + 1 < hi) xcd_barrier(bar, wave_s * 64 + fresh_lane());
    }
}

extern "C" void kernel_launch(void* const* d_in, const int* in_sizes, int n_in, void* d_out, int out_size, void* d_ws, size_t ws_size, hipStream_t stream) {
    static int grid = 0;
    if (grid == 0) {
        if (n_in != 24 || out_size != MLAT * D || ws_size < WS_END) { fprintf(stderr, "kernel_launch: unexpected shapes: n_in %d out %d ws %zu (need %zu)\n", n_in, out_size, ws_size, (size_t)WS_END); grid = -1; return; }
        int dev = 0, cus = 0, per_cu = 0;
        if (hipGetDevice(&dev) != hipSuccess || hipDeviceGetAttribute(&cus, hipDeviceAttributeMultiprocessorCount, dev) != hipSuccess) { grid = -1; return; }
        if (hipFuncSetAttribute((const void*)mk_fwd, hipFuncAttributeMaxDynamicSharedMemorySize, LDS_BYTES) != hipSuccess) { fprintf(stderr, "kernel_launch: hipFuncSetAttribute failed\n"); grid = -1; return; }
        if (hipOccupancyMaxActiveBlocksPerMultiprocessor(&per_cu, (const void*)mk_fwd, NWAVES * 64, LDS_BYTES) != hipSuccess || per_cu < 1) { fprintf(stderr, "kernel_launch: occupancy query says %d\n", per_cu); grid = -1; return; }
        (void)hipGetLastError();
        grid = cus;
        if (grid < 128) { fprintf(stderr, "kernel_launch: device too small (%d CUs)\n", grid); grid = -1; return; }
    }
    if (grid < 0) return;
    (void)hipMemsetAsync((char*)d_ws + WS_CTL, 0, CTL_ZERO_BYTES, stream);
    Args a{};
    for (int i = 0; i < 24; ++i) a.in[i] = (const float*)d_in[i];
    a.out = (float*)d_out; a.ws = (unsigned char*)d_ws;
#if MK_PER_PHASE
    for (int p = 0; p < NPH; ++p) { a.ph_lo = p; a.ph_hi = p + 1; hipLaunchKernelGGL(mk_fwd, dim3(grid), dim3(NWAVES * 64), LDS_BYTES, stream, a); }
#else
    a.ph_lo = 0; a.ph_hi = NPH;
    void* kargs[] = {&a};
    hipError_t e = hipLaunchCooperativeKernel((const void*)mk_fwd, dim3(grid), dim3(NWAVES * 64), kargs, LDS_BYTES, stream);
    if (e != hipSuccess) fprintf(stderr, "kernel_launch: cooperative launch failed: %s (grid %d)\n", hipGetErrorString(e), grid);
#endif
}
```

```cpp
#include <hip/hip_runtime.h>
#include <cstdio>
#include <cstdint>
#ifndef MK_PER_PHASE
#define MK_PER_PHASE 0
#endif
#define PROBE_KIND -1
#define PROBE_SUB 0
namespace pg8 {
#define PG8_LAS __attribute__((address_space(3)))
typedef unsigned short bf16_t;
typedef short bf16x8 __attribute__((ext_vector_type(8)));
typedef float f32x4 __attribute__((ext_vector_type(4)));
typedef unsigned u32x4 __attribute__((ext_vector_type(4)));
constexpr int BM = 256, BK = 64, HALF = 128, HTB = HALF * BK * 2  , STAGE_BYTES = 8 * HTB, NXCD = 8, WGM = 8;

__host__ __device__ __forceinline__ int lds_byte(int r, int c) { const int st = (r >> 4) * 2 + (c >> 5), rr = r & 15, cc = c & 31, ob = rr * 64 + cc * 2; return st * 1024 + (ob ^ (((ob >> 9) & 1) << 5)); }
__host__ __device__ __forceinline__ void stage_rc(int b, int& R, int& C) { const int st = b / 1024, sb = b % 1024, swz = sb ^ (((sb >> 9) & 1) << 5); R = (st >> 1) * 16 + swz / 64; C = (st & 1) * 32 + (swz % 64) / 2; }
__host__ __device__ __forceinline__ int perm32(int rho) { const int n = rho >> 4, i = rho & 15; return 8 * (i >> 2) + 4 * n + (i & 3); }

struct Unit { int pm, pn; };
struct Gemm { const bf16_t* A; const bf16_t* Bt; int M, N, K; };

struct StaticOrder {
    int nM, nN, nwg, G, c;
    __host__ __device__ void init(int M, int N, int G_, int c_) { nM = M / BM; nN = N / BM; nwg = nM * nN; G = G_; c = c_; }
    __host__ __device__ bool next(int i, Unit& u) const {
        const long L = (long)i * G + c; if (L >= nwg) return false;
        int wgid = (int)L; { const int q = nwg / NXCD, r = nwg % NXCD, xcd = wgid % NXCD, off = wgid / NXCD; wgid = (xcd < r ? xcd * (q + 1) : r * (q + 1) + (xcd - r) * q) + off; }
        const int nig = WGM * nN, gid = wgid / nig, fm = gid * WGM, gsz = (nM - fm) < WGM ? (nM - fm) : WGM;
        u.pm = fm + ((wgid % nig) % gsz); u.pn = (wgid % nig) / gsz; return true;
    }
    __device__ __forceinline__ void a_ready(const Unit&) const {}
    __device__ __forceinline__ void done(const Unit&) const {}
};

__device__ __forceinline__ unsigned cvt_pk_bf16(float lo, float hi) { unsigned r; asm volatile("v_cvt_pk_bf16_f32 %0, %1, %2" : "=v"(r) : "v"(lo), "v"(hi)); return r; }

template <int ACT  > struct EpiBf16 {
    static constexpr bool PERM = true, AFTER_DRAIN = false;
    bf16_t* O; int ldc;
    __device__ __forceinline__ void operator()(const f32x4 (&acc)[2][2][4][2], const Unit& u, int wr, int wc, int fr, int fq) const {
        const int row0 = u.pm * BM + wr * 64 + fr; const int col0 = u.pn * BM + wc * 32 + 8 * fq;
#pragma unroll
        for (int ai = 0; ai < 2; ++ai)
#pragma unroll
            for (int m = 0; m < 4; ++m) { bf16_t* rowp = O + (size_t)(row0 + ai * HALF + m * 16) * ldc + col0;
#pragma unroll
                for (int bj = 0; bj < 2; ++bj) { f32x4 v0 = acc[ai][bj][m][0], v1 = acc[ai][bj][m][1];
                    if (ACT == 1) {
#pragma unroll
                        for (int e = 0; e < 4; ++e) { float a = fmaxf(v0[e], 0.f), b = fmaxf(v1[e], 0.f); v0[e] = a * a; v1[e] = b * b; } }
                    u32x4 w; w.x = cvt_pk_bf16(v0[0], v0[1]); w.y = cvt_pk_bf16(v0[2], v0[3]); w.z = cvt_pk_bf16(v1[0], v1[1]); w.w = cvt_pk_bf16(v1[2], v1[3]);
                    *(u32x4*)(rowp + bj * HALF) = w; } }
    }
};

struct EpiResid {
    static constexpr bool PERM = false, AFTER_DRAIN = false;
    float* xlat; float* xctx; const float* gmod;
    __device__ __forceinline__ void operator()(const f32x4 (&acc)[2][2][4][2], const Unit& u, int wr, int wc, int fr, int fq) const {
        const int bm = u.pm < 64 ? (u.pm >> 3) : 8;
        float* base = u.pm < 64 ? xlat + (size_t)u.pm * BM * 1024 : xctx + (size_t)(u.pm - 64) * BM * 1024;
        const float* g = gmod + bm * 6144;
        const int col0 = u.pn * BM + wc * 32 + 4 * fq;
        f32x4 gv[2][2];
#pragma unroll
        for (int bj = 0; bj < 2; ++bj)
#pragma unroll
            for (int n = 0; n < 2; ++n) gv[bj][n] = *(const f32x4*)(g + col0 + bj * HALF + n * 16);
#pragma unroll
        for (int ai = 0; ai < 2; ++ai)
#pragma unroll
            for (int m = 0; m < 4; ++m) { float* rowp = base + (size_t)(ai * HALF + wr * 64 + m * 16 + fr) * 1024 + col0;
                f32x4 xv[2][2];
#pragma unroll
                for (int bj = 0; bj < 2; ++bj)
#pragma unroll
                    for (int n = 0; n < 2; ++n) xv[bj][n] = *(const f32x4*)(rowp + bj * HALF + n * 16);
#pragma unroll
                for (int bj = 0; bj < 2; ++bj)
#pragma unroll
                    for (int n = 0; n < 2; ++n) *(f32x4*)(rowp + bj * HALF + n * 16) = xv[bj][n] + gv[bj][n] * acc[ai][bj][m][n];
                if (m & 1) asm volatile("" ::: "memory"); }
    }
};

template <class Epi, class Sched, bool ALIGN_EPI = false, bool SP2 = false>
__device__ __forceinline__ void gemm_phase(PG8_LAS unsigned char* lds, const Gemm g, const Sched& S, const Epi& E, int tid_in) {
    int tid_o = tid_in; asm volatile("" : "+v"(tid_o)); const int tid = tid_o, wid = __builtin_amdgcn_readfirstlane(tid >> 6), lane = tid & 63, wr = wid >> 2, wc = wid & 3, fr = lane & 15, fq = lane >> 4;
    const int K = g.K, nt = K / BK;
    unsigned voffA[2], voffB[2];
#pragma unroll
    for (int i = 0; i < 2; ++i) { int R, C; stage_rc(tid * 16 + i * 8192, R, C); const int Rb = Epi::PERM ? ((R & ~31) + perm32(R & 31)) : R;
        voffA[i] = (unsigned)(R * K + C) * 2u; voffB[i] = (unsigned)(Rb * K + C) * 2u; }
    const size_t kstep = (size_t)(BK * 2);
    const size_t hstep = (size_t)HALF * K * 2;
    const size_t tstep = 2 * hstep;
    const unsigned ldsw = (unsigned)wid * 1024u;
    const int aoff = lds_byte(wr * 64 + fr, fq * 8), boff = lds_byte(wc * 32 + fr, fq * 8);
#define PG8_SA(b, h) (((b) * 2 + (h)) * HTB)
#define PG8_SB(b, h) ((4 + (b) * 2 + (h)) * HTB)
#define PG8_STAGE(bufoff, gbase, voff) do { _Pragma("unroll") for (int _i = 0; _i < 2; ++_i) \
        __builtin_amdgcn_global_load_lds((const unsigned*)((const char*)(gbase) + (voff)[_i]), (PG8_LAS unsigned*)(lds + (bufoff) + ldsw + _i * 8192), 16, 0, 0); } while (0)
#define PG8_LDA(dst, b, h) do { _Pragma("unroll") for (int m = 0; m < 4; ++m) _Pragma("unroll") for (int k = 0; k < 2; ++k) dst[m][k] = *(const PG8_LAS bf16x8*)(lds + PG8_SA(b, h) + aoff + m * 2048 + k * 1024); } while (0)
#define PG8_LDB(dst, b, h) do { _Pragma("unroll") for (int n = 0; n < 2; ++n) _Pragma("unroll") for (int k = 0; k < 2; ++k) dst[n][k] = *(const PG8_LAS bf16x8*)(lds + PG8_SB(b, h) + boff + n * 2048 + k * 1024); } while (0)
#define PG8_MMA(ai, bj, At, Bt) do { __builtin_amdgcn_s_setprio(1); _Pragma("unroll") for (int m = 0; m < 4; ++m) _Pragma("unroll") for (int n = 0; n < 2; ++n) _Pragma("unroll") for (int k = 0; k < 2; ++k) \
        acc[ai][bj][m][n] = __builtin_amdgcn_mfma_f32_16x16x32_bf16(Bt[n][k], At[m][k], acc[ai][bj][m][n], 0, 0, 0); __builtin_amdgcn_s_setprio(0); } while (0)
#define PG8_WAIT_V(n) asm volatile("s_waitcnt vmcnt(" #n ")" ::: "memory")
#define PG8_WAIT_L(n) asm volatile("s_waitcnt lgkmcnt(" #n ")" ::: "memory")
#define PG8_BAR __builtin_amdgcn_s_barrier()
#define PG8_SCHED __builtin_amdgcn_sched_barrier(0)
    Unit cur, nxt; int ui = 0;
    if (!S.next(0, cur)) return;
    f32x4 acc[2][2][4][2];
#pragma unroll
    for (int a = 0; a < 2; ++a)
#pragma unroll
        for (int b = 0; b < 2; ++b)
#pragma unroll
            for (int m = 0; m < 4; ++m)
#pragma unroll
                for (int n = 0; n < 2; ++n) acc[a][b][m][n] = (f32x4){0.f, 0.f, 0.f, 0.f};
    bf16x8 At[4][2], B0[2][2], B1[2][2];
    const char* cA = (const char*)g.A + (size_t)cur.pm * tstep; const char* cB = (const char*)g.Bt + (size_t)cur.pn * tstep;
    S.a_ready(cur);
    if constexpr (SP2) {
        PG8_STAGE(PG8_SB(0, 0), cB, voffB); PG8_STAGE(PG8_SB(0, 1), cB + hstep, voffB); PG8_STAGE(PG8_SA(0, 0), cA, voffA); PG8_STAGE(PG8_SA(0, 1), cA + hstep, voffA);
        if (wr == 1) PG8_BAR;
        PG8_WAIT_V(2); PG8_BAR;
        PG8_STAGE(PG8_SB(1, 0), cB + kstep, voffB); PG8_STAGE(PG8_SA(1, 0), cA + kstep, voffA); PG8_STAGE(PG8_SB(1, 1), cB + hstep + kstep, voffB);
        PG8_WAIT_V(6); PG8_BAR;
    } else {
        PG8_STAGE(PG8_SB(0, 0), cB, voffB); PG8_STAGE(PG8_SA(0, 0), cA, voffA); PG8_STAGE(PG8_SB(0, 1), cB + hstep, voffB); PG8_STAGE(PG8_SA(0, 1), cA + hstep, voffA);
        if (wr == 1) PG8_BAR;
        PG8_WAIT_V(4); PG8_BAR;
        PG8_STAGE(PG8_SB(1, 0), cB + kstep, voffB); PG8_STAGE(PG8_SA(1, 0), cA + kstep, voffA); PG8_STAGE(PG8_SB(1, 1), cB + hstep + kstep, voffB);
        PG8_WAIT_V(6); PG8_BAR;
    }
    for (;;) {
        const bool has_next = S.next(ui + 1, nxt);
        const char* nA = has_next ? (const char*)g.A + (size_t)nxt.pm * tstep : cA; const char* nB = has_next ? (const char*)g.Bt + (size_t)nxt.pn * tstep : cB;
        for (int t = 0; t < nt; t += 2) {
            const bool last = (t == nt - 2);
            const char* a1 = cA + (size_t)(t + 1) * kstep;
            const char* a2 = last ? nA : cA + (size_t)(t + 2) * kstep; const char* b2 = last ? nB : cB + (size_t)(t + 2) * kstep;
            const char* a3 = a2 + kstep; const char* b3 = b2 + kstep;
            if (last && has_next) S.a_ready(nxt);
            if constexpr (SP2) {
            PG8_LDB(B0, 0, 0); PG8_LDB(B1, 0, 1); PG8_SCHED; PG8_LDA(At, 0, 0); PG8_STAGE(PG8_SA(1, 1), a1 + hstep, voffA);
            PG8_WAIT_V(8); PG8_WAIT_L(0); PG8_BAR; PG8_MMA(0, 0, At, B0); PG8_MMA(0, 1, At, B1); PG8_BAR; PG8_SCHED;
            PG8_LDA(At, 0, 1); PG8_STAGE(PG8_SB(0, 0), b2, voffB); PG8_STAGE(PG8_SB(0, 1), b2 + hstep, voffB); PG8_STAGE(PG8_SA(0, 0), a2, voffA);
            PG8_WAIT_V(8); PG8_WAIT_L(0); PG8_BAR; PG8_MMA(1, 0, At, B0); PG8_MMA(1, 1, At, B1); PG8_BAR; PG8_SCHED;
            PG8_LDB(B0, 1, 0); PG8_LDB(B1, 1, 1); PG8_SCHED; PG8_LDA(At, 1, 0); PG8_STAGE(PG8_SA(0, 1), a2 + hstep, voffA);
            PG8_WAIT_V(8); PG8_WAIT_L(0); PG8_BAR; PG8_MMA(0, 0, At, B0); PG8_MMA(0, 1, At, B1); PG8_BAR; PG8_SCHED;
            PG8_LDA(At, 1, 1); PG8_STAGE(PG8_SB(1, 0), b3, voffB); PG8_STAGE(PG8_SB(1, 1), b3 + hstep, voffB); PG8_STAGE(PG8_SA(1, 0), a3, voffA);
            PG8_WAIT_V(8); PG8_WAIT_L(0); PG8_BAR; PG8_MMA(1, 0, At, B0); PG8_MMA(1, 1, At, B1); PG8_BAR; PG8_SCHED;
            } else {
            PG8_LDB(B0, 0, 0); PG8_SCHED; PG8_LDA(At, 0, 0); PG8_STAGE(PG8_SA(1, 1), a1 + hstep, voffA);
            PG8_WAIT_L(8); PG8_BAR; PG8_WAIT_L(0); PG8_MMA(0, 0, At, B0); PG8_BAR; PG8_SCHED;
            PG8_LDB(B1, 0, 1); PG8_STAGE(PG8_SB(0, 0), b2, voffB);
            PG8_BAR; PG8_WAIT_L(0); PG8_MMA(0, 1, At, B1); PG8_BAR;
            PG8_LDA(At, 0, 1); PG8_STAGE(PG8_SA(0, 0), a2, voffA);
            PG8_BAR; PG8_WAIT_L(0); PG8_MMA(1, 0, At, B0); PG8_BAR; PG8_SCHED;
            PG8_STAGE(PG8_SB(0, 1), b2 + hstep, voffB);
            PG8_WAIT_V(6); PG8_BAR; PG8_MMA(1, 1, At, B1); PG8_BAR;
            PG8_LDB(B0, 1, 0); PG8_SCHED; PG8_LDA(At, 1, 0); PG8_STAGE(PG8_SA(0, 1), a2 + hstep, voffA);
            PG8_WAIT_L(8); PG8_BAR; PG8_WAIT_L(0); PG8_MMA(0, 0, At, B0); PG8_BAR; PG8_SCHED;
            PG8_LDB(B1, 1, 1); PG8_STAGE(PG8_SB(1, 0), b3, voffB);
            PG8_BAR; PG8_WAIT_L(0); PG8_MMA(0, 1, At, B1); PG8_BAR;
            PG8_LDA(At, 1, 1); PG8_STAGE(PG8_SA(1, 0), a3, voffA);
            PG8_BAR; PG8_WAIT_L(0); PG8_MMA(1, 0, At, B0); PG8_BAR; PG8_SCHED;
            PG8_STAGE(PG8_SB(1, 1), b3 + hstep, voffB);
            PG8_WAIT_V(6); PG8_BAR; PG8_MMA(1, 1, At, B1); PG8_BAR;
            }
        }
        if constexpr (ALIGN_EPI) { if (wr == 0) PG8_BAR; }
        if constexpr (!Epi::AFTER_DRAIN) { E(acc, cur, wr, wc, fr, fq); S.done(cur); }
        if (!has_next) break;
#pragma unroll
        for (int a = 0; a < 2; ++a)
#pragma unroll
            for (int b = 0; b < 2; ++b)
#pragma unroll
                for (int m = 0; m < 4; ++m)
#pragma unroll
                    for (int n = 0; n < 2; ++n) acc[a][b][m][n] = (f32x4){0.f, 0.f, 0.f, 0.f};
        cur = nxt; cA = nA; cB = nB; ++ui;
        if constexpr (ALIGN_EPI) { if (wr == 1) PG8_BAR; }
    }
    PG8_WAIT_V(0);
    if constexpr (!ALIGN_EPI) { if (wr == 0) PG8_BAR; }
    PG8_BAR;
    if constexpr (Epi::AFTER_DRAIN) { E.fused(acc, cur, wr, wc, fr, fq, lds, wid, lane); S.done(cur); }
#undef PG8_SA
#undef PG8_SB
#undef PG8_STAGE
#undef PG8_LDA
#undef PG8_LDB
#undef PG8_MMA
#undef PG8_WAIT_V
#undef PG8_WAIT_L
#undef PG8_BAR
#undef PG8_SCHED
}
}
constexpr int NWAVES = 8;
constexpr int NB = 8, SEQ = 2048, CTXL = 256, D = 1024, DEPTH = 4, FF = 4096;
constexpr int MLAT = NB * SEQ, MCTX = NB * CTXL, MALL = MLAT + MCTX;
constexpr int ZW = 3328;
constexpr int ZC_GQ = 0, ZC_GK = 256, ZC_GV = 512, ZC_GZ = 768, ZC_SQ = 1024, ZC_SK = 1280, ZC_SV = 1408, ZC_MU = 1536, ZC_MV = 1792,
              ZC_LQ = 2048, ZC_LK = 2304, ZC_LV = 2560, ZC_LO = 2816, ZC_GA = 3072, ZC_GB = 3080, ZC_LI = 3088, ZC_LF = 3096;
constexpr float EPS = 1e-6f;
constexpr size_t MiB = 1u << 20;
constexpr size_t WS_CTL = 0, CTL_ZERO_BYTES = 65536;
constexpr size_t WS_MOD = 1 * MiB;
constexpr size_t WS_WIN = 2 * MiB, WS_WOUT = 9 * MiB, WS_W1 = 11 * MiB, WS_W2 = 19 * MiB, WS_WSP = 27 * MiB;
constexpr size_t WS_CHS = 27 * MiB + 512 * 1024;
constexpr size_t WS_GLG = 27 * MiB + 768 * 1024;
constexpr size_t WS_XC = 29 * MiB;
constexpr size_t WS_H = 37 * MiB;
constexpr size_t WS_MIX = 73 * MiB;
constexpr size_t WS_Z = 109 * MiB;
constexpr size_t WS_PG = 226 * MiB;
constexpr size_t WS_PM = 298 * MiB;
constexpr size_t WS_HID = 109 * MiB;
constexpr size_t WS_END = 343 * MiB;
constexpr int CW_BAR = 1024;
constexpr int LDS_BYTES = 147456;
constexpr int MISC_OFF = 131072 + 8192;

#define LAS __attribute__((address_space(3)))
typedef unsigned short bf16_t;
typedef unsigned v4u __attribute__((ext_vector_type(4)));
typedef unsigned v2u __attribute__((ext_vector_type(2)));
typedef float f32x4 __attribute__((ext_vector_type(4)));
typedef short bf16x8 __attribute__((ext_vector_type(8)));
#define LDS_WAIT() asm volatile("s_waitcnt lgkmcnt(0)" ::: "memory")
#define VM_WAIT() asm volatile("s_waitcnt vmcnt(0)" ::: "memory")
__device__ __forceinline__ unsigned f2bf(float f) { unsigned u = __builtin_bit_cast(unsigned, f); return (u + 0x7fffu + ((u >> 16) & 1u)) >> 16; }
__device__ __forceinline__ unsigned pk2(float lo, float hi) { return f2bf(lo) | (f2bf(hi) << 16); }
__device__ __forceinline__ float bf2f(unsigned v) { return __builtin_bit_cast(float, v << 16); }
__device__ __forceinline__ float bflo(unsigned w) { return __builtin_bit_cast(float, w << 16); }
__device__ __forceinline__ float bfhi(unsigned w) { return __builtin_bit_cast(float, w & 0xffff0000u); }
__device__ __forceinline__ float wave_sum(float v) {
#pragma unroll
    for (int o = 1; o < 64; o <<= 1) v += __shfl_xor(v, o);
    return v;
}
__device__ __forceinline__ float sigmoidf_(float x) { return 1.f / (1.f + __expf(-x)); }
__device__ __forceinline__ float siluf_(float x) { return x / (1.f + __expf(-x)); }
__device__ __forceinline__ float softplusf_(float x) { return x > 20.f ? x : log1pf(expf(x)); }
__device__ __forceinline__ float logsigf_(float x) { return x >= 0.f ? -log1pf(expf(-x)) : x - log1pf(expf(x)); }
__device__ __forceinline__ float geluf_(float x) { const float u = 0.7978845608028654f * (x + 0.044715f * x * x * x); return 0.5f * x * (1.f + tanhf(u)); }
template <int KS> __device__ __forceinline__ f32x4 mma_ll(const LAS bf16_t* A, int lda, const LAS bf16_t* Bt, int ldb, f32x4 acc, int lane) {
    const LAS bf16_t* ap = A + (lane & 15) * lda + 8 * (lane >> 4);
    const LAS bf16_t* bp = Bt + (lane & 15) * ldb + 8 * (lane >> 4);
#pragma unroll
    for (int ks = 0; ks < KS; ++ks) {
        const bf16x8 a = *(const LAS bf16x8*)(ap + 32 * ks); const bf16x8 b = *(const LAS bf16x8*)(bp + 32 * ks);
        acc = __builtin_amdgcn_mfma_f32_16x16x32_bf16(a, b, acc, 0, 0, 0);
    }
    return acc;
}
__device__ __forceinline__ v2u pack4(const f32x4 v) { v2u r; r.x = pk2(v[0], v[1]); r.y = pk2(v[2], v[3]); return r; }
__device__ __forceinline__ f32x4 unpack4(const v2u w) { f32x4 r; r[0] = bflo(w.x); r[1] = bfhi(w.x); r[2] = bflo(w.y); r[3] = bfhi(w.y); return r; }
__device__ __forceinline__ int chunk_row0(int b, int cidx) { return cidx < 4 ? MLAT + b * CTXL + cidx * 64 : b * SEQ + (cidx - 4) * 64; }

#define XB_TMO      128
#define XB_XCNT(j)  (256  + 64 * (j))
#define XB_XSUB(j)  (1280 + 64 * (j))
#define XB_XGEN(j)  (2304 + 64 * (j))
#define XB_TOP      3328
#define XB_TOPGEN   3392
#define XCD_BAR_WORDS 3456
#define XB_SPIN_CAP (1u << 18)

__device__ __forceinline__ unsigned xb_ld(unsigned* p)              { return __hip_atomic_load(p, __ATOMIC_RELAXED, __HIP_MEMORY_SCOPE_AGENT); }
__device__ __forceinline__ unsigned xb_add(unsigned* p, unsigned v) { return __hip_atomic_fetch_add(p, v, __ATOMIC_RELAXED, __HIP_MEMORY_SCOPE_AGENT); }
__device__ __forceinline__ unsigned xb_xcc_id() { return (unsigned)__builtin_amdgcn_s_getreg((3 << 11) | 20) & 0xFu; }
#define XB_SPIN(cond, bar) do { unsigned _sp = 0; while (cond) { __builtin_amdgcn_s_sleep(1); \
    if ((++_sp & 255u) == 0u) { if (xb_ld(&(bar)[XB_TMO])) break; if (_sp > XB_SPIN_CAP) { atomicAdd(&(bar)[XB_TMO], 1u); break; } } } } while (0)

struct XcdBarrier {
    unsigned* bar; unsigned x;
    volatile LAS unsigned* st;
};

__device__ __forceinline__ XcdBarrier xcd_barrier_post(unsigned* bar, volatile LAS unsigned* st, int tid) {
    XcdBarrier b; b.bar = bar; b.x = xb_xcc_id(); b.st = st;
    if (tid == 0) (void)xb_add(&bar[XB_XCNT(b.x)], 1u);
    return b;
}
__device__ __forceinline__ void xcd_barrier_complete(unsigned* bar, unsigned x, unsigned& nloc, unsigned& nx) {
    const unsigned G = gridDim.x * gridDim.y * gridDim.z;
    unsigned sum, cnt, mine, sp = 0u;
    for (;;) {
        sum = 0u; cnt = 0u; mine = 0u;
#pragma unroll
        for (unsigned j = 0; j < 16; ++j) { const unsigned c = xb_ld(&bar[XB_XCNT(j)]); sum += c; cnt += (c > 0u) ? 1u : 0u; mine = (j == x) ? c : mine; }
        if (sum == G) break;
        __builtin_amdgcn_s_sleep(1);
        if ((++sp & 255u) == 0u) { if (xb_ld(&bar[XB_TMO])) break; if (sp > XB_SPIN_CAP) { atomicAdd(&bar[XB_TMO], 1u); break; } }
    }
    nloc = mine > 0u ? mine : 1u; nx = cnt > 0u ? cnt : 1u;
}

__device__ __forceinline__ void xcd_barrier(const XcdBarrier& b, int tid) {
    asm volatile("s_waitcnt vmcnt(0)" ::: "memory");
    __syncthreads();
    if (tid == 0) {
        unsigned* bar = b.bar;
        __builtin_amdgcn_s_waitcnt(0);
        unsigned nloc = b.st[0], nx = b.st[1];
        if (nloc == 0u) { xcd_barrier_complete(bar, b.x, nloc, nx); b.st[0] = nloc; b.st[1] = nx; }
        const unsigned old = xb_add(&bar[XB_XSUB(b.x)], 1u);
        const unsigned gen = old / nloc;
        if (old + 1u == (gen + 1u) * nloc) {
            __builtin_amdgcn_fence(__ATOMIC_RELEASE, "agent");
            asm volatile("s_waitcnt vmcnt(0)" ::: "memory");
            const unsigned og = xb_add(&bar[XB_TOP], 1u);
            const unsigned tg = og / nx;
            if (og + 1u == (tg + 1u) * nx) xb_add(&bar[XB_TOPGEN], 1u);
            else XB_SPIN(xb_ld(&bar[XB_TOPGEN]) == tg, bar);
            __builtin_amdgcn_fence(__ATOMIC_ACQUIRE, "agent");
            xb_add(&bar[XB_XGEN(b.x)], 1u);
            asm volatile("s_waitcnt vmcnt(0)" ::: "memory");
        } else {
            XB_SPIN(xb_ld(&bar[XB_XGEN(b.x)]) == gen, bar);
            __builtin_amdgcn_fence(__ATOMIC_ACQUIRE, "agent");
            asm volatile("s_waitcnt vmcnt(0)" ::: "memory");
        }
    }
    __syncthreads();
}

struct Frame {
    LAS unsigned char* lds;
    int wave, G, gw, NGW;
    const float *x, *c, *ctx, *cctx, *ada_w, *ada_b, *norm1_w, *norm2_w, *w_in, *w_out, *conv_w, *a_log, *dt_bias, *gdn_norm_w, *sink, *w_s, *b_s,
                *gmlp_norm_w, *ig_bias, *fg_bias, *mlstm_norm_w, *w1, *w2, *final_w;
    float* out; unsigned char* ws;
    float *MOD, *XC, *CHS, *GLG, *GLM, *WI, *PEND;
    bf16_t *WIN, *WOUT, *W1, *W2, *WSP, *H, *MIX, *Z, *PG, *PM, *HID;
};

__device__ __forceinline__ int fresh_lane() { int t; asm volatile("v_mbcnt_lo_u32_b32 %0, -1, 0\n\tv_mbcnt_hi_u32_b32 %0, -1, %0" : "=v"(t)); return t; }
__device__ __forceinline__ void phase_mod(const Frame& F) {
    LAS float* sact = (LAS float*)F.lds;
    const int lane0 = fresh_lane(), tid0 = F.wave * 64 + lane0;
    for (int i = tid0; i < 9 * 1024; i += NWAVES * 64) { const float v = i < 8192 ? F.c[i] : F.cctx[i - 8192]; sact[i] = v / (1.f + expf(-v)); }
    __syncthreads();
    for (int task = F.gw; task < DEPTH * 384; task += F.NGW) {
        const int lane = fresh_lane();
        const int l = task / 384, cg = task % 384, col = cg * 16 + (lane & 15), kq = lane >> 4;
        const float* w = F.ada_w + (size_t)l * 1024 * 6144 + col;
        float acc[9];
#pragma unroll
        for (int b = 0; b < 9; ++b) acc[b] = 0.f;
#pragma unroll 4
        for (int k = kq; k < 1024; k += 4) { const float wv = w[(size_t)k * 6144];
#pragma unroll
            for (int b = 0; b < 9; ++b) acc[b] += sact[b * 1024 + k] * wv; }
#pragma unroll
        for (int b = 0; b < 9; ++b) { acc[b] += __shfl_xor(acc[b], 16); acc[b] += __shfl_xor(acc[b], 32); }
        if (kq == 0) { const float bias = F.ada_b[l * 6144 + col];
#pragma unroll
            for (int b = 0; b < 9; ++b) F.MOD[(l * 9 + b) * 6144 + col] = acc[b] + bias; }
    }
    __syncthreads();
}

__device__ __forceinline__ void transpose_item(const float* W, int K, int N, int Ndst, bf16_t* WT, LAS float* scr, int item, int lane, bool remap) {
    const int nblk = Ndst / 32, kb = item / nblk, nb = item % nblk, k0 = 64 * kb, n0 = 32 * nb;
    const int n = n0 + (lane & 31);
    const int src = remap ? (n < 1024 ? n : n < 3072 ? n + 16 : n < 3088 ? n - 2048 : n < 3104 ? n : -1) : n;
#pragma unroll 8
    for (int i = 0; i < 32; ++i) { const int kk = 2 * i + (lane >> 5); scr[kk * 33 + (lane & 31)] = src >= 0 ? W[(size_t)(k0 + kk) * N + src] : 0.f; }
    LDS_WAIT(); asm volatile("" ::: "memory");
    const int c = lane & 7;
#pragma unroll
    for (int j = 0; j < 4; ++j) { const int nn = (lane >> 3) + 8 * j; const LAS float* s = scr + (8 * c) * 33 + nn;
        v4u o; o.x = pk2(s[0 * 33], s[1 * 33]); o.y = pk2(s[2 * 33], s[3 * 33]); o.z = pk2(s[4 * 33], s[5 * 33]); o.w = pk2(s[6 * 33], s[7 * 33]);
        *(v4u*)(WT + (size_t)(n0 + nn) * K + k0 + 8 * c) = o; }
    LDS_WAIT(); asm volatile("" ::: "memory");
}
__device__ __forceinline__ void convert_weights(const Frame& F, int l) {
    LAS float* scr = (LAS float*)(F.lds + F.wave * 16384);
    constexpr int I_IN = 16 * (ZW / 32), I_OUT = 16 * 32, I_1 = 16 * 128, I_2 = 64 * 32, I_S = 128;
    for (int it = F.gw; it < I_IN + I_OUT + I_1 + I_2 + I_S; it += F.NGW) {
        int r = it; const int lane = fresh_lane();
        if (r < I_IN) { transpose_item(F.w_in + (size_t)l * 1024 * 3104, 1024, 3104, ZW, F.WIN, scr, r, lane, true); continue; } r -= I_IN;
        if (r < I_OUT) { transpose_item(F.w_out + (size_t)l * 1024 * 1024, 1024, 1024, 1024, F.WOUT, scr, r, lane, false); continue; } r -= I_OUT;
        if (r < I_1) { transpose_item(F.w1 + (size_t)l * 1024 * 4096, 1024, 4096, 4096, F.W1, scr, r, lane, false); continue; } r -= I_1;
        if (r < I_2) { transpose_item(F.w2 + (size_t)l * 4096 * 1024, 4096, 1024, 1024, F.W2, scr, r, lane, false); continue; } r -= I_2;
        { const float* s = F.w_s + (size_t)l * 65536 + r * 512 + lane * 8; const f32x4 a = *(const f32x4*)s, b = *(const f32x4*)(s + 4);
          v4u o; o.x = pk2(a[0], a[1]); o.y = pk2(a[2], a[3]); o.z = pk2(b[0], b[1]); o.w = pk2(b[2], b[3]); *(v4u*)(F.WSP + r * 512 + lane * 8) = o; }
    }
}

__device__ __forceinline__ void phase_norm(const Frame& F, int l, int which, int nrows) {
    const float* nwp = (which == 0 ? F.norm1_w : F.norm2_w) + l * 1024;
    const bool init = (which == 0 && l == 0);
    for (int m = F.gw; m < nrows; m += F.NGW) {
        const int lane = fresh_lane();
        const bool lat = m < MLAT; const int bm = lat ? (m >> 11) : 8;
        float* xrow = lat ? F.out + (size_t)m * 1024 : F.XC + (size_t)(m - MLAT) * 1024;
        const float* src = init ? (lat ? F.x + (size_t)m * 1024 : F.ctx + (size_t)(m - MLAT) * 1024) : xrow;
        const float* mod = F.MOD + (l * 9 + bm) * 6144 + (which == 0 ? 0 : 3 * 1024);
        f32x4 v[4]; float s = 0.f;
#pragma unroll
        for (int j = 0; j < 4; ++j) { v[j] = *(const f32x4*)(src + 256 * j + 4 * lane); s += (v[j][0] * v[j][0] + v[j][1] * v[j][1]) + (v[j][2] * v[j][2] + v[j][3] * v[j][3]); }
        const float rstd = 1.0f / sqrtf(wave_sum(s) * (1.f / 1024.f) + EPS);
#pragma unroll
        for (int j = 0; j < 4; ++j) {
            const int col = 256 * j + 4 * lane;
            if (init) *(f32x4*)(xrow + col) = v[j];
            const f32x4 nw = *(const f32x4*)(nwp + col), sh = *(const f32x4*)(mod + col), sc = *(const f32x4*)(mod + 1024 + col);
            const f32x4 hh = (v[j] * rstd * nw) * (sc + 1.0f) + sh;
            *(v2u*)(F.H + (size_t)m * 1024 + col) = pack4(hh);
        }
    }
}
__device__ __forceinline__ void phase_final(const Frame& F, bool poison) {
    for (int m = F.gw; m < MLAT; m += F.NGW) {
        const int lane = fresh_lane();
        float* xrow = F.out + (size_t)m * 1024;
        f32x4 v[4]; float s = 0.f;
#pragma unroll
        for (int j = 0; j < 4; ++j) { v[j] = *(const f32x4*)(xrow + 256 * j + 4 * lane); s += (v[j][0] * v[j][0] + v[j][1] * v[j][1]) + (v[j][2] * v[j][2] + v[j][3] * v[j][3]); }
        float rstd = 1.0f / sqrtf(wave_sum(s) * (1.f / 1024.f) + EPS);
        if (poison) rstd = __builtin_nanf("");
#pragma unroll
        for (int j = 0; j < 4; ++j) { const int col = 256 * j + 4 * lane; const f32x4 nw = *(const f32x4*)(F.final_w + col); *(f32x4*)(xrow + col) = v[j] * rstd * nw; }
    }
}

__device__ __forceinline__ void ew_unit(const Frame& F, int l, int rg) {
    const int r0 = rg * 16;
    const int t_o = F.wave * 64 + fresh_lane();
    const int tid = t_o, lane_ = t_o & 63, wave_ = __builtin_amdgcn_readfirstlane(t_o >> 6);
#pragma unroll 1
    for (int j = 0; j < 6; ++j) {
        const int idx = tid + 512 * j, rr = idx / 192, pr = idx % 192, hd = pr >> 5, f = pr & 31, row = r0 + rr;
        const int col = (hd < 4 ? ZC_SQ + hd * 64 : ZC_SK + (hd - 4) * 64) + f;
        bf16_t* p = F.Z + (size_t)row * ZW + col;
        if (row < MLAT) {
            const int t = row & (SEQ - 1); const float pos = (float)(f < 16 ? (t >> 6) : (t & 63));
            const float inv = powf(10000.0f, -(float)(f & 15) * (1.0f / 16.0f));
            const float ang = pos * inv; const float cs = cosf(ang), sn = sinf(ang);
            const float t1 = bf2f(p[0]), t2 = bf2f(p[32]); const float sc = hd < 4 ? 0.125f : 1.0f;
            p[0] = (bf16_t)f2bf((t1 * cs - t2 * sn) * sc); p[32] = (bf16_t)f2bf((t1 * sn + t2 * cs) * sc);
        } else if (hd < 4) {
            p[0] = (bf16_t)f2bf(bf2f(p[0]) * 0.125f); p[32] = (bf16_t)f2bf(bf2f(p[32]) * 0.125f);
        }
    }
#pragma unroll 1
    for (int j = 0; j < 2; ++j) {
        const int row = r0 + 2 * wave_ + j;
        bf16_t* pu = F.Z + (size_t)row * ZW + ZC_MU + 4 * lane_; bf16_t* pv = F.Z + (size_t)row * ZW + ZC_MV + 4 * lane_;
        f32x4 u = unpack4(*(const v2u*)pu), v = unpack4(*(const v2u*)pv); float ss = 0.f;
#pragma unroll
        for (int e = 0; e < 4; ++e) { u[e] = geluf_(u[e]); v[e] = geluf_(v[e]); ss += v[e] * v[e]; }
        const float rs = 1.0f / sqrtf(wave_sum(ss) * (1.f / 256.f) + EPS);
        const f32x4 nw = *(const f32x4*)(F.gmlp_norm_w + l * 256 + 4 * lane_);
        *(v2u*)pu = pack4(u); *(v2u*)pv = pack4(v * rs * nw);
    }
}
__device__ __forceinline__ void chs_unit(const Frame& F, int l, int ck) {
    const int b = ck / 36, cidx = ck % 36, row0 = chunk_row0(b, cidx);
    const int t = F.wave * 64 + fresh_lane();
    LAS float* G = (LAS float*)F.lds;
#pragma unroll
    for (int j = 0; j < 2; ++j) { const int idx = t + 512 * j, p = idx >> 4, c = idx & 15, dh = c & 7;
        const float raw = bf2f(F.Z[(size_t)(row0 + p) * ZW + ZC_LI + c]);
        G[c * 64 + p] = c < 8 ? raw + F.ig_bias[l * 8 + dh] : logsigf_(raw + F.fg_bias[l * 8 + dh]); }
    __syncthreads();
    if (t < 8) { const int d = t >> 2, h = t & 3; float bsum = 0.f, mx = -1e30f;
        for (int i = 0; i < 64; ++i) { const int p = d ? 63 - i : i; bsum += G[(8 + t) * 64 + p]; mx = fmaxf(mx, G[t * 64 + p] - bsum); }
        float* o = F.CHS + ((((b * 4 + h) * 2 + d) * 36) + cidx) * 2; o[0] = bsum; o[1] = bsum + mx; }
    __syncthreads();
}

__device__ __forceinline__ void gdn_prep_unit(const Frame& F, int l, int u) {
    const int b = u / 144, h = (u / 36) & 3, cidx = u % 36;
    const int row0 = chunk_row0(b, cidx);
    const int seg_lo = cidx < 4 ? MLAT + b * CTXL : b * SEQ, seg_hi = seg_lo + (cidx < 4 ? CTXL : SEQ);
    const int t_o = F.wave * 64 + fresh_lane();
    const int t = t_o, lane = t & 63, w = __builtin_amdgcn_readfirstlane(t >> 6), lr = lane & 15, lq = lane >> 4;
    LAS unsigned char* L = F.lds;
    LAS bf16_t* Qs = (LAS bf16_t*)(L + 0); LAS bf16_t* Ks = (LAS bf16_t*)(L + 9216); LAS bf16_t* Kt = (LAS bf16_t*)(L + 18432); LAS bf16_t* Vt = (LAS bf16_t*)(L + 27648);
    LAS float* gS = (LAS float*)(L + 36864); LAS float* bS = gS + 128; LAS float* gcS = gS + 256; LAS float* totS = gS + 384;
    LAS float* As = (LAS float*)(L + 38912);
    LAS float* CV = (LAS float*)(L + 38912);
    LAS bf16_t* UT = (LAS bf16_t*)(L + 38912); LAS bf16_t* UTd = UT + 4608; LAS bf16_t* WT = UT + 9216; LAS bf16_t* WTd = UT + 13824;
    LAS bf16_t* Tb = (LAS bf16_t*)(L + 75776);
    LAS bf16_t* At = (LAS bf16_t*)(L + 112640);
    if (t < 384) {
        const int pair = t % 96, rg = t / 96, c0 = 2 * pair, part = c0 >> 6, d0 = c0 & 63, zcol = part * 256 + h * 64 + d0;
        float cw[5][2];
#pragma unroll
        for (int j = 0; j < 5; ++j) { const float* wp = F.conv_w + (size_t)(l * 5 + j) * 768 + part * 256 + h * 64 + d0; cw[j][0] = wp[0]; cw[j][1] = wp[1]; }
        float win[20][2];
#pragma unroll
        for (int rr = 0; rr < 20; ++rr) { const int row = row0 + rg * 16 - 2 + rr; unsigned wv = 0u;
            if (row >= seg_lo && row < seg_hi) wv = *(const unsigned*)(F.Z + (size_t)row * ZW + zcol);
            win[rr][0] = bflo(wv); win[rr][1] = bfhi(wv); }
#pragma unroll
        for (int i = 0; i < 16; ++i) { float a0 = 0.f, a1 = 0.f;
#pragma unroll
            for (int j = 0; j < 5; ++j) { a0 += cw[j][0] * win[i + j][0]; a1 += cw[j][1] * win[i + j][1]; }
            CV[(rg * 16 + i) * 196 + c0] = siluf_(a0); CV[(rg * 16 + i) * 196 + c0 + 1] = siluf_(a1); }
    } else {
        const int tt = t - 384, d = tt >> 6, p = tt & 63; const bf16_t* zr = F.Z + (size_t)(row0 + p) * ZW;
        const float a = bf2f(zr[ZC_GA + d * 4 + h]), bb = bf2f(zr[ZC_GB + d * 4 + h]);
        gS[d * 64 + p] = -expf(F.a_log[l * 8 + d * 4 + h]) * softplusf_(a + F.dt_bias[l * 8 + d * 4 + h]);
        bS[d * 64 + p] = sigmoidf_(bb);
    }
    __syncthreads();
    {
        const int combo = t >> 2, sub = t & 3, row = combo & 63, part = combo >> 6;
        float v[16]; float ss = 0.f;
#pragma unroll
        for (int i = 0; i < 16; ++i) { v[i] = CV[row * 196 + part * 64 + sub * 16 + i]; ss += v[i] * v[i]; }
        ss += __shfl_xor(ss, 1); ss += __shfl_xor(ss, 2);
        const float rs = 1.0f / sqrtf(ss + EPS);
        LAS bf16_t* dst = (part == 0 ? Qs : Ks) + row * 72 + sub * 16;
        v4u o0, o1;
        o0.x = pk2(v[0] * rs, v[1] * rs); o0.y = pk2(v[2] * rs, v[3] * rs); o0.z = pk2(v[4] * rs, v[5] * rs); o0.w = pk2(v[6] * rs, v[7] * rs);
        o1.x = pk2(v[8] * rs, v[9] * rs); o1.y = pk2(v[10] * rs, v[11] * rs); o1.z = pk2(v[12] * rs, v[13] * rs); o1.w = pk2(v[14] * rs, v[15] * rs);
        *(LAS v4u*)dst = o0; *(LAS v4u*)(dst + 8) = o1;
        if (part == 1) {
#pragma unroll
            for (int i = 0; i < 16; ++i) Kt[(sub * 16 + i) * 72 + row] = (bf16_t)f2bf(v[i] * rs);
        }
        const int vrow = t & 63, dg = t >> 6;
#pragma unroll
        for (int i = 0; i < 8; ++i) Vt[(dg * 8 + i) * 72 + vrow] = (bf16_t)f2bf(CV[vrow * 196 + 128 + dg * 8 + i]);
        if (t < 128) { const int d = t >> 6, p = t & 63; float s = 0.f, tot = 0.f;
            for (int r = 0; r < 64; ++r) { const float g = gS[d * 64 + r]; tot += g; if (d == 0 ? (r <= p) : (r >= p)) s += g; }
            gcS[d * 64 + p] = s; if (p == 0) totS[d] = tot; }
    }
    __syncthreads();
#pragma unroll
    for (int k2 = 0; k2 < 2; ++k2) {
        const int tt = 2 * w + k2, mt = tt >> 2, nt = tt & 3;
        f32x4 accG = {0.f, 0.f, 0.f, 0.f}, accQ = {0.f, 0.f, 0.f, 0.f};
        accG = mma_ll<2>(Ks + mt * 16 * 72, 72, Ks + nt * 16 * 72, 72, accG, lane);
        accQ = mma_ll<2>(Ks + mt * 16 * 72, 72, Qs + nt * 16 * 72, 72, accQ, lane);
        const int n = nt * 16 + lr, m0 = mt * 16 + 4 * lq;
#pragma unroll
        for (int d = 0; d < 2; ++d) {
            const float gcn = gcS[d * 64 + n], bn = bS[d * 64 + n];
            f32x4 av, tv;
#pragma unroll
            for (int i = 0; i < 4; ++i) { const int m = m0 + i; const float gcm = gcS[d * 64 + m];
                const bool strict = d == 0 ? (m < n) : (m > n); const bool incl = d == 0 ? (m <= n) : (m >= n);
                const float e = __expf(incl ? (gcn - gcm) : 0.f);
                av[i] = strict ? bn * accG[i] * e : 0.f; tv[i] = incl ? 0.125f * accQ[i] * e : 0.f; }
            if (d == 0) *(LAS f32x4*)(As + n * 68 + m0) = av;
            else { f32x4 rv; rv[0] = av[3]; rv[1] = av[2]; rv[2] = av[1]; rv[3] = av[0]; *(LAS f32x4*)(As + 4352 + (63 - n) * 68 + 60 - m0) = rv; }
            *(LAS v2u*)(At + d * 4608 + n * 72 + m0) = pack4(tv);
        }
    }
    __syncthreads();
    if (w < 2) {
        const int d = w; const LAS float* Ad = As + d * 4352;
        float tr[64]; int lane_o = lane;
#pragma unroll
        for (int i = 0; i < 64; ++i) {
            float a0 = 0.f, a1 = 0.f, a2 = 0.f, a3 = 0.f;
#pragma unroll
            for (int j4 = 0; j4 < i; j4 += 4) {
                const f32x4 av = *(const LAS f32x4*)(Ad + i * 68 + j4);
                a0 += av[0] * tr[j4];
                if (j4 + 1 < i) a1 += av[1] * tr[j4 + 1];
                if (j4 + 2 < i) a2 += av[2] * tr[j4 + 2];
                if (j4 + 3 < i) a3 += av[3] * tr[j4 + 3];
            }
            asm volatile("" : "+v"(lane_o) :: "memory");
            tr[i] = (lane_o == i ? 1.f : 0.f) - ((a0 + a1) + (a2 + a3));
        }
        const int pb = d ? 63 - lane : lane; const float sb = bS[d * 64 + pb], sbe = sb * __expf(gcS[d * 64 + pb]);
        LAS bf16_t* T0 = Tb + d * 9216; LAS bf16_t* T1 = T0 + 4608;
#pragma unroll
        for (int i = 0; i < 64; ++i) { const int pa = d ? 63 - i : i; T0[pa * 72 + pb] = (bf16_t)f2bf(tr[i] * sb); T1[pa * 72 + pb] = (bf16_t)f2bf(tr[i] * sbe); }
    }
    __syncthreads();
#pragma unroll 1
    for (int d = 0; d < 2; ++d) {
        const int ud = u * 2 + d; const float tot = totS[d];
        const LAS bf16_t* T0 = Tb + d * 9216; const LAS bf16_t* T1 = T0 + 4608; const LAS bf16_t* Ad = At + d * 4608;
        {
            const bool isw = w >= 4; const LAS bf16_t* Aop = isw ? T1 : T0; const LAS bf16_t* Bop = isw ? Kt : Vt;
            LAS bf16_t* o0 = isw ? WT : UT; LAS bf16_t* o1 = isw ? WTd : UTd;
#pragma unroll
            for (int k4 = 0; k4 < 4; ++k4) { const int tt = (w & 3) * 4 + k4, mt = tt >> 2, nt = tt & 3;
                f32x4 acc = {0.f, 0.f, 0.f, 0.f}; acc = mma_ll<2>(Aop + mt * 16 * 72, 72, Bop + nt * 16 * 72, 72, acc, lane);
                const int n = nt * 16 + lr, m0 = mt * 16 + 4 * lq; f32x4 dv;
#pragma unroll
                for (int i = 0; i < 4; ++i) dv[i] = acc[i] * __expf(tot - gcS[d * 64 + m0 + i]);
                *(LAS v2u*)(o0 + n * 72 + m0) = pack4(acc); *(LAS v2u*)(o1 + n * 72 + m0) = pack4(dv); }
        }
        __syncthreads();
        {
            const int prod = w >> 1; bf16_t* gout = F.PG + (size_t)ud * 16384 + prod * 4096;
            const LAS bf16_t* Aop = prod == 0 ? WTd : prod == 1 ? Kt : prod == 2 ? WT : Ad;
            const LAS bf16_t* Bop = prod == 0 ? Kt : prod == 1 ? UTd : prod == 2 ? Ad : UT;
#pragma unroll
            for (int k8 = 0; k8 < 8; ++k8) { const int tt = (w & 1) * 8 + k8, mt = tt >> 2, nt = tt & 3;
                f32x4 acc = {0.f, 0.f, 0.f, 0.f}; acc = mma_ll<2>(Aop + mt * 16 * 72, 72, Bop + nt * 16 * 72, 72, acc, lane);
                const int n = nt * 16 + lr, m0 = mt * 16 + 4 * lq;
                if (prod == 2) { const f32x4 qv = unpack4(*(const LAS v2u*)(Qs + n * 72 + m0)); const float e = 0.125f * __expf(gcS[d * 64 + n]); acc = qv * e - acc; }
                const int off = (prod == 0 || prod == 2) ? ((nt * 2 + (mt >> 1)) * 64 + ((mt & 1) * 2 + (lq >> 1)) * 16 + lr) * 8 + 4 * (lq & 1) : ((mt * 4 + nt) * 64 + lane) * 4;
                *(v2u*)(gout + off) = pack4(acc); }
        }
        if (t == 0) F.GLG[ud] = __expf(tot);
        __syncthreads();
    }
}

__device__ __forceinline__ void mlstm_prep_unit(const Frame& F, int l, int u) {
    const int b = u / 144, h = (u / 36) & 3, cidx = u % 36;
    const int row0 = chunk_row0(b, cidx);
    const int t_o = F.wave * 64 + fresh_lane();
    const int t = t_o, lane = t & 63, w = __builtin_amdgcn_readfirstlane(t >> 6), lr = lane & 15, lq = lane >> 4;
    LAS unsigned char* L = F.lds;
    LAS bf16_t* Qs = (LAS bf16_t*)(L + 0); LAS bf16_t* Ks = (LAS bf16_t*)(L + 9216); LAS bf16_t* Vta = (LAS bf16_t*)(L + 18432);
    LAS bf16_t* Kte = (LAS bf16_t*)(L + 29952);
    LAS bf16_t* S0 = (LAS bf16_t*)(L + 48384);
    LAS float* igS = (LAS float*)(L + 66816); LAS float* lfS = igS + 128; LAS float* bS = igS + 256; LAS float* dmS = igS + 384; LAS float* rS = igS + 512;
    LAS float* flS = igS + 640; LAS float* eS = igS + 768; LAS float* mpS = igS + 896; LAS float* chS = igS + 904;
    {
        const int r = t >> 3, seg = t & 7; const bf16_t* zr = F.Z + (size_t)(row0 + r) * ZW + h * 64 + seg * 8;
        const v4u q = *(const v4u*)(zr + ZC_LQ), k = *(const v4u*)(zr + ZC_LK), v = *(const v4u*)(zr + ZC_LV);
        *(LAS v4u*)(Qs + r * 72 + seg * 8) = q; *(LAS v4u*)(Ks + r * 72 + seg * 8) = k;
        Vta[(seg * 8 + 0) * 72 + r] = (bf16_t)(v.x & 0xffffu); Vta[(seg * 8 + 1) * 72 + r] = (bf16_t)(v.x >> 16);
        Vta[(seg * 8 + 2) * 72 + r] = (bf16_t)(v.y & 0xffffu); Vta[(seg * 8 + 3) * 72 + r] = (bf16_t)(v.y >> 16);
        Vta[(seg * 8 + 4) * 72 + r] = (bf16_t)(v.z & 0xffffu); Vta[(seg * 8 + 5) * 72 + r] = (bf16_t)(v.z >> 16);
        Vta[(seg * 8 + 6) * 72 + r] = (bf16_t)(v.w & 0xffffu); Vta[(seg * 8 + 7) * 72 + r] = (bf16_t)(v.w >> 16);
#pragma unroll
        for (int j = 0; j < 2; ++j) { const int idx = t + 512 * j, rr = 64 + (idx >> 6), cc = idx & 63; Vta[rr * 72 + cc] = (bf16_t)(rr == 64 ? 0x3F80u : 0u); }
        if (t < 128) { const int d = t >> 6, p = t & 63; const bf16_t* zg = F.Z + (size_t)(row0 + p) * ZW;
            igS[d * 64 + p] = bf2f(zg[ZC_LI + d * 4 + h]) + F.ig_bias[l * 8 + d * 4 + h];
            lfS[d * 64 + p] = logsigf_(bf2f(zg[ZC_LF + d * 4 + h]) + F.fg_bias[l * 8 + d * 4 + h]); }
        if (t >= 128 && t < 272) chS[t - 128] = F.CHS[(size_t)((b * 4 + h) * 2) * 72 + (t - 128)];
    }
    __syncthreads();
    if (t < 128) { const int d = t >> 6, p = t & 63; float s = 0.f;
        for (int r = 0; r < 64; ++r) if (d == 0 ? (r <= p) : (r >= p)) s += lfS[d * 64 + r];
        bS[d * 64 + p] = s; }
    else if (t < 130) { const int d = t - 128; const int step_of = d ? (cidx < 4 ? 3 - cidx : 39 - cidx) : cidx; float m = 0.f;
        for (int s = 0; s < step_of; ++s) { const int ci = d ? (s < 4 ? 3 - s : 39 - s) : s; m = fmaxf(chS[d * 72 + ci * 2] + m, chS[d * 72 + ci * 2 + 1]); }
        mpS[d] = m; }
    __syncthreads();
    if (t < 128) { const int d = t >> 6, p = t & 63; float mxp = -1e30f, mxall = -1e30f;
        for (int j = 0; j < 64; ++j) { const float v = igS[d * 64 + j] - bS[d * 64 + j]; mxall = fmaxf(mxall, v); if (d == 0 ? (j <= p) : (j >= p)) mxp = fmaxf(mxp, v); }
        const float bp = bS[d * 64 + p], dmax = bp + mxp, bl = d == 0 ? bS[63] : bS[64], wsmax = bl + mxall, mprev = mpS[d];
        const float mnew = fmaxf(bl + mprev, wsmax), cd = expf(bl + mprev - mnew), e2 = expf(wsmax - mnew);
        const float mt = fmaxf(bp + mprev, dmax);
        dmS[d * 64 + p] = dmax; rS[d * 64 + p] = expf(dmax - mt); flS[d * 64 + p] = expf(-mt);
        eS[d * 64 + p] = expf(bl - bp + igS[d * 64 + p] - wsmax) * e2;
        const int ud = u * 2 + d; F.WI[ud * 64 + p] = 0.125f * expf(bp + mprev - mt); if (p == 0) F.GLM[ud] = cd; }
    __syncthreads();
    {
        const int d = t >> 8, tt = t & 255, p = tt & 63, dg = tt >> 6; const float e = eS[d * 64 + p];
#pragma unroll
        for (int i = 0; i < 16; ++i) Kte[d * 4608 + (dg * 16 + i) * 72 + p] = (bf16_t)f2bf(bf2f(Ks[p * 72 + dg * 16 + i]) * e);
#pragma unroll
        for (int k2 = 0; k2 < 2; ++k2) { const int tl = 2 * w + k2, mt = tl >> 2, nt = tl & 3;
            f32x4 acc = {0.f, 0.f, 0.f, 0.f}; acc = mma_ll<2>(Ks + mt * 16 * 72, 72, Qs + nt * 16 * 72, 72, acc, lane);
            const int n = nt * 16 + lr, m0 = mt * 16 + 4 * lq;
#pragma unroll
            for (int dd = 0; dd < 2; ++dd) { const float bn = bS[dd * 64 + n], dn = dmS[dd * 64 + n], rn = rS[dd * 64 + n]; f32x4 sv;
#pragma unroll
                for (int i = 0; i < 4; ++i) { const int m = m0 + i; const bool incl = dd == 0 ? (m <= n) : (m >= n);
                    const float arg = incl ? (bn - bS[dd * 64 + m] + igS[dd * 64 + m] - dn) : 0.f; sv[i] = incl ? 0.125f * acc[i] * __expf(arg) * rn : 0.f; }
                *(LAS v2u*)(S0 + dd * 4608 + n * 72 + m0) = pack4(sv); } }
    }
    __syncthreads();
    {
        const int d = w >> 2, ud = u * 2 + d; bf16_t* gO = F.PM + (size_t)ud * 10240; bf16_t* gB = gO + 5120;
#pragma unroll 2
        for (int k = 0; k < 10; ++k) { const int tl = (w & 3) * 10 + k; const bool iskv = tl >= 20; const int t2 = iskv ? tl - 20 : tl, mt = t2 / 5, nt = t2 % 5;
            const LAS bf16_t* Aop = (iskv ? Kte : S0) + d * 4608 + mt * 16 * 72;
            f32x4 acc = {0.f, 0.f, 0.f, 0.f}; acc = mma_ll<2>(Aop, 72, Vta + nt * 16 * 72, 72, acc, lane);
            const int n = nt * 16 + lr, m0 = mt * 16 + 4 * lq;
            if (!iskv && n == 65) {
#pragma unroll
                for (int i = 0; i < 4; ++i) acc[i] = flS[d * 64 + m0 + i]; }
            *(v2u*)((iskv ? gB : gO) + ((mt * 5 + nt) * 64 + lane) * 4) = pack4(acc); }
    }
    __syncthreads();
}

template <int NT> struct ScanOps { bf16x8 Qf[2], Mf[2]; v2u bv[NT], ov[NT]; float gl; f32x4 wi; };
template <bool GDN, int NT> __device__ __forceinline__ void scan_load(const Frame& F, int b, int h, int dir, int wq, int lr, int lq, int s, ScanOps<NT>& o) {
    const int cidx = dir ? (s < 4 ? 3 - s : 39 - s) : s;
    const int ud = ((b * 4 + h) * 36 + cidx) * 2 + dir;
    if (GDN) {
        const bf16_t* gM = F.PG + (size_t)ud * 16384; const bf16_t* gQ = gM + 8192;
#pragma unroll
        for (int ks = 0; ks < 2; ++ks) { o.Mf[ks] = *(const bf16x8*)(gM + ((wq * 2 + ks) * 64 + lq * 16 + lr) * 8); o.Qf[ks] = *(const bf16x8*)(gQ + ((wq * 2 + ks) * 64 + lq * 16 + lr) * 8); }
    } else {
        const bf16_t* zq = F.Z + (size_t)(chunk_row0(b, cidx) + 16 * wq + lr) * ZW + ZC_LQ + h * 64;
#pragma unroll
        for (int ks = 0; ks < 2; ++ks) { o.Qf[ks] = *(const bf16x8*)(zq + 32 * ks + 8 * lq); o.Mf[ks] = o.Qf[ks]; }
    }
    const bf16_t* gB = GDN ? F.PG + (size_t)ud * 16384 + 4096 : F.PM + (size_t)ud * 10240 + 5120;
    const bf16_t* gO = GDN ? F.PG + (size_t)ud * 16384 + 12288 : F.PM + (size_t)ud * 10240;
#pragma unroll
    for (int t = 0; t < NT; ++t) { o.bv[t] = *(const v2u*)(gB + ((wq * NT + t) * 64 + lq * 16 + lr) * 4); o.ov[t] = *(const v2u*)(gO + ((wq * NT + t) * 64 + lq * 16 + lr) * 4); }
    o.gl = GDN ? F.GLG[ud] : F.GLM[ud];
    o.wi = (f32x4){1.f, 1.f, 1.f, 1.f}; if (!GDN) o.wi = *(const f32x4*)(F.WI + ud * 64 + 16 * wq + 4 * lq);
}
struct ScanFin { f32x4 pend[4]; unsigned short gz[4][4]; };
template <bool GDN> __device__ __forceinline__ void scan_fin_load(const Frame& F, int b, int h, int dir, int wq, int lr, int lq, int s, const float* PEND, ScanFin& f) {
    const int cidx = dir ? (s < 4 ? 3 - s : 39 - s) : s; const int row0 = chunk_row0(b, cidx);
    const float* pp = PEND + (size_t)((b * 4 + h) * 36 + cidx) * 4096 + (wq * 256 + lq * 16 + lr) * 4;
#pragma unroll
    for (int t = 0; t < 4; ++t) { f.pend[t] = *(const f32x4*)(pp + t * 256);
#pragma unroll
        for (int i = 0; i < 4; ++i) f.gz[t][i] = F.Z[(size_t)(row0 + 16 * wq + 4 * lq + i) * ZW + (GDN ? ZC_GZ : ZC_LO) + h * 64 + 16 * t + lr]; }
}
__device__ __forceinline__ bool scan_first(int s) { return s < 4 ? (s <= 1) : (s <= 19); }
template <bool GDN> __device__ __forceinline__ void scan_finish(const Frame& F, int b, int h, int dir, int wq, int lr, int lq, int s, float* PEND, const f32x4 (&Oin)[4], const ScanFin& f, const float (&nwv)[4]) {
    const int cidx = dir ? (s < 4 ? 3 - s : 39 - s) : s; const int row0 = chunk_row0(b, cidx);
    float* pp = PEND + (size_t)((b * 4 + h) * 36 + cidx) * 4096 + (wq * 256 + lq * 16 + lr) * 4;
    if (scan_first(s)) {
#pragma unroll
        for (int t = 0; t < 4; ++t) *(f32x4*)(pp + t * 256) = Oin[t];
    } else {
        f32x4 O[4]; float ss[4] = {0.f, 0.f, 0.f, 0.f};
#pragma unroll
        for (int t = 0; t < 4; ++t)
#pragma unroll
            for (int i = 0; i < 4; ++i) { O[t][i] = Oin[t][i] + f.pend[t][i]; ss[i] += O[t][i] * O[t][i]; }
#pragma unroll
        for (int i = 0; i < 4; ++i) { ss[i] += __shfl_xor(ss[i], 1); ss[i] += __shfl_xor(ss[i], 2); ss[i] += __shfl_xor(ss[i], 4); ss[i] += __shfl_xor(ss[i], 8); ss[i] = 1.0f / sqrtf(ss[i] * (1.f / 64.f) + EPS); }
#pragma unroll
        for (int t = 0; t < 4; ++t) { const int dv = 16 * t + lr;
#pragma unroll
            for (int i = 0; i < 4; ++i) { const int row = row0 + 16 * wq + 4 * lq + i;
                const float g = bf2f(f.gz[t][i]);
                const float gate = GDN ? siluf_(g) : sigmoidf_(g);
                F.MIX[(size_t)row * 1024 + (GDN ? 0 : 768) + h * 64 + dv] = (bf16_t)f2bf(O[t][i] * ss[i] * nwv[t] * gate); } }
    }
}
template <bool GDN> __device__ __forceinline__ void scan_wg(const Frame& F, int l, int bh) {
    constexpr int NT = GDN ? 4 : 5;
    const int b = bh >> 2, h = bh & 3;
    const int lane = fresh_lane(), dir = F.wave >> 2, wq = F.wave & 3, lr = lane & 15, lq = lane >> 4;
    LAS bf16_t* St = (LAS bf16_t*)F.lds;
    f32x4 S[NT];
#pragma unroll
    for (int t = 0; t < NT; ++t) S[t] = (f32x4){0.f, 0.f, 0.f, 0.f};
    const float* nw = GDN ? F.gdn_norm_w + l * 64 : F.mlstm_norm_w + l * 256 + h * 64;
    float nwv[4];
#pragma unroll
    for (int t = 0; t < 4; ++t) nwv[t] = nw[16 * t + lr];
    float* PEND = F.PEND + (GDN ? (size_t)0 : (size_t)1152 * 4096);
    ScanOps<NT> cur, nxt; ScanFin fcur, fprev;
    f32x4 Oprev[4];
#pragma unroll
    for (int t = 0; t < 4; ++t) { Oprev[t] = (f32x4){0.f, 0.f, 0.f, 0.f}; fcur.pend[t] = (f32x4){0.f, 0.f, 0.f, 0.f}; fprev.pend[t] = (f32x4){0.f, 0.f, 0.f, 0.f};
#pragma unroll
        for (int i = 0; i < 4; ++i) { fcur.gz[t][i] = 0; fprev.gz[t][i] = 0; } }
    scan_load<GDN, NT>(F, b, h, dir, wq, lr, lq, 0, cur);
#pragma unroll 1
    for (int s = 0; s < 37; ++s) {
        LAS bf16_t* Sb = St + ((dir * 2 + (s & 1)) * 80) * 72;
        if (s < 36) {
#pragma unroll
            for (int t = 0; t < NT; ++t) *(LAS v2u*)(Sb + (16 * t + lr) * 72 + 16 * wq + 4 * lq) = pack4(S[t]); }
        VM_WAIT();
        __syncthreads();
        if (s > 0) {
            const int sp = s - 1;
            if (sp == 20 || sp == 2) scan_fin_load<GDN>(F, b, h, dir, wq, lr, lq, sp, PEND, fprev);
            scan_finish<GDN>(F, b, h, dir, wq, lr, lq, sp, PEND, Oprev, fprev, nwv);
        }
        if (s == 36) break;
        scan_load<GDN, NT>(F, b, h, dir, wq, lr, lq, s < 35 ? s + 1 : 35, nxt);
        if (!scan_first(s) && s != 20 && s != 2) scan_fin_load<GDN>(F, b, h, dir, wq, lr, lq, s, PEND, fcur);
        f32x4 O[NT];
#pragma unroll
        for (int t = 0; t < NT; ++t) {
            const LAS bf16_t* sp = Sb + (16 * t + lr) * 72 + 8 * lq;
            const bf16x8 s0 = *(const LAS bf16x8*)sp, s1 = *(const LAS bf16x8*)(sp + 32);
            f32x4 o = {0.f, 0.f, 0.f, 0.f};
            o = __builtin_amdgcn_mfma_f32_16x16x32_bf16(cur.Qf[0], s0, o, 0, 0, 0); o = __builtin_amdgcn_mfma_f32_16x16x32_bf16(cur.Qf[1], s1, o, 0, 0, 0);
            const f32x4 bv = unpack4(cur.bv[t]), ov = unpack4(cur.ov[t]);
            if (GDN) {
                f32x4 ms = {0.f, 0.f, 0.f, 0.f};
                ms = __builtin_amdgcn_mfma_f32_16x16x32_bf16(cur.Mf[0], s0, ms, 0, 0, 0); ms = __builtin_amdgcn_mfma_f32_16x16x32_bf16(cur.Mf[1], s1, ms, 0, 0, 0);
                S[t] = S[t] * cur.gl - ms + bv; O[t] = o + ov;
            } else { S[t] = S[t] * cur.gl + bv; O[t] = o * cur.wi + ov; }
        }
        if (!GDN) {
#pragma unroll
            for (int i = 0; i < 4; ++i) { const float den = __shfl(O[NT - 1][i], lane & 48), fl = __shfl(O[NT - 1][i], (lane & 48) + 1); const float dv = 1.0f / fmaxf(fabsf(den), fl);
#pragma unroll
                for (int t = 0; t < 4; ++t) O[t][i] *= dv; }
        }
#pragma unroll
        for (int t = 0; t < 4; ++t) Oprev[t] = O[t];
        fprev = fcur; cur = nxt;
    }
    VM_WAIT();
    __syncthreads();
}

__device__ __forceinline__ void swa_unit(const Frame& F, int l, int it) {
    const bool lat = it < 256; int b, kvh, qb;
    if (lat) { b = it >> 5; kvh = (it >> 4) & 1; qb = it & 15; } else { const int j = it - 256; b = j >> 2; kvh = (j >> 1) & 1; qb = j & 1; }
    const int t_o = F.wave * 64 + fresh_lane();
    const int t = t_o, lane = t & 63, w = __builtin_amdgcn_readfirstlane(t >> 6), lr = lane & 15, lq = lane >> 4;
    const int hq = kvh * 2 + (w >> 2), wrow = (w & 3) * 32;
    const int qrow = (lat ? b * SEQ : MLAT + b * CTXL) + qb * 128 + wrow;
    LAS bf16_t* Ksh = (LAS bf16_t*)F.lds; LAS bf16_t* Vt = Ksh + 4608; LAS bf16_t* Pw = Ksh + 9216 + w * 2304;
    bf16x8 Qf[2][2];
#pragma unroll
    for (int mt = 0; mt < 2; ++mt)
#pragma unroll
        for (int ks = 0; ks < 2; ++ks) Qf[mt][ks] = *(const bf16x8*)(F.Z + (size_t)(qrow + mt * 16 + lr) * ZW + ZC_SQ + hq * 64 + 32 * ks + 8 * lq);
    const float sk = F.sink[l * 4 + hq];
    float mi[2][4], li[2][4]; f32x4 O[2][4];
#pragma unroll
    for (int mt = 0; mt < 2; ++mt)
#pragma unroll
        for (int i = 0; i < 4; ++i) { mi[mt][i] = sk; li[mt][i] = 1.f; O[mt][i] = (f32x4){0.f, 0.f, 0.f, 0.f}; }
    const int ntile = lat ? 10 : 4;
#pragma unroll 1
    for (int kt = 0; kt < ntile; ++kt) {
        int krow, kpos0 = 0; bool masked = false;
        if (lat && kt < 6) { kpos0 = (qb - 1) * 128 + kt * 64; if (kpos0 < 0 || kpos0 >= SEQ) continue; krow = b * SEQ + kpos0; masked = true; }
        else { const int cj = lat ? kt - 6 : kt; krow = MLAT + b * CTXL + cj * 64; }
        __syncthreads();
        { const int r = t >> 3, seg = t & 7; const bf16_t* zr = F.Z + (size_t)(krow + r) * ZW + kvh * 64 + seg * 8;
          const v4u k = *(const v4u*)(zr + ZC_SK), v = *(const v4u*)(zr + ZC_SV);
          *(LAS v4u*)(Ksh + r * 72 + seg * 8) = k;
          Vt[(seg * 8 + 0) * 72 + r] = (bf16_t)(v.x & 0xffffu); Vt[(seg * 8 + 1) * 72 + r] = (bf16_t)(v.x >> 16);
          Vt[(seg * 8 + 2) * 72 + r] = (bf16_t)(v.y & 0xffffu); Vt[(seg * 8 + 3) * 72 + r] = (bf16_t)(v.y >> 16);
          Vt[(seg * 8 + 4) * 72 + r] = (bf16_t)(v.z & 0xffffu); Vt[(seg * 8 + 5) * 72 + r] = (bf16_t)(v.z >> 16);
          Vt[(seg * 8 + 6) * 72 + r] = (bf16_t)(v.w & 0xffffu); Vt[(seg * 8 + 7) * 72 + r] = (bf16_t)(v.w >> 16); }
        __syncthreads();
        f32x4 sc[2][4];
#pragma unroll
        for (int nt = 0; nt < 4; ++nt) { const LAS bf16_t* kp = Ksh + (nt * 16 + lr) * 72 + 8 * lq; const bf16x8 k0 = *(const LAS bf16x8*)kp, k1 = *(const LAS bf16x8*)(kp + 32);
#pragma unroll
            for (int mt = 0; mt < 2; ++mt) { f32x4 a = {0.f, 0.f, 0.f, 0.f};
                a = __builtin_amdgcn_mfma_f32_16x16x32_bf16(Qf[mt][0], k0, a, 0, 0, 0); a = __builtin_amdgcn_mfma_f32_16x16x32_bf16(Qf[mt][1], k1, a, 0, 0, 0); sc[mt][nt] = a; } }
#pragma unroll
        for (int mt = 0; mt < 2; ++mt) {
            float mx[4] = {-1e30f, -1e30f, -1e30f, -1e30f};
#pragma unroll
            for (int nt = 0; nt < 4; ++nt)
#pragma unroll
                for (int i = 0; i < 4; ++i) {
                    if (masked) { const int qpos = qb * 128 + wrow + mt * 16 + 4 * lq + i, kpos = kpos0 + nt * 16 + lr; const int dd = qpos - kpos; if (dd > 128 || dd < -128) sc[mt][nt][i] = -1e30f; }
                    mx[i] = fmaxf(mx[i], sc[mt][nt][i]); }
#pragma unroll
            for (int i = 0; i < 4; ++i) { mx[i] = fmaxf(mx[i], __shfl_xor(mx[i], 1)); mx[i] = fmaxf(mx[i], __shfl_xor(mx[i], 2)); mx[i] = fmaxf(mx[i], __shfl_xor(mx[i], 4)); mx[i] = fmaxf(mx[i], __shfl_xor(mx[i], 8)); }
            float al[4], rsum[4];
#pragma unroll
            for (int i = 0; i < 4; ++i) { const float mn = fmaxf(mi[mt][i], mx[i]); al[i] = __expf(mi[mt][i] - mn); mi[mt][i] = mn; rsum[i] = 0.f; }
#pragma unroll
            for (int nt = 0; nt < 4; ++nt)
#pragma unroll
                for (int i = 0; i < 4; ++i) { const float p = __expf(sc[mt][nt][i] - mi[mt][i]); rsum[i] += p; Pw[(mt * 16 + 4 * lq + i) * 72 + nt * 16 + lr] = (bf16_t)f2bf(p); }
#pragma unroll
            for (int i = 0; i < 4; ++i) { rsum[i] += __shfl_xor(rsum[i], 1); rsum[i] += __shfl_xor(rsum[i], 2); rsum[i] += __shfl_xor(rsum[i], 4); rsum[i] += __shfl_xor(rsum[i], 8); li[mt][i] = li[mt][i] * al[i] + rsum[i]; }
#pragma unroll
            for (int nt = 0; nt < 4; ++nt)
#pragma unroll
                for (int i = 0; i < 4; ++i) O[mt][nt][i] *= al[i];
        }
        LDS_WAIT(); asm volatile("" ::: "memory");
#pragma unroll
        for (int nt = 0; nt < 4; ++nt) { const LAS bf16_t* vp = Vt + (nt * 16 + lr) * 72 + 8 * lq; const bf16x8 v0 = *(const LAS bf16x8*)vp, v1 = *(const LAS bf16x8*)(vp + 32);
#pragma unroll
            for (int mt = 0; mt < 2; ++mt) { const LAS bf16_t* pp = Pw + (mt * 16 + lr) * 72 + 8 * lq; const bf16x8 p0 = *(const LAS bf16x8*)pp, p1 = *(const LAS bf16x8*)(pp + 32);
                O[mt][nt] = __builtin_amdgcn_mfma_f32_16x16x32_bf16(p0, v0, O[mt][nt], 0, 0, 0); O[mt][nt] = __builtin_amdgcn_mfma_f32_16x16x32_bf16(p1, v1, O[mt][nt], 0, 0, 0); } }
    }
#pragma unroll
    for (int mt = 0; mt < 2; ++mt)
#pragma unroll
        for (int i = 0; i < 4; ++i) { const float inv = 1.0f / li[mt][i]; bf16_t* orow = F.MIX + (size_t)(qrow + mt * 16 + 4 * lq + i) * 1024 + 256 + hq * 64 + lr;
#pragma unroll
            for (int nt = 0; nt < 4; ++nt) orow[nt * 16] = (bf16_t)f2bf(O[mt][nt][i] * inv); }
    __syncthreads();
}

__device__ __forceinline__ void gmlp_unit(const Frame& F, int l, int it) {
    const int b = it / 72, c = (it >> 2) % 18, g = it & 3;
    const int r0 = c < 16 ? b * SEQ + c * 128 : MLAT + b * CTXL + (c - 16) * 128;
    const int t_o = F.wave * 64 + fresh_lane();
    const int t = t_o, lane = t & 63, w = __builtin_amdgcn_readfirstlane(t >> 6), lr = lane & 15, lq = lane >> 4;
    LAS bf16_t* Vt = (LAS bf16_t*)F.lds;
#pragma unroll
    for (int j = 0; j < 2; ++j) { const int idx = t + 512 * j, q = idx >> 3, seg = idx & 7;
        const v4u v = *(const v4u*)(F.Z + (size_t)(r0 + q) * ZW + ZC_MV + g * 64 + seg * 8);
        Vt[(seg * 8 + 0) * 136 + q] = (bf16_t)(v.x & 0xffffu); Vt[(seg * 8 + 1) * 136 + q] = (bf16_t)(v.x >> 16);
        Vt[(seg * 8 + 2) * 136 + q] = (bf16_t)(v.y & 0xffffu); Vt[(seg * 8 + 3) * 136 + q] = (bf16_t)(v.y >> 16);
        Vt[(seg * 8 + 4) * 136 + q] = (bf16_t)(v.z & 0xffffu); Vt[(seg * 8 + 5) * 136 + q] = (bf16_t)(v.z >> 16);
        Vt[(seg * 8 + 6) * 136 + q] = (bf16_t)(v.w & 0xffffu); Vt[(seg * 8 + 7) * 136 + q] = (bf16_t)(v.w >> 16); }
    __syncthreads();
    bf16x8 Af[4];
#pragma unroll
    for (int ks = 0; ks < 4; ++ks) Af[ks] = *(const bf16x8*)(F.WSP + (size_t)g * 16384 + (16 * w + lr) * 128 + 32 * ks + 8 * lq);
    f32x4 bsv = *(const f32x4*)(F.b_s + (size_t)(l * 4 + g) * 128 + 16 * w + 4 * lq);
#pragma unroll
    for (int nt = 0; nt < 4; ++nt) { f32x4 acc = {0.f, 0.f, 0.f, 0.f};
#pragma unroll
        for (int ks = 0; ks < 4; ++ks) { const bf16x8 bfr = *(const LAS bf16x8*)(Vt + (nt * 16 + lr) * 136 + 32 * ks + 8 * lq); acc = __builtin_amdgcn_mfma_f32_16x16x32_bf16(Af[ks], bfr, acc, 0, 0, 0); }
#pragma unroll
        for (int i = 0; i < 4; ++i) { const int row = r0 + 16 * w + 4 * lq + i, col = g * 64 + nt * 16 + lr;
            const float uv = bf2f(F.Z[(size_t)row * ZW + ZC_MU + col]);
            F.MIX[(size_t)row * 1024 + 512 + col] = (bf16_t)f2bf(uv * (acc[i] + bsv[i])); } }
    __syncthreads();
}

#ifndef PROBE_KIND
#define PROBE_KIND -1
#endif
#ifndef ONLY_CASE
#define ONLY_CASE -1
#endif
struct Args { const float* in[24]; float* out; unsigned char* ws; int ph_lo, ph_hi; };
constexpr int NPH = 2 + 9 * DEPTH;
__global__ void __launch_bounds__(NWAVES * 64, 2) mk_fwd(Args args) {
    extern __shared__ __attribute__((aligned(16))) unsigned char lds[];
    const int wave_s = __builtin_amdgcn_readfirstlane((int)threadIdx.x >> 6);
    const int tid_ = wave_s * 64 + fresh_lane();
    volatile LAS unsigned* MISC = (volatile LAS unsigned*)((LAS unsigned char*)lds + MISC_OFF);
    if (tid_ < 32) MISC[tid_] = 0u;
    __syncthreads();
    unsigned* barw = (unsigned*)(args.ws + WS_CTL) + CW_BAR;
    XcdBarrier bar; bar.bar = barw; bar.x = 0; bar.st = nullptr;
    const int lo = args.ph_lo, hi = args.ph_hi;
    if (hi - lo > 1) bar = xcd_barrier_post(barw, MISC + 8, tid_);

#pragma unroll 1
    for (int ph = lo; ph < hi; ++ph) {
        int zero; asm volatile("s_mov_b32 %0, 0" : "=s"(zero));
        Frame F;
        F.lds = (LAS unsigned char*)lds;
        F.wave = wave_s;
        F.G = gridDim.x; F.gw = blockIdx.x * NWAVES + F.wave; F.NGW = F.G * NWAVES;
        const float* const* inp = args.in + zero;
        F.x = inp[0]; F.c = inp[1]; F.ctx = inp[2]; F.cctx = inp[3]; F.ada_w = inp[4]; F.ada_b = inp[5]; F.norm1_w = inp[6]; F.norm2_w = inp[7];
        F.w_in = inp[8]; F.w_out = inp[9]; F.conv_w = inp[10]; F.a_log = inp[11]; F.dt_bias = inp[12]; F.gdn_norm_w = inp[13]; F.sink = inp[14];
        F.w_s = inp[15]; F.b_s = inp[16]; F.gmlp_norm_w = inp[17]; F.ig_bias = inp[18]; F.fg_bias = inp[19]; F.mlstm_norm_w = inp[20];
        F.w1 = inp[21]; F.w2 = inp[22]; F.final_w = inp[23];
        unsigned char* ws = args.ws + zero;
        F.out = args.out + zero; F.ws = ws;
        F.MOD = (float*)(ws + WS_MOD); F.XC = (float*)(ws + WS_XC); F.CHS = (float*)(ws + WS_CHS); F.GLG = (float*)(ws + WS_GLG); F.GLM = F.GLG + 2304; F.WI = F.GLG + 4608;
        F.PEND = (float*)(ws + WS_H);
        F.WIN = (bf16_t*)(ws + WS_WIN); F.WOUT = (bf16_t*)(ws + WS_WOUT); F.W1 = (bf16_t*)(ws + WS_W1); F.W2 = (bf16_t*)(ws + WS_W2); F.WSP = (bf16_t*)(ws + WS_WSP);
        F.H = (bf16_t*)(ws + WS_H); F.MIX = (bf16_t*)(ws + WS_MIX); F.Z = (bf16_t*)(ws + WS_Z); F.PG = (bf16_t*)(ws + WS_PG); F.PM = (bf16_t*)(ws + WS_PM); F.HID = (bf16_t*)(ws + WS_HID);
        int kind, l;
        if (ph == 0) { kind = 0; l = 0; } else if (ph == NPH - 1) { kind = 10; l = DEPTH - 1; } else { l = (ph - 1) / 9; kind = 1 + (ph - 1) % 9; }
        const bool last = (l == DEPTH - 1);
        const int Mrows = last ? MLAT : MALL;
        const int nrep = (kind == PROBE_KIND) ? 2 : 1;
#pragma unroll 1
        for (int rep = 0; rep < nrep; ++rep) {
        if (rep) xcd_barrier(bar, wave_s * 64 + fresh_lane());
        switch (kind) {
        case 0: if (ONLY_CASE >= 0 && ONLY_CASE != 0) break; phase_mod(F); break;
        case 1: if (ONLY_CASE >= 0 && ONLY_CASE != 1) break; convert_weights(F, l); phase_norm(F, l, 0, MALL); break;
        case 2: if (ONLY_CASE >= 0 && ONLY_CASE != 2) break; { pg8::Gemm g{F.H, F.WIN, MALL, ZW, D}; pg8::StaticOrder S; S.init(MALL, ZW, F.G, (int)blockIdx.x);
                  pg8::EpiBf16<0> E{F.Z, ZW}; pg8::gemm_phase<pg8::EpiBf16<0>, pg8::StaticOrder, true, true>(F.lds, g, S, E, wave_s * 64 + fresh_lane()); } break;
        case 3: if (ONLY_CASE >= 0 && ONLY_CASE != 3) break; for (int rg = blockIdx.x; rg < MALL / 16 + 288; rg += F.G) { if (rg < MALL / 16) ew_unit(F, l, rg); else chs_unit(F, l, rg - MALL / 16); } break;
        case 4: if (ONLY_CASE >= 0 && ONLY_CASE != 4) break; for (int it = blockIdx.x; it < 2304; it += F.G) { if (it < 1152) { if (!rep || PROBE_SUB != 2) gdn_prep_unit(F, l, it); } else { if (!rep || PROBE_SUB != 1) mlstm_prep_unit(F, l, it - 1152); } } break;
        case 5: if (ONLY_CASE >= 0 && ONLY_CASE != 5) break; { const int bx = blockIdx.x;
                  if (bx < 32) { if (!rep || PROBE_SUB == 0 || PROBE_SUB == 1) scan_wg<true>(F, l, bx); }
                  else if (bx < 64) { if (!rep || PROBE_SUB == 0 || PROBE_SUB == 1 || PROBE_SUB == 4) scan_wg<false>(F, l, bx - 32); }
                  else for (int it = bx - 64; it < 288 + 576; it += F.G - 64) { if (it < 288) { if (!rep || PROBE_SUB == 0 || PROBE_SUB == 2) swa_unit(F, l, it); } else { if (!rep || PROBE_SUB == 0 || PROBE_SUB == 3) gmlp_unit(F, l, it - 288); } } } break;
        case 6: case 9: { if (ONLY_CASE >= 0 && ONLY_CASE != 6) break; const bool isout = (kind == 6);
                  pg8::Gemm g{isout ? F.MIX : F.HID, isout ? F.WOUT : F.W2, Mrows, D, isout ? D : FF}; pg8::StaticOrder S; S.init(Mrows, D, F.G, (int)blockIdx.x);
                  pg8::EpiResid E{rep ? (float*)(F.ws + WS_H) : F.out, rep ? (float*)(F.ws + WS_H) + (size_t)MLAT * 1024 : F.XC, F.MOD + (size_t)l * 9 * 6144 + (isout ? 2 : 5) * 1024};
                  pg8::gemm_phase<pg8::EpiResid, pg8::StaticOrder, true, true>(F.lds, g, S, E, wave_s * 64 + fresh_lane()); } break;
        case 7: if (ONLY_CASE >= 0 && ONLY_CASE != 7) break; phase_norm(F, l, 1, Mrows); break;
        case 8: if (ONLY_CASE >= 0 && ONLY_CASE != 8) break; { pg8::Gemm g{F.H, F.W1, Mrows, FF, D}; pg8::StaticOrder S; S.init(Mrows, FF, F.G, (int)blockIdx.x);
                  pg8::EpiBf16<1> E{F.HID, FF}; pg8::gemm_phase<pg8::EpiBf16<1>, pg8::StaticOrder, true, true>(F.lds, g, S, E, wave_s * 64 + fresh_lane()); } break;
        default: { const bool poison = (hi - lo > 1) && (__hip_atomic_load(barw + XB_TMO, __ATOMIC_RELAXED, __HIP_MEMORY_SCOPE_AGENT) != 0u); phase_final(F, poison); } break;
        }
        }
        if (ph + 1 < hi) xcd_barrier(bar, wave_s * 64 + fresh_lane());
    }
}

extern "C" void kernel_launch(void* const* d_in, const int* in_sizes, int n_in, void* d_out, int out_size, void* d_ws, size_t ws_size, hipStream_t stream) {
    static int grid = 0;
    if (grid == 0) {
        if (n_in != 24 || out_size != MLAT * D || ws_size < WS_END) { fprintf(stderr, "kernel_launch: unexpected shapes: n_in %d out %d ws %zu (need %zu)\n", n_in, out_size, ws_size, (size_t)WS_END); grid = -1; return; }
        int dev = 0, cus = 0, per_cu = 0;
        if (hipGetDevice(&dev) != hipSuccess || hipDeviceGetAttribute(&cus, hipDeviceAttributeMultiprocessorCount, dev) != hipSuccess) { grid = -1; return; }
        if (hipFuncSetAttribute((const void*)mk_fwd, hipFuncAttributeMaxDynamicSharedMemorySize, LDS_BYTES) != hipSuccess) { fprintf(stderr, "kernel_launch: hipFuncSetAttribute failed\n"); grid = -1; return; }
        if (hipOccupancyMaxActiveBlocksPerMultiprocessor(&per_cu, (const void*)mk_fwd, NWAVES * 64, LDS_BYTES) != hipSuccess || per_cu < 1) { fprintf(stderr, "kernel_launch: occupancy query says %d\n", per_cu); grid = -1; return; }
        (void)hipGetLastError();
        grid = cus;
        if (grid < 128) { fprintf(stderr, "kernel_launch: device too small (%d CUs)\n", grid); grid = -1; return; }
    }
    if (grid < 0) return;
    (void)hipMemsetAsync((char*)d_ws + WS_CTL, 0, CTL_ZERO_BYTES, stream);
    Args a{};
    for (int i = 0; i < 24; ++i) a.in[i] = (const float*)d_in[i];
    a.out = (float*)d_out; a.ws = (unsigned char*)d_ws;
#if MK_PER_PHASE
    for (int p = 0; p < NPH; ++p) { a.ph_lo = p; a.ph_hi = p + 1; hipLaunchKernelGGL(mk_fwd, dim3(grid), dim3(NWAVES * 64), LDS_BYTES, stream, a); }
#else
    a.ph_lo = 0; a.ph_hi = NPH;
    void* kargs[] = {&a};
    hipError_t e = hipLaunchCooperativeKernel((const void*)mk_fwd, dim3(grid), dim3(NWAVES * 64), kargs, LDS_BYTES, stream);
    if (e != hipSuccess) fprintf(stderr, "kernel_launch: cooperative launch failed: %s (grid %d)\n", hipGetErrorString(e), grid);
#endif
}
```

```cpp
#include <hip/hip_runtime.h>
#include <cstdio>
#include <cstdint>
#ifndef MK_PER_PHASE
#define MK_PER_PHASE 0
#endif
#define PROBE_KIND -1
#define PROBE_SUB 0
namespace pg8 {
#define PG8_LAS __attribute__((address_space(3)))
typedef unsigned short bf16_t;
typedef short bf16x8 __attribute__((ext_vector_type(8)));
typedef float f32x4 __attribute__((ext_vector_type(4)));
typedef unsigned u32x4 __attribute__((ext_vector_type(4)));
constexpr int BM = 256, BK = 64, HALF = 128, HTB = HALF * BK * 2  , STAGE_BYTES = 8 * HTB, NXCD = 8, WGM = 8;

__host__ __device__ __forceinline__ int lds_byte(int r, int c) { const int st = (r >> 4) * 2 + (c >> 5), rr = r & 15, cc = c & 31, ob = rr * 64 + cc * 2; return st * 1024 + (ob ^ (((ob >> 9) & 1) << 5)); }
__host__ __device__ __forceinline__ void stage_rc(int b, int& R, int& C) { const int st = b / 1024, sb = b % 1024, swz = sb ^ (((sb >> 9) & 1) << 5); R = (st >> 1) * 16 + swz / 64; C = (st & 1) * 32 + (swz % 64) / 2; }
__host__ __device__ __forceinline__ int perm32(int rho) { const int n = rho >> 4, i = rho & 15; return 8 * (i >> 2) + 4 * n + (i & 3); }

struct Unit { int pm, pn, kofs, nt, slab; };
struct Gemm { const bf16_t* A; const bf16_t* Bt; int M, N, K, lda, ldb; };

struct StaticOrder {
    int nM, nN, nwg, G, c, ntk, nsp, nsplit, kslice, pm0;
    __host__ __device__ void init(int M, int N, int K, int G_, int c_) { nM = M / BM; nN = N / BM; nwg = nM * nN; G = G_; c = c_; ntk = K / BK; nsp = 0; nsplit = 1; kslice = K; pm0 = nM; }
    __host__ __device__ void add_split(int npanels, int nsplit_, int K) { nsplit = nsplit_; kslice = K / nsplit_; nsp = npanels * nN * nsplit_; }
    __host__ __device__ void map(long L, Unit& u) const {
        int wgid = (int)L; { const int q = nwg / NXCD, r = nwg % NXCD, xcd = wgid % NXCD, off = wgid / NXCD; wgid = (xcd < r ? xcd * (q + 1) : r * (q + 1) + (xcd - r) * q) + off; }
        const int nig = WGM * nN, gid = wgid / nig, fm = gid * WGM, gsz = (nM - fm) < WGM ? (nM - fm) : WGM;
        u.pm = fm + ((wgid % nig) % gsz); u.pn = (wgid % nig) / gsz; u.kofs = 0; u.nt = ntk; u.slab = 0;
    }
    __host__ __device__ bool next(int i, Unit& u) const {
        const long L = (long)i * G + c;
        if (L < nwg) { map(L, u); return true; }
        const long J = L - nwg; if (J >= nsp) return false;
        const int ks = (int)(J % nsplit), tile = (int)(J / nsplit);
        u.pn = tile % nN; u.pm = pm0 + tile / nN; u.kofs = ks * kslice; u.nt = kslice / BK; u.slab = ks + 1; return true;
    }
    __device__ __forceinline__ void a_ready(const Unit&) const {}
    __device__ __forceinline__ void done(const Unit&) const {}
};

__device__ __forceinline__ unsigned cvt_pk_bf16(float lo, float hi) { unsigned r; asm volatile("v_cvt_pk_bf16_f32 %0, %1, %2" : "=v"(r) : "v"(lo), "v"(hi)); return r; }

template <int ACT  > struct EpiBf16 {
    static constexpr bool PERM = true, AFTER_DRAIN = false;
    bf16_t* O; int ldc;
    __device__ __forceinline__ void operator()(const f32x4 (&acc)[2][2][4][2], const Unit& u, int wr, int wc, int fr, int fq) const {
        const int row0 = u.pm * BM + wr * 64 + fr; const int col0 = u.pn * BM + wc * 32 + 8 * fq;
#pragma unroll
        for (int ai = 0; ai < 2; ++ai)
#pragma unroll
            for (int m = 0; m < 4; ++m) { bf16_t* rowp = O + (size_t)(row0 + ai * HALF + m * 16) * ldc + col0;
#pragma unroll
                for (int bj = 0; bj < 2; ++bj) { f32x4 v0 = acc[ai][bj][m][0], v1 = acc[ai][bj][m][1];
                    if (ACT == 1) {
#pragma unroll
                        for (int e = 0; e < 4; ++e) { float a = fmaxf(v0[e], 0.f), b = fmaxf(v1[e], 0.f); v0[e] = a * a; v1[e] = b * b; } }
                    u32x4 w; w.x = cvt_pk_bf16(v0[0], v0[1]); w.y = cvt_pk_bf16(v0[2], v0[3]); w.z = cvt_pk_bf16(v1[0], v1[1]); w.w = cvt_pk_bf16(v1[2], v1[3]);
                    *(u32x4*)(rowp + bj * HALF) = w; } }
    }
};

struct EpiResid {
    static constexpr bool PERM = false, AFTER_DRAIN = false;
    float* xlat; float* xctx; const float* gmod; float* slab;
    __device__ __forceinline__ void operator()(const f32x4 (&acc)[2][2][4][2], const Unit& u, int wr, int wc, int fr, int fq) const {
        if (u.slab) {
            float* sb = slab + (size_t)(u.slab - 1) * 2048 * 1024 + (size_t)(u.pm - 64) * BM * 1024 + u.pn * BM + wc * 32 + 4 * fq;
#pragma unroll
            for (int ai = 0; ai < 2; ++ai)
#pragma unroll
                for (int m = 0; m < 4; ++m) { float* rowp = sb + (size_t)(ai * HALF + wr * 64 + m * 16 + fr) * 1024;
#pragma unroll
                    for (int bj = 0; bj < 2; ++bj)
#pragma unroll
                        for (int n = 0; n < 2; ++n) *(f32x4*)(rowp + bj * HALF + n * 16) = acc[ai][bj][m][n]; }
            return;
        }
        const int bm = u.pm < 64 ? (u.pm >> 3) : 8;
        float* base = u.pm < 64 ? xlat + (size_t)u.pm * BM * 1024 : xctx + (size_t)(u.pm - 64) * BM * 1024;
        const float* g = gmod + bm * 6144;
        const int col0 = u.pn * BM + wc * 32 + 4 * fq;
        f32x4 gv[2][2];
#pragma unroll
        for (int bj = 0; bj < 2; ++bj)
#pragma unroll
            for (int n = 0; n < 2; ++n) gv[bj][n] = *(const f32x4*)(g + col0 + bj * HALF + n * 16);
#pragma unroll
        for (int ai = 0; ai < 2; ++ai)
#pragma unroll
            for (int m = 0; m < 4; ++m) { float* rowp = base + (size_t)(ai * HALF + wr * 64 + m * 16 + fr) * 1024 + col0;
                f32x4 xv[2][2];
#pragma unroll
                for (int bj = 0; bj < 2; ++bj)
#pragma unroll
                    for (int n = 0; n < 2; ++n) xv[bj][n] = *(const f32x4*)(rowp + bj * HALF + n * 16);
#pragma unroll
                for (int bj = 0; bj < 2; ++bj)
#pragma unroll
                    for (int n = 0; n < 2; ++n) *(f32x4*)(rowp + bj * HALF + n * 16) = xv[bj][n] + gv[bj][n] * acc[ai][bj][m][n];
                if (m & 1) asm volatile("" ::: "memory"); }
    }
};

template <class Epi, class Sched, bool ALIGN_EPI = false, bool SP2 = false>
__device__ __forceinline__ void gemm_phase(PG8_LAS unsigned char* lds, const Gemm g, const Sched& S, const Epi& E, int tid_in) {
    int tid_o = tid_in; asm volatile("" : "+v"(tid_o)); const int tid = tid_o, wid = __builtin_amdgcn_readfirstlane(tid >> 6), lane = tid & 63, wr = wid >> 2, wc = wid & 3, fr = lane & 15, fq = lane >> 4;
    const int lda = g.lda, ldb = g.ldb;
    unsigned voffA[2], voffB[2];
#pragma unroll
    for (int i = 0; i < 2; ++i) { int R, C; stage_rc(tid * 16 + i * 8192, R, C); const int Rb = Epi::PERM ? ((R & ~31) + perm32(R & 31)) : R;
        voffA[i] = (unsigned)(R * lda + C) * 2u; voffB[i] = (unsigned)(Rb * ldb + C) * 2u; }
    const size_t kstep = (size_t)(BK * 2);
    const size_t hstepA = (size_t)HALF * lda * 2, hstepB = (size_t)HALF * ldb * 2;
    const size_t tstepA = 2 * hstepA, tstepB = 2 * hstepB;
    const unsigned ldsw = (unsigned)wid * 1024u;
    const int aoff = lds_byte(wr * 64 + fr, fq * 8), boff = lds_byte(wc * 32 + fr, fq * 8);
#define PG8_SA(b, h) (((b) * 2 + (h)) * HTB)
#define PG8_SB(b, h) ((4 + (b) * 2 + (h)) * HTB)
#define PG8_STAGE(bufoff, gbase, voff) do { _Pragma("unroll") for (int _i = 0; _i < 2; ++_i) \
        __builtin_amdgcn_global_load_lds((const unsigned*)((const char*)(gbase) + (voff)[_i]), (PG8_LAS unsigned*)(lds + (bufoff) + ldsw + _i * 8192), 16, 0, 0); } while (0)
#define PG8_LDA(dst, b, h) do { _Pragma("unroll") for (int m = 0; m < 4; ++m) _Pragma("unroll") for (int k = 0; k < 2; ++k) dst[m][k] = *(const PG8_LAS bf16x8*)(lds + PG8_SA(b, h) + aoff + m * 2048 + k * 1024); } while (0)
#define PG8_LDB(dst, b, h) do { _Pragma("unroll") for (int n = 0; n < 2; ++n) _Pragma("unroll") for (int k = 0; k < 2; ++k) dst[n][k] = *(const PG8_LAS bf16x8*)(lds + PG8_SB(b, h) + boff + n * 2048 + k * 1024); } while (0)
#define PG8_MMA(ai, bj, At, Bt) do { __builtin_amdgcn_s_setprio(1); _Pragma("unroll") for (int m = 0; m < 4; ++m) _Pragma("unroll") for (int n = 0; n < 2; ++n) _Pragma("unroll") for (int k = 0; k < 2; ++k) \
        acc[ai][bj][m][n] = __builtin_amdgcn_mfma_f32_16x16x32_bf16(Bt[n][k], At[m][k], acc[ai][bj][m][n], 0, 0, 0); __builtin_amdgcn_s_setprio(0); } while (0)
#define PG8_WAIT_V(n) asm volatile("s_waitcnt vmcnt(" #n ")" ::: "memory")
#define PG8_WAIT_L(n) asm volatile("s_waitcnt lgkmcnt(" #n ")" ::: "memory")
#define PG8_BAR __builtin_amdgcn_s_barrier()
#define PG8_SCHED __builtin_amdgcn_sched_barrier(0)
    Unit cur, nxt; int ui = 0;
    if (!S.next(0, cur)) return;
    f32x4 acc[2][2][4][2];
#pragma unroll
    for (int a = 0; a < 2; ++a)
#pragma unroll
        for (int b = 0; b < 2; ++b)
#pragma unroll
            for (int m = 0; m < 4; ++m)
#pragma unroll
                for (int n = 0; n < 2; ++n) acc[a][b][m][n] = (f32x4){0.f, 0.f, 0.f, 0.f};
    bf16x8 At[4][2], B0[2][2], B1[2][2];
    const char* cA = (const char*)g.A + (size_t)cur.pm * tstepA + (size_t)cur.kofs * 2; const char* cB = (const char*)g.Bt + (size_t)cur.pn * tstepB + (size_t)cur.kofs * 2;
    S.a_ready(cur);
    if constexpr (SP2) {
        PG8_STAGE(PG8_SB(0, 0), cB, voffB); PG8_STAGE(PG8_SB(0, 1), cB + hstepB, voffB); PG8_STAGE(PG8_SA(0, 0), cA, voffA); PG8_STAGE(PG8_SA(0, 1), cA + hstepA, voffA);
        if (wr == 1) PG8_BAR;
        PG8_WAIT_V(2); PG8_BAR;
        PG8_STAGE(PG8_SB(1, 0), cB + kstep, voffB); PG8_STAGE(PG8_SA(1, 0), cA + kstep, voffA); PG8_STAGE(PG8_SB(1, 1), cB + hstepB + kstep, voffB);
        PG8_WAIT_V(6); PG8_BAR;
    } else {
        PG8_STAGE(PG8_SB(0, 0), cB, voffB); PG8_STAGE(PG8_SA(0, 0), cA, voffA); PG8_STAGE(PG8_SB(0, 1), cB + hstepB, voffB); PG8_STAGE(PG8_SA(0, 1), cA + hstepA, voffA);
        if (wr == 1) PG8_BAR;
        PG8_WAIT_V(4); PG8_BAR;
        PG8_STAGE(PG8_SB(1, 0), cB + kstep, voffB); PG8_STAGE(PG8_SA(1, 0), cA + kstep, voffA); PG8_STAGE(PG8_SB(1, 1), cB + hstepB + kstep, voffB);
        PG8_WAIT_V(6); PG8_BAR;
    }
    for (;;) {
        const bool has_next = S.next(ui + 1, nxt);
        const char* nA = has_next ? (const char*)g.A + (size_t)nxt.pm * tstepA + (size_t)nxt.kofs * 2 : cA; const char* nB = has_next ? (const char*)g.Bt + (size_t)nxt.pn * tstepB + (size_t)nxt.kofs * 2 : cB;
        const int nt = cur.nt;
        for (int t = 0; t < nt; t += 2) {
            const bool last = (t == nt - 2);
            const char* a1 = cA + (size_t)(t + 1) * kstep;
            const char* a2 = last ? nA : cA + (size_t)(t + 2) * kstep; const char* b2 = last ? nB : cB + (size_t)(t + 2) * kstep;
            const char* a3 = a2 + kstep; const char* b3 = b2 + kstep;
            if (last && has_next) S.a_ready(nxt);
            if constexpr (SP2) {
            PG8_LDB(B0, 0, 0); PG8_LDB(B1, 0, 1); PG8_SCHED; PG8_LDA(At, 0, 0); PG8_STAGE(PG8_SA(1, 1), a1 + hstepA, voffA);
            PG8_WAIT_V(8); PG8_WAIT_L(0); PG8_BAR; PG8_MMA(0, 0, At, B0); PG8_MMA(0, 1, At, B1); PG8_BAR; PG8_SCHED;
            PG8_LDA(At, 0, 1); PG8_STAGE(PG8_SB(0, 0), b2, voffB); PG8_STAGE(PG8_SB(0, 1), b2 + hstepB, voffB); PG8_STAGE(PG8_SA(0, 0), a2, voffA);
            PG8_WAIT_V(8); PG8_WAIT_L(0); PG8_BAR; PG8_MMA(1, 0, At, B0); PG8_MMA(1, 1, At, B1); PG8_BAR; PG8_SCHED;
            PG8_LDB(B0, 1, 0); PG8_LDB(B1, 1, 1); PG8_SCHED; PG8_LDA(At, 1, 0); PG8_STAGE(PG8_SA(0, 1), a2 + hstepA, voffA);
            PG8_WAIT_V(8); PG8_WAIT_L(0); PG8_BAR; PG8_MMA(0, 0, At, B0); PG8_MMA(0, 1, At, B1); PG8_BAR; PG8_SCHED;
            PG8_LDA(At, 1, 1); PG8_STAGE(PG8_SB(1, 0), b3, voffB); PG8_STAGE(PG8_SB(1, 1), b3 + hstepB, voffB); PG8_STAGE(PG8_SA(1, 0), a3, voffA);
            PG8_WAIT_V(8); PG8_WAIT_L(0); PG8_BAR; PG8_MMA(1, 0, At, B0); PG8_MMA(1, 1, At, B1); PG8_BAR; PG8_SCHED;
            } else {
            PG8_LDB(B0, 0, 0); PG8_SCHED; PG8_LDA(At, 0, 0); PG8_STAGE(PG8_SA(1, 1), a1 + hstepA, voffA);
            PG8_WAIT_L(8); PG8_BAR; PG8_WAIT_L(0); PG8_MMA(0, 0, At, B0); PG8_BAR; PG8_SCHED;
            PG8_LDB(B1, 0, 1); PG8_STAGE(PG8_SB(0, 0), b2, voffB);
            PG8_BAR; PG8_WAIT_L(0); PG8_MMA(0, 1, At, B1); PG8_BAR;
            PG8_LDA(At, 0, 1); PG8_STAGE(PG8_SA(0, 0), a2, voffA);
            PG8_BAR; PG8_WAIT_L(0); PG8_MMA(1, 0, At, B0); PG8_BAR; PG8_SCHED;
            PG8_STAGE(PG8_SB(0, 1), b2 + hstepB, voffB);
            PG8_WAIT_V(6); PG8_BAR; PG8_MMA(1, 1, At, B1); PG8_BAR;
            PG8_LDB(B0, 1, 0); PG8_SCHED; PG8_LDA(At, 1, 0); PG8_STAGE(PG8_SA(0, 1), a2 + hstepA, voffA);
            PG8_WAIT_L(8); PG8_BAR; PG8_WAIT_L(0); PG8_MMA(0, 0, At, B0); PG8_BAR; PG8_SCHED;
            PG8_LDB(B1, 1, 1); PG8_STAGE(PG8_SB(1, 0), b3, voffB);
            PG8_BAR; PG8_WAIT_L(0); PG8_MMA(0, 1, At, B1); PG8_BAR;
            PG8_LDA(At, 1, 1); PG8_STAGE(PG8_SA(1, 0), a3, voffA);
            PG8_BAR; PG8_WAIT_L(0); PG8_MMA(1, 0, At, B0); PG8_BAR; PG8_SCHED;
            PG8_STAGE(PG8_SB(1, 1), b3 + hstepB, voffB);
            PG8_WAIT_V(6); PG8_BAR; PG8_MMA(1, 1, At, B1); PG8_BAR;
            }
        }
        if constexpr (ALIGN_EPI) { if (wr == 0) PG8_BAR; }
        if constexpr (!Epi::AFTER_DRAIN) { E(acc, cur, wr, wc, fr, fq); S.done(cur); }
        if (!has_next) break;
#pragma unroll
        for (int a = 0; a < 2; ++a)
#pragma unroll
            for (int b = 0; b < 2; ++b)
#pragma unroll
                for (int m = 0; m < 4; ++m)
#pragma unroll
                    for (int n = 0; n < 2; ++n) acc[a][b][m][n] = (f32x4){0.f, 0.f, 0.f, 0.f};
        cur = nxt; cA = nA; cB = nB; ++ui;
        if constexpr (ALIGN_EPI) { if (wr == 1) PG8_BAR; }
    }
    PG8_WAIT_V(0);
    if constexpr (!ALIGN_EPI) { if (wr == 0) PG8_BAR; }
    PG8_BAR;
    if constexpr (Epi::AFTER_DRAIN) { E.fused(acc, cur, wr, wc, fr, fq, lds, wid, lane); S.done(cur); }
#undef PG8_SA
#undef PG8_SB
#undef PG8_STAGE
#undef PG8_LDA
#undef PG8_LDB
#undef PG8_MMA
#undef PG8_WAIT_V
#undef PG8_WAIT_L
#undef PG8_BAR
#undef PG8_SCHED
}
}
constexpr int NWAVES = 8;
constexpr int NB = 8, SEQ = 2048, CTXL = 256, D = 1024, DEPTH = 4, FF = 4096;
constexpr int MLAT = NB * SEQ, MCTX = NB * CTXL, MALL = MLAT + MCTX;
constexpr int ZW = 3328;
constexpr int ZC_GQ = 0, ZC_GK = 256, ZC_GV = 512, ZC_GZ = 768, ZC_SQ = 1024, ZC_SK = 1280, ZC_SV = 1408, ZC_MU = 1536, ZC_MV = 1792,
              ZC_LQ = 2048, ZC_LK = 2304, ZC_LV = 2560, ZC_LO = 2816, ZC_GA = 3072, ZC_GB = 3080, ZC_LI = 3088, ZC_LF = 3096;
constexpr float EPS = 1e-6f;
constexpr size_t MiB = 1u << 20;
constexpr size_t WS_CTL = 0, CTL_ZERO_BYTES = 65536;
constexpr size_t WS_MOD = 1 * MiB;
constexpr size_t WS_WIN = 2 * MiB, WS_WOUT = 9 * MiB, WS_W1 = 11 * MiB, WS_W2 = 19 * MiB, WS_WSP = 27 * MiB;
constexpr size_t WS_CHS = 27 * MiB + 512 * 1024;
constexpr size_t WS_GLG = 27 * MiB + 768 * 1024;
constexpr size_t WS_XC = 29 * MiB;
constexpr size_t WS_H = 37 * MiB;
constexpr size_t WS_MIX = 73 * MiB;
constexpr size_t WS_Z = 109 * MiB;
constexpr size_t WS_PG = 226 * MiB;
constexpr size_t WS_PM = 298 * MiB;
constexpr size_t WS_HID = 109 * MiB;
constexpr size_t WS_SLAB = 254 * MiB;
constexpr size_t WS_END = 343 * MiB;
constexpr int NSPLIT_OUT = 4, NSPLIT_2 = 8;
constexpr int CW_BAR = 1024;
constexpr int LDS_BYTES = 147456;
constexpr int MISC_OFF = 131072 + 8192;

#define LAS __attribute__((address_space(3)))
typedef unsigned short bf16_t;
typedef unsigned v4u __attribute__((ext_vector_type(4)));
typedef unsigned v2u __attribute__((ext_vector_type(2)));
typedef float f32x4 __attribute__((ext_vector_type(4)));
typedef short bf16x8 __attribute__((ext_vector_type(8)));
#define LDS_WAIT() asm volatile("s_waitcnt lgkmcnt(0)" ::: "memory")
#define VM_WAIT() asm volatile("s_waitcnt vmcnt(0)" ::: "memory")
__device__ __forceinline__ unsigned f2bf(float f) { unsigned u = __builtin_bit_cast(unsigned, f); return (u + 0x7fffu + ((u >> 16) & 1u)) >> 16; }
__device__ __forceinline__ unsigned pk2(float lo, float hi) { return f2bf(lo) | (f2bf(hi) << 16); }
__device__ __forceinline__ float bf2f(unsigned v) { return __builtin_bit_cast(float, v << 16); }
__device__ __forceinline__ float bflo(unsigned w) { return __builtin_bit_cast(float, w << 16); }
__device__ __forceinline__ float bfhi(unsigned w) { return __builtin_bit_cast(float, w & 0xffff0000u); }
__device__ __forceinline__ float wave_sum(float v) {
#pragma unroll
    for (int o = 1; o < 64; o <<= 1) v += __shfl_xor(v, o);
    return v;
}
__device__ __forceinline__ float frcp(float x) { return __builtin_amdgcn_rcpf(x); }
__device__ __forceinline__ float frsq(float x) { return __builtin_amdgcn_rsqf(x); }
__device__ __forceinline__ float fexp(float x) { return __builtin_amdgcn_exp2f(x * 1.4426950408889634f); }
__device__ __forceinline__ float flog1p(float y) { return y < 0.02f ? y * (1.0f - y * (0.5f - y * (0.33333333f - 0.25f * y))) : __builtin_amdgcn_logf(1.0f + y) * 0.6931471805599453f; }
__device__ __forceinline__ float sigmoidf_(float x) { return frcp(1.f + fexp(-x)); }
__device__ __forceinline__ float siluf_(float x) { return x * frcp(1.f + fexp(-x)); }
__device__ __forceinline__ float softplusf_(float x) { return x > 20.f ? x : flog1p(fexp(x)); }
__device__ __forceinline__ float logsigf_(float x) { return x >= 0.f ? -flog1p(fexp(-x)) : x - flog1p(fexp(x)); }
__device__ __forceinline__ float geluf_(float x) { const float u = 0.7978845608028654f * (x + 0.044715f * x * x * x); const float th = 1.0f - 2.0f * frcp(1.0f + fexp(2.0f * u)); return 0.5f * x * (1.f + th); }
template <int KS> __device__ __forceinline__ f32x4 mma_ll(const LAS bf16_t* A, int lda, const LAS bf16_t* Bt, int ldb, f32x4 acc, int lane) {
    const LAS bf16_t* ap = A + (lane & 15) * lda + 8 * (lane >> 4);
    const LAS bf16_t* bp = Bt + (lane & 15) * ldb + 8 * (lane >> 4);
#pragma unroll
    for (int ks = 0; ks < KS; ++ks) {
        const bf16x8 a = *(const LAS bf16x8*)(ap + 32 * ks); const bf16x8 b = *(const LAS bf16x8*)(bp + 32 * ks);
        acc = __builtin_amdgcn_mfma_f32_16x16x32_bf16(a, b, acc, 0, 0, 0);
    }
    return acc;
}
__device__ __forceinline__ v2u pack4(const f32x4 v) { v2u r; r.x = pk2(v[0], v[1]); r.y = pk2(v[2], v[3]); return r; }
__device__ __forceinline__ f32x4 unpack4(const v2u w) { f32x4 r; r[0] = bflo(w.x); r[1] = bfhi(w.x); r[2] = bflo(w.y); r[3] = bfhi(w.y); return r; }
__device__ __forceinline__ int chunk_row0(int b, int cidx) { return cidx < 4 ? MLAT + b * CTXL + cidx * 64 : b * SEQ + (cidx - 4) * 64; }

#define XB_TMO      128
#define XB_XCNT(j)  (256  + 64 * (j))
#define XB_XSUB(j)  (1280 + 64 * (j))
#define XB_XGEN(j)  (2304 + 64 * (j))
#define XB_TOP      3328
#define XB_TOPGEN   3392
#define XCD_BAR_WORDS 3456
#define XB_SPIN_CAP (1u << 18)

__device__ __forceinline__ unsigned xb_ld(unsigned* p)              { return __hip_atomic_load(p, __ATOMIC_RELAXED, __HIP_MEMORY_SCOPE_AGENT); }
__device__ __forceinline__ unsigned xb_add(unsigned* p, unsigned v) { return __hip_atomic_fetch_add(p, v, __ATOMIC_RELAXED, __HIP_MEMORY_SCOPE_AGENT); }
__device__ __forceinline__ unsigned xb_xcc_id() { return (unsigned)__builtin_amdgcn_s_getreg((3 << 11) | 20) & 0xFu; }
#define XB_SPIN(cond, bar) do { unsigned _sp = 0; while (cond) { __builtin_amdgcn_s_sleep(1); \
    if ((++_sp & 255u) == 0u) { if (xb_ld(&(bar)[XB_TMO])) break; if (_sp > XB_SPIN_CAP) { atomicAdd(&(bar)[XB_TMO], 1u); break; } } } } while (0)

struct XcdBarrier {
    unsigned* bar; unsigned x;
    volatile LAS unsigned* st;
};

__device__ __forceinline__ XcdBarrier xcd_barrier_post(unsigned* bar, volatile LAS unsigned* st, int tid) {
    XcdBarrier b; b.bar = bar; b.x = xb_xcc_id(); b.st = st;
    if (tid == 0) (void)xb_add(&bar[XB_XCNT(b.x)], 1u);
    return b;
}
__device__ __forceinline__ void xcd_barrier_complete(unsigned* bar, unsigned x, unsigned& nloc, unsigned& nx) {
    const unsigned G = gridDim.x * gridDim.y * gridDim.z;
    unsigned sum, cnt, mine, sp = 0u;
    for (;;) {
        sum = 0u; cnt = 0u; mine = 0u;
#pragma unroll
        for (unsigned j = 0; j < 16; ++j) { const unsigned c = xb_ld(&bar[XB_XCNT(j)]); sum += c; cnt += (c > 0u) ? 1u : 0u; mine = (j == x) ? c : mine; }
        if (sum == G) break;
        __builtin_amdgcn_s_sleep(1);
        if ((++sp & 255u) == 0u) { if (xb_ld(&bar[XB_TMO])) break; if (sp > XB_SPIN_CAP) { atomicAdd(&bar[XB_TMO], 1u); break; } }
    }
    nloc = mine > 0u ? mine : 1u; nx = cnt > 0u ? cnt : 1u;
}

__device__ __forceinline__ void xcd_barrier(const XcdBarrier& b, int tid) {
    asm volatile("s_waitcnt vmcnt(0)" ::: "memory");
    __syncthreads();
    if (tid == 0) {
        unsigned* bar = b.bar;
        __builtin_amdgcn_s_waitcnt(0);
        unsigned nloc = b.st[0], nx = b.st[1];
        if (nloc == 0u) { xcd_barrier_complete(bar, b.x, nloc, nx); b.st[0] = nloc; b.st[1] = nx; }
        const unsigned old = xb_add(&bar[XB_XSUB(b.x)], 1u);
        const unsigned gen = old / nloc;
        if (old + 1u == (gen + 1u) * nloc) {
            __builtin_amdgcn_fence(__ATOMIC_RELEASE, "agent");
            asm volatile("s_waitcnt vmcnt(0)" ::: "memory");
            const unsigned og = xb_add(&bar[XB_TOP], 1u);
            const unsigned tg = og / nx;
            if (og + 1u == (tg + 1u) * nx) xb_add(&bar[XB_TOPGEN], 1u);
            else XB_SPIN(xb_ld(&bar[XB_TOPGEN]) == tg, bar);
            __builtin_amdgcn_fence(__ATOMIC_ACQUIRE, "agent");
            xb_add(&bar[XB_XGEN(b.x)], 1u);
            asm volatile("s_waitcnt vmcnt(0)" ::: "memory");
        } else {
            XB_SPIN(xb_ld(&bar[XB_XGEN(b.x)]) == gen, bar);
            __builtin_amdgcn_fence(__ATOMIC_ACQUIRE, "agent");
            asm volatile("s_waitcnt vmcnt(0)" ::: "memory");
        }
    }
    __syncthreads();
}

struct Frame {
    LAS unsigned char* lds;
    int wave, G, gw, NGW;
    const float *x, *c, *ctx, *cctx, *ada_w, *ada_b, *norm1_w, *norm2_w, *w_in, *w_out, *conv_w, *a_log, *dt_bias, *gdn_norm_w, *sink, *w_s, *b_s,
                *gmlp_norm_w, *ig_bias, *fg_bias, *mlstm_norm_w, *w1, *w2, *final_w;
    float* out; unsigned char* ws;
    float *MOD, *XC, *CHS, *GLG, *GLM, *WI, *PEND, *SLAB;
    bf16_t *WIN, *WOUT, *W1, *W2, *WSP, *H, *MIX, *Z, *PG, *PM, *HID;
};

__device__ __forceinline__ int fresh_lane() { int t; asm volatile("v_mbcnt_lo_u32_b32 %0, -1, 0\n\tv_mbcnt_hi_u32_b32 %0, -1, %0" : "=v"(t)); return t; }
__device__ __forceinline__ void phase_mod(const Frame& F) {
    LAS float* sact = (LAS float*)F.lds;
    const int lane0 = fresh_lane(), tid0 = F.wave * 64 + lane0;
    for (int i = tid0; i < 9 * 1024; i += NWAVES * 64) { const float v = i < 8192 ? F.c[i] : F.cctx[i - 8192]; sact[i] = v * frcp(1.f + fexp(-v)); }
    __syncthreads();
    for (int task = F.gw; task < DEPTH * 384; task += F.NGW) {
        const int lane = fresh_lane();
        const int l = task / 384, cg = task % 384, col = cg * 16 + (lane & 15), kq = lane >> 4;
        const float* w = F.ada_w + (size_t)l * 1024 * 6144 + col;
        float acc[9];
#pragma unroll
        for (int b = 0; b < 9; ++b) acc[b] = 0.f;
#pragma unroll 4
        for (int k = kq; k < 1024; k += 4) { const float wv = w[(size_t)k * 6144];
#pragma unroll
            for (int b = 0; b < 9; ++b) acc[b] += sact[b * 1024 + k] * wv; }
#pragma unroll
        for (int b = 0; b < 9; ++b) { acc[b] += __shfl_xor(acc[b], 16); acc[b] += __shfl_xor(acc[b], 32); }
        if (kq == 0) { const float bias = F.ada_b[l * 6144 + col];
#pragma unroll
            for (int b = 0; b < 9; ++b) F.MOD[(l * 9 + b) * 6144 + col] = acc[b] + bias; }
    }
    __syncthreads();
}

__device__ __forceinline__ void transpose_item(const float* W, int K, int N, int Ndst, bf16_t* WT, LAS float* scr, int item, int lane, bool remap) {
    const int nblk = Ndst / 32, kb = item / nblk, nb = item % nblk, k0 = 64 * kb, n0 = 32 * nb;
    const int n = n0 + (lane & 31);
    const int src = remap ? (n < 1024 ? n : n < 3072 ? n + 16 : n < 3088 ? n - 2048 : n < 3104 ? n : -1) : n;
#pragma unroll 8
    for (int i = 0; i < 32; ++i) { const int kk = 2 * i + (lane >> 5); scr[kk * 33 + (lane & 31)] = src >= 0 ? W[(size_t)(k0 + kk) * N + src] : 0.f; }
    LDS_WAIT(); asm volatile("" ::: "memory");
    const int c = lane & 7;
#pragma unroll
    for (int j = 0; j < 4; ++j) { const int nn = (lane >> 3) + 8 * j; const LAS float* s = scr + (8 * c) * 33 + nn;
        v4u o; o.x = pk2(s[0 * 33], s[1 * 33]); o.y = pk2(s[2 * 33], s[3 * 33]); o.z = pk2(s[4 * 33], s[5 * 33]); o.w = pk2(s[6 * 33], s[7 * 33]);
        *(v4u*)(WT + (size_t)(n0 + nn) * K + k0 + 8 * c) = o; }
    LDS_WAIT(); asm volatile("" ::: "memory");
}
__device__ __forceinline__ void convert_weights(const Frame& F, int l) {
    LAS float* scr = (LAS float*)(F.lds + F.wave * 16384);
    constexpr int I_IN = 16 * (ZW / 32), I_OUT = 16 * 32, I_1 = 16 * 128, I_2 = 64 * 32, I_S = 128;
    for (int it = F.gw; it < I_IN + I_OUT + I_1 + I_2 + I_S; it += F.NGW) {
        int r = it; const int lane = fresh_lane();
        if (r < I_IN) { transpose_item(F.w_in + (size_t)l * 1024 * 3104, 1024, 3104, ZW, F.WIN, scr, r, lane, true); continue; } r -= I_IN;
        if (r < I_OUT) { transpose_item(F.w_out + (size_t)l * 1024 * 1024, 1024, 1024, 1024, F.WOUT, scr, r, lane, false); continue; } r -= I_OUT;
        if (r < I_1) { transpose_item(F.w1 + (size_t)l * 1024 * 4096, 1024, 4096, 4096, F.W1, scr, r, lane, false); continue; } r -= I_1;
        if (r < I_2) { transpose_item(F.w2 + (size_t)l * 4096 * 1024, 4096, 1024, 1024, F.W2, scr, r, lane, false); continue; } r -= I_2;
        { const float* s = F.w_s + (size_t)l * 65536 + r * 512 + lane * 8; const f32x4 a = *(const f32x4*)s, b = *(const f32x4*)(s + 4);
          v4u o; o.x = pk2(a[0], a[1]); o.y = pk2(a[2], a[3]); o.z = pk2(b[0], b[1]); o.w = pk2(b[2], b[3]); *(v4u*)(F.WSP + r * 512 + lane * 8) = o; }
    }
}

__device__ __forceinline__ void phase_norm(const Frame& F, int l, int which, int nrows, int nslab, const float* sgate) {
    const float* nwp = (which == 0 ? F.norm1_w : F.norm2_w) + l * 1024;
    const bool init = (which == 0 && l == 0);
    for (int m = F.gw; m < nrows; m += F.NGW) {
        const int lane = fresh_lane();
        const bool lat = m < MLAT; const int bm = lat ? (m >> 11) : 8;
        float* xrow = lat ? F.out + (size_t)m * 1024 : F.XC + (size_t)(m - MLAT) * 1024;
        const float* src = init ? (lat ? F.x + (size_t)m * 1024 : F.ctx + (size_t)(m - MLAT) * 1024) : xrow;
        const float* mod = F.MOD + (l * 9 + bm) * 6144 + (which == 0 ? 0 : 3 * 1024);
        f32x4 v[4]; float s = 0.f;
#pragma unroll
        for (int j = 0; j < 4; ++j) v[j] = *(const f32x4*)(src + 256 * j + 4 * lane);
        const bool red = !lat && nslab > 0;
        if (red) {
#pragma unroll
            for (int j = 0; j < 4; ++j) { f32x4 a = {0.f, 0.f, 0.f, 0.f};
                for (int k = 0; k < nslab; ++k) a += *(const f32x4*)(F.SLAB + ((size_t)k * MCTX + (m - MLAT)) * 1024 + 256 * j + 4 * lane);
                v[j] += a * *(const f32x4*)(sgate + 256 * j + 4 * lane); }
        }
#pragma unroll
        for (int j = 0; j < 4; ++j) s += (v[j][0] * v[j][0] + v[j][1] * v[j][1]) + (v[j][2] * v[j][2] + v[j][3] * v[j][3]);
        const float rstd = frsq(wave_sum(s) * (1.f / 1024.f) + EPS);
#pragma unroll
        for (int j = 0; j < 4; ++j) {
            const int col = 256 * j + 4 * lane;
            if (init || red) *(f32x4*)(xrow + col) = v[j];
            const f32x4 nw = *(const f32x4*)(nwp + col), sh = *(const f32x4*)(mod + col), sc = *(const f32x4*)(mod + 1024 + col);
            const f32x4 hh = (v[j] * rstd * nw) * (sc + 1.0f) + sh;
            *(v2u*)(F.H + (size_t)m * 1024 + col) = pack4(hh);
        }
    }
}
__device__ __forceinline__ void phase_final(const Frame& F, bool poison) {
    for (int m = F.gw; m < MLAT; m += F.NGW) {
        const int lane = fresh_lane();
        float* xrow = F.out + (size_t)m * 1024;
        f32x4 v[4]; float s = 0.f;
#pragma unroll
        for (int j = 0; j < 4; ++j) { v[j] = *(const f32x4*)(xrow + 256 * j + 4 * lane); s += (v[j][0] * v[j][0] + v[j][1] * v[j][1]) + (v[j][2] * v[j][2] + v[j][3] * v[j][3]); }
        float rstd = frsq(wave_sum(s) * (1.f / 1024.f) + EPS);
        if (poison) rstd = __builtin_nanf("");
#pragma unroll
        for (int j = 0; j < 4; ++j) { const int col = 256 * j + 4 * lane; const f32x4 nw = *(const f32x4*)(F.final_w + col); *(f32x4*)(xrow + col) = v[j] * rstd * nw; }
    }
}

__device__ __forceinline__ void ew_unit(const Frame& F, int l, int rg) {
    const int r0 = rg * 16;
    const int t_o = F.wave * 64 + fresh_lane();
    const int tid = t_o, lane_ = t_o & 63, wave_ = __builtin_amdgcn_readfirstlane(t_o >> 6);
#pragma unroll 1
    for (int j = 0; j < 6; ++j) {
        const int idx = tid + 512 * j, rr = idx / 192, pr = idx % 192, hd = pr >> 5, f = pr & 31, row = r0 + rr;
        const int col = (hd < 4 ? ZC_SQ + hd * 64 : ZC_SK + (hd - 4) * 64) + f;
        bf16_t* p = F.Z + (size_t)row * ZW + col;
        if (row < MLAT) {
            const int t = row & (SEQ - 1); const float pos = (float)(f < 16 ? (t >> 6) : (t & 63));
            const float inv = __builtin_amdgcn_exp2f(-(float)(f & 15) * 0.8304820237218406f);
            const float ang = pos * inv; const float rev = ang * 0.15915494309189535f; const float cs = __builtin_amdgcn_cosf(rev), sn = __builtin_amdgcn_sinf(rev);
            const float t1 = bf2f(p[0]), t2 = bf2f(p[32]); const float sc = hd < 4 ? 0.125f : 1.0f;
            p[0] = (bf16_t)f2bf((t1 * cs - t2 * sn) * sc); p[32] = (bf16_t)f2bf((t1 * sn + t2 * cs) * sc);
        } else if (hd < 4) {
            p[0] = (bf16_t)f2bf(bf2f(p[0]) * 0.125f); p[32] = (bf16_t)f2bf(bf2f(p[32]) * 0.125f);
        }
    }
#pragma unroll 1
    for (int j = 0; j < 2; ++j) {
        const int row = r0 + 2 * wave_ + j;
        bf16_t* pu = F.Z + (size_t)row * ZW + ZC_MU + 4 * lane_; bf16_t* pv = F.Z + (size_t)row * ZW + ZC_MV + 4 * lane_;
        f32x4 u = unpack4(*(const v2u*)pu), v = unpack4(*(const v2u*)pv); float ss = 0.f;
#pragma unroll
        for (int e = 0; e < 4; ++e) { u[e] = geluf_(u[e]); v[e] = geluf_(v[e]); ss += v[e] * v[e]; }
        const float rs = frsq(wave_sum(ss) * (1.f / 256.f) + EPS);
        const f32x4 nw = *(const f32x4*)(F.gmlp_norm_w + l * 256 + 4 * lane_);
        *(v2u*)pu = pack4(u); *(v2u*)pv = pack4(v * rs * nw);
    }
}
__device__ __forceinline__ void chs_unit(const Frame& F, int l, int ck) {
    const int b = ck / 36, cidx = ck % 36, row0 = chunk_row0(b, cidx);
    const int t = F.wave * 64 + fresh_lane();
    LAS float* G = (LAS float*)F.lds;
#pragma unroll
    for (int j = 0; j < 2; ++j) { const int idx = t + 512 * j, p = idx >> 4, c = idx & 15, dh = c & 7;
        const float raw = bf2f(F.Z[(size_t)(row0 + p) * ZW + ZC_LI + c]);
        G[c * 64 + p] = c < 8 ? raw + F.ig_bias[l * 8 + dh] : logsigf_(raw + F.fg_bias[l * 8 + dh]); }
    __syncthreads();
    if (t < 8) { const int d = t >> 2, h = t & 3; float bsum = 0.f, mx = -1e30f;
        for (int i = 0; i < 64; ++i) { const int p = d ? 63 - i : i; bsum += G[(8 + t) * 64 + p]; mx = fmaxf(mx, G[t * 64 + p] - bsum); }
        float* o = F.CHS + ((((b * 4 + h) * 2 + d) * 36) + cidx) * 2; o[0] = bsum; o[1] = bsum + mx; }
    __syncthreads();
}

__device__ __forceinline__ void gdn_prep_unit(const Frame& F, int l, int u) {
    const int b = u / 144, h = (u / 36) & 3, cidx = u % 36;
    const int row0 = chunk_row0(b, cidx);
    const int seg_lo = cidx < 4 ? MLAT + b * CTXL : b * SEQ, seg_hi = seg_lo + (cidx < 4 ? CTXL : SEQ);
    const int t_o = F.wave * 64 + fresh_lane();
    const int t = t_o, lane = t & 63, w = __builtin_amdgcn_readfirstlane(t >> 6), lr = lane & 15, lq = lane >> 4;
    LAS unsigned char* L = F.lds;
    LAS bf16_t* Qs = (LAS bf16_t*)(L + 0); LAS bf16_t* Ks = (LAS bf16_t*)(L + 9216); LAS bf16_t* Kt = (LAS bf16_t*)(L + 18432); LAS bf16_t* Vt = (LAS bf16_t*)(L + 27648);
    LAS float* gS = (LAS float*)(L + 36864); LAS float* bS = gS + 128; LAS float* gcS = gS + 256; LAS float* totS = gS + 384;
    LAS float* As = (LAS float*)(L + 38912);
    LAS float* CV = (LAS float*)(L + 38912);
    LAS bf16_t* UT = (LAS bf16_t*)(L + 38912); LAS bf16_t* UTd = UT + 4608; LAS bf16_t* WT = UT + 9216; LAS bf16_t* WTd = UT + 13824;
    LAS bf16_t* Tb = (LAS bf16_t*)(L + 75776);
    LAS bf16_t* At = (LAS bf16_t*)(L + 112640);
    if (t < 384) {
        const int pair = t % 96, rg = t / 96, c0 = 2 * pair, part = c0 >> 6, d0 = c0 & 63, zcol = part * 256 + h * 64 + d0;
        float cw[5][2];
#pragma unroll
        for (int j = 0; j < 5; ++j) { const float* wp = F.conv_w + (size_t)(l * 5 + j) * 768 + part * 256 + h * 64 + d0; cw[j][0] = wp[0]; cw[j][1] = wp[1]; }
        float win[20][2];
#pragma unroll
        for (int rr = 0; rr < 20; ++rr) { const int row = row0 + rg * 16 - 2 + rr; unsigned wv = 0u;
            if (row >= seg_lo && row < seg_hi) wv = *(const unsigned*)(F.Z + (size_t)row * ZW + zcol);
            win[rr][0] = bflo(wv); win[rr][1] = bfhi(wv); }
#pragma unroll
        for (int i = 0; i < 16; ++i) { float a0 = 0.f, a1 = 0.f;
#pragma unroll
            for (int j = 0; j < 5; ++j) { a0 += cw[j][0] * win[i + j][0]; a1 += cw[j][1] * win[i + j][1]; }
            CV[(rg * 16 + i) * 196 + c0] = siluf_(a0); CV[(rg * 16 + i) * 196 + c0 + 1] = siluf_(a1); }
    } else {
        const int tt = t - 384, d = tt >> 6, p = tt & 63; const bf16_t* zr = F.Z + (size_t)(row0 + p) * ZW;
        const float a = bf2f(zr[ZC_GA + d * 4 + h]), bb = bf2f(zr[ZC_GB + d * 4 + h]);
        gS[d * 64 + p] = -fexp(F.a_log[l * 8 + d * 4 + h]) * softplusf_(a + F.dt_bias[l * 8 + d * 4 + h]);
        bS[d * 64 + p] = sigmoidf_(bb);
    }
    __syncthreads();
    {
        const int combo = t >> 2, sub = t & 3, row = combo & 63, part = combo >> 6;
        float v[16]; float ss = 0.f;
#pragma unroll
        for (int i = 0; i < 16; ++i) { v[i] = CV[row * 196 + part * 64 + sub * 16 + i]; ss += v[i] * v[i]; }
        ss += __shfl_xor(ss, 1); ss += __shfl_xor(ss, 2);
        const float rs = frsq(ss + EPS);
        LAS bf16_t* dst = (part == 0 ? Qs : Ks) + row * 72 + sub * 16;
        v4u o0, o1;
        o0.x = pk2(v[0] * rs, v[1] * rs); o0.y = pk2(v[2] * rs, v[3] * rs); o0.z = pk2(v[4] * rs, v[5] * rs); o0.w = pk2(v[6] * rs, v[7] * rs);
        o1.x = pk2(v[8] * rs, v[9] * rs); o1.y = pk2(v[10] * rs, v[11] * rs); o1.z = pk2(v[12] * rs, v[13] * rs); o1.w = pk2(v[14] * rs, v[15] * rs);
        *(LAS v4u*)dst = o0; *(LAS v4u*)(dst + 8) = o1;
        if (part == 1) {
#pragma unroll
            for (int i = 0; i < 16; ++i) Kt[(sub * 16 + i) * 72 + row] = (bf16_t)f2bf(v[i] * rs);
        }
        const int vrow = t & 63, dg = t >> 6;
#pragma unroll
        for (int i = 0; i < 8; ++i) Vt[(dg * 8 + i) * 72 + vrow] = (bf16_t)f2bf(CV[vrow * 196 + 128 + dg * 8 + i]);
        if (w < 2) { const int d = w, p = d ? 63 - lane : lane; float s = gS[d * 64 + p];
#pragma unroll
            for (int off = 1; off < 64; off <<= 1) { const float y = __shfl_up(s, off); if (lane >= off) s += y; }
            gcS[d * 64 + p] = s; if (lane == 63) totS[d] = s; }
    }
    __syncthreads();
#pragma unroll
    for (int k2 = 0; k2 < 2; ++k2) {
        const int tt = 2 * w + k2, mt = tt >> 2, nt = tt & 3;
        f32x4 accG = {0.f, 0.f, 0.f, 0.f}, accQ = {0.f, 0.f, 0.f, 0.f};
        accG = mma_ll<2>(Ks + mt * 16 * 72, 72, Ks + nt * 16 * 72, 72, accG, lane);
        accQ = mma_ll<2>(Ks + mt * 16 * 72, 72, Qs + nt * 16 * 72, 72, accQ, lane);
        const int n = nt * 16 + lr, m0 = mt * 16 + 4 * lq;
#pragma unroll
        for (int d = 0; d < 2; ++d) {
            const float gcn = gcS[d * 64 + n], bn = bS[d * 64 + n];
            f32x4 av, tv;
#pragma unroll
            for (int i = 0; i < 4; ++i) { const int m = m0 + i; const float gcm = gcS[d * 64 + m];
                const bool strict = d == 0 ? (m < n) : (m > n); const bool incl = d == 0 ? (m <= n) : (m >= n);
                const float e = fexp(incl ? (gcn - gcm) : 0.f);
                av[i] = strict ? bn * accG[i] * e : 0.f; tv[i] = incl ? 0.125f * accQ[i] * e : 0.f; }
            if (d == 0) *(LAS f32x4*)(As + n * 68 + m0) = av;
            else { f32x4 rv; rv[0] = av[3]; rv[1] = av[2]; rv[2] = av[1]; rv[3] = av[0]; *(LAS f32x4*)(As + 4352 + (63 - n) * 68 + 60 - m0) = rv; }
            *(LAS v2u*)(At + d * 4608 + n * 72 + m0) = pack4(tv);
        }
    }
    __syncthreads();
    if (w < 2) {
        const int d = w; const LAS float* Ad = As + d * 4352;
        float tr[64]; int lane_o = lane;
        f32x4 rowv[2][16];
        rowv[1][0] = *(const LAS f32x4*)(Ad + 1 * 68);
#pragma unroll
        for (int i = 0; i < 64; ++i) {
            if (i + 1 < 64) {
#pragma unroll
                for (int j4 = 0; j4 < i + 1; j4 += 4) rowv[(i + 1) & 1][j4 >> 2] = *(const LAS f32x4*)(Ad + (i + 1) * 68 + j4);
            }
            asm volatile("" : "+v"(lane_o) :: "memory");
            float a0 = 0.f, a1 = 0.f, a2 = 0.f, a3 = 0.f;
#pragma unroll
            for (int j4 = 0; j4 < i; j4 += 4) {
                const f32x4 av = rowv[i & 1][j4 >> 2];
                a0 += av[0] * tr[j4];
                if (j4 + 1 < i) a1 += av[1] * tr[j4 + 1];
                if (j4 + 2 < i) a2 += av[2] * tr[j4 + 2];
                if (j4 + 3 < i) a3 += av[3] * tr[j4 + 3];
            }
            tr[i] = (lane_o == i ? 1.f : 0.f) - ((a0 + a1) + (a2 + a3));
        }
        const int pb = d ? 63 - lane : lane; const float sb = bS[d * 64 + pb], sbe = sb * fexp(gcS[d * 64 + pb]);
        LAS bf16_t* T0 = Tb + d * 9216; LAS bf16_t* T1 = T0 + 4608;
#pragma unroll
        for (int i = 0; i < 64; ++i) { const int pa = d ? 63 - i : i; T0[pa * 72 + pb] = (bf16_t)f2bf(tr[i] * sb); T1[pa * 72 + pb] = (bf16_t)f2bf(tr[i] * sbe); }
    }
    __syncthreads();
#pragma unroll 1
    for (int d = 0; d < 2; ++d) {
        const int ud = u * 2 + d; const float tot = totS[d];
        const LAS bf16_t* T0 = Tb + d * 9216; const LAS bf16_t* T1 = T0 + 4608; const LAS bf16_t* Ad = At + d * 4608;
        {
            const bool isw = w >= 4; const LAS bf16_t* Aop = isw ? T1 : T0; const LAS bf16_t* Bop = isw ? Kt : Vt;
            LAS bf16_t* o0 = isw ? WT : UT; LAS bf16_t* o1 = isw ? WTd : UTd;
#pragma unroll
            for (int k4 = 0; k4 < 4; ++k4) { const int tt = (w & 3) * 4 + k4, mt = tt >> 2, nt = tt & 3;
                f32x4 acc = {0.f, 0.f, 0.f, 0.f}; acc = mma_ll<2>(Aop + mt * 16 * 72, 72, Bop + nt * 16 * 72, 72, acc, lane);
                const int n = nt * 16 + lr, m0 = mt * 16 + 4 * lq; f32x4 dv;
#pragma unroll
                for (int i = 0; i < 4; ++i) dv[i] = acc[i] * fexp(tot - gcS[d * 64 + m0 + i]);
                *(LAS v2u*)(o0 + n * 72 + m0) = pack4(acc); *(LAS v2u*)(o1 + n * 72 + m0) = pack4(dv); }
        }
        __syncthreads();
        {
            const int prod = w >> 1; bf16_t* gout = F.PG + (size_t)ud * 16384 + prod * 4096;
            const LAS bf16_t* Aop = prod == 0 ? WTd : prod == 1 ? Kt : prod == 2 ? WT : Ad;
            const LAS bf16_t* Bop = prod == 0 ? Kt : prod == 1 ? UTd : prod == 2 ? Ad : UT;
#pragma unroll
            for (int k8 = 0; k8 < 8; ++k8) { const int tt = (w & 1) * 8 + k8, mt = tt >> 2, nt = tt & 3;
                f32x4 acc = {0.f, 0.f, 0.f, 0.f}; acc = mma_ll<2>(Aop + mt * 16 * 72, 72, Bop + nt * 16 * 72, 72, acc, lane);
                const int n = nt * 16 + lr, m0 = mt * 16 + 4 * lq;
                if (prod == 2) { const f32x4 qv = unpack4(*(const LAS v2u*)(Qs + n * 72 + m0)); const float e = 0.125f * fexp(gcS[d * 64 + n]); acc = qv * e - acc; }
                const int off = (prod == 0 || prod == 2) ? ((nt * 2 + (mt >> 1)) * 64 + ((mt & 1) * 2 + (lq >> 1)) * 16 + lr) * 8 + 4 * (lq & 1) : ((mt * 4 + nt) * 64 + lane) * 4;
                *(v2u*)(gout + off) = pack4(acc); }
        }
        if (t == 0) F.GLG[ud] = fexp(tot);
        __syncthreads();
    }
}

__device__ __forceinline__ void mlstm_prep_unit(const Frame& F, int l, int u) {
    const int b = u / 144, h = (u / 36) & 3, cidx = u % 36;
    const int row0 = chunk_row0(b, cidx);
    const int t_o = F.wave * 64 + fresh_lane();
    const int t = t_o, lane = t & 63, w = __builtin_amdgcn_readfirstlane(t >> 6), lr = lane & 15, lq = lane >> 4;
    LAS unsigned char* L = F.lds;
    LAS bf16_t* Qs = (LAS bf16_t*)(L + 0); LAS bf16_t* Ks = (LAS bf16_t*)(L + 9216); LAS bf16_t* Vta = (LAS bf16_t*)(L + 18432);
    LAS bf16_t* Kte = (LAS bf16_t*)(L + 29952);
    LAS bf16_t* S0 = (LAS bf16_t*)(L + 48384);
    LAS float* igS = (LAS float*)(L + 66816); LAS float* lfS = igS + 128; LAS float* bS = igS + 256; LAS float* dmS = igS + 384; LAS float* rS = igS + 512;
    LAS float* flS = igS + 640; LAS float* eS = igS + 768; LAS float* mpS = igS + 896; LAS float* chS = igS + 904;
    {
        const int r = t >> 3, seg = t & 7; const bf16_t* zr = F.Z + (size_t)(row0 + r) * ZW + h * 64 + seg * 8;
        const v4u q = *(const v4u*)(zr + ZC_LQ), k = *(const v4u*)(zr + ZC_LK), v = *(const v4u*)(zr + ZC_LV);
        *(LAS v4u*)(Qs + r * 72 + seg * 8) = q; *(LAS v4u*)(Ks + r * 72 + seg * 8) = k;
        Vta[(seg * 8 + 0) * 72 + r] = (bf16_t)(v.x & 0xffffu); Vta[(seg * 8 + 1) * 72 + r] = (bf16_t)(v.x >> 16);
        Vta[(seg * 8 + 2) * 72 + r] = (bf16_t)(v.y & 0xffffu); Vta[(seg * 8 + 3) * 72 + r] = (bf16_t)(v.y >> 16);
        Vta[(seg * 8 + 4) * 72 + r] = (bf16_t)(v.z & 0xffffu); Vta[(seg * 8 + 5) * 72 + r] = (bf16_t)(v.z >> 16);
        Vta[(seg * 8 + 6) * 72 + r] = (bf16_t)(v.w & 0xffffu); Vta[(seg * 8 + 7) * 72 + r] = (bf16_t)(v.w >> 16);
#pragma unroll
        for (int j = 0; j < 2; ++j) { const int idx = t + 512 * j, rr = 64 + (idx >> 6), cc = idx & 63; Vta[rr * 72 + cc] = (bf16_t)(rr == 64 ? 0x3F80u : 0u); }
        if (t < 128) { const int d = t >> 6, p = t & 63; const bf16_t* zg = F.Z + (size_t)(row0 + p) * ZW;
            igS[d * 64 + p] = bf2f(zg[ZC_LI + d * 4 + h]) + F.ig_bias[l * 8 + d * 4 + h];
            lfS[d * 64 + p] = logsigf_(bf2f(zg[ZC_LF + d * 4 + h]) + F.fg_bias[l * 8 + d * 4 + h]); }
        if (t >= 128 && t < 272) chS[t - 128] = F.CHS[(size_t)((b * 4 + h) * 2) * 72 + (t - 128)];
    }
    __syncthreads();
    if (w < 2) {
        const int d = w, p = d ? 63 - lane : lane;
        const int step_of = d ? (cidx < 4 ? 3 - cidx : 39 - cidx) : cidx; float mprev = 0.f;
        for (int s = 0; s < step_of; ++s) { const int ci = d ? (s < 4 ? 3 - s : 39 - s) : s; mprev = fmaxf(chS[d * 72 + ci * 2] + mprev, chS[d * 72 + ci * 2 + 1]); }
        const float ig = igS[d * 64 + p]; float bp = lfS[d * 64 + p];
#pragma unroll
        for (int off = 1; off < 64; off <<= 1) { const float y = __shfl_up(bp, off); if (lane >= off) bp += y; }
        float mxp = ig - bp;
#pragma unroll
        for (int off = 1; off < 64; off <<= 1) { const float y = __shfl_up(mxp, off); if (lane >= off) mxp = fmaxf(mxp, y); }
        const float mxall = __shfl(mxp, 63), bl = __shfl(bp, 63);
        const float dmax = bp + mxp, wsmax = bl + mxall;
        const float mnew = fmaxf(bl + mprev, wsmax), cd = fexp(bl + mprev - mnew), e2 = fexp(wsmax - mnew);
        const float mt = fmaxf(bp + mprev, dmax);
        bS[d * 64 + p] = bp; dmS[d * 64 + p] = dmax; rS[d * 64 + p] = fexp(dmax - mt); flS[d * 64 + p] = fexp(-mt);
        eS[d * 64 + p] = fexp(bl - bp + ig - wsmax) * e2;
        const int ud = u * 2 + d; F.WI[ud * 64 + p] = 0.125f * fexp(bp + mprev - mt); if (lane == 0) F.GLM[ud] = cd; }
    __syncthreads();
    {
        const int d = t >> 8, tt = t & 255, p = tt & 63, dg = tt >> 6; const float e = eS[d * 64 + p];
#pragma unroll
        for (int i = 0; i < 16; ++i) Kte[d * 4608 + (dg * 16 + i) * 72 + p] = (bf16_t)f2bf(bf2f(Ks[p * 72 + dg * 16 + i]) * e);
#pragma unroll
        for (int k2 = 0; k2 < 2; ++k2) { const int tl = 2 * w + k2, mt = tl >> 2, nt = tl & 3;
            f32x4 acc = {0.f, 0.f, 0.f, 0.f}; acc = mma_ll<2>(Ks + mt * 16 * 72, 72, Qs + nt * 16 * 72, 72, acc, lane);
            const int n = nt * 16 + lr, m0 = mt * 16 + 4 * lq;
#pragma unroll
            for (int dd = 0; dd < 2; ++dd) { const float bn = bS[dd * 64 + n], dn = dmS[dd * 64 + n], rn = rS[dd * 64 + n]; f32x4 sv;
#pragma unroll
                for (int i = 0; i < 4; ++i) { const int m = m0 + i; const bool incl = dd == 0 ? (m <= n) : (m >= n);
                    const float arg = incl ? (bn - bS[dd * 64 + m] + igS[dd * 64 + m] - dn) : 0.f; sv[i] = incl ? 0.125f * acc[i] * fexp(arg) * rn : 0.f; }
                *(LAS v2u*)(S0 + dd * 4608 + n * 72 + m0) = pack4(sv); } }
    }
    __syncthreads();
    {
        const int d = w >> 2, ud = u * 2 + d; bf16_t* gO = F.PM + (size_t)ud * 10240; bf16_t* gB = gO + 5120;
#pragma unroll 2
        for (int k = 0; k < 10; ++k) { const int tl = (w & 3) * 10 + k; const bool iskv = tl >= 20; const int t2 = iskv ? tl - 20 : tl, mt = t2 / 5, nt = t2 % 5;
            const LAS bf16_t* Aop = (iskv ? Kte : S0) + d * 4608 + mt * 16 * 72;
            f32x4 acc = {0.f, 0.f, 0.f, 0.f}; acc = mma_ll<2>(Aop, 72, Vta + nt * 16 * 72, 72, acc, lane);
            const int n = nt * 16 + lr, m0 = mt * 16 + 4 * lq;
            if (!iskv && n == 65) {
#pragma unroll
                for (int i = 0; i < 4; ++i) acc[i] = flS[d * 64 + m0 + i]; }
            *(v2u*)((iskv ? gB : gO) + ((mt * 5 + nt) * 64 + lane) * 4) = pack4(acc); }
    }
    __syncthreads();
}

template <int NT> struct ScanOps { bf16x8 Qf[2], Mf[2]; v2u bv[NT], ov[NT]; float gl; f32x4 wi; };
template <bool GDN, int NT> __device__ __forceinline__ void scan_load(const Frame& F, int b, int h, int dir, int wq, int lr, int lq, int s, ScanOps<NT>& o) {
    const int cidx = dir ? (s < 4 ? 3 - s : 39 - s) : s;
    const int ud = ((b * 4 + h) * 36 + cidx) * 2 + dir;
    if (GDN) {
        const bf16_t* gM = F.PG + (size_t)ud * 16384; const bf16_t* gQ = gM + 8192;
#pragma unroll
        for (int ks = 0; ks < 2; ++ks) { o.Mf[ks] = *(const bf16x8*)(gM + ((wq * 2 + ks) * 64 + lq * 16 + lr) * 8); o.Qf[ks] = *(const bf16x8*)(gQ + ((wq * 2 + ks) * 64 + lq * 16 + lr) * 8); }
    } else {
        const bf16_t* zq = F.Z + (size_t)(chunk_row0(b, cidx) + 16 * wq + lr) * ZW + ZC_LQ + h * 64;
#pragma unroll
        for (int ks = 0; ks < 2; ++ks) { o.Qf[ks] = *(const bf16x8*)(zq + 32 * ks + 8 * lq); o.Mf[ks] = o.Qf[ks]; }
    }
    const bf16_t* gB = GDN ? F.PG + (size_t)ud * 16384 + 4096 : F.PM + (size_t)ud * 10240 + 5120;
    const bf16_t* gO = GDN ? F.PG + (size_t)ud * 16384 + 12288 : F.PM + (size_t)ud * 10240;
#pragma unroll
    for (int t = 0; t < NT; ++t) { o.bv[t] = *(const v2u*)(gB + ((wq * NT + t) * 64 + lq * 16 + lr) * 4); o.ov[t] = *(const v2u*)(gO + ((wq * NT + t) * 64 + lq * 16 + lr) * 4); }
    o.gl = GDN ? F.GLG[ud] : F.GLM[ud];
    o.wi = (f32x4){1.f, 1.f, 1.f, 1.f}; if (!GDN) o.wi = *(const f32x4*)(F.WI + ud * 64 + 16 * wq + 4 * lq);
}
struct ScanFin { f32x4 pend[4]; unsigned short gz[4][4]; };
template <bool GDN> __device__ __forceinline__ void scan_fin_load(const Frame& F, int b, int h, int dir, int wq, int lr, int lq, int s, const float* PEND, ScanFin& f) {
    const int cidx = dir ? (s < 4 ? 3 - s : 39 - s) : s; const int row0 = chunk_row0(b, cidx);
    const float* pp = PEND + (size_t)((b * 4 + h) * 36 + cidx) * 4096 + (wq * 256 + lq * 16 + lr) * 4;
#pragma unroll
    for (int t = 0; t < 4; ++t) { f.pend[t] = *(const f32x4*)(pp + t * 256);
#pragma unroll
        for (int i = 0; i < 4; ++i) f.gz[t][i] = F.Z[(size_t)(row0 + 16 * wq + 4 * lq + i) * ZW + (GDN ? ZC_GZ : ZC_LO) + h * 64 + 16 * t + lr]; }
}
__device__ __forceinline__ bool scan_first(int s) { return s < 4 ? (s <= 1) : (s <= 19); }
template <bool GDN> __device__ __forceinline__ void scan_finish(const Frame& F, int b, int h, int dir, int wq, int lr, int lq, int s, float* PEND, const f32x4 (&Oin)[4], const ScanFin& f, const float (&nwv)[4]) {
    const int cidx = dir ? (s < 4 ? 3 - s : 39 - s) : s; const int row0 = chunk_row0(b, cidx);
    float* pp = PEND + (size_t)((b * 4 + h) * 36 + cidx) * 4096 + (wq * 256 + lq * 16 + lr) * 4;
    if (scan_first(s)) {
#pragma unroll
        for (int t = 0; t < 4; ++t) *(f32x4*)(pp + t * 256) = Oin[t];
    } else {
        f32x4 O[4]; float ss[4] = {0.f, 0.f, 0.f, 0.f};
#pragma unroll
        for (int t = 0; t < 4; ++t)
#pragma unroll
            for (int i = 0; i < 4; ++i) { O[t][i] = Oin[t][i] + f.pend[t][i]; ss[i] += O[t][i] * O[t][i]; }
#pragma unroll
        for (int i = 0; i < 4; ++i) { ss[i] += __shfl_xor(ss[i], 1); ss[i] += __shfl_xor(ss[i], 2); ss[i] += __shfl_xor(ss[i], 4); ss[i] += __shfl_xor(ss[i], 8); ss[i] = frsq(ss[i] * (1.f / 64.f) + EPS); }
#pragma unroll
        for (int t = 0; t < 4; ++t) { const int dv = 16 * t + lr;
#pragma unroll
            for (int i = 0; i < 4; ++i) { const int row = row0 + 16 * wq + 4 * lq + i;
                const float g = bf2f(f.gz[t][i]);
                const float gate = GDN ? siluf_(g) : sigmoidf_(g);
                F.MIX[(size_t)row * 1024 + (GDN ? 0 : 768) + h * 64 + dv] = (bf16_t)f2bf(O[t][i] * ss[i] * nwv[t] * gate); } }
    }
}
template <bool GDN> __device__ __forceinline__ void scan_wg(const Frame& F, int l, int bh) {
    constexpr int NT = GDN ? 4 : 5;
    const int b = bh >> 2, h = bh & 3;
    const int lane = fresh_lane(), dir = F.wave >> 2, wq = F.wave & 3, lr = lane & 15, lq = lane >> 4;
    LAS bf16_t* St = (LAS bf16_t*)F.lds;
    f32x4 S[NT];
#pragma unroll
    for (int t = 0; t < NT; ++t) S[t] = (f32x4){0.f, 0.f, 0.f, 0.f};
    const float* nw = GDN ? F.gdn_norm_w + l * 64 : F.mlstm_norm_w + l * 256 + h * 64;
    float nwv[4];
#pragma unroll
    for (int t = 0; t < 4; ++t) nwv[t] = nw[16 * t + lr];
    float* PEND = F.PEND + (GDN ? (size_t)0 : (size_t)1152 * 4096);
    ScanOps<NT> cur, nxt; ScanFin fcur, fprev;
    f32x4 Oprev[4];
#pragma unroll
    for (int t = 0; t < 4; ++t) { Oprev[t] = (f32x4){0.f, 0.f, 0.f, 0.f}; fcur.pend[t] = (f32x4){0.f, 0.f, 0.f, 0.f}; fprev.pend[t] = (f32x4){0.f, 0.f, 0.f, 0.f};
#pragma unroll
        for (int i = 0; i < 4; ++i) { fcur.gz[t][i] = 0; fprev.gz[t][i] = 0; } }
    scan_load<GDN, NT>(F, b, h, dir, wq, lr, lq, 0, cur);
#pragma unroll 1
    for (int s = 0; s < 37; ++s) {
        LAS bf16_t* Sb = St + ((dir * 2 + (s & 1)) * 80) * 72;
        if (s < 36) {
#pragma unroll
            for (int t = 0; t < NT; ++t) *(LAS v2u*)(Sb + (16 * t + lr) * 72 + 16 * wq + 4 * lq) = pack4(S[t]); }
        VM_WAIT();
        __syncthreads();
        if (s > 0) {
            const int sp = s - 1;
            if (sp == 20 || sp == 2) scan_fin_load<GDN>(F, b, h, dir, wq, lr, lq, sp, PEND, fprev);
            scan_finish<GDN>(F, b, h, dir, wq, lr, lq, sp, PEND, Oprev, fprev, nwv);
        }
        if (s == 36) break;
        scan_load<GDN, NT>(F, b, h, dir, wq, lr, lq, s < 35 ? s + 1 : 35, nxt);
        if (!scan_first(s) && s != 20 && s != 2) scan_fin_load<GDN>(F, b, h, dir, wq, lr, lq, s, PEND, fcur);
        f32x4 O[NT];
#pragma unroll
        for (int t = 0; t < NT; ++t) {
            const LAS bf16_t* sp = Sb + (16 * t + lr) * 72 + 8 * lq;
            const bf16x8 s0 = *(const LAS bf16x8*)sp, s1 = *(const LAS bf16x8*)(sp + 32);
            f32x4 o = {0.f, 0.f, 0.f, 0.f};
            o = __builtin_amdgcn_mfma_f32_16x16x32_bf16(cur.Qf[0], s0, o, 0, 0, 0); o = __builtin_amdgcn_mfma_f32_16x16x32_bf16(cur.Qf[1], s1, o, 0, 0, 0);
            const f32x4 bv = unpack4(cur.bv[t]), ov = unpack4(cur.ov[t]);
            if (GDN) {
                f32x4 ms = {0.f, 0.f, 0.f, 0.f};
                ms = __builtin_amdgcn_mfma_f32_16x16x32_bf16(cur.Mf[0], s0, ms, 0, 0, 0); ms = __builtin_amdgcn_mfma_f32_16x16x32_bf16(cur.Mf[1], s1, ms, 0, 0, 0);
                S[t] = S[t] * cur.gl - ms + bv; O[t] = o + ov;
            } else { S[t] = S[t] * cur.gl + bv; O[t] = o * cur.wi + ov; }
        }
        if (!GDN) {
#pragma unroll
            for (int i = 0; i < 4; ++i) { const float den = __shfl(O[NT - 1][i], lane & 48), fl = __shfl(O[NT - 1][i], (lane & 48) + 1); const float dv = frcp(fmaxf(fabsf(den), fl));
#pragma unroll
                for (int t = 0; t < 4; ++t) O[t][i] *= dv; }
        }
#pragma unroll
        for (int t = 0; t < 4; ++t) Oprev[t] = O[t];
        fprev = fcur; cur = nxt;
    }
    VM_WAIT();
    __syncthreads();
}

__device__ __forceinline__ void swa_unit(const Frame& F, int l, int it) {
    const bool lat = it < 256; int b, kvh, qb;
    if (lat) { b = it >> 5; kvh = (it >> 4) & 1; qb = it & 15; } else { const int j = it - 256; b = j >> 2; kvh = (j >> 1) & 1; qb = j & 1; }
    const int t_o = F.wave * 64 + fresh_lane();
    const int t = t_o, lane = t & 63, w = __builtin_amdgcn_readfirstlane(t >> 6), lr = lane & 15, lq = lane >> 4;
    const int hq = kvh * 2 + (w >> 2), wrow = (w & 3) * 32;
    const int qrow = (lat ? b * SEQ : MLAT + b * CTXL) + qb * 128 + wrow;
    LAS bf16_t* Ksh = (LAS bf16_t*)F.lds; LAS bf16_t* Vt = Ksh + 4608; LAS bf16_t* Pw = Ksh + 9216 + w * 2304;
    bf16x8 Qf[2][2];
#pragma unroll
    for (int mt = 0; mt < 2; ++mt)
#pragma unroll
        for (int ks = 0; ks < 2; ++ks) Qf[mt][ks] = *(const bf16x8*)(F.Z + (size_t)(qrow + mt * 16 + lr) * ZW + ZC_SQ + hq * 64 + 32 * ks + 8 * lq);
    const float sk = F.sink[l * 4 + hq];
    float mi[2][4], li[2][4]; f32x4 O[2][4];
#pragma unroll
    for (int mt = 0; mt < 2; ++mt)
#pragma unroll
        for (int i = 0; i < 4; ++i) { mi[mt][i] = sk; li[mt][i] = 1.f; O[mt][i] = (f32x4){0.f, 0.f, 0.f, 0.f}; }
    const int ntile = lat ? 10 : 4;
#pragma unroll 1
    for (int kt = 0; kt < ntile; ++kt) {
        int krow, kpos0 = 0; bool masked = false;
        if (lat && kt < 6) { kpos0 = (qb - 1) * 128 + kt * 64; if (kpos0 < 0 || kpos0 >= SEQ) continue; krow = b * SEQ + kpos0; masked = true; }
        else { const int cj = lat ? kt - 6 : kt; krow = MLAT + b * CTXL + cj * 64; }
        __syncthreads();
        { const int r = t >> 3, seg = t & 7; const bf16_t* zr = F.Z + (size_t)(krow + r) * ZW + kvh * 64 + seg * 8;
          const v4u k = *(const v4u*)(zr + ZC_SK), v = *(const v4u*)(zr + ZC_SV);
          *(LAS v4u*)(Ksh + r * 72 + seg * 8) = k;
          Vt[(seg * 8 + 0) * 72 + r] = (bf16_t)(v.x & 0xffffu); Vt[(seg * 8 + 1) * 72 + r] = (bf16_t)(v.x >> 16);
          Vt[(seg * 8 + 2) * 72 + r] = (bf16_t)(v.y & 0xffffu); Vt[(seg * 8 + 3) * 72 + r] = (bf16_t)(v.y >> 16);
          Vt[(seg * 8 + 4) * 72 + r] = (bf16_t)(v.z & 0xffffu); Vt[(seg * 8 + 5) * 72 + r] = (bf16_t)(v.z >> 16);
          Vt[(seg * 8 + 6) * 72 + r] = (bf16_t)(v.w & 0xffffu); Vt[(seg * 8 + 7) * 72 + r] = (bf16_t)(v.w >> 16); }
        __syncthreads();
        f32x4 sc[2][4];
#pragma unroll
        for (int nt = 0; nt < 4; ++nt) { const LAS bf16_t* kp = Ksh + (nt * 16 + lr) * 72 + 8 * lq; const bf16x8 k0 = *(const LAS bf16x8*)kp, k1 = *(const LAS bf16x8*)(kp + 32);
#pragma unroll
            for (int mt = 0; mt < 2; ++mt) { f32x4 a = {0.f, 0.f, 0.f, 0.f};
                a = __builtin_amdgcn_mfma_f32_16x16x32_bf16(Qf[mt][0], k0, a, 0, 0, 0); a = __builtin_amdgcn_mfma_f32_16x16x32_bf16(Qf[mt][1], k1, a, 0, 0, 0); sc[mt][nt] = a; } }
#pragma unroll
        for (int mt = 0; mt < 2; ++mt) {
            float mx[4] = {-1e30f, -1e30f, -1e30f, -1e30f};
#pragma unroll
            for (int nt = 0; nt < 4; ++nt)
#pragma unroll
                for (int i = 0; i < 4; ++i) {
                    if (masked) { const int qpos = qb * 128 + wrow + mt * 16 + 4 * lq + i, kpos = kpos0 + nt * 16 + lr; const int dd = qpos - kpos; if (dd > 128 || dd < -128) sc[mt][nt][i] = -1e30f; }
                    mx[i] = fmaxf(mx[i], sc[mt][nt][i]); }
#pragma unroll
            for (int i = 0; i < 4; ++i) { mx[i] = fmaxf(mx[i], __shfl_xor(mx[i], 1)); mx[i] = fmaxf(mx[i], __shfl_xor(mx[i], 2)); mx[i] = fmaxf(mx[i], __shfl_xor(mx[i], 4)); mx[i] = fmaxf(mx[i], __shfl_xor(mx[i], 8)); }
            float al[4], rsum[4];
#pragma unroll
            for (int i = 0; i < 4; ++i) { const float mn = fmaxf(mi[mt][i], mx[i]); al[i] = fexp(mi[mt][i] - mn); mi[mt][i] = mn; rsum[i] = 0.f; }
#pragma unroll
            for (int nt = 0; nt < 4; ++nt)
#pragma unroll
                for (int i = 0; i < 4; ++i) { const float p = fexp(sc[mt][nt][i] - mi[mt][i]); rsum[i] += p; Pw[(mt * 16 + 4 * lq + i) * 72 + nt * 16 + lr] = (bf16_t)f2bf(p); }
#pragma unroll
            for (int i = 0; i < 4; ++i) { rsum[i] += __shfl_xor(rsum[i], 1); rsum[i] += __shfl_xor(rsum[i], 2); rsum[i] += __shfl_xor(rsum[i], 4); rsum[i] += __shfl_xor(rsum[i], 8); li[mt][i] = li[mt][i] * al[i] + rsum[i]; }
#pragma unroll
            for (int nt = 0; nt < 4; ++nt)
#pragma unroll
                for (int i = 0; i < 4; ++i) O[mt][nt][i] *= al[i];
        }
        LDS_WAIT(); asm volatile("" ::: "memory");
#pragma unroll
        for (int nt = 0; nt < 4; ++nt) { const LAS bf16_t* vp = Vt + (nt * 16 + lr) * 72 + 8 * lq; const bf16x8 v0 = *(const LAS bf16x8*)vp, v1 = *(const LAS bf16x8*)(vp + 32);
#pragma unroll
            for (int mt = 0; mt < 2; ++mt) { const LAS bf16_t* pp = Pw + (mt * 16 + lr) * 72 + 8 * lq; const bf16x8 p0 = *(const LAS bf16x8*)pp, p1 = *(const LAS bf16x8*)(pp + 32);
                O[mt][nt] = __builtin_amdgcn_mfma_f32_16x16x32_bf16(p0, v0, O[mt][nt], 0, 0, 0); O[mt][nt] = __builtin_amdgcn_mfma_f32_16x16x32_bf16(p1, v1, O[mt][nt], 0, 0, 0); } }
    }
#pragma unroll
    for (int mt = 0; mt < 2; ++mt)
#pragma unroll
        for (int i = 0; i < 4; ++i) { const float inv = frcp(li[mt][i]); bf16_t* orow = F.MIX + (size_t)(qrow + mt * 16 + 4 * lq + i) * 1024 + 256 + hq * 64 + lr;
#pragma unroll
            for (int nt = 0; nt < 4; ++nt) orow[nt * 16] = (bf16_t)f2bf(O[mt][nt][i] * inv); }
    __syncthreads();
}

__device__ __forceinline__ void gmlp_unit(const Frame& F, int l, int it) {
    const int b = it / 72, c = (it >> 2) % 18, g = it & 3;
    const int r0 = c < 16 ? b * SEQ + c * 128 : MLAT + b * CTXL + (c - 16) * 128;
    const int t_o = F.wave * 64 + fresh_lane();
    const int t = t_o, lane = t & 63, w = __builtin_amdgcn_readfirstlane(t >> 6), lr = lane & 15, lq = lane >> 4;
    LAS bf16_t* Vt = (LAS bf16_t*)F.lds;
#pragma unroll
    for (int j = 0; j < 2; ++j) { const int idx = t + 512 * j, q = idx >> 3, seg = idx & 7;
        const v4u v = *(const v4u*)(F.Z + (size_t)(r0 + q) * ZW + ZC_MV + g * 64 + seg * 8);
        Vt[(seg * 8 + 0) * 136 + q] = (bf16_t)(v.x & 0xffffu); Vt[(seg * 8 + 1) * 136 + q] = (bf16_t)(v.x >> 16);
        Vt[(seg * 8 + 2) * 136 + q] = (bf16_t)(v.y & 0xffffu); Vt[(seg * 8 + 3) * 136 + q] = (bf16_t)(v.y >> 16);
        Vt[(seg * 8 + 4) * 136 + q] = (bf16_t)(v.z & 0xffffu); Vt[(seg * 8 + 5) * 136 + q] = (bf16_t)(v.z >> 16);
        Vt[(seg * 8 + 6) * 136 + q] = (bf16_t)(v.w & 0xffffu); Vt[(seg * 8 + 7) * 136 + q] = (bf16_t)(v.w >> 16); }
    __syncthreads();
    bf16x8 Af[4];
#pragma unroll
    for (int ks = 0; ks < 4; ++ks) Af[ks] = *(const bf16x8*)(F.WSP + (size_t)g * 16384 + (16 * w + lr) * 128 + 32 * ks + 8 * lq);
    f32x4 bsv = *(const f32x4*)(F.b_s + (size_t)(l * 4 + g) * 128 + 16 * w + 4 * lq);
#pragma unroll
    for (int nt = 0; nt < 4; ++nt) { f32x4 acc = {0.f, 0.f, 0.f, 0.f};
#pragma unroll
        for (int ks = 0; ks < 4; ++ks) { const bf16x8 bfr = *(const LAS bf16x8*)(Vt + (nt * 16 + lr) * 136 + 32 * ks + 8 * lq); acc = __builtin_amdgcn_mfma_f32_16x16x32_bf16(Af[ks], bfr, acc, 0, 0, 0); }
#pragma unroll
        for (int i = 0; i < 4; ++i) { const int row = r0 + 16 * w + 4 * lq + i, col = g * 64 + nt * 16 + lr;
            const float uv = bf2f(F.Z[(size_t)row * ZW + ZC_MU + col]);
            F.MIX[(size_t)row * 1024 + 512 + col] = (bf16_t)f2bf(uv * (acc[i] + bsv[i])); } }
    __syncthreads();
}

#ifndef PROBE_KIND
#define PROBE_KIND -1
#endif
#ifndef ONLY_CASE
#define ONLY_CASE -1
#endif
struct Args { const float* in[24]; float* out; unsigned char* ws; int ph_lo, ph_hi; };
constexpr int NPH = 2 + 9 * DEPTH;
__global__ void __launch_bounds__(NWAVES * 64, 2) mk_fwd(Args args) {
    extern __shared__ __attribute__((aligned(16))) unsigned char lds[];
    const int wave_s = __builtin_amdgcn_readfirstlane((int)threadIdx.x >> 6);
    const int tid_ = wave_s * 64 + fresh_lane();
    volatile LAS unsigned* MISC = (volatile LAS unsigned*)((LAS unsigned char*)lds + MISC_OFF);
    if (tid_ < 32) MISC[tid_] = 0u;
    __syncthreads();
    unsigned* barw = (unsigned*)(args.ws + WS_CTL) + CW_BAR;
    XcdBarrier bar; bar.bar = barw; bar.x = 0; bar.st = nullptr;
    const int lo = args.ph_lo, hi = args.ph_hi;
    if (hi - lo > 1) bar = xcd_barrier_post(barw, MISC + 8, tid_);

#pragma unroll 1
    for (int ph = lo; ph < hi; ++ph) {
        int zero; asm volatile("s_mov_b32 %0, 0" : "=s"(zero));
        Frame F;
        F.lds = (LAS unsigned char*)lds;
        F.wave = wave_s;
        F.G = gridDim.x; F.gw = blockIdx.x * NWAVES + F.wave; F.NGW = F.G * NWAVES;
        const float* const* inp = args.in + zero;
        F.x = inp[0]; F.c = inp[1]; F.ctx = inp[2]; F.cctx = inp[3]; F.ada_w = inp[4]; F.ada_b = inp[5]; F.norm1_w = inp[6]; F.norm2_w = inp[7];
        F.w_in = inp[8]; F.w_out = inp[9]; F.conv_w = inp[10]; F.a_log = inp[11]; F.dt_bias = inp[12]; F.gdn_norm_w = inp[13]; F.sink = inp[14];
        F.w_s = inp[15]; F.b_s = inp[16]; F.gmlp_norm_w = inp[17]; F.ig_bias = inp[18]; F.fg_bias = inp[19]; F.mlstm_norm_w = inp[20];
        F.w1 = inp[21]; F.w2 = inp[22]; F.final_w = inp[23];
        unsigned char* ws = args.ws + zero;
        F.out = args.out + zero; F.ws = ws;
        F.MOD = (float*)(ws + WS_MOD); F.XC = (float*)(ws + WS_XC); F.CHS = (float*)(ws + WS_CHS); F.GLG = (float*)(ws + WS_GLG); F.GLM = F.GLG + 2304; F.WI = F.GLG + 4608;
        F.PEND = (float*)(ws + WS_H); F.SLAB = (float*)(ws + WS_SLAB);
        F.WIN = (bf16_t*)(ws + WS_WIN); F.WOUT = (bf16_t*)(ws + WS_WOUT); F.W1 = (bf16_t*)(ws + WS_W1); F.W2 = (bf16_t*)(ws + WS_W2); F.WSP = (bf16_t*)(ws + WS_WSP);
        F.H = (bf16_t*)(ws + WS_H); F.MIX = (bf16_t*)(ws + WS_MIX); F.Z = (bf16_t*)(ws + WS_Z); F.PG = (bf16_t*)(ws + WS_PG); F.PM = (bf16_t*)(ws + WS_PM); F.HID = (bf16_t*)(ws + WS_HID);
        int kind, l;
        if (ph == 0) { kind = 0; l = 0; } else if (ph == NPH - 1) { kind = 10; l = DEPTH - 1; } else { l = (ph - 1) / 9; kind = 1 + (ph - 1) % 9; }
        const bool last = (l == DEPTH - 1);
        const int Mrows = last ? MLAT : MALL;
        const int nrep = (kind == PROBE_KIND) ? 2 : 1;
#pragma unroll 1
        for (int rep = 0; rep < nrep; ++rep) {
        if (rep) xcd_barrier(bar, wave_s * 64 + fresh_lane());
        switch (kind) {
        case 0: if (ONLY_CASE >= 0 && ONLY_CASE != 0) break; phase_mod(F); break;
        case 1: if (ONLY_CASE >= 0 && ONLY_CASE != 1) break; convert_weights(F, l); phase_norm(F, l, 0, MALL, (l > 0 && !rep) ? NSPLIT_2 : 0, F.MOD + (size_t)((l > 0 ? l - 1 : 0) * 9 + 8) * 6144 + 5 * 1024); break;
        case 2: if (ONLY_CASE >= 0 && ONLY_CASE != 2) break; { pg8::Gemm g{F.H, F.WIN, MALL, ZW, D, D, D}; pg8::StaticOrder S; S.init(MALL, ZW, D, F.G, (int)blockIdx.x);
                  pg8::EpiBf16<0> E{F.Z, ZW}; pg8::gemm_phase<pg8::EpiBf16<0>, pg8::StaticOrder, true, true>(F.lds, g, S, E, wave_s * 64 + fresh_lane()); } break;
        case 3: if (ONLY_CASE >= 0 && ONLY_CASE != 3) break; for (int rg = blockIdx.x; rg < MALL / 16 + 288; rg += F.G) { if (rg < MALL / 16) ew_unit(F, l, rg); else chs_unit(F, l, rg - MALL / 16); } break;
        case 4: if (ONLY_CASE >= 0 && ONLY_CASE != 4) break; for (int it = blockIdx.x; it < 2304; it += F.G) { if (it < 1152) { if (!rep || PROBE_SUB != 2) gdn_prep_unit(F, l, it); } else { if (!rep || PROBE_SUB != 1) mlstm_prep_unit(F, l, it - 1152); } } break;
        case 5: if (ONLY_CASE >= 0 && ONLY_CASE != 5) break; { const int bx = blockIdx.x;
                  if (bx < 32) { if (!rep || PROBE_SUB == 0 || PROBE_SUB == 1) scan_wg<true>(F, l, bx); }
                  else if (bx < 64) { if (!rep || PROBE_SUB == 0 || PROBE_SUB == 1 || PROBE_SUB == 4) scan_wg<false>(F, l, bx - 32); }
                  else for (int it = bx - 64; it < 288 + 576; it += F.G - 64) { if (it < 288) { if (!rep || PROBE_SUB == 0 || PROBE_SUB == 2) swa_unit(F, l, it); } else { if (!rep || PROBE_SUB == 0 || PROBE_SUB == 3) gmlp_unit(F, l, it - 288); } } } break;
        case 6: case 9: { if (ONLY_CASE >= 0 && ONLY_CASE != 6) break; const bool isout = (kind == 6);
                  const int Kd = isout ? D : FF;
                  pg8::Gemm g{isout ? F.MIX : F.HID, isout ? F.WOUT : F.W2, MLAT, D, Kd, Kd, Kd}; pg8::StaticOrder S; S.init(MLAT, D, Kd, F.G, (int)blockIdx.x);
                  if (!last) S.add_split(MCTX / 256, isout ? NSPLIT_OUT : NSPLIT_2, Kd);
                  pg8::EpiResid E{rep ? (float*)(F.ws + WS_H) : F.out, rep ? (float*)(F.ws + WS_H) + (size_t)MLAT * 1024 : F.XC, F.MOD + (size_t)l * 9 * 6144 + (isout ? 2 : 5) * 1024, (float*)(F.ws + WS_SLAB)};
                  pg8::gemm_phase<pg8::EpiResid, pg8::StaticOrder, true, true>(F.lds, g, S, E, wave_s * 64 + fresh_lane()); } break;
        case 7: if (ONLY_CASE >= 0 && ONLY_CASE != 7) break; phase_norm(F, l, 1, Mrows, (!last && !rep) ? NSPLIT_OUT : 0, F.MOD + (size_t)(l * 9 + 8) * 6144 + 2 * 1024); break;
        case 8: if (ONLY_CASE >= 0 && ONLY_CASE != 8) break; { pg8::Gemm g{F.H, F.W1, Mrows, FF, D, D, D}; pg8::StaticOrder S; S.init(Mrows, FF, D, F.G, (int)blockIdx.x);
                  pg8::EpiBf16<1> E{F.HID, FF}; pg8::gemm_phase<pg8::EpiBf16<1>, pg8::StaticOrder, true, true>(F.lds, g, S, E, wave_s * 64 + fresh_lane()); } break;
        default: { const bool poison = (hi - lo > 1) && (__hip_atomic_load(barw + XB_TMO, __ATOMIC_RELAXED, __HIP_MEMORY_SCOPE_AGENT) != 0u); phase_final(F, poison); } break;
        }
        }
        if (ph + 1 < hi) xcd_barrier(bar, wave_s * 64 + fresh_lane());
    }
}

extern "C" void kernel_launch(void* const* d_in, const int* in_sizes, int n_in, void* d_out, int out_size, void* d_ws, size_t ws_size, hipStream_t stream) {
    static int grid = 0;
    if (grid == 0) {
        if (n_in != 24 || out_size != MLAT * D || ws_size < WS_END) { fprintf(stderr, "kernel_launch: unexpected shapes: n_in %d out %d ws %zu (need %zu)\n", n_in, out_size, ws_size, (size_t)WS_END); grid = -1; return; }
        int dev = 0, cus = 0, per_cu = 0;
        if (hipGetDevice(&dev) != hipSuccess || hipDeviceGetAttribute(&cus, hipDeviceAttributeMultiprocessorCount, dev) != hipSuccess) { grid = -1; return; }
        if (hipFuncSetAttribute((const void*)mk_fwd, hipFuncAttributeMaxDynamicSharedMemorySize, LDS_BYTES) != hipSuccess) { fprintf(stderr, "kernel_launch: hipFuncSetAttribute failed\n"); grid = -1; return; }
        if (hipOccupancyMaxActiveBlocksPerMultiprocessor(&per_cu, (const void*)mk_fwd, NWAVES * 64, LDS_BYTES) != hipSuccess || per_cu < 1) { fprintf(stderr, "kernel_launch: occupancy query says %d\n", per_cu); grid = -1; return; }
        (void)hipGetLastError();
        grid = cus;
        if (grid < 128) { fprintf(stderr, "kernel_launch: device too small (%d CUs)\n", grid); grid = -1; return; }
    }
    if (grid < 0) return;
    (void)hipMemsetAsync((char*)d_ws + WS_CTL, 0, CTL_ZERO_BYTES, stream);
    Args a{};
    for (int i = 0; i < 24; ++i) a.in[i] = (const float*)d_in[i];
    a.out = (float*)d_out; a.ws = (unsigned char*)d_ws;
#if MK_PER_PHASE
    for (int p = 0; p < NPH; ++p) { a.ph_lo = p; a.ph_hi = p + 1; hipLaunchKernelGGL(mk_fwd, dim3(grid), dim3(NWAVES * 64), LDS_BYTES, stream, a); }
#else
    a.ph_lo = 0; a.ph_hi = NPH;
    void* kargs[] = {&a};
    hipError_t e = hipLaunchCooperativeKernel((const void*)mk_fwd, dim3(grid), dim3(NWAVES * 64), kargs, LDS_BYTES, stream);
    if (e != hipSuccess) fprintf(stderr, "kernel_launch: cooperative launch failed: %s (grid %d)\n", hipGetErrorString(e), grid);
#endif
}
```

```cpp
#include <hip/hip_runtime.h>
#include <cstdio>
#include <cstdint>
#ifndef MK_PER_PHASE
#define MK_PER_PHASE 0
#endif
#define PROBE_KIND -1
#define PROBE_SUB 0
namespace pg8 {
#define PG8_LAS __attribute__((address_space(3)))
typedef unsigned short bf16_t;
typedef short bf16x8 __attribute__((ext_vector_type(8)));
typedef float f32x4 __attribute__((ext_vector_type(4)));
typedef unsigned u32x4 __attribute__((ext_vector_type(4)));
constexpr int BM = 256, BK = 64, HALF = 128, HTB = HALF * BK * 2  , STAGE_BYTES = 8 * HTB, NXCD = 8, WGM = 8;

__host__ __device__ __forceinline__ int lds_byte(int r, int c) { const int st = (r >> 4) * 2 + (c >> 5), rr = r & 15, cc = c & 31, ob = rr * 64 + cc * 2; return st * 1024 + (ob ^ (((ob >> 9) & 1) << 5)); }
__host__ __device__ __forceinline__ void stage_rc(int b, int& R, int& C) { const int st = b / 1024, sb = b % 1024, swz = sb ^ (((sb >> 9) & 1) << 5); R = (st >> 1) * 16 + swz / 64; C = (st & 1) * 32 + (swz % 64) / 2; }
__host__ __device__ __forceinline__ int perm32(int rho) { const int n = rho >> 4, i = rho & 15; return 8 * (i >> 2) + 4 * n + (i & 3); }

struct Unit { int pm, pn, kofs, nt, slab; };
struct Gemm { const bf16_t* A; const bf16_t* Bt; int M, N, K, lda, ldb; };

struct StaticOrder {
    int nM, nN, nwg, G, c, ntk, nsp, nsplit, kslice, pm0;
    __host__ __device__ void init(int M, int N, int K, int G_, int c_) { nM = M / BM; nN = N / BM; nwg = nM * nN; G = G_; c = c_; ntk = K / BK; nsp = 0; nsplit = 1; kslice = K; pm0 = nM; }
    __host__ __device__ void add_split(int npanels, int nsplit_, int K) { nsplit = nsplit_; kslice = K / nsplit_; nsp = npanels * nN * nsplit_; }
    __host__ __device__ void map(long L, Unit& u) const {
        int wgid = (int)L; { const int q = nwg / NXCD, r = nwg % NXCD, xcd = wgid % NXCD, off = wgid / NXCD; wgid = (xcd < r ? xcd * (q + 1) : r * (q + 1) + (xcd - r) * q) + off; }
        const int nig = WGM * nN, gid = wgid / nig, fm = gid * WGM, gsz = (nM - fm) < WGM ? (nM - fm) : WGM;
        u.pm = fm + ((wgid % nig) % gsz); u.pn = (wgid % nig) / gsz; u.kofs = 0; u.nt = ntk; u.slab = 0;
    }
    __host__ __device__ bool next(int i, Unit& u) const {
        const long L = (long)i * G + c;
        if (L < nwg) { map(L, u); return true; }
        const long J = L - nwg; if (J >= nsp) return false;
        const int ks = (int)(J % nsplit), tile = (int)(J / nsplit);
        u.pn = tile % nN; u.pm = pm0 + tile / nN; u.kofs = ks * kslice; u.nt = kslice / BK; u.slab = ks + 1; return true;
    }
    __device__ __forceinline__ void a_ready(const Unit&) const {}
    __device__ __forceinline__ void done(const Unit&) const {}
};

__device__ __forceinline__ unsigned cvt_pk_bf16(float lo, float hi) { unsigned r; asm volatile("v_cvt_pk_bf16_f32 %0, %1, %2" : "=v"(r) : "v"(lo), "v"(hi)); return r; }

template <int ACT  > struct EpiBf16 {
    static constexpr bool PERM = true, AFTER_DRAIN = false;
    bf16_t* O; int ldc;
    __device__ __forceinline__ void operator()(const f32x4 (&acc)[2][2][4][2], const Unit& u, int wr, int wc, int fr, int fq) const {
        const int row0 = u.pm * BM + wr * 64 + fr; const int col0 = u.pn * BM + wc * 32 + 8 * fq;
#pragma unroll
        for (int ai = 0; ai < 2; ++ai)
#pragma unroll
            for (int m = 0; m < 4; ++m) { bf16_t* rowp = O + (size_t)(row0 + ai * HALF + m * 16) * ldc + col0;
#pragma unroll
                for (int bj = 0; bj < 2; ++bj) { f32x4 v0 = acc[ai][bj][m][0], v1 = acc[ai][bj][m][1];
                    if (ACT == 1) {
#pragma unroll
                        for (int e = 0; e < 4; ++e) { float a = fmaxf(v0[e], 0.f), b = fmaxf(v1[e], 0.f); v0[e] = a * a; v1[e] = b * b; } }
                    u32x4 w; w.x = cvt_pk_bf16(v0[0], v0[1]); w.y = cvt_pk_bf16(v0[2], v0[3]); w.z = cvt_pk_bf16(v1[0], v1[1]); w.w = cvt_pk_bf16(v1[2], v1[3]);
                    *(u32x4*)(rowp + bj * HALF) = w; } }
    }
};

struct EpiResid {
    static constexpr bool PERM = false, AFTER_DRAIN = false;
    float* xlat; float* xctx; const float* gmod; float* slab;
    __device__ __forceinline__ void operator()(const f32x4 (&acc)[2][2][4][2], const Unit& u, int wr, int wc, int fr, int fq) const {
        if (u.slab) {
            float* sb = slab + (size_t)(u.slab - 1) * 2048 * 1024 + (size_t)(u.pm - 64) * BM * 1024 + u.pn * BM + wc * 32 + 4 * fq;
#pragma unroll
            for (int ai = 0; ai < 2; ++ai)
#pragma unroll
                for (int m = 0; m < 4; ++m) { float* rowp = sb + (size_t)(ai * HALF + wr * 64 + m * 16 + fr) * 1024;
#pragma unroll
                    for (int bj = 0; bj < 2; ++bj)
#pragma unroll
                        for (int n = 0; n < 2; ++n) *(f32x4*)(rowp + bj * HALF + n * 16) = acc[ai][bj][m][n]; }
            return;
        }
        const int bm = u.pm < 64 ? (u.pm >> 3) : 8;
        float* base = u.pm < 64 ? xlat + (size_t)u.pm * BM * 1024 : xctx + (size_t)(u.pm - 64) * BM * 1024;
        const float* g = gmod + bm * 6144;
        const int col0 = u.pn * BM + wc * 32 + 4 * fq;
        f32x4 gv[2][2];
#pragma unroll
        for (int bj = 0; bj < 2; ++bj)
#pragma unroll
            for (int n = 0; n < 2; ++n) gv[bj][n] = *(const f32x4*)(g + col0 + bj * HALF + n * 16);
#pragma unroll
        for (int ai = 0; ai < 2; ++ai)
#pragma unroll
            for (int m = 0; m < 4; ++m) { float* rowp = base + (size_t)(ai * HALF + wr * 64 + m * 16 + fr) * 1024 + col0;
                f32x4 xv[2][2];
#pragma unroll
                for (int bj = 0; bj < 2; ++bj)
#pragma unroll
                    for (int n = 0; n < 2; ++n) xv[bj][n] = *(const f32x4*)(rowp + bj * HALF + n * 16);
#pragma unroll
                for (int bj = 0; bj < 2; ++bj)
#pragma unroll
                    for (int n = 0; n < 2; ++n) *(f32x4*)(rowp + bj * HALF + n * 16) = xv[bj][n] + gv[bj][n] * acc[ai][bj][m][n];
                if (m & 1) asm volatile("" ::: "memory"); }
    }
};

template <class Epi, class Sched, bool ALIGN_EPI = false, bool SP2 = false, bool UNIFORM_NT = false>
__device__ __forceinline__ void gemm_phase(PG8_LAS unsigned char* lds, const Gemm g, const Sched& S, const Epi& E, int tid_in) {
    int tid_o = tid_in; asm volatile("" : "+v"(tid_o)); const int tid = tid_o, wid = __builtin_amdgcn_readfirstlane(tid >> 6), lane = tid & 63, wr = wid >> 2, wc = wid & 3, fr = lane & 15, fq = lane >> 4;
    const int lda = g.lda, ldb = g.ldb; const int nt_uniform = g.K / BK;
    unsigned voffA[2], voffB[2];
#pragma unroll
    for (int i = 0; i < 2; ++i) { int R, C; stage_rc(tid * 16 + i * 8192, R, C); const int Rb = Epi::PERM ? ((R & ~31) + perm32(R & 31)) : R;
        voffA[i] = (unsigned)(R * lda + C) * 2u; voffB[i] = (unsigned)(Rb * ldb + C) * 2u; }
    const size_t kstep = (size_t)(BK * 2);
    const size_t hstepA = (size_t)HALF * lda * 2, hstepB = (size_t)HALF * ldb * 2;
    const size_t tstepA = 2 * hstepA, tstepB = 2 * hstepB;
    const unsigned ldsw = (unsigned)wid * 1024u;
    const int aoff = lds_byte(wr * 64 + fr, fq * 8), boff = lds_byte(wc * 32 + fr, fq * 8);
#define PG8_SA(b, h) (((b) * 2 + (h)) * HTB)
#define PG8_SB(b, h) ((4 + (b) * 2 + (h)) * HTB)
#define PG8_STAGE(bufoff, gbase, voff) do { _Pragma("unroll") for (int _i = 0; _i < 2; ++_i) \
        __builtin_amdgcn_global_load_lds((const unsigned*)((const char*)(gbase) + (voff)[_i]), (PG8_LAS unsigned*)(lds + (bufoff) + ldsw + _i * 8192), 16, 0, 0); } while (0)
#define PG8_LDA(dst, b, h) do { _Pragma("unroll") for (int m = 0; m < 4; ++m) _Pragma("unroll") for (int k = 0; k < 2; ++k) dst[m][k] = *(const PG8_LAS bf16x8*)(lds + PG8_SA(b, h) + aoff + m * 2048 + k * 1024); } while (0)
#define PG8_LDB(dst, b, h) do { _Pragma("unroll") for (int n = 0; n < 2; ++n) _Pragma("unroll") for (int k = 0; k < 2; ++k) dst[n][k] = *(const PG8_LAS bf16x8*)(lds + PG8_SB(b, h) + boff + n * 2048 + k * 1024); } while (0)
#define PG8_MMA(ai, bj, At, Bt) do { __builtin_amdgcn_s_setprio(1); _Pragma("unroll") for (int m = 0; m < 4; ++m) _Pragma("unroll") for (int n = 0; n < 2; ++n) _Pragma("unroll") for (int k = 0; k < 2; ++k) \
        acc[ai][bj][m][n] = __builtin_amdgcn_mfma_f32_16x16x32_bf16(Bt[n][k], At[m][k], acc[ai][bj][m][n], 0, 0, 0); __builtin_amdgcn_s_setprio(0); } while (0)
#define PG8_WAIT_V(n) asm volatile("s_waitcnt vmcnt(" #n ")" ::: "memory")
#define PG8_WAIT_L(n) asm volatile("s_waitcnt lgkmcnt(" #n ")" ::: "memory")
#define PG8_BAR __builtin_amdgcn_s_barrier()
#define PG8_SCHED __builtin_amdgcn_sched_barrier(0)
    Unit cur, nxt; int ui = 0;
    if (!S.next(0, cur)) return;
    f32x4 acc[2][2][4][2];
#pragma unroll
    for (int a = 0; a < 2; ++a)
#pragma unroll
        for (int b = 0; b < 2; ++b)
#pragma unroll
            for (int m = 0; m < 4; ++m)
#pragma unroll
                for (int n = 0; n < 2; ++n) acc[a][b][m][n] = (f32x4){0.f, 0.f, 0.f, 0.f};
    bf16x8 At[4][2], B0[2][2], B1[2][2];
    const char* cA = (const char*)g.A + (size_t)cur.pm * tstepA + (size_t)cur.kofs * 2; const char* cB = (const char*)g.Bt + (size_t)cur.pn * tstepB + (size_t)cur.kofs * 2;
    S.a_ready(cur);
    if constexpr (SP2) {
        PG8_STAGE(PG8_SB(0, 0), cB, voffB); PG8_STAGE(PG8_SB(0, 1), cB + hstepB, voffB); PG8_STAGE(PG8_SA(0, 0), cA, voffA); PG8_STAGE(PG8_SA(0, 1), cA + hstepA, voffA);
        if (wr == 1) PG8_BAR;
        PG8_WAIT_V(2); PG8_BAR;
        PG8_STAGE(PG8_SB(1, 0), cB + kstep, voffB); PG8_STAGE(PG8_SA(1, 0), cA + kstep, voffA); PG8_STAGE(PG8_SB(1, 1), cB + hstepB + kstep, voffB);
        PG8_WAIT_V(6); PG8_BAR;
    } else {
        PG8_STAGE(PG8_SB(0, 0), cB, voffB); PG8_STAGE(PG8_SA(0, 0), cA, voffA); PG8_STAGE(PG8_SB(0, 1), cB + hstepB, voffB); PG8_STAGE(PG8_SA(0, 1), cA + hstepA, voffA);
        if (wr == 1) PG8_BAR;
        PG8_WAIT_V(4); PG8_BAR;
        PG8_STAGE(PG8_SB(1, 0), cB + kstep, voffB); PG8_STAGE(PG8_SA(1, 0), cA + kstep, voffA); PG8_STAGE(PG8_SB(1, 1), cB + hstepB + kstep, voffB);
        PG8_WAIT_V(6); PG8_BAR;
    }
    for (;;) {
        const bool has_next = S.next(ui + 1, nxt);
        const char* nA = has_next ? (const char*)g.A + (size_t)nxt.pm * tstepA + (size_t)nxt.kofs * 2 : cA; const char* nB = has_next ? (const char*)g.Bt + (size_t)nxt.pn * tstepB + (size_t)nxt.kofs * 2 : cB;
        const int nt = UNIFORM_NT ? nt_uniform : cur.nt;
        for (int t = 0; t < nt; t += 2) {
            const bool last = (t == nt - 2);
            const char* a1 = cA + (size_t)(t + 1) * kstep;
            const char* a2 = last ? nA : cA + (size_t)(t + 2) * kstep; const char* b2 = last ? nB : cB + (size_t)(t + 2) * kstep;
            const char* a3 = a2 + kstep; const char* b3 = b2 + kstep;
            if (last && has_next) S.a_ready(nxt);
            if constexpr (SP2) {
            PG8_LDB(B0, 0, 0); PG8_LDB(B1, 0, 1); PG8_SCHED; PG8_LDA(At, 0, 0); PG8_STAGE(PG8_SA(1, 1), a1 + hstepA, voffA);
            PG8_WAIT_V(8); PG8_WAIT_L(0); PG8_BAR; PG8_MMA(0, 0, At, B0); PG8_MMA(0, 1, At, B1); PG8_BAR; PG8_SCHED;
            PG8_LDA(At, 0, 1); PG8_STAGE(PG8_SB(0, 0), b2, voffB); PG8_STAGE(PG8_SB(0, 1), b2 + hstepB, voffB); PG8_STAGE(PG8_SA(0, 0), a2, voffA);
            PG8_WAIT_V(8); PG8_WAIT_L(0); PG8_BAR; PG8_MMA(1, 0, At, B0); PG8_MMA(1, 1, At, B1); PG8_BAR; PG8_SCHED;
            PG8_LDB(B0, 1, 0); PG8_LDB(B1, 1, 1); PG8_SCHED; PG8_LDA(At, 1, 0); PG8_STAGE(PG8_SA(0, 1), a2 + hstepA, voffA);
            PG8_WAIT_V(8); PG8_WAIT_L(0); PG8_BAR; PG8_MMA(0, 0, At, B0); PG8_MMA(0, 1, At, B1); PG8_BAR; PG8_SCHED;
            PG8_LDA(At, 1, 1); PG8_STAGE(PG8_SB(1, 0), b3, voffB); PG8_STAGE(PG8_SB(1, 1), b3 + hstepB, voffB); PG8_STAGE(PG8_SA(1, 0), a3, voffA);
            PG8_WAIT_V(8); PG8_WAIT_L(0); PG8_BAR; PG8_MMA(1, 0, At, B0); PG8_MMA(1, 1, At, B1); PG8_BAR; PG8_SCHED;
            } else {
            PG8_LDB(B0, 0, 0); PG8_SCHED; PG8_LDA(At, 0, 0); PG8_STAGE(PG8_SA(1, 1), a1 + hstepA, voffA);
            PG8_WAIT_L(8); PG8_BAR; PG8_WAIT_L(0); PG8_MMA(0, 0, At, B0); PG8_BAR; PG8_SCHED;
            PG8_LDB(B1, 0, 1); PG8_STAGE(PG8_SB(0, 0), b2, voffB);
            PG8_BAR; PG8_WAIT_L(0); PG8_MMA(0, 1, At, B1); PG8_BAR;
            PG8_LDA(At, 0, 1); PG8_STAGE(PG8_SA(0, 0), a2, voffA);
            PG8_BAR; PG8_WAIT_L(0); PG8_MMA(1, 0, At, B0); PG8_BAR; PG8_SCHED;
            PG8_STAGE(PG8_SB(0, 1), b2 + hstepB, voffB);
            PG8_WAIT_V(6); PG8_BAR; PG8_MMA(1, 1, At, B1); PG8_BAR;
            PG8_LDB(B0, 1, 0); PG8_SCHED; PG8_LDA(At, 1, 0); PG8_STAGE(PG8_SA(0, 1), a2 + hstepA, voffA);
            PG8_WAIT_L(8); PG8_BAR; PG8_WAIT_L(0); PG8_MMA(0, 0, At, B0); PG8_BAR; PG8_SCHED;
            PG8_LDB(B1, 1, 1); PG8_STAGE(PG8_SB(1, 0), b3, voffB);
            PG8_BAR; PG8_WAIT_L(0); PG8_MMA(0, 1, At, B1); PG8_BAR;
            PG8_LDA(At, 1, 1); PG8_STAGE(PG8_SA(1, 0), a3, voffA);
            PG8_BAR; PG8_WAIT_L(0); PG8_MMA(1, 0, At, B0); PG8_BAR; PG8_SCHED;
            PG8_STAGE(PG8_SB(1, 1), b3 + hstepB, voffB);
            PG8_WAIT_V(6); PG8_BAR; PG8_MMA(1, 1, At, B1); PG8_BAR;
            }
        }
        if constexpr (ALIGN_EPI) { if (wr == 0) PG8_BAR; }
        if constexpr (!Epi::AFTER_DRAIN) { E(acc, cur, wr, wc, fr, fq); S.done(cur); }
        if (!has_next) break;
#pragma unroll
        for (int a = 0; a < 2; ++a)
#pragma unroll
            for (int b = 0; b < 2; ++b)
#pragma unroll
                for (int m = 0; m < 4; ++m)
#pragma unroll
                    for (int n = 0; n < 2; ++n) acc[a][b][m][n] = (f32x4){0.f, 0.f, 0.f, 0.f};
        cur = nxt; cA = nA; cB = nB; ++ui;
        if constexpr (ALIGN_EPI) { if (wr == 1) PG8_BAR; }
    }
    PG8_WAIT_V(0);
    if constexpr (!ALIGN_EPI) { if (wr == 0) PG8_BAR; }
    PG8_BAR;
    if constexpr (Epi::AFTER_DRAIN) { E.fused(acc, cur, wr, wc, fr, fq, lds, wid, lane); S.done(cur); }
#undef PG8_SA
#undef PG8_SB
#undef PG8_STAGE
#undef PG8_LDA
#undef PG8_LDB
#undef PG8_MMA
#undef PG8_WAIT_V
#undef PG8_WAIT_L
#undef PG8_BAR
#undef PG8_SCHED
}
}
constexpr int NWAVES = 8;
constexpr int NB = 8, SEQ = 2048, CTXL = 256, D = 1024, DEPTH = 4, FF = 4096;
constexpr int MLAT = NB * SEQ, MCTX = NB * CTXL, MALL = MLAT + MCTX;
constexpr int ZW = 3328;
constexpr int ZC_GQ = 0, ZC_GK = 256, ZC_GV = 512, ZC_GZ = 768, ZC_SQ = 1024, ZC_SK = 1280, ZC_SV = 1408, ZC_MU = 1536, ZC_MV = 1792,
              ZC_LQ = 2048, ZC_LK = 2304, ZC_LV = 2560, ZC_LO = 2816, ZC_GA = 3072, ZC_GB = 3080, ZC_LI = 3088, ZC_LF = 3096;
constexpr float EPS = 1e-6f;
constexpr size_t MiB = 1u << 20;
constexpr size_t WS_CTL = 0, CTL_ZERO_BYTES = 65536;
constexpr size_t WS_MOD = 1 * MiB;
constexpr size_t WS_WIN = 2 * MiB, WS_WOUT = 9 * MiB, WS_W1 = 11 * MiB, WS_W2 = 19 * MiB, WS_WSP = 27 * MiB;
constexpr size_t WS_CHS = 27 * MiB + 512 * 1024;
constexpr size_t WS_GLG = 27 * MiB + 768 * 1024;
constexpr size_t WS_XC = 29 * MiB;
constexpr size_t WS_H = 37 * MiB;
constexpr size_t WS_MIX = 73 * MiB;
constexpr size_t WS_Z = 109 * MiB;
constexpr size_t WS_PG = 226 * MiB;
constexpr size_t WS_PM = 298 * MiB;
constexpr size_t WS_HID = 109 * MiB;
constexpr size_t WS_SLAB = 254 * MiB;
constexpr size_t WS_WSET2 = 343 * MiB;
constexpr size_t WSET_STRIDE = WS_WSET2 - 2 * MiB;
constexpr size_t WS_END = 369 * MiB;
constexpr int NSPLIT_OUT = 4, NSPLIT_2 = 8;
constexpr int CW_BAR = 1024;
constexpr int LDS_BYTES = 147456;
constexpr int MISC_OFF = 131072 + 8192;

#define LAS __attribute__((address_space(3)))
typedef unsigned short bf16_t;
typedef unsigned v4u __attribute__((ext_vector_type(4)));
typedef unsigned v2u __attribute__((ext_vector_type(2)));
typedef float f32x4 __attribute__((ext_vector_type(4)));
typedef short bf16x8 __attribute__((ext_vector_type(8)));
#define LDS_WAIT() asm volatile("s_waitcnt lgkmcnt(0)" ::: "memory")
#define VM_WAIT() asm volatile("s_waitcnt vmcnt(0)" ::: "memory")
typedef float f32x2_ __attribute__((ext_vector_type(2)));
typedef __bf16 bf16x2_ __attribute__((ext_vector_type(2)));
__device__ __forceinline__ unsigned pk2(float lo, float hi) { const f32x2_ v = {lo, hi}; const bf16x2_ r = __builtin_convertvector(v, bf16x2_); return __builtin_bit_cast(unsigned, r); }
__device__ __forceinline__ unsigned f2bf(float f) { return pk2(f, 0.f) & 0xffffu; }
__device__ __forceinline__ float bf2f(unsigned v) { return __builtin_bit_cast(float, v << 16); }
__device__ __forceinline__ float bflo(unsigned w) { return __builtin_bit_cast(float, w << 16); }
__device__ __forceinline__ float bfhi(unsigned w) { return __builtin_bit_cast(float, w & 0xffff0000u); }
__device__ __forceinline__ float wave_sum(float v) {
#pragma unroll
    for (int o = 1; o < 64; o <<= 1) v += __shfl_xor(v, o);
    return v;
}
__device__ __forceinline__ float frcp(float x) { return __builtin_amdgcn_rcpf(x); }
__device__ __forceinline__ float frsq(float x) { return __builtin_amdgcn_rsqf(x); }
__device__ __forceinline__ float fexp(float x) { return __builtin_amdgcn_exp2f(x * 1.4426950408889634f); }
__device__ __forceinline__ float flog1p(float y) { return y < 0.02f ? y * (1.0f - y * (0.5f - y * (0.33333333f - 0.25f * y))) : __builtin_amdgcn_logf(1.0f + y) * 0.6931471805599453f; }
__device__ __forceinline__ float sigmoidf_(float x) { return frcp(1.f + fexp(-x)); }
__device__ __forceinline__ float siluf_(float x) { return x * frcp(1.f + fexp(-x)); }
__device__ __forceinline__ float softplusf_(float x) { return x > 20.f ? x : flog1p(fexp(x)); }
__device__ __forceinline__ float logsigf_(float x) { return x >= 0.f ? -flog1p(fexp(-x)) : x - flog1p(fexp(x)); }
__device__ __forceinline__ float geluf_(float x) { const float u = 0.7978845608028654f * (x + 0.044715f * x * x * x); const float th = 1.0f - 2.0f * frcp(1.0f + fexp(2.0f * u)); return 0.5f * x * (1.f + th); }
template <int KS> __device__ __forceinline__ f32x4 mma_ll(const LAS bf16_t* A, int lda, const LAS bf16_t* Bt, int ldb, f32x4 acc, int lane) {
    const LAS bf16_t* ap = A + (lane & 15) * lda + 8 * (lane >> 4);
    const LAS bf16_t* bp = Bt + (lane & 15) * ldb + 8 * (lane >> 4);
#pragma unroll
    for (int ks = 0; ks < KS; ++ks) {
        const bf16x8 a = *(const LAS bf16x8*)(ap + 32 * ks); const bf16x8 b = *(const LAS bf16x8*)(bp + 32 * ks);
        acc = __builtin_amdgcn_mfma_f32_16x16x32_bf16(a, b, acc, 0, 0, 0);
    }
    return acc;
}
__device__ __forceinline__ v2u pack4(const f32x4 v) { v2u r; r.x = pk2(v[0], v[1]); r.y = pk2(v[2], v[3]); return r; }
__device__ __forceinline__ f32x4 unpack4(const v2u w) { f32x4 r; r[0] = bflo(w.x); r[1] = bfhi(w.x); r[2] = bflo(w.y); r[3] = bfhi(w.y); return r; }
__device__ __forceinline__ int chunk_row0(int b, int cidx) { return cidx < 4 ? MLAT + b * CTXL + cidx * 64 : b * SEQ + (cidx - 4) * 64; }

#define XB_TMO      128
#define XB_XCNT(j)  (256  + 64 * (j))
#define XB_XSUB(j)  (1280 + 64 * (j))
#define XB_XGEN(j)  (2304 + 64 * (j))
#define XB_TOP      3328
#define XB_TOPGEN   3392
#define XCD_BAR_WORDS 3456
#define XB_SPIN_CAP (1u << 18)

__device__ __forceinline__ unsigned xb_ld(unsigned* p)              { return __hip_atomic_load(p, __ATOMIC_RELAXED, __HIP_MEMORY_SCOPE_AGENT); }
__device__ __forceinline__ unsigned xb_add(unsigned* p, unsigned v) { return __hip_atomic_fetch_add(p, v, __ATOMIC_RELAXED, __HIP_MEMORY_SCOPE_AGENT); }
__device__ __forceinline__ unsigned xb_xcc_id() { return (unsigned)__builtin_amdgcn_s_getreg((3 << 11) | 20) & 0xFu; }
#define XB_SPIN(cond, bar) do { unsigned _sp = 0; while (cond) { __builtin_amdgcn_s_sleep(1); \
    if ((++_sp & 255u) == 0u) { if (xb_ld(&(bar)[XB_TMO])) break; if (_sp > XB_SPIN_CAP) { atomicAdd(&(bar)[XB_TMO], 1u); break; } } } } while (0)

struct XcdBarrier {
    unsigned* bar; unsigned x;
    volatile LAS unsigned* st;
};

__device__ __forceinline__ XcdBarrier xcd_barrier_post(unsigned* bar, volatile LAS unsigned* st, int tid) {
    XcdBarrier b; b.bar = bar; b.x = xb_xcc_id(); b.st = st;
    if (tid == 0) (void)xb_add(&bar[XB_XCNT(b.x)], 1u);
    return b;
}
__device__ __forceinline__ void xcd_barrier_complete(unsigned* bar, unsigned x, unsigned& nloc, unsigned& nx) {
    const unsigned G = gridDim.x * gridDim.y * gridDim.z;
    unsigned sum, cnt, mine, sp = 0u;
    for (;;) {
        sum = 0u; cnt = 0u; mine = 0u;
#pragma unroll
        for (unsigned j = 0; j < 16; ++j) { const unsigned c = xb_ld(&bar[XB_XCNT(j)]); sum += c; cnt += (c > 0u) ? 1u : 0u; mine = (j == x) ? c : mine; }
        if (sum == G) break;
        __builtin_amdgcn_s_sleep(1);
        if ((++sp & 255u) == 0u) { if (xb_ld(&bar[XB_TMO])) break; if (sp > XB_SPIN_CAP) { atomicAdd(&bar[XB_TMO], 1u); break; } }
    }
    nloc = mine > 0u ? mine : 1u; nx = cnt > 0u ? cnt : 1u;
}

__device__ __forceinline__ void xcd_barrier(const XcdBarrier& b, int tid) {
    asm volatile("s_waitcnt vmcnt(0)" ::: "memory");
    __syncthreads();
    if (tid == 0) {
        unsigned* bar = b.bar;
        __builtin_amdgcn_s_waitcnt(0);
        unsigned nloc = b.st[0], nx = b.st[1];
        if (nloc == 0u) { xcd_barrier_complete(bar, b.x, nloc, nx); b.st[0] = nloc; b.st[1] = nx; }
        const unsigned old = xb_add(&bar[XB_XSUB(b.x)], 1u);
        const unsigned gen = old / nloc;
        if (old + 1u == (gen + 1u) * nloc) {
            __builtin_amdgcn_fence(__ATOMIC_RELEASE, "agent");
            asm volatile("s_waitcnt vmcnt(0)" ::: "memory");
            const unsigned og = xb_add(&bar[XB_TOP], 1u);
            const unsigned tg = og / nx;
            if (og + 1u == (tg + 1u) * nx) xb_add(&bar[XB_TOPGEN], 1u);
            else XB_SPIN(xb_ld(&bar[XB_TOPGEN]) == tg, bar);
            __builtin_amdgcn_fence(__ATOMIC_ACQUIRE, "agent");
            xb_add(&bar[XB_XGEN(b.x)], 1u);
            asm volatile("s_waitcnt vmcnt(0)" ::: "memory");
        } else {
            XB_SPIN(xb_ld(&bar[XB_XGEN(b.x)]) == gen, bar);
            __builtin_amdgcn_fence(__ATOMIC_ACQUIRE, "agent");
            asm volatile("s_waitcnt vmcnt(0)" ::: "memory");
        }
    }
    __syncthreads();
}

struct Frame {
    LAS unsigned char* lds;
    int wave, G, gw, NGW;
    const float *x, *c, *ctx, *cctx, *ada_w, *ada_b, *norm1_w, *norm2_w, *w_in, *w_out, *conv_w, *a_log, *dt_bias, *gdn_norm_w, *sink, *w_s, *b_s,
                *gmlp_norm_w, *ig_bias, *fg_bias, *mlstm_norm_w, *w1, *w2, *final_w;
    float* out; unsigned char* ws;
    float *MOD, *XC, *CHS, *GLG, *GLM, *WI, *PEND, *SLAB;
    bf16_t *WIN, *WOUT, *W1, *W2, *WSP, *H, *MIX, *Z, *PG, *PM, *HID;
};

__device__ __forceinline__ int fresh_lane() { int t; asm volatile("v_mbcnt_lo_u32_b32 %0, -1, 0\n\tv_mbcnt_hi_u32_b32 %0, -1, %0" : "=v"(t)); return t; }
__device__ __forceinline__ void phase_mod(const Frame& F) {
    LAS float* sact = (LAS float*)F.lds;
    LAS float* part = sact + 9 * 1024;
    const int lane0 = fresh_lane(), tid0 = F.wave * 64 + lane0;
    for (int i = tid0; i < 9 * 1024; i += NWAVES * 64) { const float v = i < 8192 ? F.c[i] : F.cctx[i - 8192]; sact[i] = v * frcp(1.f + fexp(-v)); }
    __syncthreads();
    for (int task = blockIdx.x; task < DEPTH * 48; task += F.G) {
        const int lane = fresh_lane(), tid = F.wave * 64 + lane;
        const int l = task / 48, cg = task % 48, col = cg * 128 + 2 * lane, k0 = F.wave * 128;
        const float* w = F.ada_w + (size_t)l * 1024 * 6144 + (size_t)k0 * 6144 + col;
        float a0[9], a1[9];
#pragma unroll
        for (int b = 0; b < 9; ++b) { a0[b] = 0.f; a1[b] = 0.f; }
#pragma unroll 8
        for (int k = 0; k < 128; ++k) { const f32x2_ wv = *(const f32x2_*)(w + (size_t)k * 6144);
#pragma unroll
            for (int b = 0; b < 9; ++b) { const float sv = sact[b * 1024 + k0 + k]; a0[b] += sv * wv[0]; a1[b] += sv * wv[1]; } }
#pragma unroll
        for (int b = 0; b < 9; ++b) { part[(F.wave * 9 + b) * 128 + 2 * lane] = a0[b]; part[(F.wave * 9 + b) * 128 + 2 * lane + 1] = a1[b]; }
        __syncthreads();
        for (int o = tid; o < 9 * 128; o += NWAVES * 64) { const int b = o >> 7, cc = o & 127; float s = F.ada_b[l * 6144 + cg * 128 + cc];
#pragma unroll
            for (int wv = 0; wv < 8; ++wv) s += part[(wv * 9 + b) * 128 + cc];
            F.MOD[(l * 9 + b) * 6144 + cg * 128 + cc] = s; }
        __syncthreads();
    }
}

__device__ __forceinline__ void transpose_item(const float* W, int K, int N, int Ndst, bf16_t* WT, LAS float* scr, int item, int lane, bool remap) {
    const int nblk = Ndst / 32, kb = item / nblk, nb = item % nblk, k0 = 64 * kb, n0 = 32 * nb;
    const int n = n0 + (lane & 31);
    const int src = remap ? (n < 1024 ? n : n < 3072 ? n + 16 : n < 3088 ? n - 2048 : n < 3104 ? n : -1) : n;
    float wv[32]; const int srcc = src >= 0 ? src : 0;
#pragma unroll
    for (int i = 0; i < 32; ++i) wv[i] = W[(size_t)(k0 + 2 * i + (lane >> 5)) * N + srcc];
#pragma unroll
    for (int i = 0; i < 32; ++i) scr[(2 * i + (lane >> 5)) * 33 + (lane & 31)] = src >= 0 ? wv[i] : 0.f;
    LDS_WAIT(); asm volatile("" ::: "memory");
    const int c = lane & 7;
#pragma unroll
    for (int j = 0; j < 4; ++j) { const int nn = (lane >> 3) + 8 * j; const LAS float* s = scr + (8 * c) * 33 + nn;
        v4u o; o.x = pk2(s[0 * 33], s[1 * 33]); o.y = pk2(s[2 * 33], s[3 * 33]); o.z = pk2(s[4 * 33], s[5 * 33]); o.w = pk2(s[6 * 33], s[7 * 33]);
        *(v4u*)(WT + (size_t)(n0 + nn) * K + k0 + 8 * c) = o; }
    LDS_WAIT(); asm volatile("" ::: "memory");
}
__device__ __forceinline__ void convert_weights(const Frame& F, int l, int gw, int ngw) {
    LAS float* scr = (LAS float*)(F.lds + F.wave * 16384);
    unsigned char* wb = F.ws + (size_t)(l & 1) * WSET_STRIDE;
    bf16_t* dWIN = (bf16_t*)(wb + WS_WIN); bf16_t* dWOUT = (bf16_t*)(wb + WS_WOUT); bf16_t* dW1 = (bf16_t*)(wb + WS_W1); bf16_t* dW2 = (bf16_t*)(wb + WS_W2); bf16_t* dWSP = (bf16_t*)(wb + WS_WSP);
    constexpr int I_IN = 16 * (ZW / 32), I_OUT = 16 * 32, I_1 = 16 * 128, I_2 = 64 * 32, I_S = 128;
    for (int it = gw; it < I_IN + I_OUT + I_1 + I_2 + I_S; it += ngw) {
        int r = it; const int lane = fresh_lane();
        if (r < I_IN) { transpose_item(F.w_in + (size_t)l * 1024 * 3104, 1024, 3104, ZW, dWIN, scr, r, lane, true); continue; } r -= I_IN;
        if (r < I_OUT) { transpose_item(F.w_out + (size_t)l * 1024 * 1024, 1024, 1024, 1024, dWOUT, scr, r, lane, false); continue; } r -= I_OUT;
        if (r < I_1) { transpose_item(F.w1 + (size_t)l * 1024 * 4096, 1024, 4096, 4096, dW1, scr, r, lane, false); continue; } r -= I_1;
        if (r < I_2) { transpose_item(F.w2 + (size_t)l * 4096 * 1024, 4096, 1024, 1024, dW2, scr, r, lane, false); continue; } r -= I_2;
        { const float* s = F.w_s + (size_t)l * 65536 + r * 512 + lane * 8; const f32x4 a = *(const f32x4*)s, b = *(const f32x4*)(s + 4);
          v4u o; o.x = pk2(a[0], a[1]); o.y = pk2(a[2], a[3]); o.z = pk2(b[0], b[1]); o.w = pk2(b[2], b[3]); *(v4u*)(dWSP + r * 512 + lane * 8) = o; }
    }
}

__device__ __forceinline__ void phase_norm(const Frame& F, int l, int which, int nrows, int nslab, const float* sgate) {
    const float* nwp = (which == 0 ? F.norm1_w : F.norm2_w) + l * 1024;
    const bool init = (which == 0 && l == 0);
    const int lane = fresh_lane();
    f32x4 nwv[4];
#pragma unroll
    for (int j = 0; j < 4; ++j) nwv[j] = *(const f32x4*)(nwp + 256 * j + 4 * lane);
    int m = F.gw; if (m >= nrows) return;
    f32x4 v[4], vn[4];
    { const bool lat = m < MLAT; const float* src = init ? (lat ? F.x + (size_t)m * 1024 : F.ctx + (size_t)(m - MLAT) * 1024) : (lat ? F.out + (size_t)m * 1024 : F.XC + (size_t)(m - MLAT) * 1024);
#pragma unroll
      for (int j = 0; j < 4; ++j) v[j] = *(const f32x4*)(src + 256 * j + 4 * lane); }
    for (; m < nrows; m += F.NGW) {
        const bool lat = m < MLAT; const int bm = lat ? (m >> 11) : 8;
        float* xrow = lat ? F.out + (size_t)m * 1024 : F.XC + (size_t)(m - MLAT) * 1024;
        const float* mod = F.MOD + (l * 9 + bm) * 6144 + (which == 0 ? 0 : 3 * 1024);
        f32x4 shv[4], scv[4];
#pragma unroll
        for (int j = 0; j < 4; ++j) { const int col = 256 * j + 4 * lane; shv[j] = *(const f32x4*)(mod + col); scv[j] = *(const f32x4*)(mod + 1024 + col); }
        const int mn = m + F.NGW;
        if (mn < nrows) { const bool latn = mn < MLAT; const float* srcn = init ? (latn ? F.x + (size_t)mn * 1024 : F.ctx + (size_t)(mn - MLAT) * 1024) : (latn ? F.out + (size_t)mn * 1024 : F.XC + (size_t)(mn - MLAT) * 1024);
#pragma unroll
            for (int j = 0; j < 4; ++j) vn[j] = *(const f32x4*)(srcn + 256 * j + 4 * lane); }
        const bool red = !lat && nslab > 0;
        if (red) {
#pragma unroll
            for (int j = 0; j < 4; ++j) { f32x4 a = {0.f, 0.f, 0.f, 0.f};
                for (int k = 0; k < nslab; ++k) a += *(const f32x4*)(F.SLAB + ((size_t)k * MCTX + (m - MLAT)) * 1024 + 256 * j + 4 * lane);
                v[j] += a * *(const f32x4*)(sgate + 256 * j + 4 * lane); }
        }
        float s = 0.f;
#pragma unroll
        for (int j = 0; j < 4; ++j) s += (v[j][0] * v[j][0] + v[j][1] * v[j][1]) + (v[j][2] * v[j][2] + v[j][3] * v[j][3]);
        const float rstd = frsq(wave_sum(s) * (1.f / 1024.f) + EPS);
#pragma unroll
        for (int j = 0; j < 4; ++j) {
            const int col = 256 * j + 4 * lane;
            if (init || red) *(f32x4*)(xrow + col) = v[j];
            const f32x4 hh = (v[j] * rstd * nwv[j]) * (scv[j] + 1.0f) + shv[j];
            *(v2u*)(F.H + (size_t)m * 1024 + col) = pack4(hh);
        }
#pragma unroll
        for (int j = 0; j < 4; ++j) v[j] = vn[j];
    }
}
__device__ __forceinline__ void phase_final(const Frame& F, bool poison) {
    for (int m = F.gw; m < MLAT; m += F.NGW) {
        const int lane = fresh_lane();
        float* xrow = F.out + (size_t)m * 1024;
        f32x4 v[4]; float s = 0.f;
#pragma unroll
        for (int j = 0; j < 4; ++j) { v[j] = *(const f32x4*)(xrow + 256 * j + 4 * lane); s += (v[j][0] * v[j][0] + v[j][1] * v[j][1]) + (v[j][2] * v[j][2] + v[j][3] * v[j][3]); }
        float rstd = frsq(wave_sum(s) * (1.f / 1024.f) + EPS);
        if (poison) rstd = __builtin_nanf("");
        f32x4 nwv[4];
#pragma unroll
        for (int j = 0; j < 4; ++j) nwv[j] = *(const f32x4*)(F.final_w + 256 * j + 4 * lane);
#pragma unroll
        for (int j = 0; j < 4; ++j) *(f32x4*)(xrow + 256 * j + 4 * lane) = v[j] * rstd * nwv[j];
    }
}

__device__ __forceinline__ void ew_unit(const Frame& F, int l, int rg) {
    const int r0 = rg * 16;
    const int t_o = F.wave * 64 + fresh_lane();
    const int tid = t_o, lane_ = t_o & 63, wave_ = __builtin_amdgcn_readfirstlane(t_o >> 6);
    unsigned short ra[6], rb[6];
#pragma unroll
    for (int j = 0; j < 6; ++j) { const int idx = tid + 512 * j, rr = idx / 192, pr = idx % 192, hd = pr >> 5, f = pr & 31;
        const bf16_t* p = F.Z + (size_t)(r0 + rr) * ZW + (hd < 4 ? ZC_SQ + hd * 64 : ZC_SK + (hd - 4) * 64) + f; ra[j] = p[0]; rb[j] = p[32]; }
#pragma unroll
    for (int j = 0; j < 6; ++j) {
        const int idx = tid + 512 * j, rr = idx / 192, pr = idx % 192, hd = pr >> 5, f = pr & 31, row = r0 + rr;
        bf16_t* p = F.Z + (size_t)row * ZW + (hd < 4 ? ZC_SQ + hd * 64 : ZC_SK + (hd - 4) * 64) + f;
        const float t1 = bf2f(ra[j]), t2 = bf2f(rb[j]);
        if (row < MLAT) {
            const int t = row & (SEQ - 1); const float pos = (float)(f < 16 ? (t >> 6) : (t & 63));
            const float inv = __builtin_amdgcn_exp2f(-(float)(f & 15) * 0.8304820237218406f);
            const float rev = pos * inv * 0.15915494309189535f; const float cs = __builtin_amdgcn_cosf(rev), sn = __builtin_amdgcn_sinf(rev);
            const float sc = hd < 4 ? 0.125f : 1.0f;
            p[0] = (bf16_t)f2bf((t1 * cs - t2 * sn) * sc); p[32] = (bf16_t)f2bf((t1 * sn + t2 * cs) * sc);
        } else if (hd < 4) {
            p[0] = (bf16_t)f2bf(t1 * 0.125f); p[32] = (bf16_t)f2bf(t2 * 0.125f);
        }
    }
    v2u ur[2], vr[2];
#pragma unroll
    for (int j = 0; j < 2; ++j) { const bf16_t* zr = F.Z + (size_t)(r0 + 2 * wave_ + j) * ZW + 4 * lane_; ur[j] = *(const v2u*)(zr + ZC_MU); vr[j] = *(const v2u*)(zr + ZC_MV); }
    const f32x4 gnw = *(const f32x4*)(F.gmlp_norm_w + l * 256 + 4 * lane_);
#pragma unroll
    for (int j = 0; j < 2; ++j) {
        bf16_t* zr = F.Z + (size_t)(r0 + 2 * wave_ + j) * ZW + 4 * lane_;
        f32x4 u = unpack4(ur[j]), v = unpack4(vr[j]); float ss = 0.f;
#pragma unroll
        for (int e = 0; e < 4; ++e) { u[e] = geluf_(u[e]); v[e] = geluf_(v[e]); ss += v[e] * v[e]; }
        const float rs = frsq(wave_sum(ss) * (1.f / 256.f) + EPS);
        *(v2u*)(zr + ZC_MU) = pack4(u); *(v2u*)(zr + ZC_MV) = pack4(v * rs * gnw);
    }
}
__device__ __forceinline__ void chs_unit(const Frame& F, int l, int ck) {
    const int b = ck / 36, cidx = ck % 36, row0 = chunk_row0(b, cidx);
    const int t = F.wave * 64 + fresh_lane();
    LAS float* G = (LAS float*)F.lds;
#pragma unroll
    for (int j = 0; j < 2; ++j) { const int idx = t + 512 * j, p = idx >> 4, c = idx & 15, dh = c & 7;
        const float raw = bf2f(F.Z[(size_t)(row0 + p) * ZW + ZC_LI + c]);
        G[c * 64 + p] = c < 8 ? raw + F.ig_bias[l * 8 + dh] : logsigf_(raw + F.fg_bias[l * 8 + dh]); }
    __syncthreads();
    if (t < 8) { const int d = t >> 2, h = t & 3; float bsum = 0.f, mx = -1e30f;
        for (int i = 0; i < 64; ++i) { const int p = d ? 63 - i : i; bsum += G[(8 + t) * 64 + p]; mx = fmaxf(mx, G[t * 64 + p] - bsum); }
        float* o = F.CHS + ((((b * 4 + h) * 2 + d) * 36) + cidx) * 2; o[0] = bsum; o[1] = bsum + mx; }
    __syncthreads();
}

__device__ __forceinline__ void gdn_prep_unit(const Frame& F, int l, int u, int stop = 99, bf16_t* PGo = nullptr) {
    if (!PGo) PGo = F.PG;
    const int b = u / 144, h = (u / 36) & 3, cidx = u % 36;
    const int row0 = chunk_row0(b, cidx);
    const int seg_lo = cidx < 4 ? MLAT + b * CTXL : b * SEQ, seg_hi = seg_lo + (cidx < 4 ? CTXL : SEQ);
    const int t_o = F.wave * 64 + fresh_lane();
    const int t = t_o, lane = t & 63, w = __builtin_amdgcn_readfirstlane(t >> 6), lr = lane & 15, lq = lane >> 4;
    LAS unsigned char* L = F.lds;
    LAS bf16_t* Qs = (LAS bf16_t*)(L + 0); LAS bf16_t* Ks = (LAS bf16_t*)(L + 9216); LAS bf16_t* Kt = (LAS bf16_t*)(L + 18432); LAS bf16_t* Vt = (LAS bf16_t*)(L + 27648);
    LAS float* gS = (LAS float*)(L + 36864); LAS float* bS = gS + 128; LAS float* gcS = gS + 256; LAS float* totS = gS + 384;
    LAS float* As = (LAS float*)(L + 38912);
    LAS float* CV = (LAS float*)(L + 38912);
    LAS bf16_t* UT = (LAS bf16_t*)(L + 38912); LAS bf16_t* UTd = UT + 4608; LAS bf16_t* WT = UT + 9216; LAS bf16_t* WTd = UT + 13824;
    LAS bf16_t* Tb = (LAS bf16_t*)(L + 75776);
    LAS bf16_t* At = (LAS bf16_t*)(L + 112640);
    if (t < 384) {
        const int pair = t % 96, rg = t / 96, c0 = 2 * pair, part = c0 >> 6, d0 = c0 & 63, zcol = part * 256 + h * 64 + d0;
        float cw[5][2];
#pragma unroll
        for (int j = 0; j < 5; ++j) { const float* wp = F.conv_w + (size_t)(l * 5 + j) * 768 + part * 256 + h * 64 + d0; cw[j][0] = wp[0]; cw[j][1] = wp[1]; }
        float win[20][2];
        unsigned raw[20];
        { const int rbase = row0 + rg * 16 - 2; const bf16_t* zc = F.Z + zcol;
#pragma unroll
          for (int rr = 0; rr < 20; ++rr) { int row = rbase + rr; row = row < seg_lo ? seg_lo : (row >= seg_hi ? seg_hi - 1 : row); raw[rr] = *(const unsigned*)(zc + (size_t)row * ZW); }
          asm volatile("" : "+v"(raw[0]), "+v"(raw[1]), "+v"(raw[2]), "+v"(raw[3]), "+v"(raw[4]), "+v"(raw[5]), "+v"(raw[6]), "+v"(raw[7]), "+v"(raw[8]), "+v"(raw[9]));
          asm volatile("" : "+v"(raw[10]), "+v"(raw[11]), "+v"(raw[12]), "+v"(raw[13]), "+v"(raw[14]), "+v"(raw[15]), "+v"(raw[16]), "+v"(raw[17]), "+v"(raw[18]), "+v"(raw[19]));
#pragma unroll
          for (int rr = 0; rr < 20; ++rr) { const int row = rbase + rr; const unsigned wv = (row >= seg_lo && row < seg_hi) ? raw[rr] : 0u; win[rr][0] = bflo(wv); win[rr][1] = bfhi(wv); } }
#pragma unroll
        for (int i = 0; i < 16; ++i) { float a0 = 0.f, a1 = 0.f;
#pragma unroll
            for (int j = 0; j < 5; ++j) { a0 += cw[j][0] * win[i + j][0]; a1 += cw[j][1] * win[i + j][1]; }
            CV[(rg * 16 + i) * 196 + c0] = siluf_(a0); CV[(rg * 16 + i) * 196 + c0 + 1] = siluf_(a1); }
    } else {
        const int tt = t - 384, d = tt >> 6, p = tt & 63; const bf16_t* zr = F.Z + (size_t)(row0 + p) * ZW;
        const float a = bf2f(zr[ZC_GA + d * 4 + h]), bb = bf2f(zr[ZC_GB + d * 4 + h]);
        gS[d * 64 + p] = -fexp(F.a_log[l * 8 + d * 4 + h]) * softplusf_(a + F.dt_bias[l * 8 + d * 4 + h]);
        bS[d * 64 + p] = sigmoidf_(bb);
    }
    __syncthreads();
    if (stop <= 1) return;
    {
        const int combo = t >> 2, sub = t & 3, row = combo & 63, part = combo >> 6;
        float v[16]; float ss = 0.f;
#pragma unroll
        for (int i = 0; i < 16; ++i) { v[i] = CV[row * 196 + part * 64 + sub * 16 + i]; ss += v[i] * v[i]; }
        ss += __shfl_xor(ss, 1); ss += __shfl_xor(ss, 2);
        const float rs = frsq(ss + EPS);
        LAS bf16_t* dst = (part == 0 ? Qs : Ks) + row * 72 + sub * 16;
        v4u o0, o1;
        o0.x = pk2(v[0] * rs, v[1] * rs); o0.y = pk2(v[2] * rs, v[3] * rs); o0.z = pk2(v[4] * rs, v[5] * rs); o0.w = pk2(v[6] * rs, v[7] * rs);
        o1.x = pk2(v[8] * rs, v[9] * rs); o1.y = pk2(v[10] * rs, v[11] * rs); o1.z = pk2(v[12] * rs, v[13] * rs); o1.w = pk2(v[14] * rs, v[15] * rs);
        *(LAS v4u*)dst = o0; *(LAS v4u*)(dst + 8) = o1;
        if (part == 1) {
#pragma unroll
            for (int i = 0; i < 16; ++i) Kt[(sub * 16 + i) * 72 + row] = (bf16_t)f2bf(v[i] * rs);
        }
        const int vrow = t & 63, dg = t >> 6;
#pragma unroll
        for (int i = 0; i < 8; ++i) Vt[(dg * 8 + i) * 72 + vrow] = (bf16_t)f2bf(CV[vrow * 196 + 128 + dg * 8 + i]);
        if (w < 2) { const int d = w, p = d ? 63 - lane : lane; float s = gS[d * 64 + p];
#pragma unroll
            for (int off = 1; off < 64; off <<= 1) { const float y = __shfl_up(s, off); if (lane >= off) s += y; }
            gcS[d * 64 + p] = s; if (lane == 63) totS[d] = s; }
    }
    __syncthreads();
    if (stop <= 2) return;
#pragma unroll
    for (int k2 = 0; k2 < 2; ++k2) {
        const int tt = 2 * w + k2, mt = tt >> 2, nt = tt & 3;
        f32x4 accG = {0.f, 0.f, 0.f, 0.f}, accQ = {0.f, 0.f, 0.f, 0.f};
        accG = mma_ll<2>(Ks + mt * 16 * 72, 72, Ks + nt * 16 * 72, 72, accG, lane);
        accQ = mma_ll<2>(Ks + mt * 16 * 72, 72, Qs + nt * 16 * 72, 72, accQ, lane);
        const int n = nt * 16 + lr, m0 = mt * 16 + 4 * lq;
#pragma unroll
        for (int d = 0; d < 2; ++d) {
            const float gcn = gcS[d * 64 + n], bn = bS[d * 64 + n];
            f32x4 av, tv;
#pragma unroll
            for (int i = 0; i < 4; ++i) { const int m = m0 + i; const float gcm = gcS[d * 64 + m];
                const bool strict = d == 0 ? (m < n) : (m > n); const bool incl = d == 0 ? (m <= n) : (m >= n);
                const float e = fexp(incl ? (gcn - gcm) : 0.f);
                av[i] = strict ? bn * accG[i] * e : 0.f; tv[i] = incl ? 0.125f * accQ[i] * e : 0.f; }
#pragma unroll
            for (int i = 0; i < 4; ++i) { const int si = d ? 63 - n : n, sj = d ? 63 - (m0 + i) : m0 + i; As[d * 4352 + (si >> 1) * 136 + sj * 2 + (si & 1)] = av[i]; }
            *(LAS v2u*)(At + d * 4608 + n * 72 + m0) = pack4(tv);
        }
    }
    __syncthreads();
    if (stop <= 3) return;
    if (w < 2) {
        const int d = w; const LAS float* Ad = As + d * 4352;
        float tr[64]; int lane_o = lane;
#pragma unroll
        for (int ip = 0; ip < 32; ++ip) {
            const int i0 = 2 * ip;
            f32x4 rv[32];
#pragma unroll
            for (int jp = 0; jp <= ip; ++jp) rv[jp] = *(const LAS f32x4*)(Ad + ip * 136 + 4 * jp);
            asm volatile("" : "+v"(lane_o) :: "memory");
            f32x2_ a0 = {0.f, 0.f}, a1 = {0.f, 0.f}, a2 = {0.f, 0.f}, a3 = {0.f, 0.f};
#pragma unroll
            for (int jp = 0; jp < ip; ++jp) {
                const f32x2_ ta = {tr[2 * jp], tr[2 * jp]}, tb = {tr[2 * jp + 1], tr[2 * jp + 1]};
                const f32x2_ va = {rv[jp][0], rv[jp][1]}, vb = {rv[jp][2], rv[jp][3]};
                if (jp & 1) { a2 += va * ta; a3 += vb * tb; } else { a0 += va * ta; a1 += vb * tb; }
            }
            const f32x2_ sum = (a0 + a1) + (a2 + a3);
            const float t0 = (lane_o == i0 ? 1.f : 0.f) - sum[0];
            tr[i0] = t0;
            tr[i0 + 1] = (lane_o == i0 + 1 ? 1.f : 0.f) - sum[1] - rv[ip][1] * t0;
        }
        const int pb = d ? 63 - lane : lane; const float sb = bS[d * 64 + pb], sbe = sb * fexp(gcS[d * 64 + pb]);
        LAS bf16_t* T0 = Tb + d * 9216; LAS bf16_t* T1 = T0 + 4608;
#pragma unroll
        for (int i = 0; i < 64; ++i) { const int pa = d ? 63 - i : i; T0[pa * 72 + pb] = (bf16_t)f2bf(tr[i] * sb); T1[pa * 72 + pb] = (bf16_t)f2bf(tr[i] * sbe); }
    }
    __syncthreads();
    if (stop <= 4) return;
#pragma unroll 1
    for (int d = 0; d < 2; ++d) {
        const int ud = u * 2 + d; const float tot = totS[d];
        const LAS bf16_t* T0 = Tb + d * 9216; const LAS bf16_t* T1 = T0 + 4608; const LAS bf16_t* Ad = At + d * 4608;
        {
            const bool isw = w >= 4; const LAS bf16_t* Aop = isw ? T1 : T0; const LAS bf16_t* Bop = isw ? Kt : Vt;
            LAS bf16_t* o0 = isw ? WT : UT; LAS bf16_t* o1 = isw ? WTd : UTd;
#pragma unroll
            for (int k4 = 0; k4 < 4; ++k4) { const int tt = (w & 3) * 4 + k4, mt = tt >> 2, nt = tt & 3;
                f32x4 acc = {0.f, 0.f, 0.f, 0.f}; acc = mma_ll<2>(Aop + mt * 16 * 72, 72, Bop + nt * 16 * 72, 72, acc, lane);
                const int n = nt * 16 + lr, m0 = mt * 16 + 4 * lq; f32x4 dv;
#pragma unroll
                for (int i = 0; i < 4; ++i) dv[i] = acc[i] * fexp(tot - gcS[d * 64 + m0 + i]);
                *(LAS v2u*)(o0 + n * 72 + m0) = pack4(acc); *(LAS v2u*)(o1 + n * 72 + m0) = pack4(dv); }
        }
        __syncthreads();
        {
            const int prod = w >> 1; bf16_t* gout = PGo + (size_t)ud * 16384 + prod * 4096;
            const LAS bf16_t* Aop = prod == 0 ? WTd : prod == 1 ? Kt : prod == 2 ? WT : Ad;
            const LAS bf16_t* Bop = prod == 0 ? Kt : prod == 1 ? UTd : prod == 2 ? Ad : UT;
#pragma unroll
            for (int k8 = 0; k8 < 8; ++k8) { const int tt = (w & 1) * 8 + k8, mt = tt >> 2, nt = tt & 3;
                f32x4 acc = {0.f, 0.f, 0.f, 0.f}; acc = mma_ll<2>(Aop + mt * 16 * 72, 72, Bop + nt * 16 * 72, 72, acc, lane);
                const int n = nt * 16 + lr, m0 = mt * 16 + 4 * lq;
                if (prod == 2) { const f32x4 qv = unpack4(*(const LAS v2u*)(Qs + n * 72 + m0)); const float e = 0.125f * fexp(gcS[d * 64 + n]); acc = qv * e - acc; }
                const int off = (prod == 0 || prod == 2) ? ((nt * 2 + (mt >> 1)) * 64 + ((mt & 1) * 2 + (lq >> 1)) * 16 + lr) * 8 + 4 * (lq & 1) : ((mt * 4 + nt) * 64 + lane) * 4;
                *(v2u*)(gout + off) = pack4(acc); }
        }
        if (t == 0 && PGo == F.PG) F.GLG[ud] = fexp(tot);
        __syncthreads();
    }
}

__device__ __forceinline__ void mlstm_prep_unit(const Frame& F, int l, int u) {
    const int b = u / 144, h = (u / 36) & 3, cidx = u % 36;
    const int row0 = chunk_row0(b, cidx);
    const int t_o = F.wave * 64 + fresh_lane();
    const int t = t_o, lane = t & 63, w = __builtin_amdgcn_readfirstlane(t >> 6), lr = lane & 15, lq = lane >> 4;
    LAS unsigned char* L = F.lds;
    LAS bf16_t* Qs = (LAS bf16_t*)(L + 0); LAS bf16_t* Ks = (LAS bf16_t*)(L + 9216); LAS bf16_t* Vta = (LAS bf16_t*)(L + 18432);
    LAS bf16_t* Kte = (LAS bf16_t*)(L + 29952);
    LAS bf16_t* S0 = (LAS bf16_t*)(L + 48384);
    LAS float* igS = (LAS float*)(L + 66816); LAS float* lfS = igS + 128; LAS float* bS = igS + 256; LAS float* dmS = igS + 384; LAS float* rS = igS + 512;
    LAS float* flS = igS + 640; LAS float* eS = igS + 768; LAS float* mpS = igS + 896; LAS float* chS = igS + 904;
    {
        const int r = t >> 3, seg = t & 7; const bf16_t* zr = F.Z + (size_t)(row0 + r) * ZW + h * 64 + seg * 8;
        const v4u q = *(const v4u*)(zr + ZC_LQ), k = *(const v4u*)(zr + ZC_LK), v = *(const v4u*)(zr + ZC_LV);
        *(LAS v4u*)(Qs + r * 72 + seg * 8) = q; *(LAS v4u*)(Ks + r * 72 + seg * 8) = k;
        Vta[(seg * 8 + 0) * 72 + r] = (bf16_t)(v.x & 0xffffu); Vta[(seg * 8 + 1) * 72 + r] = (bf16_t)(v.x >> 16);
        Vta[(seg * 8 + 2) * 72 + r] = (bf16_t)(v.y & 0xffffu); Vta[(seg * 8 + 3) * 72 + r] = (bf16_t)(v.y >> 16);
        Vta[(seg * 8 + 4) * 72 + r] = (bf16_t)(v.z & 0xffffu); Vta[(seg * 8 + 5) * 72 + r] = (bf16_t)(v.z >> 16);
        Vta[(seg * 8 + 6) * 72 + r] = (bf16_t)(v.w & 0xffffu); Vta[(seg * 8 + 7) * 72 + r] = (bf16_t)(v.w >> 16);
#pragma unroll
        for (int j = 0; j < 2; ++j) { const int idx = t + 512 * j, rr = 64 + (idx >> 6), cc = idx & 63; Vta[rr * 72 + cc] = (bf16_t)(rr == 64 ? 0x3F80u : 0u); }
        if (t < 128) { const int d = t >> 6, p = t & 63; const bf16_t* zg = F.Z + (size_t)(row0 + p) * ZW;
            igS[d * 64 + p] = bf2f(zg[ZC_LI + d * 4 + h]) + F.ig_bias[l * 8 + d * 4 + h];
            lfS[d * 64 + p] = logsigf_(bf2f(zg[ZC_LF + d * 4 + h]) + F.fg_bias[l * 8 + d * 4 + h]); }
        if (t >= 128 && t < 272) chS[t - 128] = F.CHS[(size_t)((b * 4 + h) * 2) * 72 + (t - 128)];
    }
    __syncthreads();
    if (w < 2) {
        const int d = w, p = d ? 63 - lane : lane;
        const int step_of = d ? (cidx < 4 ? 3 - cidx : 39 - cidx) : cidx; float mprev = 0.f;
        for (int s = 0; s < step_of; ++s) { const int ci = d ? (s < 4 ? 3 - s : 39 - s) : s; mprev = fmaxf(chS[d * 72 + ci * 2] + mprev, chS[d * 72 + ci * 2 + 1]); }
        const float ig = igS[d * 64 + p]; float bp = lfS[d * 64 + p];
#pragma unroll
        for (int off = 1; off < 64; off <<= 1) { const float y = __shfl_up(bp, off); if (lane >= off) bp += y; }
        float mxp = ig - bp;
#pragma unroll
        for (int off = 1; off < 64; off <<= 1) { const float y = __shfl_up(mxp, off); if (lane >= off) mxp = fmaxf(mxp, y); }
        const float mxall = __shfl(mxp, 63), bl = __shfl(bp, 63);
        const float dmax = bp + mxp, wsmax = bl + mxall;
        const float mnew = fmaxf(bl + mprev, wsmax), cd = fexp(bl + mprev - mnew), e2 = fexp(wsmax - mnew);
        const float mt = fmaxf(bp + mprev, dmax);
        bS[d * 64 + p] = bp; dmS[d * 64 + p] = dmax; rS[d * 64 + p] = fexp(dmax - mt); flS[d * 64 + p] = fexp(-mt);
        eS[d * 64 + p] = fexp(bl - bp + ig - wsmax) * e2;
        const int ud = u * 2 + d; F.WI[ud * 64 + p] = 0.125f * fexp(bp + mprev - mt); if (lane == 0) F.GLM[ud] = cd; }
    __syncthreads();
    {
        const int d = t >> 8, tt = t & 255, p = tt & 63, dg = tt >> 6; const float e = eS[d * 64 + p];
#pragma unroll
        for (int i = 0; i < 16; ++i) Kte[d * 4608 + (dg * 16 + i) * 72 + p] = (bf16_t)f2bf(bf2f(Ks[p * 72 + dg * 16 + i]) * e);
#pragma unroll
        for (int k2 = 0; k2 < 2; ++k2) { const int tl = 2 * w + k2, mt = tl >> 2, nt = tl & 3;
            f32x4 acc = {0.f, 0.f, 0.f, 0.f}; acc = mma_ll<2>(Ks + mt * 16 * 72, 72, Qs + nt * 16 * 72, 72, acc, lane);
            const int n = nt * 16 + lr, m0 = mt * 16 + 4 * lq;
#pragma unroll
            for (int dd = 0; dd < 2; ++dd) { const float bn = bS[dd * 64 + n], dn = dmS[dd * 64 + n], rn = rS[dd * 64 + n]; f32x4 sv;
#pragma unroll
                for (int i = 0; i < 4; ++i) { const int m = m0 + i; const bool incl = dd == 0 ? (m <= n) : (m >= n);
                    const float arg = incl ? (bn - bS[dd * 64 + m] + igS[dd * 64 + m] - dn) : 0.f; sv[i] = incl ? 0.125f * acc[i] * fexp(arg) * rn : 0.f; }
                *(LAS v2u*)(S0 + dd * 4608 + n * 72 + m0) = pack4(sv); } }
    }
    __syncthreads();
    {
        const int d = w >> 2, ud = u * 2 + d; bf16_t* gO = F.PM + (size_t)ud * 10240; bf16_t* gB = gO + 5120;
#pragma unroll 2
        for (int k = 0; k < 10; ++k) { const int tl = (w & 3) * 10 + k; const bool iskv = tl >= 20; const int t2 = iskv ? tl - 20 : tl, mt = t2 / 5, nt = t2 % 5;
            const LAS bf16_t* Aop = (iskv ? Kte : S0) + d * 4608 + mt * 16 * 72;
            f32x4 acc = {0.f, 0.f, 0.f, 0.f}; acc = mma_ll<2>(Aop, 72, Vta + nt * 16 * 72, 72, acc, lane);
            const int n = nt * 16 + lr, m0 = mt * 16 + 4 * lq;
            if (!iskv && n == 65) {
#pragma unroll
                for (int i = 0; i < 4; ++i) acc[i] = flS[d * 64 + m0 + i]; }
            *(v2u*)((iskv ? gB : gO) + ((mt * 5 + nt) * 64 + lane) * 4) = pack4(acc); }
    }
    __syncthreads();
}

__device__ __forceinline__ void l2_touch(const void* gsrc, unsigned lds_dst) {
    unsigned keep;
    asm volatile("s_mov_b32 %0, m0\n\ts_mov_b32 m0, %2\n\ts_nop 0\n\tglobal_load_lds_dword %1, off\n\ts_mov_b32 m0, %0" : "=&s"(keep) : "v"(gsrc), "s"(lds_dst) : "memory");
}
template <int NT> struct ScanOps { bf16x8 Qf[2], Mf[2]; v2u bv[NT], ov[NT]; float gl; f32x4 wi; };
template <bool GDN, int NT> __device__ __forceinline__ void scan_load(const Frame& F, int b, int h, int dir, int wq, int lr, int lq, int s, ScanOps<NT>& o) {
    const int cidx = dir ? (s < 4 ? 3 - s : 39 - s) : s;
    const int ud = ((b * 4 + h) * 36 + cidx) * 2 + dir;
    if (GDN) {
        const bf16_t* gM = F.PG + (size_t)ud * 16384; const bf16_t* gQ = gM + 8192;
#pragma unroll
        for (int ks = 0; ks < 2; ++ks) { o.Mf[ks] = *(const bf16x8*)(gM + ((wq * 2 + ks) * 64 + lq * 16 + lr) * 8); o.Qf[ks] = *(const bf16x8*)(gQ + ((wq * 2 + ks) * 64 + lq * 16 + lr) * 8); }
    } else {
        const bf16_t* zq = F.Z + (size_t)(chunk_row0(b, cidx) + 16 * wq + lr) * ZW + ZC_LQ + h * 64;
#pragma unroll
        for (int ks = 0; ks < 2; ++ks) { o.Qf[ks] = *(const bf16x8*)(zq + 32 * ks + 8 * lq); o.Mf[ks] = o.Qf[ks]; }
    }
    const bf16_t* gB = GDN ? F.PG + (size_t)ud * 16384 + 4096 : F.PM + (size_t)ud * 10240 + 5120;
    const bf16_t* gO = GDN ? F.PG + (size_t)ud * 16384 + 12288 : F.PM + (size_t)ud * 10240;
#pragma unroll
    for (int t = 0; t < NT; ++t) { o.bv[t] = *(const v2u*)(gB + ((wq * NT + t) * 64 + lq * 16 + lr) * 4); o.ov[t] = *(const v2u*)(gO + ((wq * NT + t) * 64 + lq * 16 + lr) * 4); }
    o.gl = GDN ? F.GLG[ud] : F.GLM[ud];
    o.wi = (f32x4){1.f, 1.f, 1.f, 1.f}; if (!GDN) o.wi = *(const f32x4*)(F.WI + ud * 64 + 16 * wq + 4 * lq);
}
struct ScanFin { f32x4 pend[4]; unsigned short gz[4][4]; };
template <bool GDN> __device__ __forceinline__ void scan_fin_load(const Frame& F, int b, int h, int dir, int wq, int lr, int lq, int s, const float* PEND, ScanFin& f) {
    const int cidx = dir ? (s < 4 ? 3 - s : 39 - s) : s; const int row0 = chunk_row0(b, cidx);
    const float* pp = PEND + (size_t)((b * 4 + h) * 36 + cidx) * 4096 + (wq * 256 + lq * 16 + lr) * 4;
#pragma unroll
    for (int t = 0; t < 4; ++t) { f.pend[t] = *(const f32x4*)(pp + t * 256);
#pragma unroll
        for (int i = 0; i < 4; ++i) f.gz[t][i] = F.Z[(size_t)(row0 + 16 * wq + 4 * lq + i) * ZW + (GDN ? ZC_GZ : ZC_LO) + h * 64 + 16 * t + lr]; }
}
__device__ __forceinline__ bool scan_first(int s) { return s < 4 ? (s <= 1) : (s <= 19); }
template <bool GDN> __device__ __forceinline__ void scan_finish(const Frame& F, int b, int h, int dir, int wq, int lr, int lq, int s, float* PEND, const f32x4 (&Oin)[4], const ScanFin& f, const float (&nwv)[4]) {
    const int cidx = dir ? (s < 4 ? 3 - s : 39 - s) : s; const int row0 = chunk_row0(b, cidx);
    float* pp = PEND + (size_t)((b * 4 + h) * 36 + cidx) * 4096 + (wq * 256 + lq * 16 + lr) * 4;
    if (scan_first(s)) {
#pragma unroll
        for (int t = 0; t < 4; ++t) *(f32x4*)(pp + t * 256) = Oin[t];
    } else {
        f32x4 O[4]; float ss[4] = {0.f, 0.f, 0.f, 0.f};
#pragma unroll
        for (int t = 0; t < 4; ++t)
#pragma unroll
            for (int i = 0; i < 4; ++i) { O[t][i] = Oin[t][i] + f.pend[t][i]; ss[i] += O[t][i] * O[t][i]; }
#pragma unroll
        for (int i = 0; i < 4; ++i) { ss[i] += __shfl_xor(ss[i], 1); ss[i] += __shfl_xor(ss[i], 2); ss[i] += __shfl_xor(ss[i], 4); ss[i] += __shfl_xor(ss[i], 8); ss[i] = frsq(ss[i] * (1.f / 64.f) + EPS); }
#pragma unroll
        for (int t = 0; t < 4; ++t) { const int dv = 16 * t + lr;
#pragma unroll
            for (int i = 0; i < 4; ++i) { const int row = row0 + 16 * wq + 4 * lq + i;
                const float g = bf2f(f.gz[t][i]);
                const float gate = GDN ? siluf_(g) : sigmoidf_(g);
                F.MIX[(size_t)row * 1024 + (GDN ? 0 : 768) + h * 64 + dv] = (bf16_t)f2bf(O[t][i] * ss[i] * nwv[t] * gate); } }
    }
}
template <bool GDN> __device__ __forceinline__ void scan_wg(const Frame& F, int l, int bh, bool nofin = false) {
    constexpr int NT = GDN ? 4 : 5;
    const int b = bh >> 2, h = bh & 3;
    const int lane = fresh_lane(), dir = F.wave >> 2, wq = F.wave & 3, lr = lane & 15, lq = lane >> 4;
    LAS bf16_t* St = (LAS bf16_t*)F.lds;
    f32x4 S[NT];
#pragma unroll
    for (int t = 0; t < NT; ++t) S[t] = (f32x4){0.f, 0.f, 0.f, 0.f};
    const float* nw = GDN ? F.gdn_norm_w + l * 64 : F.mlstm_norm_w + l * 256 + h * 64;
    float nwv[4];
#pragma unroll
    for (int t = 0; t < 4; ++t) nwv[t] = nw[16 * t + lr];
    float* PEND = F.PEND + (GDN ? (size_t)0 : (size_t)1152 * 4096);
    ScanOps<NT> cur, nxt; ScanFin fcur, fprev;
    f32x4 Oprev[4];
#pragma unroll
    for (int t = 0; t < 4; ++t) { Oprev[t] = (f32x4){0.f, 0.f, 0.f, 0.f}; fcur.pend[t] = (f32x4){0.f, 0.f, 0.f, 0.f}; fprev.pend[t] = (f32x4){0.f, 0.f, 0.f, 0.f};
#pragma unroll
        for (int i = 0; i < 4; ++i) { fcur.gz[t][i] = 0; fprev.gz[t][i] = 0; } }
    scan_load<GDN, NT>(F, b, h, dir, wq, lr, lq, 0, cur);
#pragma unroll 1
    for (int s = 0; s < 37; ++s) {
        LAS bf16_t* Sb = St + ((dir * 2 + (s & 1)) * 80) * 72;
        if (s < 36) {
#pragma unroll
            for (int t = 0; t < NT; ++t) *(LAS v2u*)(Sb + (16 * t + lr) * 72 + 16 * wq + 4 * lq) = pack4(S[t]); }
        VM_WAIT();
        __syncthreads();
        if (s > 0) {
            const int sp = s - 1;
            if (sp == 20 || sp == 2) scan_fin_load<GDN>(F, b, h, dir, wq, lr, lq, sp, PEND, fprev);
            if (!nofin) scan_finish<GDN>(F, b, h, dir, wq, lr, lq, sp, PEND, Oprev, fprev, nwv);
        }
        if (s == 36) break;
        scan_load<GDN, NT>(F, b, h, dir, wq, lr, lq, s < 35 ? s + 1 : 35, nxt);
        if (!scan_first(s) && s != 20 && s != 2) scan_fin_load<GDN>(F, b, h, dir, wq, lr, lq, s, PEND, fcur);
        f32x4 O[NT];
#pragma unroll
        for (int t = 0; t < NT; ++t) {
            const LAS bf16_t* sp = Sb + (16 * t + lr) * 72 + 8 * lq;
            const bf16x8 s0 = *(const LAS bf16x8*)sp, s1 = *(const LAS bf16x8*)(sp + 32);
            f32x4 o = {0.f, 0.f, 0.f, 0.f};
            o = __builtin_amdgcn_mfma_f32_16x16x32_bf16(cur.Qf[0], s0, o, 0, 0, 0); o = __builtin_amdgcn_mfma_f32_16x16x32_bf16(cur.Qf[1], s1, o, 0, 0, 0);
            const f32x4 bv = unpack4(cur.bv[t]), ov = unpack4(cur.ov[t]);
            if (GDN) {
                f32x4 ms = {0.f, 0.f, 0.f, 0.f};
                ms = __builtin_amdgcn_mfma_f32_16x16x32_bf16(cur.Mf[0], s0, ms, 0, 0, 0); ms = __builtin_amdgcn_mfma_f32_16x16x32_bf16(cur.Mf[1], s1, ms, 0, 0, 0);
                S[t] = S[t] * cur.gl - ms + bv; O[t] = o + ov;
            } else { S[t] = S[t] * cur.gl + bv; O[t] = o * cur.wi + ov; }
        }
        if (!GDN) {
#pragma unroll
            for (int i = 0; i < 4; ++i) { const float den = __shfl(O[NT - 1][i], lane & 48), fl = __shfl(O[NT - 1][i], (lane & 48) + 1); const float dv = frcp(fmaxf(fabsf(den), fl));
#pragma unroll
                for (int t = 0; t < 4; ++t) O[t][i] *= dv; }
        }
#pragma unroll
        for (int t = 0; t < 4; ++t) Oprev[t] = O[t];
        fprev = fcur; cur = nxt;
    }
    VM_WAIT();
    __syncthreads();
}

__device__ __forceinline__ void swa_unit(const Frame& F, int l, int it) {
    const bool lat = it < 256; int b, kvh, qb;
    if (lat) { b = it >> 5; kvh = (it >> 4) & 1; qb = it & 15; } else { const int j = it - 256; b = j >> 2; kvh = (j >> 1) & 1; qb = j & 1; }
    const int t_o = F.wave * 64 + fresh_lane();
    const int t = t_o, lane = t & 63, w = __builtin_amdgcn_readfirstlane(t >> 6), lr = lane & 15, lq = lane >> 4;
    const int hq = kvh * 2 + (w >> 2), wrow = (w & 3) * 32;
    const int qrow = (lat ? b * SEQ : MLAT + b * CTXL) + qb * 128 + wrow;
    LAS bf16_t* Ksh = (LAS bf16_t*)F.lds; LAS bf16_t* Vt = Ksh + 4608; LAS bf16_t* Pw = Ksh + 9216 + w * 2304;
    bf16x8 Qf[2][2];
#pragma unroll
    for (int mt = 0; mt < 2; ++mt)
#pragma unroll
        for (int ks = 0; ks < 2; ++ks) Qf[mt][ks] = *(const bf16x8*)(F.Z + (size_t)(qrow + mt * 16 + lr) * ZW + ZC_SQ + hq * 64 + 32 * ks + 8 * lq);
    const float sk = F.sink[l * 4 + hq];
    float mi[2][4], li[2][4]; f32x4 O[2][4];
#pragma unroll
    for (int mt = 0; mt < 2; ++mt)
#pragma unroll
        for (int i = 0; i < 4; ++i) { mi[mt][i] = sk; li[mt][i] = 1.f; O[mt][i] = (f32x4){0.f, 0.f, 0.f, 0.f}; }
    const int lo = lat ? (qb == 0 ? 2 : 0) : 0, nloc = lat ? ((qb == 15 ? 4 : 6) - lo) : 0, ntile = nloc + 4;
    const int sr = t >> 3, sseg = t & 7;
    v4u kreg, vreg;
    { const int krow0 = nloc > 0 ? b * SEQ + (qb - 1) * 128 + lo * 64 : MLAT + b * CTXL;
      const bf16_t* zr = F.Z + (size_t)(krow0 + sr) * ZW + kvh * 64 + sseg * 8; kreg = *(const v4u*)(zr + ZC_SK); vreg = *(const v4u*)(zr + ZC_SV); }
#pragma unroll 1
    for (int j = 0; j < ntile; ++j) {
        const bool masked = j < nloc; const int kpos0 = (qb - 1) * 128 + (lo + j) * 64;
        __syncthreads();
        { *(LAS v4u*)(Ksh + sr * 72 + sseg * 8) = kreg;
          Vt[(sseg * 8 + 0) * 72 + sr] = (bf16_t)(vreg.x & 0xffffu); Vt[(sseg * 8 + 1) * 72 + sr] = (bf16_t)(vreg.x >> 16);
          Vt[(sseg * 8 + 2) * 72 + sr] = (bf16_t)(vreg.y & 0xffffu); Vt[(sseg * 8 + 3) * 72 + sr] = (bf16_t)(vreg.y >> 16);
          Vt[(sseg * 8 + 4) * 72 + sr] = (bf16_t)(vreg.z & 0xffffu); Vt[(sseg * 8 + 5) * 72 + sr] = (bf16_t)(vreg.z >> 16);
          Vt[(sseg * 8 + 6) * 72 + sr] = (bf16_t)(vreg.w & 0xffffu); Vt[(sseg * 8 + 7) * 72 + sr] = (bf16_t)(vreg.w >> 16); }
        if (j + 1 < ntile) { const int jn = j + 1; const int krown = jn < nloc ? b * SEQ + (qb - 1) * 128 + (lo + jn) * 64 : MLAT + b * CTXL + (jn - nloc) * 64;
            const bf16_t* zr = F.Z + (size_t)(krown + sr) * ZW + kvh * 64 + sseg * 8; kreg = *(const v4u*)(zr + ZC_SK); vreg = *(const v4u*)(zr + ZC_SV); }
        __syncthreads();
        f32x4 sc[2][4];
#pragma unroll
        for (int nt = 0; nt < 4; ++nt) { const LAS bf16_t* kp = Ksh + (nt * 16 + lr) * 72 + 8 * lq; const bf16x8 k0 = *(const LAS bf16x8*)kp, k1 = *(const LAS bf16x8*)(kp + 32);
#pragma unroll
            for (int mt = 0; mt < 2; ++mt) { f32x4 a = {0.f, 0.f, 0.f, 0.f};
                a = __builtin_amdgcn_mfma_f32_16x16x32_bf16(Qf[mt][0], k0, a, 0, 0, 0); a = __builtin_amdgcn_mfma_f32_16x16x32_bf16(Qf[mt][1], k1, a, 0, 0, 0); sc[mt][nt] = a; } }
#pragma unroll
        for (int mt = 0; mt < 2; ++mt) {
            float mx[4] = {-1e30f, -1e30f, -1e30f, -1e30f};
#pragma unroll
            for (int nt = 0; nt < 4; ++nt)
#pragma unroll
                for (int i = 0; i < 4; ++i) {
                    if (masked) { const int qpos = qb * 128 + wrow + mt * 16 + 4 * lq + i, kpos = kpos0 + nt * 16 + lr; const int dd = qpos - kpos; if (dd > 128 || dd < -128) sc[mt][nt][i] = -1e30f; }
                    mx[i] = fmaxf(mx[i], sc[mt][nt][i]); }
#pragma unroll
            for (int i = 0; i < 4; ++i) { mx[i] = fmaxf(mx[i], __shfl_xor(mx[i], 1)); mx[i] = fmaxf(mx[i], __shfl_xor(mx[i], 2)); mx[i] = fmaxf(mx[i], __shfl_xor(mx[i], 4)); mx[i] = fmaxf(mx[i], __shfl_xor(mx[i], 8)); }
            float al[4], rsum[4];
#pragma unroll
            for (int i = 0; i < 4; ++i) { const float mn = fmaxf(mi[mt][i], mx[i]); al[i] = fexp(mi[mt][i] - mn); mi[mt][i] = mn; rsum[i] = 0.f; }
#pragma unroll
            for (int nt = 0; nt < 4; ++nt)
#pragma unroll
                for (int i = 0; i < 4; ++i) { const float p = fexp(sc[mt][nt][i] - mi[mt][i]); rsum[i] += p; Pw[(mt * 16 + 4 * lq + i) * 72 + nt * 16 + lr] = (bf16_t)f2bf(p); }
#pragma unroll
            for (int i = 0; i < 4; ++i) { rsum[i] += __shfl_xor(rsum[i], 1); rsum[i] += __shfl_xor(rsum[i], 2); rsum[i] += __shfl_xor(rsum[i], 4); rsum[i] += __shfl_xor(rsum[i], 8); li[mt][i] = li[mt][i] * al[i] + rsum[i]; }
#pragma unroll
            for (int nt = 0; nt < 4; ++nt)
#pragma unroll
                for (int i = 0; i < 4; ++i) O[mt][nt][i] *= al[i];
        }
        LDS_WAIT(); asm volatile("" ::: "memory");
#pragma unroll
        for (int nt = 0; nt < 4; ++nt) { const LAS bf16_t* vp = Vt + (nt * 16 + lr) * 72 + 8 * lq; const bf16x8 v0 = *(const LAS bf16x8*)vp, v1 = *(const LAS bf16x8*)(vp + 32);
#pragma unroll
            for (int mt = 0; mt < 2; ++mt) { const LAS bf16_t* pp = Pw + (mt * 16 + lr) * 72 + 8 * lq; const bf16x8 p0 = *(const LAS bf16x8*)pp, p1 = *(const LAS bf16x8*)(pp + 32);
                O[mt][nt] = __builtin_amdgcn_mfma_f32_16x16x32_bf16(p0, v0, O[mt][nt], 0, 0, 0); O[mt][nt] = __builtin_amdgcn_mfma_f32_16x16x32_bf16(p1, v1, O[mt][nt], 0, 0, 0); } }
    }
#pragma unroll
    for (int mt = 0; mt < 2; ++mt)
#pragma unroll
        for (int i = 0; i < 4; ++i) { const float inv = frcp(li[mt][i]); bf16_t* orow = F.MIX + (size_t)(qrow + mt * 16 + 4 * lq + i) * 1024 + 256 + hq * 64 + lr;
#pragma unroll
            for (int nt = 0; nt < 4; ++nt) orow[nt * 16] = (bf16_t)f2bf(O[mt][nt][i] * inv); }
    __syncthreads();
}

__device__ __forceinline__ void gmlp_unit(const Frame& F, int l, int it) {
    const int b = it / 72, c = (it >> 2) % 18, g = it & 3;
    const int r0 = c < 16 ? b * SEQ + c * 128 : MLAT + b * CTXL + (c - 16) * 128;
    const int t_o = F.wave * 64 + fresh_lane();
    const int t = t_o, lane = t & 63, w = __builtin_amdgcn_readfirstlane(t >> 6), lr = lane & 15, lq = lane >> 4;
    LAS bf16_t* Vt = (LAS bf16_t*)F.lds;
#pragma unroll
    for (int j = 0; j < 2; ++j) { const int idx = t + 512 * j, q = idx >> 3, seg = idx & 7;
        const v4u v = *(const v4u*)(F.Z + (size_t)(r0 + q) * ZW + ZC_MV + g * 64 + seg * 8);
        Vt[(seg * 8 + 0) * 136 + q] = (bf16_t)(v.x & 0xffffu); Vt[(seg * 8 + 1) * 136 + q] = (bf16_t)(v.x >> 16);
        Vt[(seg * 8 + 2) * 136 + q] = (bf16_t)(v.y & 0xffffu); Vt[(seg * 8 + 3) * 136 + q] = (bf16_t)(v.y >> 16);
        Vt[(seg * 8 + 4) * 136 + q] = (bf16_t)(v.z & 0xffffu); Vt[(seg * 8 + 5) * 136 + q] = (bf16_t)(v.z >> 16);
        Vt[(seg * 8 + 6) * 136 + q] = (bf16_t)(v.w & 0xffffu); Vt[(seg * 8 + 7) * 136 + q] = (bf16_t)(v.w >> 16); }
    __syncthreads();
    bf16x8 Af[4];
#pragma unroll
    for (int ks = 0; ks < 4; ++ks) Af[ks] = *(const bf16x8*)(F.WSP + (size_t)g * 16384 + (16 * w + lr) * 128 + 32 * ks + 8 * lq);
    f32x4 bsv = *(const f32x4*)(F.b_s + (size_t)(l * 4 + g) * 128 + 16 * w + 4 * lq);
    unsigned short uraw[4][4];
#pragma unroll
    for (int nt = 0; nt < 4; ++nt)
#pragma unroll
        for (int i = 0; i < 4; ++i) uraw[nt][i] = F.Z[(size_t)(r0 + 16 * w + 4 * lq + i) * ZW + ZC_MU + g * 64 + nt * 16 + lr];
    f32x4 accs[4];
#pragma unroll
    for (int nt = 0; nt < 4; ++nt) { f32x4 acc = {0.f, 0.f, 0.f, 0.f};
#pragma unroll
        for (int ks = 0; ks < 4; ++ks) { const bf16x8 bfr = *(const LAS bf16x8*)(Vt + (nt * 16 + lr) * 136 + 32 * ks + 8 * lq); acc = __builtin_amdgcn_mfma_f32_16x16x32_bf16(Af[ks], bfr, acc, 0, 0, 0); }
        accs[nt] = acc; }
#pragma unroll
    for (int nt = 0; nt < 4; ++nt)
#pragma unroll
        for (int i = 0; i < 4; ++i) { const int row = r0 + 16 * w + 4 * lq + i, col = g * 64 + nt * 16 + lr;
            F.MIX[(size_t)row * 1024 + 512 + col] = (bf16_t)f2bf(bf2f(uraw[nt][i]) * (accs[nt][i] + bsv[i])); }
    __syncthreads();
}

#ifndef PROBE_KIND
#define PROBE_KIND -1
#endif
#ifndef ONLY_CASE
#define ONLY_CASE -1
#endif
struct Args { const float* in[24]; float* out; unsigned char* ws; int ph_lo, ph_hi; };
constexpr int NPH = 2 + 9 * DEPTH;
__global__ void __launch_bounds__(NWAVES * 64, 2) mk_fwd(Args args) {
    extern __shared__ __attribute__((aligned(16))) unsigned char lds[];
    const int wave_s = __builtin_amdgcn_readfirstlane((int)threadIdx.x >> 6);
    const int tid_ = wave_s * 64 + fresh_lane();
    volatile LAS unsigned* MISC = (volatile LAS unsigned*)((LAS unsigned char*)lds + MISC_OFF);
    if (tid_ < 32) MISC[tid_] = 0u;
    __syncthreads();
    unsigned* barw = (unsigned*)(args.ws + WS_CTL) + CW_BAR;
    XcdBarrier bar; bar.bar = barw; bar.x = 0; bar.st = nullptr;
    const int lo = args.ph_lo, hi = args.ph_hi;
    if (hi - lo > 1) bar = xcd_barrier_post(barw, MISC + 8, tid_);

#pragma unroll 1
    for (int ph = lo; ph < hi; ++ph) {
        int zero; asm volatile("s_mov_b32 %0, 0" : "=s"(zero));
        Frame F;
        F.lds = (LAS unsigned char*)lds;
        F.wave = wave_s;
        F.G = gridDim.x; F.gw = blockIdx.x * NWAVES + F.wave; F.NGW = F.G * NWAVES;
        const float* const* inp = args.in + zero;
        F.x = inp[0]; F.c = inp[1]; F.ctx = inp[2]; F.cctx = inp[3]; F.ada_w = inp[4]; F.ada_b = inp[5]; F.norm1_w = inp[6]; F.norm2_w = inp[7];
        F.w_in = inp[8]; F.w_out = inp[9]; F.conv_w = inp[10]; F.a_log = inp[11]; F.dt_bias = inp[12]; F.gdn_norm_w = inp[13]; F.sink = inp[14];
        F.w_s = inp[15]; F.b_s = inp[16]; F.gmlp_norm_w = inp[17]; F.ig_bias = inp[18]; F.fg_bias = inp[19]; F.mlstm_norm_w = inp[20];
        F.w1 = inp[21]; F.w2 = inp[22]; F.final_w = inp[23];
        unsigned char* ws = args.ws + zero;
        F.out = args.out + zero; F.ws = ws;
        F.MOD = (float*)(ws + WS_MOD); F.XC = (float*)(ws + WS_XC); F.CHS = (float*)(ws + WS_CHS); F.GLG = (float*)(ws + WS_GLG); F.GLM = F.GLG + 2304; F.WI = F.GLG + 4608;
        F.PEND = (float*)(ws + WS_H); F.SLAB = (float*)(ws + WS_SLAB);
        F.H = (bf16_t*)(ws + WS_H); F.MIX = (bf16_t*)(ws + WS_MIX); F.Z = (bf16_t*)(ws + WS_Z); F.PG = (bf16_t*)(ws + WS_PG); F.PM = (bf16_t*)(ws + WS_PM); F.HID = (bf16_t*)(ws + WS_HID);
        int kind, l;
        if (ph == 0) { kind = 0; l = 0; } else if (ph == NPH - 1) { kind = 10; l = DEPTH - 1; } else { l = (ph - 1) / 9; kind = 1 + (ph - 1) % 9; }
        const bool last = (l == DEPTH - 1);
        { unsigned char* wb = ws + (size_t)(l & 1) * WSET_STRIDE;
          F.WIN = (bf16_t*)(wb + WS_WIN); F.WOUT = (bf16_t*)(wb + WS_WOUT); F.W1 = (bf16_t*)(wb + WS_W1); F.W2 = (bf16_t*)(wb + WS_W2); F.WSP = (bf16_t*)(wb + WS_WSP); }
        const int Mrows = last ? MLAT : MALL;
        const int nrep = (kind == PROBE_KIND) ? 2 : 1;
#pragma unroll 1
        for (int rep = 0; rep < nrep; ++rep) {
        if (rep) xcd_barrier(bar, wave_s * 64 + fresh_lane());
        switch (kind) {
        case 0: if (ONLY_CASE >= 0 && ONLY_CASE != 0) break; phase_mod(F); break;
        case 1: if (ONLY_CASE >= 0 && ONLY_CASE != 1) break; convert_weights(F, l, F.gw, F.NGW); phase_norm(F, l, 0, MALL, (l > 0 && !rep) ? NSPLIT_2 : 0, F.MOD + (size_t)((l > 0 ? l - 1 : 0) * 9 + 8) * 6144 + 5 * 1024); break;
        case 2: if (ONLY_CASE >= 0 && ONLY_CASE != 2) break; { pg8::Gemm g{F.H, F.WIN, MALL, ZW, D, D, D}; pg8::StaticOrder S; S.init(MALL, ZW, D, F.G, (int)blockIdx.x);
                  pg8::EpiBf16<0> E{F.Z, ZW}; pg8::gemm_phase<pg8::EpiBf16<0>, pg8::StaticOrder, true, true, true>(F.lds, g, S, E, wave_s * 64 + fresh_lane()); } break;
        case 3: if (ONLY_CASE >= 0 && ONLY_CASE != 3) break; for (int rg = blockIdx.x; rg < MALL / 16 + 288; rg += F.G) { if (rg < MALL / 16) ew_unit(F, l, rg); else chs_unit(F, l, rg - MALL / 16); } break;
        case 4: if (ONLY_CASE >= 0 && ONLY_CASE != 4) break; for (int it = blockIdx.x; it < 2304; it += F.G) { if (it < 1152) { if (!rep) gdn_prep_unit(F, l, it); else if (PROBE_SUB != 2) gdn_prep_unit(F, l, it, PROBE_SUB >= 10 ? PROBE_SUB - 10 : 99, (bf16_t*)(F.ws + WS_H)); } else { if (!rep || PROBE_SUB != 1) mlstm_prep_unit(F, l, it - 1152); } } break;
        case 5: if (ONLY_CASE >= 0 && ONLY_CASE != 5) break; { const int bx = blockIdx.x;
                  if (bx < 32) { if (!rep || PROBE_SUB == 0 || PROBE_SUB == 1 || PROBE_SUB == 5) scan_wg<true>(F, l, bx, rep && PROBE_SUB == 5); }
                  else if (bx < 64) { if (!rep || PROBE_SUB == 0 || PROBE_SUB == 1 || PROBE_SUB == 4 || PROBE_SUB == 5) scan_wg<false>(F, l, bx - 32, rep && PROBE_SUB == 5); }
                  else for (int it = bx - 64; it < 288 + 576; it += F.G - 64) { if (it < 288) { if (!rep || PROBE_SUB == 0 || PROBE_SUB == 2) swa_unit(F, l, it); } else { if (!rep || PROBE_SUB == 0 || PROBE_SUB == 3) gmlp_unit(F, l, it - 288); } } } break;
        case 6: case 9: { if (ONLY_CASE >= 0 && ONLY_CASE != 6) break; const bool isout = (kind == 6);
                  const int Kd = isout ? D : FF;
                  pg8::Gemm g{isout ? F.MIX : F.HID, isout ? F.WOUT : F.W2, MLAT, D, Kd, Kd, Kd}; pg8::StaticOrder S; S.init(MLAT, D, Kd, F.G, (int)blockIdx.x);
                  if (!last) S.add_split(MCTX / 256, isout ? NSPLIT_OUT : NSPLIT_2, Kd);
                  pg8::EpiResid E{rep ? (float*)(F.ws + WS_H) : F.out, rep ? (float*)(F.ws + WS_H) + (size_t)MLAT * 1024 : F.XC, F.MOD + (size_t)l * 9 * 6144 + (isout ? 2 : 5) * 1024, (float*)(F.ws + WS_SLAB)};
                  pg8::gemm_phase<pg8::EpiResid, pg8::StaticOrder, true, true>(F.lds, g, S, E, wave_s * 64 + fresh_lane()); } break;
        case 7: if (ONLY_CASE >= 0 && ONLY_CASE != 7) break; phase_norm(F, l, 1, Mrows, (!last && !rep) ? NSPLIT_OUT : 0, F.MOD + (size_t)(l * 9 + 8) * 6144 + 2 * 1024); break;
        case 8: if (ONLY_CASE >= 0 && ONLY_CASE != 8) break; { pg8::Gemm g{F.H, F.W1, Mrows, FF, D, D, D}; pg8::StaticOrder S; S.init(Mrows, FF, D, F.G, (int)blockIdx.x);
                  pg8::EpiBf16<1> E{F.HID, FF}; pg8::gemm_phase<pg8::EpiBf16<1>, pg8::StaticOrder, true, true, true>(F.lds, g, S, E, wave_s * 64 + fresh_lane()); } break;
        default: { const bool poison = (hi - lo > 1) && (__hip_atomic_load(barw + XB_TMO, __ATOMIC_RELAXED, __HIP_MEMORY_SCOPE_AGENT) != 0u); phase_final(F, poison); } break;
        }
        }
        if (ph + 1 < hi) xcd_barrier(bar, wave_s * 64 + fresh_lane());
    }
}

extern "C" void kernel_launch(void* const* d_in, const int* in_sizes, int n_in, void* d_out, int out_size, void* d_ws, size_t ws_size, hipStream_t stream) {
    static int grid = 0;
    if (grid == 0) {
        if (n_in != 24 || out_size != MLAT * D || ws_size < WS_END) { fprintf(stderr, "kernel_launch: unexpected shapes: n_in %d out %d ws %zu (need %zu)\n", n_in, out_size, ws_size, (size_t)WS_END); grid = -1; return; }
        int dev = 0, cus = 0, per_cu = 0;
        if (hipGetDevice(&dev) != hipSuccess || hipDeviceGetAttribute(&cus, hipDeviceAttributeMultiprocessorCount, dev) != hipSuccess) { grid = -1; return; }
        if (hipFuncSetAttribute((const void*)mk_fwd, hipFuncAttributeMaxDynamicSharedMemorySize, LDS_BYTES) != hipSuccess) { fprintf(stderr, "kernel_launch: hipFuncSetAttribute failed\n"); grid = -1; return; }
        if (hipOccupancyMaxActiveBlocksPerMultiprocessor(&per_cu, (const void*)mk_fwd, NWAVES * 64, LDS_BYTES) != hipSuccess || per_cu < 1) { fprintf(stderr, "kernel_launch: occupancy query says %d\n", per_cu); grid = -1; return; }
        (void)hipGetLastError();
        grid = cus;
        if (grid < 128) { fprintf(stderr, "kernel_launch: device too small (%d CUs)\n", grid); grid = -1; return; }
    }
    if (grid < 0) return;
    (void)hipMemsetAsync((char*)d_ws + WS_CTL, 0, CTL_ZERO_BYTES, stream);
    Args a{};
    for (int i = 0; i < 24; ++i) a.in[i] = (const float*)d_in[i];
    a.out = (float*)d_out; a.ws = (unsigned char*)d_ws;
#if MK_PER_PHASE
    for (int p = 0; p < NPH; ++p) { a.ph_lo = p; a.ph_hi = p + 1; hipLaunchKernelGGL(mk_fwd, dim3(grid), dim3(NWAVES * 64), LDS_BYTES, stream, a); }
#else
    a.ph_lo = 0; a.ph_hi = NPH;
    void* kargs[] = {&a};
    hipError_t e = hipLaunchCooperativeKernel((const void*)mk_fwd, dim3(grid), dim3(NWAVES * 64), kargs, LDS_BYTES, stream);
    if (e != hipSuccess) fprintf(stderr, "kernel_launch: cooperative launch failed: %s (grid %d)\n", hipGetErrorString(e), grid);
#endif
}
```

```cpp
#include <hip/hip_runtime.h>
#include <cstdio>
#include <cstdint>
#ifndef MK_PER_PHASE
#define MK_PER_PHASE 0
#endif
#define PROBE_KIND -1
#define PROBE_SUB 0
namespace pg8 {
#define PG8_LAS __attribute__((address_space(3)))
typedef unsigned short bf16_t;
typedef short bf16x8 __attribute__((ext_vector_type(8)));
typedef float f32x4 __attribute__((ext_vector_type(4)));
typedef unsigned u32x4 __attribute__((ext_vector_type(4)));
constexpr int BM = 256, BK = 64, HALF = 128, HTB = HALF * BK * 2  , STAGE_BYTES = 8 * HTB, NXCD = 8, WGM = 8;

__host__ __device__ __forceinline__ int lds_byte(int r, int c) { const int st = (r >> 4) * 2 + (c >> 5), rr = r & 15, cc = c & 31, ob = rr * 64 + cc * 2; return st * 1024 + (ob ^ (((ob >> 9) & 1) << 5)); }
__host__ __device__ __forceinline__ void stage_rc(int b, int& R, int& C) { const int st = b / 1024, sb = b % 1024, swz = sb ^ (((sb >> 9) & 1) << 5); R = (st >> 1) * 16 + swz / 64; C = (st & 1) * 32 + (swz % 64) / 2; }
__host__ __device__ __forceinline__ int perm32(int rho) { const int n = rho >> 4, i = rho & 15; return 8 * (i >> 2) + 4 * n + (i & 3); }

struct Unit { int pm, pn, kofs, nt, slab; };
struct Gemm { const bf16_t* A; const bf16_t* Bt; int M, N, K, lda, ldb; };

struct StaticOrder {
    int nM, nN, nwg, G, c, ntk, nsp, nsplit, kslice, pm0;
    __host__ __device__ void init(int M, int N, int K, int G_, int c_) { nM = M / BM; nN = N / BM; nwg = nM * nN; G = G_; c = c_; ntk = K / BK; nsp = 0; nsplit = 1; kslice = K; pm0 = nM; }
    __host__ __device__ void add_split(int npanels, int nsplit_, int K) { nsplit = nsplit_; kslice = K / nsplit_; nsp = npanels * nN * nsplit_; }
    __host__ __device__ void map(long L, Unit& u) const {
        int wgid = (int)L; { const int q = nwg / NXCD, r = nwg % NXCD, xcd = wgid % NXCD, off = wgid / NXCD; wgid = (xcd < r ? xcd * (q + 1) : r * (q + 1) + (xcd - r) * q) + off; }
        const int nig = WGM * nN, gid = wgid / nig, fm = gid * WGM, gsz = (nM - fm) < WGM ? (nM - fm) : WGM;
        u.pm = fm + ((wgid % nig) % gsz); u.pn = (wgid % nig) / gsz; u.kofs = 0; u.nt = ntk; u.slab = 0;
    }
    __host__ __device__ bool next(int i, Unit& u) const {
        const long L = (long)i * G + c;
        if (L < nwg) { map(L, u); return true; }
        const long J = L - nwg; if (J >= nsp) return false;
        const int ks = (int)(J % nsplit), tile = (int)(J / nsplit);
        u.pn = tile % nN; u.pm = pm0 + tile / nN; u.kofs = ks * kslice; u.nt = kslice / BK; u.slab = ks + 1; return true;
    }
    __device__ __forceinline__ void a_ready(const Unit&) const {}
    __device__ __forceinline__ void done(const Unit&) const {}
};

__device__ __forceinline__ unsigned cvt_pk_bf16(float lo, float hi) { unsigned r; asm volatile("v_cvt_pk_bf16_f32 %0, %1, %2" : "=v"(r) : "v"(lo), "v"(hi)); return r; }

template <int ACT  > struct EpiBf16 {
    static constexpr bool PERM = true, AFTER_DRAIN = false;
    bf16_t* O; int ldc;
    __device__ __forceinline__ void operator()(const f32x4 (&acc)[2][2][4][2], const Unit& u, int wr, int wc, int fr, int fq) const {
        const int row0 = u.pm * BM + wr * 64 + fr; const int col0 = u.pn * BM + wc * 32 + 8 * fq;
#pragma unroll
        for (int ai = 0; ai < 2; ++ai)
#pragma unroll
            for (int m = 0; m < 4; ++m) { bf16_t* rowp = O + (size_t)(row0 + ai * HALF + m * 16) * ldc + col0;
#pragma unroll
                for (int bj = 0; bj < 2; ++bj) { f32x4 v0 = acc[ai][bj][m][0], v1 = acc[ai][bj][m][1];
                    if (ACT == 1) {
#pragma unroll
                        for (int e = 0; e < 4; ++e) { float a = fmaxf(v0[e], 0.f), b = fmaxf(v1[e], 0.f); v0[e] = a * a; v1[e] = b * b; } }
                    u32x4 w; w.x = cvt_pk_bf16(v0[0], v0[1]); w.y = cvt_pk_bf16(v0[2], v0[3]); w.z = cvt_pk_bf16(v1[0], v1[1]); w.w = cvt_pk_bf16(v1[2], v1[3]);
                    *(u32x4*)(rowp + bj * HALF) = w; } }
    }
};

struct EpiResid {
    static constexpr bool PERM = false, AFTER_DRAIN = false;
    float* xlat; float* xctx; const float* gmod; float* slab;
    __device__ __forceinline__ void operator()(const f32x4 (&acc)[2][2][4][2], const Unit& u, int wr, int wc, int fr, int fq) const {
        if (u.slab) {
            float* sb = slab + (size_t)(u.slab - 1) * 2048 * 1024 + (size_t)(u.pm - 64) * BM * 1024 + u.pn * BM + wc * 32 + 4 * fq;
#pragma unroll
            for (int ai = 0; ai < 2; ++ai)
#pragma unroll
                for (int m = 0; m < 4; ++m) { float* rowp = sb + (size_t)(ai * HALF + wr * 64 + m * 16 + fr) * 1024;
#pragma unroll
                    for (int bj = 0; bj < 2; ++bj)
#pragma unroll
                        for (int n = 0; n < 2; ++n) *(f32x4*)(rowp + bj * HALF + n * 16) = acc[ai][bj][m][n]; }
            return;
        }
        const int bm = u.pm < 64 ? (u.pm >> 3) : 8;
        float* base = u.pm < 64 ? xlat + (size_t)u.pm * BM * 1024 : xctx + (size_t)(u.pm - 64) * BM * 1024;
        const float* g = gmod + bm * 6144;
        const int col0 = u.pn * BM + wc * 32 + 4 * fq;
        f32x4 gv[2][2];
#pragma unroll
        for (int bj = 0; bj < 2; ++bj)
#pragma unroll
            for (int n = 0; n < 2; ++n) gv[bj][n] = *(const f32x4*)(g + col0 + bj * HALF + n * 16);
#pragma unroll
        for (int ai = 0; ai < 2; ++ai)
#pragma unroll
            for (int m = 0; m < 4; ++m) { float* rowp = base + (size_t)(ai * HALF + wr * 64 + m * 16 + fr) * 1024 + col0;
                f32x4 xv[2][2];
#pragma unroll
                for (int bj = 0; bj < 2; ++bj)
#pragma unroll
                    for (int n = 0; n < 2; ++n) xv[bj][n] = *(const f32x4*)(rowp + bj * HALF + n * 16);
#pragma unroll
                for (int bj = 0; bj < 2; ++bj)
#pragma unroll
                    for (int n = 0; n < 2; ++n) *(f32x4*)(rowp + bj * HALF + n * 16) = xv[bj][n] + gv[bj][n] * acc[ai][bj][m][n];
                if (m & 1) asm volatile("" ::: "memory"); }
    }
};

template <class Epi, class Sched, bool ALIGN_EPI = false, bool SP2 = false, bool UNIFORM_NT = false>
__device__ __forceinline__ void gemm_phase(PG8_LAS unsigned char* lds, const Gemm g, const Sched& S, const Epi& E, int tid_in) {
    int tid_o = tid_in; asm volatile("" : "+v"(tid_o)); const int tid = tid_o, wid = __builtin_amdgcn_readfirstlane(tid >> 6), lane = tid & 63, wr = wid >> 2, wc = wid & 3, fr = lane & 15, fq = lane >> 4;
    const int lda = g.lda, ldb = g.ldb; const int nt_uniform = g.K / BK;
    unsigned voffA[2], voffB[2];
#pragma unroll
    for (int i = 0; i < 2; ++i) { int R, C; stage_rc(tid * 16 + i * 8192, R, C); const int Rb = Epi::PERM ? ((R & ~31) + perm32(R & 31)) : R;
        voffA[i] = (unsigned)(R * lda + C) * 2u; voffB[i] = (unsigned)(Rb * ldb + C) * 2u; }
    const size_t kstep = (size_t)(BK * 2);
    const size_t hstepA = (size_t)HALF * lda * 2, hstepB = (size_t)HALF * ldb * 2;
    const size_t tstepA = 2 * hstepA, tstepB = 2 * hstepB;
    const unsigned ldsw = (unsigned)wid * 1024u;
    const int aoff = lds_byte(wr * 64 + fr, fq * 8), boff = lds_byte(wc * 32 + fr, fq * 8);
#define PG8_SA(b, h) (((b) * 2 + (h)) * HTB)
#define PG8_SB(b, h) ((4 + (b) * 2 + (h)) * HTB)
#define PG8_STAGE(bufoff, gbase, voff) do { _Pragma("unroll") for (int _i = 0; _i < 2; ++_i) \
        __builtin_amdgcn_global_load_lds((const unsigned*)((const char*)(gbase) + (voff)[_i]), (PG8_LAS unsigned*)(lds + (bufoff) + ldsw + _i * 8192), 16, 0, 0); } while (0)
#define PG8_LDA(dst, b, h) do { _Pragma("unroll") for (int m = 0; m < 4; ++m) _Pragma("unroll") for (int k = 0; k < 2; ++k) dst[m][k] = *(const PG8_LAS bf16x8*)(lds + PG8_SA(b, h) + aoff + m * 2048 + k * 1024); } while (0)
#define PG8_LDB(dst, b, h) do { _Pragma("unroll") for (int n = 0; n < 2; ++n) _Pragma("unroll") for (int k = 0; k < 2; ++k) dst[n][k] = *(const PG8_LAS bf16x8*)(lds + PG8_SB(b, h) + boff + n * 2048 + k * 1024); } while (0)
#define PG8_MMA(ai, bj, At, Bt) do { __builtin_amdgcn_s_setprio(1); _Pragma("unroll") for (int m = 0; m < 4; ++m) _Pragma("unroll") for (int n = 0; n < 2; ++n) _Pragma("unroll") for (int k = 0; k < 2; ++k) \
        acc[ai][bj][m][n] = __builtin_amdgcn_mfma_f32_16x16x32_bf16(Bt[n][k], At[m][k], acc[ai][bj][m][n], 0, 0, 0); __builtin_amdgcn_s_setprio(0); } while (0)
#define PG8_WAIT_V(n) asm volatile("s_waitcnt vmcnt(" #n ")" ::: "memory")
#define PG8_WAIT_L(n) asm volatile("s_waitcnt lgkmcnt(" #n ")" ::: "memory")
#define PG8_BAR __builtin_amdgcn_s_barrier()
#define PG8_SCHED __builtin_amdgcn_sched_barrier(0)
    Unit cur, nxt; int ui = 0;
    if (!S.next(0, cur)) return;
    f32x4 acc[2][2][4][2];
#pragma unroll
    for (int a = 0; a < 2; ++a)
#pragma unroll
        for (int b = 0; b < 2; ++b)
#pragma unroll
            for (int m = 0; m < 4; ++m)
#pragma unroll
                for (int n = 0; n < 2; ++n) acc[a][b][m][n] = (f32x4){0.f, 0.f, 0.f, 0.f};
    bf16x8 At[4][2], B0[2][2], B1[2][2];
    const char* cA = (const char*)g.A + (size_t)cur.pm * tstepA + (size_t)cur.kofs * 2; const char* cB = (const char*)g.Bt + (size_t)cur.pn * tstepB + (size_t)cur.kofs * 2;
    S.a_ready(cur);
    if constexpr (SP2) {
        PG8_STAGE(PG8_SB(0, 0), cB, voffB); PG8_STAGE(PG8_SB(0, 1), cB + hstepB, voffB); PG8_STAGE(PG8_SA(0, 0), cA, voffA); PG8_STAGE(PG8_SA(0, 1), cA + hstepA, voffA);
        if (wr == 1) PG8_BAR;
        PG8_WAIT_V(2); PG8_BAR;
        PG8_STAGE(PG8_SB(1, 0), cB + kstep, voffB); PG8_STAGE(PG8_SA(1, 0), cA + kstep, voffA); PG8_STAGE(PG8_SB(1, 1), cB + hstepB + kstep, voffB);
        PG8_WAIT_V(6); PG8_BAR;
    } else {
        PG8_STAGE(PG8_SB(0, 0), cB, voffB); PG8_STAGE(PG8_SA(0, 0), cA, voffA); PG8_STAGE(PG8_SB(0, 1), cB + hstepB, voffB); PG8_STAGE(PG8_SA(0, 1), cA + hstepA, voffA);
        if (wr == 1) PG8_BAR;
        PG8_WAIT_V(4); PG8_BAR;
        PG8_STAGE(PG8_SB(1, 0), cB + kstep, voffB); PG8_STAGE(PG8_SA(1, 0), cA + kstep, voffA); PG8_STAGE(PG8_SB(1, 1), cB + hstepB + kstep, voffB);
        PG8_WAIT_V(6); PG8_BAR;
    }
    for (;;) {
        const bool has_next = S.next(ui + 1, nxt);
        const char* nA = has_next ? (const char*)g.A + (size_t)nxt.pm * tstepA + (size_t)nxt.kofs * 2 : cA; const char* nB = has_next ? (const char*)g.Bt + (size_t)nxt.pn * tstepB + (size_t)nxt.kofs * 2 : cB;
        const int nt = UNIFORM_NT ? nt_uniform : cur.nt;
        for (int t = 0; t < nt; t += 2) {
            const bool last = (t == nt - 2);
            const char* a1 = cA + (size_t)(t + 1) * kstep;
            const char* a2 = last ? nA : cA + (size_t)(t + 2) * kstep; const char* b2 = last ? nB : cB + (size_t)(t + 2) * kstep;
            const char* a3 = a2 + kstep; const char* b3 = b2 + kstep;
            if (last && has_next) S.a_ready(nxt);
            if constexpr (SP2) {
            PG8_LDB(B0, 0, 0); PG8_LDB(B1, 0, 1); PG8_SCHED; PG8_LDA(At, 0, 0); PG8_STAGE(PG8_SA(1, 1), a1 + hstepA, voffA);
            PG8_WAIT_V(8); PG8_WAIT_L(0); PG8_BAR; PG8_MMA(0, 0, At, B0); PG8_MMA(0, 1, At, B1); PG8_BAR; PG8_SCHED;
            PG8_LDA(At, 0, 1); PG8_STAGE(PG8_SB(0, 0), b2, voffB); PG8_STAGE(PG8_SB(0, 1), b2 + hstepB, voffB); PG8_STAGE(PG8_SA(0, 0), a2, voffA);
            PG8_WAIT_V(8); PG8_WAIT_L(0); PG8_BAR; PG8_MMA(1, 0, At, B0); PG8_MMA(1, 1, At, B1); PG8_BAR; PG8_SCHED;
            PG8_LDB(B0, 1, 0); PG8_LDB(B1, 1, 1); PG8_SCHED; PG8_LDA(At, 1, 0); PG8_STAGE(PG8_SA(0, 1), a2 + hstepA, voffA);
            PG8_WAIT_V(8); PG8_WAIT_L(0); PG8_BAR; PG8_MMA(0, 0, At, B0); PG8_MMA(0, 1, At, B1); PG8_BAR; PG8_SCHED;
            PG8_LDA(At, 1, 1); PG8_STAGE(PG8_SB(1, 0), b3, voffB); PG8_STAGE(PG8_SB(1, 1), b3 + hstepB, voffB); PG8_STAGE(PG8_SA(1, 0), a3, voffA);
            PG8_WAIT_V(8); PG8_WAIT_L(0); PG8_BAR; PG8_MMA(1, 0, At, B0); PG8_MMA(1, 1, At, B1); PG8_BAR; PG8_SCHED;
            } else {
            PG8_LDB(B0, 0, 0); PG8_SCHED; PG8_LDA(At, 0, 0); PG8_STAGE(PG8_SA(1, 1), a1 + hstepA, voffA);
            PG8_WAIT_L(8); PG8_BAR; PG8_WAIT_L(0); PG8_MMA(0, 0, At, B0); PG8_BAR; PG8_SCHED;
            PG8_LDB(B1, 0, 1); PG8_STAGE(PG8_SB(0, 0), b2, voffB);
            PG8_BAR; PG8_WAIT_L(0); PG8_MMA(0, 1, At, B1); PG8_BAR;
            PG8_LDA(At, 0, 1); PG8_STAGE(PG8_SA(0, 0), a2, voffA);
            PG8_BAR; PG8_WAIT_L(0); PG8_MMA(1, 0, At, B0); PG8_BAR; PG8_SCHED;
            PG8_STAGE(PG8_SB(0, 1), b2 + hstepB, voffB);
            PG8_WAIT_V(6); PG8_BAR; PG8_MMA(1, 1, At, B1); PG8_BAR;
            PG8_LDB(B0, 1, 0); PG8_SCHED; PG8_LDA(At, 1, 0); PG8_STAGE(PG8_SA(0, 1), a2 + hstepA, voffA);
            PG8_WAIT_L(8); PG8_BAR; PG8_WAIT_L(0); PG8_MMA(0, 0, At, B0); PG8_BAR; PG8_SCHED;
            PG8_LDB(B1, 1, 1); PG8_STAGE(PG8_SB(1, 0), b3, voffB);
            PG8_BAR; PG8_WAIT_L(0); PG8_MMA(0, 1, At, B1); PG8_BAR;
            PG8_LDA(At, 1, 1); PG8_STAGE(PG8_SA(1, 0), a3, voffA);
            PG8_BAR; PG8_WAIT_L(0); PG8_MMA(1, 0, At, B0); PG8_BAR; PG8_SCHED;
            PG8_STAGE(PG8_SB(1, 1), b3 + hstepB, voffB);
            PG8_WAIT_V(6); PG8_BAR; PG8_MMA(1, 1, At, B1); PG8_BAR;
            }
        }
        if constexpr (ALIGN_EPI) { if (wr == 0) PG8_BAR; }
        if constexpr (!Epi::AFTER_DRAIN) { E(acc, cur, wr, wc, fr, fq); S.done(cur); }
        if (!has_next) break;
#pragma unroll
        for (int a = 0; a < 2; ++a)
#pragma unroll
            for (int b = 0; b < 2; ++b)
#pragma unroll
                for (int m = 0; m < 4; ++m)
#pragma unroll
                    for (int n = 0; n < 2; ++n) acc[a][b][m][n] = (f32x4){0.f, 0.f, 0.f, 0.f};
        cur = nxt; cA = nA; cB = nB; ++ui;
        if constexpr (ALIGN_EPI) { if (wr == 1) PG8_BAR; }
    }
    PG8_WAIT_V(0);
    if constexpr (!ALIGN_EPI) { if (wr == 0) PG8_BAR; }
    PG8_BAR;
    if constexpr (Epi::AFTER_DRAIN) { E.fused(acc, cur, wr, wc, fr, fq, lds, wid, lane); S.done(cur); }
#undef PG8_SA
#undef PG8_SB
#undef PG8_STAGE
#undef PG8_LDA
#undef PG8_LDB
#undef PG8_MMA
#undef PG8_WAIT_V
#undef PG8_WAIT_L
#undef PG8_BAR
#undef PG8_SCHED
}
}
constexpr int NWAVES = 8;
constexpr int NB = 8, SEQ = 2048, CTXL = 256, D = 1024, DEPTH = 4, FF = 4096;
constexpr int MLAT = NB * SEQ, MCTX = NB * CTXL, MALL = MLAT + MCTX;
constexpr int ZW = 3328;
constexpr int ZC_GQ = 0, ZC_GK = 256, ZC_GV = 512, ZC_GZ = 768, ZC_SQ = 1024, ZC_SK = 1280, ZC_SV = 1408, ZC_MU = 1536, ZC_MV = 1792,
              ZC_LQ = 2048, ZC_LK = 2304, ZC_LV = 2560, ZC_LO = 2816, ZC_GA = 3072, ZC_GB = 3080, ZC_LI = 3088, ZC_LF = 3096;
constexpr float EPS = 1e-6f;
constexpr size_t MiB = 1u << 20;
constexpr size_t WS_CTL = 0, CTL_ZERO_BYTES = 65536;
constexpr size_t WS_MOD = 1 * MiB;
constexpr size_t WS_WIN = 2 * MiB, WS_WOUT = 9 * MiB, WS_W1 = 11 * MiB, WS_W2 = 19 * MiB, WS_WSP = 27 * MiB;
constexpr size_t WS_CHS = 27 * MiB + 512 * 1024;
constexpr size_t WS_GLG = 27 * MiB + 768 * 1024;
constexpr size_t WS_XC = 29 * MiB;
constexpr size_t WS_H = 37 * MiB;
constexpr size_t WS_MIX = 73 * MiB;
constexpr size_t WS_Z = 109 * MiB;
constexpr size_t WS_PG = 226 * MiB;
constexpr size_t WS_PM = 298 * MiB;
constexpr size_t WS_HID = 109 * MiB;
constexpr size_t WS_SLAB = 254 * MiB;
constexpr size_t WS_WSET2 = 343 * MiB;
constexpr size_t WSET_STRIDE = WS_WSET2 - 2 * MiB;
constexpr size_t WS_END = 369 * MiB;
constexpr int NSPLIT_OUT = 2, NSPLIT_2 = 4;
constexpr int CW_BAR = 1024;
constexpr int LDS_BYTES = 147456;
constexpr int MISC_OFF = 131072 + 8192;

#define LAS __attribute__((address_space(3)))
typedef unsigned short bf16_t;
typedef unsigned v4u __attribute__((ext_vector_type(4)));
typedef unsigned v2u __attribute__((ext_vector_type(2)));
typedef float f32x4 __attribute__((ext_vector_type(4)));
typedef short bf16x8 __attribute__((ext_vector_type(8)));
#define LDS_WAIT() asm volatile("s_waitcnt lgkmcnt(0)" ::: "memory")
#define VM_WAIT() asm volatile("s_waitcnt vmcnt(0)" ::: "memory")
typedef float f32x2_ __attribute__((ext_vector_type(2)));
typedef __bf16 bf16x2_ __attribute__((ext_vector_type(2)));
__device__ __forceinline__ unsigned pk2(float lo, float hi) { const f32x2_ v = {lo, hi}; const bf16x2_ r = __builtin_convertvector(v, bf16x2_); return __builtin_bit_cast(unsigned, r); }
__device__ __forceinline__ unsigned f2bf(float f) { return pk2(f, 0.f) & 0xffffu; }
__device__ __forceinline__ float bf2f(unsigned v) { return __builtin_bit_cast(float, v << 16); }
__device__ __forceinline__ float bflo(unsigned w) { return __builtin_bit_cast(float, w << 16); }
__device__ __forceinline__ float bfhi(unsigned w) { return __builtin_bit_cast(float, w & 0xffff0000u); }
template <int CTRL> __device__ __forceinline__ float dppf(float x) { return __builtin_bit_cast(float, __builtin_amdgcn_update_dpp(0, __builtin_bit_cast(int, x), CTRL, 0xF, 0xF, true)); }
__device__ __forceinline__ float row16_sum(float v) { v += dppf<0xB1>(v); v += dppf<0x4E>(v); v += dppf<0x141>(v); v += dppf<0x140>(v); return v; }
__device__ __forceinline__ float row16_max(float v) { v = fmaxf(v, dppf<0xB1>(v)); v = fmaxf(v, dppf<0x4E>(v)); v = fmaxf(v, dppf<0x141>(v)); v = fmaxf(v, dppf<0x140>(v)); return v; }
__device__ __forceinline__ float quad_sum(float v) { v += dppf<0xB1>(v); v += dppf<0x4E>(v); return v; }
template <int N> __device__ __forceinline__ float row16_bcast(float v) { return dppf<0x150 + N>(v); }
__device__ __forceinline__ float wave_sum(float v) { v = row16_sum(v); v += __shfl_xor(v, 16); v += __shfl_xor(v, 32); return v; }
__device__ __forceinline__ float frcp(float x) { return __builtin_amdgcn_rcpf(x); }
__device__ __forceinline__ float frsq(float x) { return __builtin_amdgcn_rsqf(x); }
__device__ __forceinline__ float fexp(float x) { return __builtin_amdgcn_exp2f(x * 1.4426950408889634f); }
__device__ __forceinline__ float flog1p(float y) { return y < 0.02f ? y * (1.0f - y * (0.5f - y * (0.33333333f - 0.25f * y))) : __builtin_amdgcn_logf(1.0f + y) * 0.6931471805599453f; }
__device__ __forceinline__ float sigmoidf_(float x) { return frcp(1.f + fexp(-x)); }
__device__ __forceinline__ float siluf_(float x) { return x * frcp(1.f + fexp(-x)); }
__device__ __forceinline__ float softplusf_(float x) { return x > 20.f ? x : flog1p(fexp(x)); }
__device__ __forceinline__ float logsigf_(float x) { return x >= 0.f ? -flog1p(fexp(-x)) : x - flog1p(fexp(x)); }
__device__ __forceinline__ float geluf_(float x) { const float u = 0.7978845608028654f * (x + 0.044715f * x * x * x); const float th = 1.0f - 2.0f * frcp(1.0f + fexp(2.0f * u)); return 0.5f * x * (1.f + th); }
template <int KS> __device__ __forceinline__ f32x4 mma_ll(const LAS bf16_t* A, int lda, const LAS bf16_t* Bt, int ldb, f32x4 acc, int lane) {
    const LAS bf16_t* ap = A + (lane & 15) * lda + 8 * (lane >> 4);
    const LAS bf16_t* bp = Bt + (lane & 15) * ldb + 8 * (lane >> 4);
#pragma unroll
    for (int ks = 0; ks < KS; ++ks) {
        const bf16x8 a = *(const LAS bf16x8*)(ap + 32 * ks); const bf16x8 b = *(const LAS bf16x8*)(bp + 32 * ks);
        acc = __builtin_amdgcn_mfma_f32_16x16x32_bf16(a, b, acc, 0, 0, 0);
    }
    return acc;
}
__device__ __forceinline__ v2u pack4(const f32x4 v) { v2u r; r.x = pk2(v[0], v[1]); r.y = pk2(v[2], v[3]); return r; }
__device__ __forceinline__ f32x4 unpack4(const v2u w) { f32x4 r; r[0] = bflo(w.x); r[1] = bfhi(w.x); r[2] = bflo(w.y); r[3] = bfhi(w.y); return r; }
__device__ __forceinline__ int chunk_row0(int b, int cidx) { return cidx < 4 ? MLAT + b * CTXL + cidx * 64 : b * SEQ + (cidx - 4) * 64; }

#define XB_TMO      128
#define XB_XCNT(j)  (256  + 64 * (j))
#define XB_XSUB(j)  (1280 + 64 * (j))
#define XB_XGEN(j)  (2304 + 64 * (j))
#define XB_TOP      3328
#define XB_TOPGEN   3392
#define XCD_BAR_WORDS 3456
#define XB_SPIN_CAP (1u << 18)

__device__ __forceinline__ unsigned xb_ld(unsigned* p)              { return __hip_atomic_load(p, __ATOMIC_RELAXED, __HIP_MEMORY_SCOPE_AGENT); }
__device__ __forceinline__ unsigned xb_add(unsigned* p, unsigned v) { return __hip_atomic_fetch_add(p, v, __ATOMIC_RELAXED, __HIP_MEMORY_SCOPE_AGENT); }
__device__ __forceinline__ unsigned xb_xcc_id() { return (unsigned)__builtin_amdgcn_s_getreg((3 << 11) | 20) & 0xFu; }
#define XB_SPIN(cond, bar) do { unsigned _sp = 0; while (cond) { __builtin_amdgcn_s_sleep(1); \
    if ((++_sp & 255u) == 0u) { if (xb_ld(&(bar)[XB_TMO])) break; if (_sp > XB_SPIN_CAP) { atomicAdd(&(bar)[XB_TMO], 1u); break; } } } } while (0)

struct XcdBarrier {
    unsigned* bar; unsigned x;
    volatile LAS unsigned* st;
};

__device__ __forceinline__ XcdBarrier xcd_barrier_post(unsigned* bar, volatile LAS unsigned* st, int tid) {
    XcdBarrier b; b.bar = bar; b.x = xb_xcc_id(); b.st = st;
    if (tid == 0) (void)xb_add(&bar[XB_XCNT(b.x)], 1u);
    return b;
}
__device__ __forceinline__ void xcd_barrier_complete(unsigned* bar, unsigned x, unsigned& nloc, unsigned& nx) {
    const unsigned G = gridDim.x * gridDim.y * gridDim.z;
    unsigned sum, cnt, mine, sp = 0u;
    for (;;) {
        sum = 0u; cnt = 0u; mine = 0u;
#pragma unroll
        for (unsigned j = 0; j < 16; ++j) { const unsigned c = xb_ld(&bar[XB_XCNT(j)]); sum += c; cnt += (c > 0u) ? 1u : 0u; mine = (j == x) ? c : mine; }
        if (sum == G) break;
        __builtin_amdgcn_s_sleep(1);
        if ((++sp & 255u) == 0u) { if (xb_ld(&bar[XB_TMO])) break; if (sp > XB_SPIN_CAP) { atomicAdd(&bar[XB_TMO], 1u); break; } }
    }
    nloc = mine > 0u ? mine : 1u; nx = cnt > 0u ? cnt : 1u;
}

__device__ __forceinline__ void xcd_barrier(const XcdBarrier& b, int tid) {
    asm volatile("s_waitcnt vmcnt(0)" ::: "memory");
    __syncthreads();
    if (tid == 0) {
        unsigned* bar = b.bar;
        __builtin_amdgcn_s_waitcnt(0);
        unsigned nloc = b.st[0], nx = b.st[1];
        if (nloc == 0u) { xcd_barrier_complete(bar, b.x, nloc, nx); b.st[0] = nloc; b.st[1] = nx; }
        const unsigned old = xb_add(&bar[XB_XSUB(b.x)], 1u);
        const unsigned gen = old / nloc;
        if (old + 1u == (gen + 1u) * nloc) {
            __builtin_amdgcn_fence(__ATOMIC_RELEASE, "agent");
            asm volatile("s_waitcnt vmcnt(0)" ::: "memory");
            const unsigned og = xb_add(&bar[XB_TOP], 1u);
            const unsigned tg = og / nx;
            if (og + 1u == (tg + 1u) * nx) xb_add(&bar[XB_TOPGEN], 1u);
            else XB_SPIN(xb_ld(&bar[XB_TOPGEN]) == tg, bar);
            __builtin_amdgcn_fence(__ATOMIC_ACQUIRE, "agent");
            xb_add(&bar[XB_XGEN(b.x)], 1u);
            asm volatile("s_waitcnt vmcnt(0)" ::: "memory");
        } else {
            XB_SPIN(xb_ld(&bar[XB_XGEN(b.x)]) == gen, bar);
            __builtin_amdgcn_fence(__ATOMIC_ACQUIRE, "agent");
            asm volatile("s_waitcnt vmcnt(0)" ::: "memory");
        }
    }
    __syncthreads();
}

struct Frame {
    LAS unsigned char* lds;
    int wave, G, gw, NGW;
    const float *x, *c, *ctx, *cctx, *ada_w, *ada_b, *norm1_w, *norm2_w, *w_in, *w_out, *conv_w, *a_log, *dt_bias, *gdn_norm_w, *sink, *w_s, *b_s,
                *gmlp_norm_w, *ig_bias, *fg_bias, *mlstm_norm_w, *w1, *w2, *final_w;
    float* out; unsigned char* ws;
    float *MOD, *XC, *CHS, *GLG, *GLM, *WI, *PEND, *SLAB;
    bf16_t *WIN, *WOUT, *W1, *W2, *WSP, *H, *MIX, *Z, *PG, *PM, *HID;
};

__device__ __forceinline__ int fresh_lane() { int t; asm volatile("v_mbcnt_lo_u32_b32 %0, -1, 0\n\tv_mbcnt_hi_u32_b32 %0, -1, %0" : "=v"(t)); return t; }
__device__ __forceinline__ void phase_mod(const Frame& F) {
    LAS float* sact = (LAS float*)F.lds;
    LAS float* part = sact + 9 * 1024;
    const int lane0 = fresh_lane(), tid0 = F.wave * 64 + lane0;
    for (int i = tid0; i < 9 * 1024; i += NWAVES * 64) { const float v = i < 8192 ? F.c[i] : F.cctx[i - 8192]; sact[i] = v * frcp(1.f + fexp(-v)); }
    __syncthreads();
    for (int task = blockIdx.x; task < DEPTH * 48; task += F.G) {
        const int lane = fresh_lane(), tid = F.wave * 64 + lane;
        const int l = task / 48, cg = task % 48, col = cg * 128 + 2 * lane, k0 = F.wave * 128;
        const float* w = F.ada_w + (size_t)l * 1024 * 6144 + (size_t)k0 * 6144 + col;
        float a0[9], a1[9];
#pragma unroll
        for (int b = 0; b < 9; ++b) { a0[b] = 0.f; a1[b] = 0.f; }
#pragma unroll 8
        for (int k = 0; k < 128; ++k) { const f32x2_ wv = *(const f32x2_*)(w + (size_t)k * 6144);
#pragma unroll
            for (int b = 0; b < 9; ++b) { const float sv = sact[b * 1024 + k0 + k]; a0[b] += sv * wv[0]; a1[b] += sv * wv[1]; } }
#pragma unroll
        for (int b = 0; b < 9; ++b) { part[(F.wave * 9 + b) * 128 + 2 * lane] = a0[b]; part[(F.wave * 9 + b) * 128 + 2 * lane + 1] = a1[b]; }
        __syncthreads();
        for (int o = tid; o < 9 * 128; o += NWAVES * 64) { const int b = o >> 7, cc = o & 127; float s = F.ada_b[l * 6144 + cg * 128 + cc];
#pragma unroll
            for (int wv = 0; wv < 8; ++wv) s += part[(wv * 9 + b) * 128 + cc];
            F.MOD[(l * 9 + b) * 6144 + cg * 128 + cc] = s; }
        __syncthreads();
    }
}

__device__ __forceinline__ void transpose_item(const float* W, int K, int N, int Ndst, bf16_t* WT, LAS float* scr, int item, int lane, bool remap) {
    const int nblk = Ndst / 32, kb = item / nblk, nb = item % nblk, k0 = 64 * kb, n0 = 32 * nb;
    const int n = n0 + (lane & 31);
    const int src = remap ? (n < 1024 ? n : n < 3072 ? n + 16 : n < 3088 ? n - 2048 : n < 3104 ? n : -1) : n;
    float wv[32]; const int srcc = src >= 0 ? src : 0;
#pragma unroll
    for (int i = 0; i < 32; ++i) wv[i] = W[(size_t)(k0 + 2 * i + (lane >> 5)) * N + srcc];
#pragma unroll
    for (int i = 0; i < 32; ++i) scr[(2 * i + (lane >> 5)) * 33 + (lane & 31)] = src >= 0 ? wv[i] : 0.f;
    LDS_WAIT(); asm volatile("" ::: "memory");
    const int c = lane & 7;
#pragma unroll
    for (int j = 0; j < 4; ++j) { const int nn = (lane >> 3) + 8 * j; const LAS float* s = scr + (8 * c) * 33 + nn;
        v4u o; o.x = pk2(s[0 * 33], s[1 * 33]); o.y = pk2(s[2 * 33], s[3 * 33]); o.z = pk2(s[4 * 33], s[5 * 33]); o.w = pk2(s[6 * 33], s[7 * 33]);
        *(v4u*)(WT + (size_t)(n0 + nn) * K + k0 + 8 * c) = o; }
    LDS_WAIT(); asm volatile("" ::: "memory");
}
__device__ __forceinline__ void convert_weights(const Frame& F, int l, int gw, int ngw) {
    LAS float* scr = (LAS float*)(F.lds + F.wave * 16384);
    unsigned char* wb = F.ws + (size_t)(l & 1) * WSET_STRIDE;
    bf16_t* dWIN = (bf16_t*)(wb + WS_WIN); bf16_t* dWOUT = (bf16_t*)(wb + WS_WOUT); bf16_t* dW1 = (bf16_t*)(wb + WS_W1); bf16_t* dW2 = (bf16_t*)(wb + WS_W2); bf16_t* dWSP = (bf16_t*)(wb + WS_WSP);
    constexpr int I_IN = 16 * (ZW / 32), I_OUT = 16 * 32, I_1 = 16 * 128, I_2 = 64 * 32, I_S = 128;
    for (int it = gw; it < I_IN + I_OUT + I_1 + I_2 + I_S; it += ngw) {
        int r = it; const int lane = fresh_lane();
        if (r < I_IN) { transpose_item(F.w_in + (size_t)l * 1024 * 3104, 1024, 3104, ZW, dWIN, scr, r, lane, true); continue; } r -= I_IN;
        if (r < I_OUT) { transpose_item(F.w_out + (size_t)l * 1024 * 1024, 1024, 1024, 1024, dWOUT, scr, r, lane, false); continue; } r -= I_OUT;
        if (r < I_1) { transpose_item(F.w1 + (size_t)l * 1024 * 4096, 1024, 4096, 4096, dW1, scr, r, lane, false); continue; } r -= I_1;
        if (r < I_2) { transpose_item(F.w2 + (size_t)l * 4096 * 1024, 4096, 1024, 1024, dW2, scr, r, lane, false); continue; } r -= I_2;
        { const float* s = F.w_s + (size_t)l * 65536 + r * 512 + lane * 8; const f32x4 a = *(const f32x4*)s, b = *(const f32x4*)(s + 4);
          v4u o; o.x = pk2(a[0], a[1]); o.y = pk2(a[2], a[3]); o.z = pk2(b[0], b[1]); o.w = pk2(b[2], b[3]); *(v4u*)(dWSP + r * 512 + lane * 8) = o; }
    }
}

__device__ __forceinline__ void phase_norm(const Frame& F, int l, int which, int nrows, int nslab, const float* sgate) {
    const float* nwp = (which == 0 ? F.norm1_w : F.norm2_w) + l * 1024;
    const bool init = (which == 0 && l == 0);
    const int lane = fresh_lane();
    f32x4 nwv[4];
#pragma unroll
    for (int j = 0; j < 4; ++j) nwv[j] = *(const f32x4*)(nwp + 256 * j + 4 * lane);
    int m = F.gw; if (m >= nrows) return;
    f32x4 v[4], vn[4];
    { const bool lat = m < MLAT; const float* src = init ? (lat ? F.x + (size_t)m * 1024 : F.ctx + (size_t)(m - MLAT) * 1024) : (lat ? F.out + (size_t)m * 1024 : F.XC + (size_t)(m - MLAT) * 1024);
#pragma unroll
      for (int j = 0; j < 4; ++j) v[j] = *(const f32x4*)(src + 256 * j + 4 * lane); }
    for (; m < nrows; m += F.NGW) {
        const bool lat = m < MLAT; const int bm = lat ? (m >> 11) : 8;
        float* xrow = lat ? F.out + (size_t)m * 1024 : F.XC + (size_t)(m - MLAT) * 1024;
        const float* mod = F.MOD + (l * 9 + bm) * 6144 + (which == 0 ? 0 : 3 * 1024);
        f32x4 shv[4], scv[4];
#pragma unroll
        for (int j = 0; j < 4; ++j) { const int col = 256 * j + 4 * lane; shv[j] = *(const f32x4*)(mod + col); scv[j] = *(const f32x4*)(mod + 1024 + col); }
        const int mn = m + F.NGW;
        if (mn < nrows) { const bool latn = mn < MLAT; const float* srcn = init ? (latn ? F.x + (size_t)mn * 1024 : F.ctx + (size_t)(mn - MLAT) * 1024) : (latn ? F.out + (size_t)mn * 1024 : F.XC + (size_t)(mn - MLAT) * 1024);
#pragma unroll
            for (int j = 0; j < 4; ++j) vn[j] = *(const f32x4*)(srcn + 256 * j + 4 * lane); }
        const bool red = !lat && nslab > 0;
        if (red) {
#pragma unroll
            for (int j = 0; j < 4; ++j) { f32x4 a = {0.f, 0.f, 0.f, 0.f};
                for (int k = 0; k < nslab; ++k) a += *(const f32x4*)(F.SLAB + ((size_t)k * MCTX + (m - MLAT)) * 1024 + 256 * j + 4 * lane);
                v[j] += a * *(const f32x4*)(sgate + 256 * j + 4 * lane); }
        }
        float s = 0.f;
#pragma unroll
        for (int j = 0; j < 4; ++j) s += (v[j][0] * v[j][0] + v[j][1] * v[j][1]) + (v[j][2] * v[j][2] + v[j][3] * v[j][3]);
        const float rstd = frsq(wave_sum(s) * (1.f / 1024.f) + EPS);
#pragma unroll
        for (int j = 0; j < 4; ++j) {
            const int col = 256 * j + 4 * lane;
            if (init || red) *(f32x4*)(xrow + col) = v[j];
            const f32x4 hh = (v[j] * rstd * nwv[j]) * (scv[j] + 1.0f) + shv[j];
            *(v2u*)(F.H + (size_t)m * 1024 + col) = pack4(hh);
        }
#pragma unroll
        for (int j = 0; j < 4; ++j) v[j] = vn[j];
    }
}
__device__ __forceinline__ void phase_final(const Frame& F, bool poison) {
    for (int m = F.gw; m < MLAT; m += F.NGW) {
        const int lane = fresh_lane();
        float* xrow = F.out + (size_t)m * 1024;
        f32x4 v[4]; float s = 0.f;
#pragma unroll
        for (int j = 0; j < 4; ++j) { v[j] = *(const f32x4*)(xrow + 256 * j + 4 * lane); s += (v[j][0] * v[j][0] + v[j][1] * v[j][1]) + (v[j][2] * v[j][2] + v[j][3] * v[j][3]); }
        float rstd = frsq(wave_sum(s) * (1.f / 1024.f) + EPS);
        if (poison) rstd = __builtin_nanf("");
        f32x4 nwv[4];
#pragma unroll
        for (int j = 0; j < 4; ++j) nwv[j] = *(const f32x4*)(F.final_w + 256 * j + 4 * lane);
#pragma unroll
        for (int j = 0; j < 4; ++j) *(f32x4*)(xrow + 256 * j + 4 * lane) = v[j] * rstd * nwv[j];
    }
}

__device__ __forceinline__ void ew_unit(const Frame& F, int l, int rg) {
    const int r0 = rg * 16;
    const int t_o = F.wave * 64 + fresh_lane();
    const int tid = t_o, lane_ = t_o & 63, wave_ = __builtin_amdgcn_readfirstlane(t_o >> 6);
    unsigned short ra[6], rb[6];
#pragma unroll
    for (int j = 0; j < 6; ++j) { const int idx = tid + 512 * j, rr = idx / 192, pr = idx % 192, hd = pr >> 5, f = pr & 31;
        const bf16_t* p = F.Z + (size_t)(r0 + rr) * ZW + (hd < 4 ? ZC_SQ + hd * 64 : ZC_SK + (hd - 4) * 64) + f; ra[j] = p[0]; rb[j] = p[32]; }
#pragma unroll
    for (int j = 0; j < 6; ++j) {
        const int idx = tid + 512 * j, rr = idx / 192, pr = idx % 192, hd = pr >> 5, f = pr & 31, row = r0 + rr;
        bf16_t* p = F.Z + (size_t)row * ZW + (hd < 4 ? ZC_SQ + hd * 64 : ZC_SK + (hd - 4) * 64) + f;
        const float t1 = bf2f(ra[j]), t2 = bf2f(rb[j]);
        if (row < MLAT) {
            const int t = row & (SEQ - 1); const float pos = (float)(f < 16 ? (t >> 6) : (t & 63));
            const float inv = __builtin_amdgcn_exp2f(-(float)(f & 15) * 0.8304820237218406f);
            const float rev = pos * inv * 0.15915494309189535f; const float cs = __builtin_amdgcn_cosf(rev), sn = __builtin_amdgcn_sinf(rev);
            const float sc = hd < 4 ? 0.125f : 1.0f;
            p[0] = (bf16_t)f2bf((t1 * cs - t2 * sn) * sc); p[32] = (bf16_t)f2bf((t1 * sn + t2 * cs) * sc);
        } else if (hd < 4) {
            p[0] = (bf16_t)f2bf(t1 * 0.125f); p[32] = (bf16_t)f2bf(t2 * 0.125f);
        }
    }
    v2u ur[2], vr[2];
#pragma unroll
    for (int j = 0; j < 2; ++j) { const bf16_t* zr = F.Z + (size_t)(r0 + 2 * wave_ + j) * ZW + 4 * lane_; ur[j] = *(const v2u*)(zr + ZC_MU); vr[j] = *(const v2u*)(zr + ZC_MV); }
    const f32x4 gnw = *(const f32x4*)(F.gmlp_norm_w + l * 256 + 4 * lane_);
#pragma unroll
    for (int j = 0; j < 2; ++j) {
        bf16_t* zr = F.Z + (size_t)(r0 + 2 * wave_ + j) * ZW + 4 * lane_;
        f32x4 u = unpack4(ur[j]), v = unpack4(vr[j]); float ss = 0.f;
#pragma unroll
        for (int e = 0; e < 4; ++e) { u[e] = geluf_(u[e]); v[e] = geluf_(v[e]); ss += v[e] * v[e]; }
        const float rs = frsq(wave_sum(ss) * (1.f / 256.f) + EPS);
        *(v2u*)(zr + ZC_MU) = pack4(u); *(v2u*)(zr + ZC_MV) = pack4(v * rs * gnw);
    }
}
__device__ __forceinline__ void chs_unit(const Frame& F, int l, int ck) {
    const int b = ck / 36, cidx = ck % 36, row0 = chunk_row0(b, cidx);
    const int t = F.wave * 64 + fresh_lane();
    LAS float* G = (LAS float*)F.lds;
#pragma unroll
    for (int j = 0; j < 2; ++j) { const int idx = t + 512 * j, p = idx >> 4, c = idx & 15, dh = c & 7;
        const float raw = bf2f(F.Z[(size_t)(row0 + p) * ZW + ZC_LI + c]);
        G[c * 64 + p] = c < 8 ? raw + F.ig_bias[l * 8 + dh] : logsigf_(raw + F.fg_bias[l * 8 + dh]); }
    __syncthreads();
    if (t < 8) { const int d = t >> 2, h = t & 3; float bsum = 0.f, mx = -1e30f;
        for (int i = 0; i < 64; ++i) { const int p = d ? 63 - i : i; bsum += G[(8 + t) * 64 + p]; mx = fmaxf(mx, G[t * 64 + p] - bsum); }
        float* o = F.CHS + ((((b * 4 + h) * 2 + d) * 36) + cidx) * 2; o[0] = bsum; o[1] = bsum + mx; }
    __syncthreads();
}

__device__ __forceinline__ void gdn_prep_unit(const Frame& F, int l, int u, int stop = 99, bf16_t* PGo = nullptr) {
    if (!PGo) PGo = F.PG;
    const int b = u / 144, h = (u / 36) & 3, cidx = u % 36;
    const int row0 = chunk_row0(b, cidx);
    const int seg_lo = cidx < 4 ? MLAT + b * CTXL : b * SEQ, seg_hi = seg_lo + (cidx < 4 ? CTXL : SEQ);
    const int t_o = F.wave * 64 + fresh_lane();
    const int t = t_o, lane = t & 63, w = __builtin_amdgcn_readfirstlane(t >> 6), lr = lane & 15, lq = lane >> 4;
    LAS unsigned char* L = F.lds;
    LAS bf16_t* Qs = (LAS bf16_t*)(L + 0); LAS bf16_t* Ks = (LAS bf16_t*)(L + 9216); LAS bf16_t* Kt = (LAS bf16_t*)(L + 18432); LAS bf16_t* Vt = (LAS bf16_t*)(L + 27648);
    LAS float* gS = (LAS float*)(L + 36864); LAS float* bS = gS + 128; LAS float* gcS = gS + 256; LAS float* totS = gS + 384;
    LAS float* As = (LAS float*)(L + 38912);
    LAS float* CV = (LAS float*)(L + 38912);
    LAS bf16_t* UT = (LAS bf16_t*)(L + 38912); LAS bf16_t* UTd = UT + 4608; LAS bf16_t* WT = UT + 9216; LAS bf16_t* WTd = UT + 13824;
    LAS bf16_t* Tb = (LAS bf16_t*)(L + 75776);
    LAS bf16_t* At = (LAS bf16_t*)(L + 112640);
    if (t < 384) {
        const int pair = t % 96, rg = t / 96, c0 = 2 * pair, part = c0 >> 6, d0 = c0 & 63, zcol = part * 256 + h * 64 + d0;
        float cw[5][2];
#pragma unroll
        for (int j = 0; j < 5; ++j) { const float* wp = F.conv_w + (size_t)(l * 5 + j) * 768 + part * 256 + h * 64 + d0; cw[j][0] = wp[0]; cw[j][1] = wp[1]; }
        float win[20][2];
        unsigned raw[20];
        { const int rbase = row0 + rg * 16 - 2; const bf16_t* zc = F.Z + zcol;
#pragma unroll
          for (int rr = 0; rr < 20; ++rr) { int row = rbase + rr; row = row < seg_lo ? seg_lo : (row >= seg_hi ? seg_hi - 1 : row); raw[rr] = *(const unsigned*)(zc + (size_t)row * ZW); }
          asm volatile("" : "+v"(raw[0]), "+v"(raw[1]), "+v"(raw[2]), "+v"(raw[3]), "+v"(raw[4]), "+v"(raw[5]), "+v"(raw[6]), "+v"(raw[7]), "+v"(raw[8]), "+v"(raw[9]));
          asm volatile("" : "+v"(raw[10]), "+v"(raw[11]), "+v"(raw[12]), "+v"(raw[13]), "+v"(raw[14]), "+v"(raw[15]), "+v"(raw[16]), "+v"(raw[17]), "+v"(raw[18]), "+v"(raw[19]));
#pragma unroll
          for (int rr = 0; rr < 20; ++rr) { const int row = rbase + rr; const unsigned wv = (row >= seg_lo && row < seg_hi) ? raw[rr] : 0u; win[rr][0] = bflo(wv); win[rr][1] = bfhi(wv); } }
#pragma unroll
        for (int i = 0; i < 16; ++i) { float a0 = 0.f, a1 = 0.f;
#pragma unroll
            for (int j = 0; j < 5; ++j) { a0 += cw[j][0] * win[i + j][0]; a1 += cw[j][1] * win[i + j][1]; }
            CV[(rg * 16 + i) * 196 + c0] = siluf_(a0); CV[(rg * 16 + i) * 196 + c0 + 1] = siluf_(a1); }
    } else {
        const int tt = t - 384, d = tt >> 6, p = tt & 63; const bf16_t* zr = F.Z + (size_t)(row0 + p) * ZW;
        const float a = bf2f(zr[ZC_GA + d * 4 + h]), bb = bf2f(zr[ZC_GB + d * 4 + h]);
        gS[d * 64 + p] = -fexp(F.a_log[l * 8 + d * 4 + h]) * softplusf_(a + F.dt_bias[l * 8 + d * 4 + h]);
        bS[d * 64 + p] = sigmoidf_(bb);
    }
    __syncthreads();
    if (stop <= 1) return;
    {
        const int combo = t >> 2, sub = t & 3, row = combo & 63, part = combo >> 6;
        float v[16]; float ss = 0.f;
#pragma unroll
        for (int i = 0; i < 16; ++i) { v[i] = CV[row * 196 + part * 64 + sub * 16 + i]; ss += v[i] * v[i]; }
        ss = quad_sum(ss);
        const float rs = frsq(ss + EPS);
        LAS bf16_t* dst = (part == 0 ? Qs : Ks) + row * 72 + sub * 16;
        v4u o0, o1;
        o0.x = pk2(v[0] * rs, v[1] * rs); o0.y = pk2(v[2] * rs, v[3] * rs); o0.z = pk2(v[4] * rs, v[5] * rs); o0.w = pk2(v[6] * rs, v[7] * rs);
        o1.x = pk2(v[8] * rs, v[9] * rs); o1.y = pk2(v[10] * rs, v[11] * rs); o1.z = pk2(v[12] * rs, v[13] * rs); o1.w = pk2(v[14] * rs, v[15] * rs);
        *(LAS v4u*)dst = o0; *(LAS v4u*)(dst + 8) = o1;
        if (part == 1) {
#pragma unroll
            for (int i = 0; i < 16; ++i) Kt[(sub * 16 + i) * 72 + row] = (bf16_t)f2bf(v[i] * rs);
        }
        const int vrow = t & 63, dg = t >> 6;
#pragma unroll
        for (int i = 0; i < 8; ++i) Vt[(dg * 8 + i) * 72 + vrow] = (bf16_t)f2bf(CV[vrow * 196 + 128 + dg * 8 + i]);
        if (w < 2) { const int d = w, p = d ? 63 - lane : lane; float s = gS[d * 64 + p];
#pragma unroll
            for (int off = 1; off < 64; off <<= 1) { const float y = __shfl_up(s, off); if (lane >= off) s += y; }
            gcS[d * 64 + p] = s; if (lane == 63) totS[d] = s; }
    }
    __syncthreads();
    if (stop <= 2) return;
#pragma unroll
    for (int k2 = 0; k2 < 2; ++k2) {
        const int tt = 2 * w + k2, mt = tt >> 2, nt = tt & 3;
        f32x4 accG = {0.f, 0.f, 0.f, 0.f}, accQ = {0.f, 0.f, 0.f, 0.f};
        accG = mma_ll<2>(Ks + mt * 16 * 72, 72, Ks + nt * 16 * 72, 72, accG, lane);
        accQ = mma_ll<2>(Ks + mt * 16 * 72, 72, Qs + nt * 16 * 72, 72, accQ, lane);
        const int n = nt * 16 + lr, m0 = mt * 16 + 4 * lq;
#pragma unroll
        for (int d = 0; d < 2; ++d) {
            const float gcn = gcS[d * 64 + n], bn = bS[d * 64 + n];
            f32x4 av, tv;
#pragma unroll
            for (int i = 0; i < 4; ++i) { const int m = m0 + i; const float gcm = gcS[d * 64 + m];
                const bool strict = d == 0 ? (m < n) : (m > n); const bool incl = d == 0 ? (m <= n) : (m >= n);
                const float e = fexp(incl ? (gcn - gcm) : 0.f);
                av[i] = strict ? bn * accG[i] * e : 0.f; tv[i] = incl ? 0.125f * accQ[i] * e : 0.f; }
#pragma unroll
            for (int i = 0; i < 4; ++i) { const int si = d ? 63 - n : n, sj = d ? 63 - (m0 + i) : m0 + i; As[d * 4352 + (si >> 1) * 136 + sj * 2 + (si & 1)] = av[i]; }
            *(LAS v2u*)(At + d * 4608 + n * 72 + m0) = pack4(tv);
        }
    }
    __syncthreads();
    if (stop <= 3) return;
    if (w < 2) {
        const int d = w; const LAS float* Ad = As + d * 4352;
        float tr[64]; int lane_o = lane;
#pragma unroll
        for (int ip = 0; ip < 32; ++ip) {
            const int i0 = 2 * ip;
            f32x4 rv[32];
#pragma unroll
            for (int jp = 0; jp <= ip; ++jp) rv[jp] = *(const LAS f32x4*)(Ad + ip * 136 + 4 * jp);
            asm volatile("" : "+v"(lane_o) :: "memory");
            f32x2_ a0 = {0.f, 0.f}, a1 = {0.f, 0.f}, a2 = {0.f, 0.f}, a3 = {0.f, 0.f};
#pragma unroll
            for (int jp = 0; jp < ip; ++jp) {
                const f32x2_ ta = {tr[2 * jp], tr[2 * jp]}, tb = {tr[2 * jp + 1], tr[2 * jp + 1]};
                const f32x2_ va = {rv[jp][0], rv[jp][1]}, vb = {rv[jp][2], rv[jp][3]};
                if (jp & 1) { a2 += va * ta; a3 += vb * tb; } else { a0 += va * ta; a1 += vb * tb; }
            }
            const f32x2_ sum = (a0 + a1) + (a2 + a3);
            const float t0 = (lane_o == i0 ? 1.f : 0.f) - sum[0];
            tr[i0] = t0;
            tr[i0 + 1] = (lane_o == i0 + 1 ? 1.f : 0.f) - sum[1] - rv[ip][1] * t0;
        }
        const int pb = d ? 63 - lane : lane; const float sb = bS[d * 64 + pb], sbe = sb * fexp(gcS[d * 64 + pb]);
        LAS bf16_t* T0 = Tb + d * 9216; LAS bf16_t* T1 = T0 + 4608;
#pragma unroll
        for (int i = 0; i < 64; ++i) { const int pa = d ? 63 - i : i; T0[pa * 72 + pb] = (bf16_t)f2bf(tr[i] * sb); T1[pa * 72 + pb] = (bf16_t)f2bf(tr[i] * sbe); }
    }
    __syncthreads();
    if (stop <= 4) return;
#pragma unroll 1
    for (int d = 0; d < 2; ++d) {
        const int ud = u * 2 + d; const float tot = totS[d];
        const LAS bf16_t* T0 = Tb + d * 9216; const LAS bf16_t* T1 = T0 + 4608; const LAS bf16_t* Ad = At + d * 4608;
        {
            const bool isw = w >= 4; const LAS bf16_t* Aop = isw ? T1 : T0; const LAS bf16_t* Bop = isw ? Kt : Vt;
            LAS bf16_t* o0 = isw ? WT : UT; LAS bf16_t* o1 = isw ? WTd : UTd;
#pragma unroll
            for (int k4 = 0; k4 < 4; ++k4) { const int tt = (w & 3) * 4 + k4, mt = tt >> 2, nt = tt & 3;
                f32x4 acc = {0.f, 0.f, 0.f, 0.f}; acc = mma_ll<2>(Aop + mt * 16 * 72, 72, Bop + nt * 16 * 72, 72, acc, lane);
                const int n = nt * 16 + lr, m0 = mt * 16 + 4 * lq; f32x4 dv;
#pragma unroll
                for (int i = 0; i < 4; ++i) dv[i] = acc[i] * fexp(tot - gcS[d * 64 + m0 + i]);
                *(LAS v2u*)(o0 + n * 72 + m0) = pack4(acc); *(LAS v2u*)(o1 + n * 72 + m0) = pack4(dv); }
        }
        __syncthreads();
        {
            const int prod = w >> 1; bf16_t* gout = PGo + (size_t)ud * 16384 + prod * 4096;
            const LAS bf16_t* Aop = prod == 0 ? WTd : prod == 1 ? Kt : prod == 2 ? WT : Ad;
            const LAS bf16_t* Bop = prod == 0 ? Kt : prod == 1 ? UTd : prod == 2 ? Ad : UT;
#pragma unroll
            for (int k8 = 0; k8 < 8; ++k8) { const int tt = (w & 1) * 8 + k8, mt = tt >> 2, nt = tt & 3;
                f32x4 acc = {0.f, 0.f, 0.f, 0.f}; acc = mma_ll<2>(Aop + mt * 16 * 72, 72, Bop + nt * 16 * 72, 72, acc, lane);
                const int n = nt * 16 + lr, m0 = mt * 16 + 4 * lq;
                if (prod == 2) { const f32x4 qv = unpack4(*(const LAS v2u*)(Qs + n * 72 + m0)); const float e = 0.125f * fexp(gcS[d * 64 + n]); acc = qv * e - acc; }
                const int off = (prod == 0 || prod == 2) ? ((nt * 2 + (mt >> 1)) * 64 + ((mt & 1) * 2 + (lq >> 1)) * 16 + lr) * 8 + 4 * (lq & 1) : ((mt * 4 + nt) * 64 + lane) * 4;
                *(v2u*)(gout + off) = pack4(acc); }
        }
        if (t == 0 && PGo == F.PG) F.GLG[ud] = fexp(tot);
        __syncthreads();
    }
}

__device__ __forceinline__ void mlstm_prep_unit(const Frame& F, int l, int u) {
    const int b = u / 144, h = (u / 36) & 3, cidx = u % 36;
    const int row0 = chunk_row0(b, cidx);
    const int t_o = F.wave * 64 + fresh_lane();
    const int t = t_o, lane = t & 63, w = __builtin_amdgcn_readfirstlane(t >> 6), lr = lane & 15, lq = lane >> 4;
    LAS unsigned char* L = F.lds;
    LAS bf16_t* Qs = (LAS bf16_t*)(L + 0); LAS bf16_t* Ks = (LAS bf16_t*)(L + 9216); LAS bf16_t* Vta = (LAS bf16_t*)(L + 18432);
    LAS bf16_t* Kte = (LAS bf16_t*)(L + 29952);
    LAS bf16_t* S0 = (LAS bf16_t*)(L + 48384);
    LAS float* igS = (LAS float*)(L + 66816); LAS float* lfS = igS + 128; LAS float* bS = igS + 256; LAS float* dmS = igS + 384; LAS float* rS = igS + 512;
    LAS float* flS = igS + 640; LAS float* eS = igS + 768; LAS float* mpS = igS + 896; LAS float* chS = igS + 904;
    {
        const int r = t >> 3, seg = t & 7; const bf16_t* zr = F.Z + (size_t)(row0 + r) * ZW + h * 64 + seg * 8;
        const v4u q = *(const v4u*)(zr + ZC_LQ), k = *(const v4u*)(zr + ZC_LK), v = *(const v4u*)(zr + ZC_LV);
        *(LAS v4u*)(Qs + r * 72 + seg * 8) = q; *(LAS v4u*)(Ks + r * 72 + seg * 8) = k;
        Vta[(seg * 8 + 0) * 72 + r] = (bf16_t)(v.x & 0xffffu); Vta[(seg * 8 + 1) * 72 + r] = (bf16_t)(v.x >> 16);
        Vta[(seg * 8 + 2) * 72 + r] = (bf16_t)(v.y & 0xffffu); Vta[(seg * 8 + 3) * 72 + r] = (bf16_t)(v.y >> 16);
        Vta[(seg * 8 + 4) * 72 + r] = (bf16_t)(v.z & 0xffffu); Vta[(seg * 8 + 5) * 72 + r] = (bf16_t)(v.z >> 16);
        Vta[(seg * 8 + 6) * 72 + r] = (bf16_t)(v.w & 0xffffu); Vta[(seg * 8 + 7) * 72 + r] = (bf16_t)(v.w >> 16);
#pragma unroll
        for (int j = 0; j < 2; ++j) { const int idx = t + 512 * j, rr = 64 + (idx >> 6), cc = idx & 63; Vta[rr * 72 + cc] = (bf16_t)(rr == 64 ? 0x3F80u : 0u); }
        if (t < 128) { const int d = t >> 6, p = t & 63; const bf16_t* zg = F.Z + (size_t)(row0 + p) * ZW;
            igS[d * 64 + p] = bf2f(zg[ZC_LI + d * 4 + h]) + F.ig_bias[l * 8 + d * 4 + h];
            lfS[d * 64 + p] = logsigf_(bf2f(zg[ZC_LF + d * 4 + h]) + F.fg_bias[l * 8 + d * 4 + h]); }
        if (t >= 128 && t < 272) chS[t - 128] = F.CHS[(size_t)((b * 4 + h) * 2) * 72 + (t - 128)];
    }
    __syncthreads();
    if (w < 2) {
        const int d = w, p = d ? 63 - lane : lane;
        const int step_of = d ? (cidx < 4 ? 3 - cidx : 39 - cidx) : cidx; float mprev = 0.f;
        for (int s = 0; s < step_of; ++s) { const int ci = d ? (s < 4 ? 3 - s : 39 - s) : s; mprev = fmaxf(chS[d * 72 + ci * 2] + mprev, chS[d * 72 + ci * 2 + 1]); }
        const float ig = igS[d * 64 + p]; float bp = lfS[d * 64 + p];
#pragma unroll
        for (int off = 1; off < 64; off <<= 1) { const float y = __shfl_up(bp, off); if (lane >= off) bp += y; }
        float mxp = ig - bp;
#pragma unroll
        for (int off = 1; off < 64; off <<= 1) { const float y = __shfl_up(mxp, off); if (lane >= off) mxp = fmaxf(mxp, y); }
        const float mxall = __shfl(mxp, 63), bl = __shfl(bp, 63);
        const float dmax = bp + mxp, wsmax = bl + mxall;
        const float mnew = fmaxf(bl + mprev, wsmax), cd = fexp(bl + mprev - mnew), e2 = fexp(wsmax - mnew);
        const float mt = fmaxf(bp + mprev, dmax);
        bS[d * 64 + p] = bp; dmS[d * 64 + p] = dmax; rS[d * 64 + p] = fexp(dmax - mt); flS[d * 64 + p] = fexp(-mt);
        eS[d * 64 + p] = fexp(bl - bp + ig - wsmax) * e2;
        const int ud = u * 2 + d; F.WI[ud * 64 + p] = 0.125f * fexp(bp + mprev - mt); if (lane == 0) F.GLM[ud] = cd; }
    __syncthreads();
    {
        const int d = t >> 8, tt = t & 255, p = tt & 63, dg = tt >> 6; const float e = eS[d * 64 + p];
#pragma unroll
        for (int i = 0; i < 16; ++i) Kte[d * 4608 + (dg * 16 + i) * 72 + p] = (bf16_t)f2bf(bf2f(Ks[p * 72 + dg * 16 + i]) * e);
#pragma unroll
        for (int k2 = 0; k2 < 2; ++k2) { const int tl = 2 * w + k2, mt = tl >> 2, nt = tl & 3;
            f32x4 acc = {0.f, 0.f, 0.f, 0.f}; acc = mma_ll<2>(Ks + mt * 16 * 72, 72, Qs + nt * 16 * 72, 72, acc, lane);
            const int n = nt * 16 + lr, m0 = mt * 16 + 4 * lq;
#pragma unroll
            for (int dd = 0; dd < 2; ++dd) { const float bn = bS[dd * 64 + n], dn = dmS[dd * 64 + n], rn = rS[dd * 64 + n]; f32x4 sv;
#pragma unroll
                for (int i = 0; i < 4; ++i) { const int m = m0 + i; const bool incl = dd == 0 ? (m <= n) : (m >= n);
                    const float arg = incl ? (bn - bS[dd * 64 + m] + igS[dd * 64 + m] - dn) : 0.f; sv[i] = incl ? 0.125f * acc[i] * fexp(arg) * rn : 0.f; }
                *(LAS v2u*)(S0 + dd * 4608 + n * 72 + m0) = pack4(sv); } }
    }
    __syncthreads();
    {
        const int d = w >> 2, ud = u * 2 + d; bf16_t* gO = F.PM + (size_t)ud * 10240; bf16_t* gB = gO + 5120;
#pragma unroll 2
        for (int k = 0; k < 10; ++k) { const int tl = (w & 3) * 10 + k; const bool iskv = tl >= 20; const int t2 = iskv ? tl - 20 : tl, mt = t2 / 5, nt = t2 % 5;
            const LAS bf16_t* Aop = (iskv ? Kte : S0) + d * 4608 + mt * 16 * 72;
            f32x4 acc = {0.f, 0.f, 0.f, 0.f}; acc = mma_ll<2>(Aop, 72, Vta + nt * 16 * 72, 72, acc, lane);
            const int n = nt * 16 + lr, m0 = mt * 16 + 4 * lq;
            if (!iskv && n == 65) {
#pragma unroll
                for (int i = 0; i < 4; ++i) acc[i] = flS[d * 64 + m0 + i]; }
            *(v2u*)((iskv ? gB : gO) + ((mt * 5 + nt) * 64 + lane) * 4) = pack4(acc); }
    }
    __syncthreads();
}

__device__ __forceinline__ void l2_touch(const void* gsrc, unsigned lds_dst) {
    unsigned keep;
    asm volatile("s_mov_b32 %0, m0\n\ts_mov_b32 m0, %2\n\ts_nop 0\n\tglobal_load_lds_dword %1, off\n\ts_mov_b32 m0, %0" : "=&s"(keep) : "v"(gsrc), "s"(lds_dst) : "memory");
}
template <int NT> struct ScanOps { bf16x8 Qf[2], Mf[2]; v2u bv[NT], ov[NT]; float gl; f32x4 wi; };
template <bool GDN, int NT> __device__ __forceinline__ void scan_load(const Frame& F, int b, int h, int dir, int wq, int lr, int lq, int s, ScanOps<NT>& o) {
    const int cidx = dir ? (s < 4 ? 3 - s : 39 - s) : s;
    const int ud = ((b * 4 + h) * 36 + cidx) * 2 + dir;
    if (GDN) {
        const bf16_t* gM = F.PG + (size_t)ud * 16384; const bf16_t* gQ = gM + 8192;
#pragma unroll
        for (int ks = 0; ks < 2; ++ks) { o.Mf[ks] = *(const bf16x8*)(gM + ((wq * 2 + ks) * 64 + lq * 16 + lr) * 8); o.Qf[ks] = *(const bf16x8*)(gQ + ((wq * 2 + ks) * 64 + lq * 16 + lr) * 8); }
    } else {
        const bf16_t* zq = F.Z + (size_t)(chunk_row0(b, cidx) + 16 * wq + lr) * ZW + ZC_LQ + h * 64;
#pragma unroll
        for (int ks = 0; ks < 2; ++ks) { o.Qf[ks] = *(const bf16x8*)(zq + 32 * ks + 8 * lq); o.Mf[ks] = o.Qf[ks]; }
    }
    const bf16_t* gB = GDN ? F.PG + (size_t)ud * 16384 + 4096 : F.PM + (size_t)ud * 10240 + 5120;
    const bf16_t* gO = GDN ? F.PG + (size_t)ud * 16384 + 12288 : F.PM + (size_t)ud * 10240;
#pragma unroll
    for (int t = 0; t < NT; ++t) { o.bv[t] = *(const v2u*)(gB + ((wq * NT + t) * 64 + lq * 16 + lr) * 4); o.ov[t] = *(const v2u*)(gO + ((wq * NT + t) * 64 + lq * 16 + lr) * 4); }
    o.gl = GDN ? F.GLG[ud] : F.GLM[ud];
    o.wi = (f32x4){1.f, 1.f, 1.f, 1.f}; if (!GDN) o.wi = *(const f32x4*)(F.WI + ud * 64 + 16 * wq + 4 * lq);
}
struct ScanFin { f32x4 pend[4]; unsigned short gz[4][4]; };
template <bool GDN> __device__ __forceinline__ void scan_fin_load(const Frame& F, int b, int h, int dir, int wq, int lr, int lq, int s, const float* PEND, ScanFin& f) {
    const int cidx = dir ? (s < 4 ? 3 - s : 39 - s) : s; const int row0 = chunk_row0(b, cidx);
    const float* pp = PEND + (size_t)((b * 4 + h) * 36 + cidx) * 4096 + (wq * 256 + lq * 16 + lr) * 4;
#pragma unroll
    for (int t = 0; t < 4; ++t) { f.pend[t] = *(const f32x4*)(pp + t * 256);
#pragma unroll
        for (int i = 0; i < 4; ++i) f.gz[t][i] = F.Z[(size_t)(row0 + 16 * wq + 4 * lq + i) * ZW + (GDN ? ZC_GZ : ZC_LO) + h * 64 + 16 * t + lr]; }
}
__device__ __forceinline__ bool scan_first(int s) { return s < 4 ? (s <= 1) : (s <= 19); }
template <bool GDN> __device__ __forceinline__ void scan_finish(const Frame& F, int b, int h, int dir, int wq, int lr, int lq, int s, float* PEND, const f32x4 (&Oin)[4], const ScanFin& f, const float (&nwv)[4]) {
    const int cidx = dir ? (s < 4 ? 3 - s : 39 - s) : s; const int row0 = chunk_row0(b, cidx);
    float* pp = PEND + (size_t)((b * 4 + h) * 36 + cidx) * 4096 + (wq * 256 + lq * 16 + lr) * 4;
    if (scan_first(s)) {
#pragma unroll
        for (int t = 0; t < 4; ++t) *(f32x4*)(pp + t * 256) = Oin[t];
    } else {
        f32x4 O[4]; float ss[4] = {0.f, 0.f, 0.f, 0.f};
#pragma unroll
        for (int t = 0; t < 4; ++t)
#pragma unroll
            for (int i = 0; i < 4; ++i) { O[t][i] = Oin[t][i] + f.pend[t][i]; ss[i] += O[t][i] * O[t][i]; }
#pragma unroll
        for (int i = 0; i < 4; ++i) ss[i] = frsq(row16_sum(ss[i]) * (1.f / 64.f) + EPS);
#pragma unroll
        for (int t = 0; t < 4; ++t) { const int dv = 16 * t + lr;
#pragma unroll
            for (int i = 0; i < 4; ++i) { const int row = row0 + 16 * wq + 4 * lq + i;
                const float g = bf2f(f.gz[t][i]);
                const float gate = GDN ? siluf_(g) : sigmoidf_(g);
                F.MIX[(size_t)row * 1024 + (GDN ? 0 : 768) + h * 64 + dv] = (bf16_t)f2bf(O[t][i] * ss[i] * nwv[t] * gate); } }
    }
}
template <bool GDN> __device__ __forceinline__ void scan_wg(const Frame& F, int l, int bh, bool nofin = false) {
    constexpr int NT = GDN ? 4 : 5;
    const int b = bh >> 2, h = bh & 3;
    const int lane = fresh_lane(), dir = F.wave >> 2, wq = F.wave & 3, lr = lane & 15, lq = lane >> 4;
    LAS bf16_t* St = (LAS bf16_t*)F.lds;
    f32x4 S[NT];
#pragma unroll
    for (int t = 0; t < NT; ++t) S[t] = (f32x4){0.f, 0.f, 0.f, 0.f};
    const float* nw = GDN ? F.gdn_norm_w + l * 64 : F.mlstm_norm_w + l * 256 + h * 64;
    float nwv[4];
#pragma unroll
    for (int t = 0; t < 4; ++t) nwv[t] = nw[16 * t + lr];
    float* PEND = F.PEND + (GDN ? (size_t)0 : (size_t)1152 * 4096);
    ScanOps<NT> cur, nxt; ScanFin fcur, fprev;
    f32x4 Oprev[4];
#pragma unroll
    for (int t = 0; t < 4; ++t) { Oprev[t] = (f32x4){0.f, 0.f, 0.f, 0.f}; fcur.pend[t] = (f32x4){0.f, 0.f, 0.f, 0.f}; fprev.pend[t] = (f32x4){0.f, 0.f, 0.f, 0.f};
#pragma unroll
        for (int i = 0; i < 4; ++i) { fcur.gz[t][i] = 0; fprev.gz[t][i] = 0; } }
    scan_load<GDN, NT>(F, b, h, dir, wq, lr, lq, 0, cur);
#pragma unroll 1
    for (int s = 0; s < 37; ++s) {
        LAS bf16_t* Sb = St + ((dir * 2 + (s & 1)) * 80) * 72;
        if (s < 36) {
#pragma unroll
            for (int t = 0; t < NT; ++t) *(LAS v2u*)(Sb + (16 * t + lr) * 72 + 16 * wq + 4 * lq) = pack4(S[t]); }
        VM_WAIT();
        __syncthreads();
        if (s > 0) {
            const int sp = s - 1;
            if (sp == 20 || sp == 2) scan_fin_load<GDN>(F, b, h, dir, wq, lr, lq, sp, PEND, fprev);
            if (!nofin) scan_finish<GDN>(F, b, h, dir, wq, lr, lq, sp, PEND, Oprev, fprev, nwv);
        }
        if (s == 36) break;
        scan_load<GDN, NT>(F, b, h, dir, wq, lr, lq, s < 35 ? s + 1 : 35, nxt);
        if (!scan_first(s) && s != 20 && s != 2) scan_fin_load<GDN>(F, b, h, dir, wq, lr, lq, s, PEND, fcur);
        f32x4 O[NT];
#pragma unroll
        for (int t = 0; t < NT; ++t) {
            const LAS bf16_t* sp = Sb + (16 * t + lr) * 72 + 8 * lq;
            const bf16x8 s0 = *(const LAS bf16x8*)sp, s1 = *(const LAS bf16x8*)(sp + 32);
            f32x4 o = {0.f, 0.f, 0.f, 0.f};
            o = __builtin_amdgcn_mfma_f32_16x16x32_bf16(cur.Qf[0], s0, o, 0, 0, 0); o = __builtin_amdgcn_mfma_f32_16x16x32_bf16(cur.Qf[1], s1, o, 0, 0, 0);
            const f32x4 bv = unpack4(cur.bv[t]), ov = unpack4(cur.ov[t]);
            if (GDN) {
                f32x4 ms = {0.f, 0.f, 0.f, 0.f};
                ms = __builtin_amdgcn_mfma_f32_16x16x32_bf16(cur.Mf[0], s0, ms, 0, 0, 0); ms = __builtin_amdgcn_mfma_f32_16x16x32_bf16(cur.Mf[1], s1, ms, 0, 0, 0);
                S[t] = S[t] * cur.gl - ms + bv; O[t] = o + ov;
            } else { S[t] = S[t] * cur.gl + bv; O[t] = o * cur.wi + ov; }
        }
        if (!GDN) {
#pragma unroll
            for (int i = 0; i < 4; ++i) { const float den = row16_bcast<0>(O[NT - 1][i]), fl = row16_bcast<1>(O[NT - 1][i]); const float dv = frcp(fmaxf(fabsf(den), fl));
#pragma unroll
                for (int t = 0; t < 4; ++t) O[t][i] *= dv; }
        }
#pragma unroll
        for (int t = 0; t < 4; ++t) Oprev[t] = O[t];
        fprev = fcur; cur = nxt;
    }
    VM_WAIT();
    __syncthreads();
}

__device__ __forceinline__ void swa_unit(const Frame& F, int l, int it) {
    const bool lat = it < 256; int b, kvh, qb;
    if (lat) { b = it >> 5; kvh = (it >> 4) & 1; qb = it & 15; } else { const int j = it - 256; b = j >> 2; kvh = (j >> 1) & 1; qb = j & 1; }
    const int t_o = F.wave * 64 + fresh_lane();
    const int t = t_o, lane = t & 63, w = __builtin_amdgcn_readfirstlane(t >> 6), lr = lane & 15, lq = lane >> 4;
    const int hq = kvh * 2 + (w >> 2), wrow = (w & 3) * 32;
    const int qrow = (lat ? b * SEQ : MLAT + b * CTXL) + qb * 128 + wrow;
    LAS bf16_t* Ksh = (LAS bf16_t*)F.lds; LAS bf16_t* Vt = Ksh + 4608; LAS bf16_t* Pw = Ksh + 9216 + w * 2304;
    bf16x8 Qf[2][2];
#pragma unroll
    for (int mt = 0; mt < 2; ++mt)
#pragma unroll
        for (int ks = 0; ks < 2; ++ks) Qf[mt][ks] = *(const bf16x8*)(F.Z + (size_t)(qrow + mt * 16 + lr) * ZW + ZC_SQ + hq * 64 + 32 * ks + 8 * lq);
    const float sk = F.sink[l * 4 + hq];
    float mi[2][4], li[2][4]; f32x4 O[2][4];
#pragma unroll
    for (int mt = 0; mt < 2; ++mt)
#pragma unroll
        for (int i = 0; i < 4; ++i) { mi[mt][i] = sk; li[mt][i] = 1.f; O[mt][i] = (f32x4){0.f, 0.f, 0.f, 0.f}; }
    const int lo = lat ? (qb == 0 ? 2 : 0) : 0, nloc = lat ? ((qb == 15 ? 4 : 6) - lo) : 0, ntile = nloc + 4;
    const int sr = t >> 3, sseg = t & 7;
    v4u kreg, vreg;
    { const int krow0 = nloc > 0 ? b * SEQ + (qb - 1) * 128 + lo * 64 : MLAT + b * CTXL;
      const bf16_t* zr = F.Z + (size_t)(krow0 + sr) * ZW + kvh * 64 + sseg * 8; kreg = *(const v4u*)(zr + ZC_SK); vreg = *(const v4u*)(zr + ZC_SV); }
#pragma unroll 1
    for (int j = 0; j < ntile; ++j) {
        const bool masked = j < nloc; const int kpos0 = (qb - 1) * 128 + (lo + j) * 64;
        __syncthreads();
        { *(LAS v4u*)(Ksh + sr * 72 + sseg * 8) = kreg;
          Vt[(sseg * 8 + 0) * 72 + sr] = (bf16_t)(vreg.x & 0xffffu); Vt[(sseg * 8 + 1) * 72 + sr] = (bf16_t)(vreg.x >> 16);
          Vt[(sseg * 8 + 2) * 72 + sr] = (bf16_t)(vreg.y & 0xffffu); Vt[(sseg * 8 + 3) * 72 + sr] = (bf16_t)(vreg.y >> 16);
          Vt[(sseg * 8 + 4) * 72 + sr] = (bf16_t)(vreg.z & 0xffffu); Vt[(sseg * 8 + 5) * 72 + sr] = (bf16_t)(vreg.z >> 16);
          Vt[(sseg * 8 + 6) * 72 + sr] = (bf16_t)(vreg.w & 0xffffu); Vt[(sseg * 8 + 7) * 72 + sr] = (bf16_t)(vreg.w >> 16); }
        if (j + 1 < ntile) { const int jn = j + 1; const int krown = jn < nloc ? b * SEQ + (qb - 1) * 128 + (lo + jn) * 64 : MLAT + b * CTXL + (jn - nloc) * 64;
            const bf16_t* zr = F.Z + (size_t)(krown + sr) * ZW + kvh * 64 + sseg * 8; kreg = *(const v4u*)(zr + ZC_SK); vreg = *(const v4u*)(zr + ZC_SV); }
        __syncthreads();
        f32x4 sc[2][4];
#pragma unroll
        for (int nt = 0; nt < 4; ++nt) { const LAS bf16_t* kp = Ksh + (nt * 16 + lr) * 72 + 8 * lq; const bf16x8 k0 = *(const LAS bf16x8*)kp, k1 = *(const LAS bf16x8*)(kp + 32);
#pragma unroll
            for (int mt = 0; mt < 2; ++mt) { f32x4 a = {0.f, 0.f, 0.f, 0.f};
                a = __builtin_amdgcn_mfma_f32_16x16x32_bf16(Qf[mt][0], k0, a, 0, 0, 0); a = __builtin_amdgcn_mfma_f32_16x16x32_bf16(Qf[mt][1], k1, a, 0, 0, 0); sc[mt][nt] = a; } }
#pragma unroll
        for (int mt = 0; mt < 2; ++mt) {
            float mx[4] = {-1e30f, -1e30f, -1e30f, -1e30f};
#pragma unroll
            for (int nt = 0; nt < 4; ++nt)
#pragma unroll
                for (int i = 0; i < 4; ++i) {
                    if (masked) { const int qpos = qb * 128 + wrow + mt * 16 + 4 * lq + i, kpos = kpos0 + nt * 16 + lr; const int dd = qpos - kpos; if (dd > 128 || dd < -128) sc[mt][nt][i] = -1e30f; }
                    mx[i] = fmaxf(mx[i], sc[mt][nt][i]); }
#pragma unroll
            for (int i = 0; i < 4; ++i) mx[i] = row16_max(mx[i]);
            float al[4], rsum[4];
#pragma unroll
            for (int i = 0; i < 4; ++i) { const float mn = fmaxf(mi[mt][i], mx[i]); al[i] = fexp(mi[mt][i] - mn); mi[mt][i] = mn; rsum[i] = 0.f; }
#pragma unroll
            for (int nt = 0; nt < 4; ++nt)
#pragma unroll
                for (int i = 0; i < 4; ++i) { const float p = fexp(sc[mt][nt][i] - mi[mt][i]); rsum[i] += p; Pw[(mt * 16 + 4 * lq + i) * 72 + nt * 16 + lr] = (bf16_t)f2bf(p); }
#pragma unroll
            for (int i = 0; i < 4; ++i) li[mt][i] = li[mt][i] * al[i] + row16_sum(rsum[i]);
#pragma unroll
            for (int nt = 0; nt < 4; ++nt)
#pragma unroll
                for (int i = 0; i < 4; ++i) O[mt][nt][i] *= al[i];
        }
        LDS_WAIT(); asm volatile("" ::: "memory");
#pragma unroll
        for (int nt = 0; nt < 4; ++nt) { const LAS bf16_t* vp = Vt + (nt * 16 + lr) * 72 + 8 * lq; const bf16x8 v0 = *(const LAS bf16x8*)vp, v1 = *(const LAS bf16x8*)(vp + 32);
#pragma unroll
            for (int mt = 0; mt < 2; ++mt) { const LAS bf16_t* pp = Pw + (mt * 16 + lr) * 72 + 8 * lq; const bf16x8 p0 = *(const LAS bf16x8*)pp, p1 = *(const LAS bf16x8*)(pp + 32);
                O[mt][nt] = __builtin_amdgcn_mfma_f32_16x16x32_bf16(p0, v0, O[mt][nt], 0, 0, 0); O[mt][nt] = __builtin_amdgcn_mfma_f32_16x16x32_bf16(p1, v1, O[mt][nt], 0, 0, 0); } }
    }
#pragma unroll
    for (int mt = 0; mt < 2; ++mt)
#pragma unroll
        for (int i = 0; i < 4; ++i) { const float inv = frcp(li[mt][i]); bf16_t* orow = F.MIX + (size_t)(qrow + mt * 16 + 4 * lq + i) * 1024 + 256 + hq * 64 + lr;
#pragma unroll
            for (int nt = 0; nt < 4; ++nt) orow[nt * 16] = (bf16_t)f2bf(O[mt][nt][i] * inv); }
    __syncthreads();
}

__device__ __forceinline__ void gmlp_unit(const Frame& F, int l, int it) {
    const int b = it / 72, c = (it >> 2) % 18, g = it & 3;
    const int r0 = c < 16 ? b * SEQ + c * 128 : MLAT + b * CTXL + (c - 16) * 128;
    const int t_o = F.wave * 64 + fresh_lane();
    const int t = t_o, lane = t & 63, w = __builtin_amdgcn_readfirstlane(t >> 6), lr = lane & 15, lq = lane >> 4;
    LAS bf16_t* Vt = (LAS bf16_t*)F.lds;
#pragma unroll
    for (int j = 0; j < 2; ++j) { const int idx = t + 512 * j, q = idx >> 3, seg = idx & 7;
        const v4u v = *(const v4u*)(F.Z + (size_t)(r0 + q) * ZW + ZC_MV + g * 64 + seg * 8);
        Vt[(seg * 8 + 0) * 136 + q] = (bf16_t)(v.x & 0xffffu); Vt[(seg * 8 + 1) * 136 + q] = (bf16_t)(v.x >> 16);
        Vt[(seg * 8 + 2) * 136 + q] = (bf16_t)(v.y & 0xffffu); Vt[(seg * 8 + 3) * 136 + q] = (bf16_t)(v.y >> 16);
        Vt[(seg * 8 + 4) * 136 + q] = (bf16_t)(v.z & 0xffffu); Vt[(seg * 8 + 5) * 136 + q] = (bf16_t)(v.z >> 16);
        Vt[(seg * 8 + 6) * 136 + q] = (bf16_t)(v.w & 0xffffu); Vt[(seg * 8 + 7) * 136 + q] = (bf16_t)(v.w >> 16); }
    __syncthreads();
    bf16x8 Af[4];
#pragma unroll
    for (int ks = 0; ks < 4; ++ks) Af[ks] = *(const bf16x8*)(F.WSP + (size_t)g * 16384 + (16 * w + lr) * 128 + 32 * ks + 8 * lq);
    f32x4 bsv = *(const f32x4*)(F.b_s + (size_t)(l * 4 + g) * 128 + 16 * w + 4 * lq);
    unsigned short uraw[4][4];
#pragma unroll
    for (int nt = 0; nt < 4; ++nt)
#pragma unroll
        for (int i = 0; i < 4; ++i) uraw[nt][i] = F.Z[(size_t)(r0 + 16 * w + 4 * lq + i) * ZW + ZC_MU + g * 64 + nt * 16 + lr];
    f32x4 accs[4];
#pragma unroll
    for (int nt = 0; nt < 4; ++nt) { f32x4 acc = {0.f, 0.f, 0.f, 0.f};
#pragma unroll
        for (int ks = 0; ks < 4; ++ks) { const bf16x8 bfr = *(const LAS bf16x8*)(Vt + (nt * 16 + lr) * 136 + 32 * ks + 8 * lq); acc = __builtin_amdgcn_mfma_f32_16x16x32_bf16(Af[ks], bfr, acc, 0, 0, 0); }
        accs[nt] = acc; }
#pragma unroll
    for (int nt = 0; nt < 4; ++nt)
#pragma unroll
        for (int i = 0; i < 4; ++i) { const int row = r0 + 16 * w + 4 * lq + i, col = g * 64 + nt * 16 + lr;
            F.MIX[(size_t)row * 1024 + 512 + col] = (bf16_t)f2bf(bf2f(uraw[nt][i]) * (accs[nt][i] + bsv[i])); }
    __syncthreads();
}

#ifndef PROBE_KIND
#define PROBE_KIND -1
#endif
#ifndef ONLY_CASE
#define ONLY_CASE -1
#endif
struct Args { const float* in[24]; float* out; unsigned char* ws; int ph_lo, ph_hi; };
constexpr int NPH = 2 + 9 * DEPTH;
__global__ void __launch_bounds__(NWAVES * 64, 2) mk_fwd(Args args) {
    extern __shared__ __attribute__((aligned(16))) unsigned char lds[];
    const int wave_s = __builtin_amdgcn_readfirstlane((int)threadIdx.x >> 6);
    const int tid_ = wave_s * 64 + fresh_lane();
    volatile LAS unsigned* MISC = (volatile LAS unsigned*)((LAS unsigned char*)lds + MISC_OFF);
    if (tid_ < 32) MISC[tid_] = 0u;
    __syncthreads();
    unsigned* barw = (unsigned*)(args.ws + WS_CTL) + CW_BAR;
    XcdBarrier bar; bar.bar = barw; bar.x = 0; bar.st = nullptr;
    const int lo = args.ph_lo, hi = args.ph_hi;
    if (hi - lo > 1) bar = xcd_barrier_post(barw, MISC + 8, tid_);

#pragma unroll 1
    for (int ph = lo; ph < hi; ++ph) {
        int zero; asm volatile("s_mov_b32 %0, 0" : "=s"(zero));
        Frame F;
        F.lds = (LAS unsigned char*)lds;
        F.wave = wave_s;
        F.G = gridDim.x; F.gw = blockIdx.x * NWAVES + F.wave; F.NGW = F.G * NWAVES;
        const float* const* inp = args.in + zero;
        F.x = inp[0]; F.c = inp[1]; F.ctx = inp[2]; F.cctx = inp[3]; F.ada_w = inp[4]; F.ada_b = inp[5]; F.norm1_w = inp[6]; F.norm2_w = inp[7];
        F.w_in = inp[8]; F.w_out = inp[9]; F.conv_w = inp[10]; F.a_log = inp[11]; F.dt_bias = inp[12]; F.gdn_norm_w = inp[13]; F.sink = inp[14];
        F.w_s = inp[15]; F.b_s = inp[16]; F.gmlp_norm_w = inp[17]; F.ig_bias = inp[18]; F.fg_bias = inp[19]; F.mlstm_norm_w = inp[20];
        F.w1 = inp[21]; F.w2 = inp[22]; F.final_w = inp[23];
        unsigned char* ws = args.ws + zero;
        F.out = args.out + zero; F.ws = ws;
        F.MOD = (float*)(ws + WS_MOD); F.XC = (float*)(ws + WS_XC); F.CHS = (float*)(ws + WS_CHS); F.GLG = (float*)(ws + WS_GLG); F.GLM = F.GLG + 2304; F.WI = F.GLG + 4608;
        F.PEND = (float*)(ws + WS_H); F.SLAB = (float*)(ws + WS_SLAB);
        F.H = (bf16_t*)(ws + WS_H); F.MIX = (bf16_t*)(ws + WS_MIX); F.Z = (bf16_t*)(ws + WS_Z); F.PG = (bf16_t*)(ws + WS_PG); F.PM = (bf16_t*)(ws + WS_PM); F.HID = (bf16_t*)(ws + WS_HID);
        int kind, l;
        if (ph == 0) { kind = 0; l = 0; } else if (ph == NPH - 1) { kind = 10; l = DEPTH - 1; } else { l = (ph - 1) / 9; kind = 1 + (ph - 1) % 9; }
        const bool last = (l == DEPTH - 1);
        { unsigned char* wb = ws + (size_t)(l & 1) * WSET_STRIDE;
          F.WIN = (bf16_t*)(wb + WS_WIN); F.WOUT = (bf16_t*)(wb + WS_WOUT); F.W1 = (bf16_t*)(wb + WS_W1); F.W2 = (bf16_t*)(wb + WS_W2); F.WSP = (bf16_t*)(wb + WS_WSP); }
        const int Mrows = last ? MLAT : MALL;
        const int nrep = (kind == PROBE_KIND) ? 2 : 1;
#pragma unroll 1
        for (int rep = 0; rep < nrep; ++rep) {
        if (rep) xcd_barrier(bar, wave_s * 64 + fresh_lane());
        switch (kind) {
        case 0: if (ONLY_CASE >= 0 && ONLY_CASE != 0) break; phase_mod(F); break;
        case 1: if (ONLY_CASE >= 0 && ONLY_CASE != 1) break; convert_weights(F, l, F.gw, F.NGW); phase_norm(F, l, 0, MALL, (l > 0 && !rep) ? NSPLIT_2 : 0, F.MOD + (size_t)((l > 0 ? l - 1 : 0) * 9 + 8) * 6144 + 5 * 1024); break;
        case 2: if (ONLY_CASE >= 0 && ONLY_CASE != 2) break; { pg8::Gemm g{F.H, F.WIN, MALL, ZW, D, D, D}; pg8::StaticOrder S; S.init(MALL, ZW, D, F.G, (int)blockIdx.x);
                  pg8::EpiBf16<0> E{F.Z, ZW}; pg8::gemm_phase<pg8::EpiBf16<0>, pg8::StaticOrder, true, true, true>(F.lds, g, S, E, wave_s * 64 + fresh_lane()); } break;
        case 3: if (ONLY_CASE >= 0 && ONLY_CASE != 3) break; for (int rg = blockIdx.x; rg < MALL / 16 + 288; rg += F.G) { if (rg < MALL / 16) ew_unit(F, l, rg); else chs_unit(F, l, rg - MALL / 16); } break;
        case 4: if (ONLY_CASE >= 0 && ONLY_CASE != 4) break; for (int it = blockIdx.x; it < 2304; it += F.G) { if (it < 1152) { if (!rep) gdn_prep_unit(F, l, it); else if (PROBE_SUB != 2) gdn_prep_unit(F, l, it, PROBE_SUB >= 10 ? PROBE_SUB - 10 : 99, (bf16_t*)(F.ws + WS_H)); } else { if (!rep || PROBE_SUB != 1) mlstm_prep_unit(F, l, it - 1152); } } break;
        case 5: if (ONLY_CASE >= 0 && ONLY_CASE != 5) break; { const int bx = blockIdx.x;
                  if (bx < 32) { if (!rep || PROBE_SUB == 0 || PROBE_SUB == 1 || PROBE_SUB == 5) scan_wg<true>(F, l, bx, rep && PROBE_SUB == 5); }
                  else if (bx < 64) { if (!rep || PROBE_SUB == 0 || PROBE_SUB == 1 || PROBE_SUB == 4 || PROBE_SUB == 5) scan_wg<false>(F, l, bx - 32, rep && PROBE_SUB == 5); }
                  else for (int it = bx - 64; it < 288 + 576; it += F.G - 64) { if (it < 288) { if (!rep || PROBE_SUB == 0 || PROBE_SUB == 2) swa_unit(F, l, it); } else { if (!rep || PROBE_SUB == 0 || PROBE_SUB == 3) gmlp_unit(F, l, it - 288); } } } break;
        case 6: case 9: { if (ONLY_CASE >= 0 && ONLY_CASE != 6) break; const bool isout = (kind == 6);
                  const int Kd = isout ? D : FF;
                  pg8::Gemm g{isout ? F.MIX : F.HID, isout ? F.WOUT : F.W2, MLAT, D, Kd, Kd, Kd}; pg8::StaticOrder S; S.init(MLAT, D, Kd, F.G, (int)blockIdx.x);
                  if (!last) S.add_split(MCTX / 256, isout ? NSPLIT_OUT : NSPLIT_2, Kd);
                  pg8::EpiResid E{rep ? (float*)(F.ws + WS_H) : F.out, rep ? (float*)(F.ws + WS_H) + (size_t)MLAT * 1024 : F.XC, F.MOD + (size_t)l * 9 * 6144 + (isout ? 2 : 5) * 1024, (float*)(F.ws + WS_SLAB)};
                  pg8::gemm_phase<pg8::EpiResid, pg8::StaticOrder, true, true>(F.lds, g, S, E, wave_s * 64 + fresh_lane()); } break;
        case 7: if (ONLY_CASE >= 0 && ONLY_CASE != 7) break; phase_norm(F, l, 1, Mrows, (!last && !rep) ? NSPLIT_OUT : 0, F.MOD + (size_t)(l * 9 + 8) * 6144 + 2 * 1024); break;
        case 8: if (ONLY_CASE >= 0 && ONLY_CASE != 8) break; { pg8::Gemm g{F.H, F.W1, Mrows, FF, D, D, D}; pg8::StaticOrder S; S.init(Mrows, FF, D, F.G, (int)blockIdx.x);
                  pg8::EpiBf16<1> E{F.HID, FF}; pg8::gemm_phase<pg8::EpiBf16<1>, pg8::StaticOrder, true, true, true>(F.lds, g, S, E, wave_s * 64 + fresh_lane()); } break;
        default: { const bool poison = (hi - lo > 1) && (__hip_atomic_load(barw + XB_TMO, __ATOMIC_RELAXED, __HIP_MEMORY_SCOPE_AGENT) != 0u); phase_final(F, poison); } break;
        }
        }
        if (ph + 1 < hi) xcd_barrier(bar, wave_s * 64 + fresh_lane());
    }
}

extern "C" void kernel_launch(void* const* d_in, const int* in_sizes, int n_in, void* d_out, int out_size, void* d_ws, size_t ws_size, hipStream_t stream) {
    static int grid = 0;
    if (grid == 0) {
        if (n_in != 24 || out_size != MLAT * D || ws_size < WS_END) { fprintf(stderr, "kernel_launch: unexpected shapes: n_in %d out %d ws %zu (need %zu)\n", n_in, out_size, ws_size, (size_t)WS_END); grid = -1; return; }
        int dev = 0, cus = 0, per_cu = 0;
        if (hipGetDevice(&dev) != hipSuccess || hipDeviceGetAttribute(&cus, hipDeviceAttributeMultiprocessorCount, dev) != hipSuccess) { grid = -1; return; }
        if (hipFuncSetAttribute((const void*)mk_fwd, hipFuncAttributeMaxDynamicSharedMemorySize, LDS_BYTES) != hipSuccess) { fprintf(stderr, "kernel_launch: hipFuncSetAttribute failed\n"); grid = -1; return; }
        if (hipOccupancyMaxActiveBlocksPerMultiprocessor(&per_cu, (const void*)mk_fwd, NWAVES * 64, LDS_BYTES) != hipSuccess || per_cu < 1) { fprintf(stderr, "kernel_launch: occupancy query says %d\n", per_cu); grid = -1; return; }
        (void)hipGetLastError();
        grid = cus;
        if (grid < 128) { fprintf(stderr, "kernel_launch: device too small (%d CUs)\n", grid); grid = -1; return; }
    }
    if (grid < 0) return;
    (void)hipMemsetAsync((char*)d_ws + WS_CTL, 0, CTL_ZERO_BYTES, stream);
    Args a{};
    for (int i = 0; i < 24; ++i) a.in[i] = (const float*)d_in[i];
    a.out = (float*)d_out; a.ws = (unsigned char*)d_ws;
#if MK_PER_PHASE
    for (int p = 0; p < NPH; ++p) { a.ph_lo = p; a.ph_hi = p + 1; hipLaunchKernelGGL(mk_fwd, dim3(grid), dim3(NWAVES * 64), LDS_BYTES, stream, a); }
#else
    a.ph_lo = 0; a.ph_hi = NPH;
    void* kargs[] = {&a};
    hipError_t e = hipLaunchCooperativeKernel((const void*)mk_fwd, dim3(grid), dim3(NWAVES * 64), kargs, LDS_BYTES, stream);
    if (e != hipSuccess) fprintf(stderr, "kernel_launch: cooperative launch failed: %s (grid %d)\n", hipGetErrorString(e), grid);
#endif
}
```

```cpp
#include <hip/hip_runtime.h>
#include <cstdio>
#include <cstdint>
#ifndef MK_PER_PHASE
#define MK_PER_PHASE 0
#endif
#define PROBE_KIND -1
#define PROBE_SUB 0
namespace pg8 {
#define PG8_LAS __attribute__((address_space(3)))
typedef unsigned short bf16_t;
typedef short bf16x8 __attribute__((ext_vector_type(8)));
typedef float f32x4 __attribute__((ext_vector_type(4)));
typedef unsigned u32x4 __attribute__((ext_vector_type(4)));
constexpr int BM = 256, BK = 64, HALF = 128, HTB = HALF * BK * 2  , STAGE_BYTES = 8 * HTB, NXCD = 8, WGM = 8;

__host__ __device__ __forceinline__ int lds_byte(int r, int c) { const int st = (r >> 4) * 2 + (c >> 5), rr = r & 15, cc = c & 31, ob = rr * 64 + cc * 2; return st * 1024 + (ob ^ (((ob >> 9) & 1) << 5)); }
__host__ __device__ __forceinline__ void stage_rc(int b, int& R, int& C) { const int st = b / 1024, sb = b % 1024, swz = sb ^ (((sb >> 9) & 1) << 5); R = (st >> 1) * 16 + swz / 64; C = (st & 1) * 32 + (swz % 64) / 2; }
__host__ __device__ __forceinline__ int perm32(int rho) { const int n = rho >> 4, i = rho & 15; return 8 * (i >> 2) + 4 * n + (i & 3); }

struct Unit { int pm, pn, kofs, nt, slab; };
struct Gemm { const bf16_t* A; const bf16_t* Bt; int M, N, K, lda, ldb; };

struct StaticOrder {
    int nM, nN, nwg, G, c, ntk, nsp, nsplit, kslice, pm0;
    __host__ __device__ void init(int M, int N, int K, int G_, int c_) { nM = M / BM; nN = N / BM; nwg = nM * nN; G = G_; c = c_; ntk = K / BK; nsp = 0; nsplit = 1; kslice = K; pm0 = nM; }
    __host__ __device__ void add_split(int npanels, int nsplit_, int K) { nsplit = nsplit_; kslice = K / nsplit_; nsp = npanels * nN * nsplit_; }
    __host__ __device__ void map(long L, Unit& u) const {
        int wgid = (int)L; { const int q = nwg / NXCD, r = nwg % NXCD, xcd = wgid % NXCD, off = wgid / NXCD; wgid = (xcd < r ? xcd * (q + 1) : r * (q + 1) + (xcd - r) * q) + off; }
        const int nig = WGM * nN, gid = wgid / nig, fm = gid * WGM, gsz = (nM - fm) < WGM ? (nM - fm) : WGM;
        u.pm = fm + ((wgid % nig) % gsz); u.pn = (wgid % nig) / gsz; u.kofs = 0; u.nt = ntk; u.slab = 0;
    }
    __host__ __device__ bool next(int i, Unit& u) const {
        const long L = (long)i * G + c;
        if (L < nwg) { map(L, u); return true; }
        const long J = L - nwg; if (J >= nsp) return false;
        const int ks = (int)(J % nsplit), tile = (int)(J / nsplit);
        u.pn = tile % nN; u.pm = pm0 + tile / nN; u.kofs = ks * kslice; u.nt = kslice / BK; u.slab = ks + 1; return true;
    }
    __device__ __forceinline__ void a_ready(const Unit&) const {}
    __device__ __forceinline__ void done(const Unit&) const {}
};

__device__ __forceinline__ unsigned cvt_pk_bf16(float lo, float hi) { unsigned r; asm volatile("v_cvt_pk_bf16_f32 %0, %1, %2" : "=v"(r) : "v"(lo), "v"(hi)); return r; }

template <int ACT  > struct EpiBf16 {
    static constexpr bool PERM = true, AFTER_DRAIN = false;
    bf16_t* O; int ldc;
    __device__ __forceinline__ void operator()(const f32x4 (&acc)[2][2][4][2], const Unit& u, int wr, int wc, int fr, int fq) const {
        const int row0 = u.pm * BM + wr * 64 + fr; const int col0 = u.pn * BM + wc * 32 + 8 * fq;
#pragma unroll
        for (int ai = 0; ai < 2; ++ai)
#pragma unroll
            for (int m = 0; m < 4; ++m) { bf16_t* rowp = O + (size_t)(row0 + ai * HALF + m * 16) * ldc + col0;
#pragma unroll
                for (int bj = 0; bj < 2; ++bj) { f32x4 v0 = acc[ai][bj][m][0], v1 = acc[ai][bj][m][1];
                    if (ACT == 1) {
#pragma unroll
                        for (int e = 0; e < 4; ++e) { float a = fmaxf(v0[e], 0.f), b = fmaxf(v1[e], 0.f); v0[e] = a * a; v1[e] = b * b; } }
                    u32x4 w; w.x = cvt_pk_bf16(v0[0], v0[1]); w.y = cvt_pk_bf16(v0[2], v0[3]); w.z = cvt_pk_bf16(v1[0], v1[1]); w.w = cvt_pk_bf16(v1[2], v1[3]);
                    *(u32x4*)(rowp + bj * HALF) = w; } }
    }
};

struct EpiResid {
    static constexpr bool PERM = false, AFTER_DRAIN = false;
    float* xlat; float* xctx; const float* gmod; float* slab;
    __device__ __forceinline__ void operator()(const f32x4 (&acc)[2][2][4][2], const Unit& u, int wr, int wc, int fr, int fq) const {
        if (u.slab) {
            float* sb = slab + (size_t)(u.slab - 1) * 2048 * 1024 + (size_t)(u.pm - 64) * BM * 1024 + u.pn * BM + wc * 32 + 4 * fq;
#pragma unroll
            for (int ai = 0; ai < 2; ++ai)
#pragma unroll
                for (int m = 0; m < 4; ++m) { float* rowp = sb + (size_t)(ai * HALF + wr * 64 + m * 16 + fr) * 1024;
#pragma unroll
                    for (int bj = 0; bj < 2; ++bj)
#pragma unroll
                        for (int n = 0; n < 2; ++n) *(f32x4*)(rowp + bj * HALF + n * 16) = acc[ai][bj][m][n]; }
            return;
        }
        const int bm = u.pm < 64 ? (u.pm >> 3) : 8;
        float* base = u.pm < 64 ? xlat + (size_t)u.pm * BM * 1024 : xctx + (size_t)(u.pm - 64) * BM * 1024;
        const float* g = gmod + bm * 6144;
        const int col0 = u.pn * BM + wc * 32 + 4 * fq;
        f32x4 gv[2][2];
#pragma unroll
        for (int bj = 0; bj < 2; ++bj)
#pragma unroll
            for (int n = 0; n < 2; ++n) gv[bj][n] = *(const f32x4*)(g + col0 + bj * HALF + n * 16);
#pragma unroll
        for (int ai = 0; ai < 2; ++ai)
#pragma unroll
            for (int m = 0; m < 4; ++m) { float* rowp = base + (size_t)(ai * HALF + wr * 64 + m * 16 + fr) * 1024 + col0;
                f32x4 xv[2][2];
#pragma unroll
                for (int bj = 0; bj < 2; ++bj)
#pragma unroll
                    for (int n = 0; n < 2; ++n) xv[bj][n] = *(const f32x4*)(rowp + bj * HALF + n * 16);
#pragma unroll
                for (int bj = 0; bj < 2; ++bj)
#pragma unroll
                    for (int n = 0; n < 2; ++n) *(f32x4*)(rowp + bj * HALF + n * 16) = xv[bj][n] + gv[bj][n] * acc[ai][bj][m][n];
                if (m & 1) asm volatile("" ::: "memory"); }
    }
};

template <class Epi, class Sched, bool ALIGN_EPI = false, bool SP2 = false, bool UNIFORM_NT = false>
__device__ __forceinline__ void gemm_phase(PG8_LAS unsigned char* lds, const Gemm g, const Sched& S, const Epi& E, int tid_in) {
    int tid_o = tid_in; asm volatile("" : "+v"(tid_o)); const int tid = tid_o, wid = __builtin_amdgcn_readfirstlane(tid >> 6), lane = tid & 63, wr = wid >> 2, wc = wid & 3, fr = lane & 15, fq = lane >> 4;
    const int lda = g.lda, ldb = g.ldb; const int nt_uniform = g.K / BK;
    unsigned voffA[2], voffB[2];
#pragma unroll
    for (int i = 0; i < 2; ++i) { int R, C; stage_rc(tid * 16 + i * 8192, R, C); const int Rb = Epi::PERM ? ((R & ~31) + perm32(R & 31)) : R;
        voffA[i] = (unsigned)(R * lda + C) * 2u; voffB[i] = (unsigned)(Rb * ldb + C) * 2u; }
    const size_t kstep = (size_t)(BK * 2);
    const size_t hstepA = (size_t)HALF * lda * 2, hstepB = (size_t)HALF * ldb * 2;
    const size_t tstepA = 2 * hstepA, tstepB = 2 * hstepB;
    const unsigned ldsw = (unsigned)wid * 1024u;
    const int aoff = lds_byte(wr * 64 + fr, fq * 8), boff = lds_byte(wc * 32 + fr, fq * 8);
#define PG8_SA(b, h) (((b) * 2 + (h)) * HTB)
#define PG8_SB(b, h) ((4 + (b) * 2 + (h)) * HTB)
#define PG8_STAGE(bufoff, gbase, voff) do { _Pragma("unroll") for (int _i = 0; _i < 2; ++_i) \
        __builtin_amdgcn_global_load_lds((const unsigned*)((const char*)(gbase) + (voff)[_i]), (PG8_LAS unsigned*)(lds + (bufoff) + ldsw + _i * 8192), 16, 0, 0); } while (0)
#define PG8_LDA(dst, b, h) do { _Pragma("unroll") for (int m = 0; m < 4; ++m) _Pragma("unroll") for (int k = 0; k < 2; ++k) dst[m][k] = *(const PG8_LAS bf16x8*)(lds + PG8_SA(b, h) + aoff + m * 2048 + k * 1024); } while (0)
#define PG8_LDB(dst, b, h) do { _Pragma("unroll") for (int n = 0; n < 2; ++n) _Pragma("unroll") for (int k = 0; k < 2; ++k) dst[n][k] = *(const PG8_LAS bf16x8*)(lds + PG8_SB(b, h) + boff + n * 2048 + k * 1024); } while (0)
#define PG8_MMA(ai, bj, At, Bt) do { __builtin_amdgcn_s_setprio(1); _Pragma("unroll") for (int m = 0; m < 4; ++m) _Pragma("unroll") for (int n = 0; n < 2; ++n) _Pragma("unroll") for (int k = 0; k < 2; ++k) \
        acc[ai][bj][m][n] = __builtin_amdgcn_mfma_f32_16x16x32_bf16(Bt[n][k], At[m][k], acc[ai][bj][m][n], 0, 0, 0); __builtin_amdgcn_s_setprio(0); } while (0)
#define PG8_WAIT_V(n) asm volatile("s_waitcnt vmcnt(" #n ")" ::: "memory")
#define PG8_WAIT_L(n) asm volatile("s_waitcnt lgkmcnt(" #n ")" ::: "memory")
#define PG8_BAR __builtin_amdgcn_s_barrier()
#define PG8_SCHED __builtin_amdgcn_sched_barrier(0)
    Unit cur, nxt; int ui = 0;
    if (!S.next(0, cur)) return;
    f32x4 acc[2][2][4][2];
#pragma unroll
    for (int a = 0; a < 2; ++a)
#pragma unroll
        for (int b = 0; b < 2; ++b)
#pragma unroll
            for (int m = 0; m < 4; ++m)
#pragma unroll
                for (int n = 0; n < 2; ++n) acc[a][b][m][n] = (f32x4){0.f, 0.f, 0.f, 0.f};
    bf16x8 At[4][2], B0[2][2], B1[2][2];
    const char* cA = (const char*)g.A + (size_t)cur.pm * tstepA + (size_t)cur.kofs * 2; const char* cB = (const char*)g.Bt + (size_t)cur.pn * tstepB + (size_t)cur.kofs * 2;
    S.a_ready(cur);
    if constexpr (SP2) {
        PG8_STAGE(PG8_SB(0, 0), cB, voffB); PG8_STAGE(PG8_SB(0, 1), cB + hstepB, voffB); PG8_STAGE(PG8_SA(0, 0), cA, voffA); PG8_STAGE(PG8_SA(0, 1), cA + hstepA, voffA);
        if (wr == 1) PG8_BAR;
        PG8_WAIT_V(2); PG8_BAR;
        PG8_STAGE(PG8_SB(1, 0), cB + kstep, voffB); PG8_STAGE(PG8_SA(1, 0), cA + kstep, voffA); PG8_STAGE(PG8_SB(1, 1), cB + hstepB + kstep, voffB);
        PG8_WAIT_V(6); PG8_BAR;
    } else {
        PG8_STAGE(PG8_SB(0, 0), cB, voffB); PG8_STAGE(PG8_SA(0, 0), cA, voffA); PG8_STAGE(PG8_SB(0, 1), cB + hstepB, voffB); PG8_STAGE(PG8_SA(0, 1), cA + hstepA, voffA);
        if (wr == 1) PG8_BAR;
        PG8_WAIT_V(4); PG8_BAR;
        PG8_STAGE(PG8_SB(1, 0), cB + kstep, voffB); PG8_STAGE(PG8_SA(1, 0), cA + kstep, voffA); PG8_STAGE(PG8_SB(1, 1), cB + hstepB + kstep, voffB);
        PG8_WAIT_V(6); PG8_BAR;
    }
    for (;;) {
        const bool has_next = S.next(ui + 1, nxt);
        const char* nA = has_next ? (const char*)g.A + (size_t)nxt.pm * tstepA + (size_t)nxt.kofs * 2 : cA; const char* nB = has_next ? (const char*)g.Bt + (size_t)nxt.pn * tstepB + (size_t)nxt.kofs * 2 : cB;
        const int nt = UNIFORM_NT ? nt_uniform : cur.nt;
        for (int t = 0; t < nt; t += 2) {
            const bool last = (t == nt - 2);
            const char* a1 = cA + (size_t)(t + 1) * kstep;
            const char* a2 = last ? nA : cA + (size_t)(t + 2) * kstep; const char* b2 = last ? nB : cB + (size_t)(t + 2) * kstep;
            const char* a3 = a2 + kstep; const char* b3 = b2 + kstep;
            if (last && has_next) S.a_ready(nxt);
            if constexpr (SP2) {
            PG8_LDB(B0, 0, 0); PG8_LDB(B1, 0, 1); PG8_SCHED; PG8_LDA(At, 0, 0); PG8_STAGE(PG8_SA(1, 1), a1 + hstepA, voffA);
            PG8_WAIT_V(8); PG8_WAIT_L(0); PG8_BAR; PG8_MMA(0, 0, At, B0); PG8_MMA(0, 1, At, B1); PG8_BAR; PG8_SCHED;
            PG8_LDA(At, 0, 1); PG8_STAGE(PG8_SB(0, 0), b2, voffB); PG8_STAGE(PG8_SB(0, 1), b2 + hstepB, voffB); PG8_STAGE(PG8_SA(0, 0), a2, voffA);
            PG8_WAIT_V(8); PG8_WAIT_L(0); PG8_BAR; PG8_MMA(1, 0, At, B0); PG8_MMA(1, 1, At, B1); PG8_BAR; PG8_SCHED;
            PG8_LDB(B0, 1, 0); PG8_LDB(B1, 1, 1); PG8_SCHED; PG8_LDA(At, 1, 0); PG8_STAGE(PG8_SA(0, 1), a2 + hstepA, voffA);
            PG8_WAIT_V(8); PG8_WAIT_L(0); PG8_BAR; PG8_MMA(0, 0, At, B0); PG8_MMA(0, 1, At, B1); PG8_BAR; PG8_SCHED;
            PG8_LDA(At, 1, 1); PG8_STAGE(PG8_SB(1, 0), b3, voffB); PG8_STAGE(PG8_SB(1, 1), b3 + hstepB, voffB); PG8_STAGE(PG8_SA(1, 0), a3, voffA);
            PG8_WAIT_V(8); PG8_WAIT_L(0); PG8_BAR; PG8_MMA(1, 0, At, B0); PG8_MMA(1, 1, At, B1); PG8_BAR; PG8_SCHED;
            } else {
            PG8_LDB(B0, 0, 0); PG8_SCHED; PG8_LDA(At, 0, 0); PG8_STAGE(PG8_SA(1, 1), a1 + hstepA, voffA);
            PG8_WAIT_L(8); PG8_BAR; PG8_WAIT_L(0); PG8_MMA(0, 0, At, B0); PG8_BAR; PG8_SCHED;
            PG8_LDB(B1, 0, 1); PG8_STAGE(PG8_SB(0, 0), b2, voffB);
            PG8_BAR; PG8_WAIT_L(0); PG8_MMA(0, 1, At, B1); PG8_BAR;
            PG8_LDA(At, 0, 1); PG8_STAGE(PG8_SA(0, 0), a2, voffA);
            PG8_BAR; PG8_WAIT_L(0); PG8_MMA(1, 0, At, B0); PG8_BAR; PG8_SCHED;
            PG8_STAGE(PG8_SB(0, 1), b2 + hstepB, voffB);
            PG8_WAIT_V(6); PG8_BAR; PG8_MMA(1, 1, At, B1); PG8_BAR;
            PG8_LDB(B0, 1, 0); PG8_SCHED; PG8_LDA(At, 1, 0); PG8_STAGE(PG8_SA(0, 1), a2 + hstepA, voffA);
            PG8_WAIT_L(8); PG8_BAR; PG8_WAIT_L(0); PG8_MMA(0, 0, At, B0); PG8_BAR; PG8_SCHED;
            PG8_LDB(B1, 1, 1); PG8_STAGE(PG8_SB(1, 0), b3, voffB);
            PG8_BAR; PG8_WAIT_L(0); PG8_MMA(0, 1, At, B1); PG8_BAR;
            PG8_LDA(At, 1, 1); PG8_STAGE(PG8_SA(1, 0), a3, voffA);
            PG8_BAR; PG8_WAIT_L(0); PG8_MMA(1, 0, At, B0); PG8_BAR; PG8_SCHED;
            PG8_STAGE(PG8_SB(1, 1), b3 + hstepB, voffB);
            PG8_WAIT_V(6); PG8_BAR; PG8_MMA(1, 1, At, B1); PG8_BAR;
            }
        }
        if constexpr (ALIGN_EPI) { if (wr == 0) PG8_BAR; }
        if constexpr (!Epi::AFTER_DRAIN) { E(acc, cur, wr, wc, fr, fq); S.done(cur); }
        if (!has_next) break;
#pragma unroll
        for (int a = 0; a < 2; ++a)
#pragma unroll
            for (int b = 0; b < 2; ++b)
#pragma unroll
                for (int m = 0; m < 4; ++m)
#pragma unroll
                    for (int n = 0; n < 2; ++n) acc[a][b][m][n] = (f32x4){0.f, 0.f, 0.f, 0.f};
        cur = nxt; cA = nA; cB = nB; ++ui;
        if constexpr (ALIGN_EPI) { if (wr == 1) PG8_BAR; }
    }
    PG8_WAIT_V(0);
    if constexpr (!ALIGN_EPI) { if (wr == 0) PG8_BAR; }
    PG8_BAR;
    if constexpr (Epi::AFTER_DRAIN) { E.fused(acc, cur, wr, wc, fr, fq, lds, wid, lane); S.done(cur); }
#undef PG8_SA
#undef PG8_SB
#undef PG8_STAGE
#undef PG8_LDA
#undef PG8_LDB
#undef PG8_MMA
#undef PG8_WAIT_V
#undef PG8_WAIT_L
#undef PG8_BAR
#undef PG8_SCHED
}
}
constexpr int NWAVES = 8;
constexpr int NB = 8, SEQ = 2048, CTXL = 256, D = 1024, DEPTH = 4, FF = 4096;
constexpr int MLAT = NB * SEQ, MCTX = NB * CTXL, MALL = MLAT + MCTX;
constexpr int ZW = 3328;
constexpr int ZC_GQ = 0, ZC_GK = 256, ZC_GV = 512, ZC_GZ = 768, ZC_SQ = 1024, ZC_SK = 1280, ZC_SV = 1408, ZC_MU = 1536, ZC_MV = 1792,
              ZC_LQ = 2048, ZC_LK = 2304, ZC_LV = 2560, ZC_LO = 2816, ZC_GA = 3072, ZC_GB = 3080, ZC_LI = 3088, ZC_LF = 3096;
constexpr float EPS = 1e-6f;
constexpr size_t MiB = 1u << 20;
constexpr size_t WS_CTL = 0, CTL_ZERO_BYTES = 65536;
constexpr size_t WS_MOD = 1 * MiB;
constexpr size_t WS_WIN = 2 * MiB, WS_WOUT = 9 * MiB, WS_W1 = 11 * MiB, WS_W2 = 19 * MiB, WS_WSP = 27 * MiB;
constexpr size_t WS_CHS = 27 * MiB + 512 * 1024;
constexpr size_t WS_GLG = 27 * MiB + 768 * 1024;
constexpr size_t WS_XC = 29 * MiB;
constexpr size_t WS_H = 37 * MiB;
constexpr size_t WS_MIX = 73 * MiB;
constexpr size_t WS_Z = 109 * MiB;
constexpr size_t WS_PG = 226 * MiB;
constexpr size_t WS_PM = 298 * MiB;
constexpr size_t WS_HID = 109 * MiB;
constexpr size_t WS_SLAB = 254 * MiB;
constexpr size_t WS_WSET2 = 343 * MiB;
constexpr size_t WSET_STRIDE = WS_WSET2 - 2 * MiB;
constexpr size_t WS_END = 369 * MiB;
constexpr int NSPLIT_OUT = 2, NSPLIT_2 = 4;
constexpr int CW_BAR = 1024;
constexpr int LDS_BYTES = 147456;
constexpr int MISC_OFF = 131072 + 8192;

#define LAS __attribute__((address_space(3)))
typedef unsigned short bf16_t;
typedef unsigned v4u __attribute__((ext_vector_type(4)));
typedef unsigned v2u __attribute__((ext_vector_type(2)));
typedef float f32x4 __attribute__((ext_vector_type(4)));
typedef short bf16x8 __attribute__((ext_vector_type(8)));
#define LDS_WAIT() asm volatile("s_waitcnt lgkmcnt(0)" ::: "memory")
#define VM_WAIT() asm volatile("s_waitcnt vmcnt(0)" ::: "memory")
typedef float f32x2_ __attribute__((ext_vector_type(2)));
typedef __bf16 bf16x2_ __attribute__((ext_vector_type(2)));
__device__ __forceinline__ unsigned pk2(float lo, float hi) { const f32x2_ v = {lo, hi}; const bf16x2_ r = __builtin_convertvector(v, bf16x2_); return __builtin_bit_cast(unsigned, r); }
__device__ __forceinline__ unsigned f2bf(float f) { return pk2(f, 0.f) & 0xffffu; }
__device__ __forceinline__ float bf2f(unsigned v) { return __builtin_bit_cast(float, v << 16); }
__device__ __forceinline__ float bflo(unsigned w) { return __builtin_bit_cast(float, w << 16); }
__device__ __forceinline__ float bfhi(unsigned w) { return __builtin_bit_cast(float, w & 0xffff0000u); }
template <int CTRL> __device__ __forceinline__ float dppf(float x) { return __builtin_bit_cast(float, __builtin_amdgcn_update_dpp(0, __builtin_bit_cast(int, x), CTRL, 0xF, 0xF, true)); }
__device__ __forceinline__ float row16_sum(float v) { v += dppf<0xB1>(v); v += dppf<0x4E>(v); v += dppf<0x141>(v); v += dppf<0x140>(v); return v; }
__device__ __forceinline__ float row16_max(float v) { v = fmaxf(v, dppf<0xB1>(v)); v = fmaxf(v, dppf<0x4E>(v)); v = fmaxf(v, dppf<0x141>(v)); v = fmaxf(v, dppf<0x140>(v)); return v; }
__device__ __forceinline__ float quad_sum(float v) { v += dppf<0xB1>(v); v += dppf<0x4E>(v); return v; }
template <int N> __device__ __forceinline__ float row16_bcast(float v) { return dppf<0x150 + N>(v); }
__device__ __forceinline__ float wave_sum(float v) { v = row16_sum(v); v += __shfl_xor(v, 16); v += __shfl_xor(v, 32); return v; }
__device__ __forceinline__ float frcp(float x) { return __builtin_amdgcn_rcpf(x); }
__device__ __forceinline__ float frsq(float x) { return __builtin_amdgcn_rsqf(x); }
__device__ __forceinline__ float fexp(float x) { return __builtin_amdgcn_exp2f(x * 1.4426950408889634f); }
__device__ __forceinline__ float flog1p(float y) { return y < 0.02f ? y * (1.0f - y * (0.5f - y * (0.33333333f - 0.25f * y))) : __builtin_amdgcn_logf(1.0f + y) * 0.6931471805599453f; }
__device__ __forceinline__ float sigmoidf_(float x) { return frcp(1.f + fexp(-x)); }
__device__ __forceinline__ float siluf_(float x) { return x * frcp(1.f + fexp(-x)); }
__device__ __forceinline__ float softplusf_(float x) { return x > 20.f ? x : flog1p(fexp(x)); }
__device__ __forceinline__ float logsigf_(float x) { return x >= 0.f ? -flog1p(fexp(-x)) : x - flog1p(fexp(x)); }
__device__ __forceinline__ float geluf_(float x) { const float u = 0.7978845608028654f * (x + 0.044715f * x * x * x); const float th = 1.0f - 2.0f * frcp(1.0f + fexp(2.0f * u)); return 0.5f * x * (1.f + th); }
template <int KS> __device__ __forceinline__ f32x4 mma_ll(const LAS bf16_t* A, int lda, const LAS bf16_t* Bt, int ldb, f32x4 acc, int lane) {
    const LAS bf16_t* ap = A + (lane & 15) * lda + 8 * (lane >> 4);
    const LAS bf16_t* bp = Bt + (lane & 15) * ldb + 8 * (lane >> 4);
#pragma unroll
    for (int ks = 0; ks < KS; ++ks) {
        const bf16x8 a = *(const LAS bf16x8*)(ap + 32 * ks); const bf16x8 b = *(const LAS bf16x8*)(bp + 32 * ks);
        acc = __builtin_amdgcn_mfma_f32_16x16x32_bf16(a, b, acc, 0, 0, 0);
    }
    return acc;
}
__device__ __forceinline__ v2u pack4(const f32x4 v) { v2u r; r.x = pk2(v[0], v[1]); r.y = pk2(v[2], v[3]); return r; }
__device__ __forceinline__ f32x4 unpack4(const v2u w) { f32x4 r; r[0] = bflo(w.x); r[1] = bfhi(w.x); r[2] = bflo(w.y); r[3] = bfhi(w.y); return r; }
__device__ __forceinline__ int chunk_row0(int b, int cidx) { return cidx < 4 ? MLAT + b * CTXL + cidx * 64 : b * SEQ + (cidx - 4) * 64; }

#define XB_TMO      128
#define XB_XCNT(j)  (256  + 64 * (j))
#define XB_XSUB(j)  (1280 + 64 * (j))
#define XB_XGEN(j)  (2304 + 64 * (j))
#define XB_TOP      3328
#define XB_TOPGEN   3392
#define XCD_BAR_WORDS 3456
#define XB_SPIN_CAP (1u << 18)

__device__ __forceinline__ unsigned xb_ld(unsigned* p)              { return __hip_atomic_load(p, __ATOMIC_RELAXED, __HIP_MEMORY_SCOPE_AGENT); }
__device__ __forceinline__ unsigned xb_add(unsigned* p, unsigned v) { return __hip_atomic_fetch_add(p, v, __ATOMIC_RELAXED, __HIP_MEMORY_SCOPE_AGENT); }
__device__ __forceinline__ unsigned xb_xcc_id() { return (unsigned)__builtin_amdgcn_s_getreg((3 << 11) | 20) & 0xFu; }
#define XB_SPIN(cond, bar) do { unsigned _sp = 0; while (cond) { __builtin_amdgcn_s_sleep(1); \
    if ((++_sp & 255u) == 0u) { if (xb_ld(&(bar)[XB_TMO])) break; if (_sp > XB_SPIN_CAP) { atomicAdd(&(bar)[XB_TMO], 1u); break; } } } } while (0)

struct XcdBarrier {
    unsigned* bar; unsigned x;
    volatile LAS unsigned* st;
};

__device__ __forceinline__ XcdBarrier xcd_barrier_post(unsigned* bar, volatile LAS unsigned* st, int tid) {
    XcdBarrier b; b.bar = bar; b.x = xb_xcc_id(); b.st = st;
    if (tid == 0) (void)xb_add(&bar[XB_XCNT(b.x)], 1u);
    return b;
}
__device__ __forceinline__ void xcd_barrier_complete(unsigned* bar, unsigned x, unsigned& nloc, unsigned& nx) {
    const unsigned G = gridDim.x * gridDim.y * gridDim.z;
    unsigned sum, cnt, mine, sp = 0u;
    for (;;) {
        sum = 0u; cnt = 0u; mine = 0u;
#pragma unroll
        for (unsigned j = 0; j < 16; ++j) { const unsigned c = xb_ld(&bar[XB_XCNT(j)]); sum += c; cnt += (c > 0u) ? 1u : 0u; mine = (j == x) ? c : mine; }
        if (sum == G) break;
        __builtin_amdgcn_s_sleep(1);
        if ((++sp & 255u) == 0u) { if (xb_ld(&bar[XB_TMO])) break; if (sp > XB_SPIN_CAP) { atomicAdd(&bar[XB_TMO], 1u); break; } }
    }
    nloc = mine > 0u ? mine : 1u; nx = cnt > 0u ? cnt : 1u;
}

__device__ __forceinline__ void xcd_barrier(const XcdBarrier& b, int tid) {
    asm volatile("s_waitcnt vmcnt(0)" ::: "memory");
    __syncthreads();
    if (tid == 0) {
        unsigned* bar = b.bar;
        __builtin_amdgcn_s_waitcnt(0);
        unsigned nloc = b.st[0], nx = b.st[1];
        if (nloc == 0u) { xcd_barrier_complete(bar, b.x, nloc, nx); b.st[0] = nloc; b.st[1] = nx; }
        const unsigned old = xb_add(&bar[XB_XSUB(b.x)], 1u);
        const unsigned gen = old / nloc;
        if (old + 1u == (gen + 1u) * nloc) {
            __builtin_amdgcn_fence(__ATOMIC_RELEASE, "agent");
            asm volatile("s_waitcnt vmcnt(0)" ::: "memory");
            const unsigned og = xb_add(&bar[XB_TOP], 1u);
            const unsigned tg = og / nx;
            if (og + 1u == (tg + 1u) * nx) xb_add(&bar[XB_TOPGEN], 1u);
            else XB_SPIN(xb_ld(&bar[XB_TOPGEN]) == tg, bar);
            __builtin_amdgcn_fence(__ATOMIC_ACQUIRE, "agent");
            xb_add(&bar[XB_XGEN(b.x)], 1u);
            asm volatile("s_waitcnt vmcnt(0)" ::: "memory");
        } else {
            XB_SPIN(xb_ld(&bar[XB_XGEN(b.x)]) == gen, bar);
            __builtin_amdgcn_fence(__ATOMIC_ACQUIRE, "agent");
            asm volatile("s_waitcnt vmcnt(0)" ::: "memory");
        }
    }
    __syncthreads();
}

struct Frame {
    LAS unsigned char* lds;
    int wave, G, gw, NGW;
    const float *x, *c, *ctx, *cctx, *ada_w, *ada_b, *norm1_w, *norm2_w, *w_in, *w_out, *conv_w, *a_log, *dt_bias, *gdn_norm_w, *sink, *w_s, *b_s,
                *gmlp_norm_w, *ig_bias, *fg_bias, *mlstm_norm_w, *w1, *w2, *final_w;
    float* out; unsigned char* ws;
    float *MOD, *XC, *CHS, *GLG, *GLM, *WI, *PEND, *SLAB;
    bf16_t *WIN, *WOUT, *W1, *W2, *WSP, *H, *MIX, *Z, *PG, *PM, *HID;
};

__device__ __forceinline__ int fresh_lane() { int t; asm volatile("v_mbcnt_lo_u32_b32 %0, -1, 0\n\tv_mbcnt_hi_u32_b32 %0, -1, %0" : "=v"(t)); return t; }
__device__ __forceinline__ void phase_mod(const Frame& F) {
    LAS float* sact = (LAS float*)F.lds;
    LAS float* part = sact + 9 * 1024;
    const int lane0 = fresh_lane(), tid0 = F.wave * 64 + lane0;
    for (int i = tid0; i < 9 * 1024; i += NWAVES * 64) { const float v = i < 8192 ? F.c[i] : F.cctx[i - 8192]; sact[i] = v * frcp(1.f + fexp(-v)); }
    __syncthreads();
    for (int task = blockIdx.x; task < DEPTH * 48; task += F.G) {
        const int lane = fresh_lane(), tid = F.wave * 64 + lane;
        const int l = task / 48, cg = task % 48, col = cg * 128 + 2 * lane, k0 = F.wave * 128;
        const float* w = F.ada_w + (size_t)l * 1024 * 6144 + (size_t)k0 * 6144 + col;
        float a0[9], a1[9];
#pragma unroll
        for (int b = 0; b < 9; ++b) { a0[b] = 0.f; a1[b] = 0.f; }
#pragma unroll 8
        for (int k = 0; k < 128; ++k) { const f32x2_ wv = *(const f32x2_*)(w + (size_t)k * 6144);
#pragma unroll
            for (int b = 0; b < 9; ++b) { const float sv = sact[b * 1024 + k0 + k]; a0[b] += sv * wv[0]; a1[b] += sv * wv[1]; } }
#pragma unroll
        for (int b = 0; b < 9; ++b) { part[(F.wave * 9 + b) * 128 + 2 * lane] = a0[b]; part[(F.wave * 9 + b) * 128 + 2 * lane + 1] = a1[b]; }
        __syncthreads();
        for (int o = tid; o < 9 * 128; o += NWAVES * 64) { const int b = o >> 7, cc = o & 127; float s = F.ada_b[l * 6144 + cg * 128 + cc];
#pragma unroll
            for (int wv = 0; wv < 8; ++wv) s += part[(wv * 9 + b) * 128 + cc];
            F.MOD[(l * 9 + b) * 6144 + cg * 128 + cc] = s; }
        __syncthreads();
    }
}

__device__ __forceinline__ void transpose_item(const float* W, int K, int N, int Ndst, bf16_t* WT, LAS float* scr, int item, int lane, bool remap) {
    const int nblk = Ndst / 32, kb = item / nblk, nb = item % nblk, k0 = 64 * kb, n0 = 32 * nb;
    const int n = n0 + (lane & 31);
    const int src = remap ? (n < 1024 ? n : n < 3072 ? n + 16 : n < 3088 ? n - 2048 : n < 3104 ? n : -1) : n;
    float wv[32]; const int srcc = src >= 0 ? src : 0;
#pragma unroll
    for (int i = 0; i < 32; ++i) wv[i] = W[(size_t)(k0 + 2 * i + (lane >> 5)) * N + srcc];
#pragma unroll
    for (int i = 0; i < 32; ++i) scr[(2 * i + (lane >> 5)) * 33 + (lane & 31)] = src >= 0 ? wv[i] : 0.f;
    LDS_WAIT(); asm volatile("" ::: "memory");
    const int c = lane & 7;
#pragma unroll
    for (int j = 0; j < 4; ++j) { const int nn = (lane >> 3) + 8 * j; const LAS float* s = scr + (8 * c) * 33 + nn;
        v4u o; o.x = pk2(s[0 * 33], s[1 * 33]); o.y = pk2(s[2 * 33], s[3 * 33]); o.z = pk2(s[4 * 33], s[5 * 33]); o.w = pk2(s[6 * 33], s[7 * 33]);
        *(v4u*)(WT + (size_t)(n0 + nn) * K + k0 + 8 * c) = o; }
    LDS_WAIT(); asm volatile("" ::: "memory");
}
__device__ __forceinline__ void convert_weights(const Frame& F, int l, int gw, int ngw) {
    LAS float* scr = (LAS float*)(F.lds + F.wave * 16384);
    unsigned char* wb = F.ws + (size_t)(l & 1) * WSET_STRIDE;
    bf16_t* dWIN = (bf16_t*)(wb + WS_WIN); bf16_t* dWOUT = (bf16_t*)(wb + WS_WOUT); bf16_t* dW1 = (bf16_t*)(wb + WS_W1); bf16_t* dW2 = (bf16_t*)(wb + WS_W2); bf16_t* dWSP = (bf16_t*)(wb + WS_WSP);
    constexpr int I_IN = 16 * (ZW / 32), I_OUT = 16 * 32, I_1 = 16 * 128, I_2 = 64 * 32, I_S = 128;
    for (int it = gw; it < I_IN + I_OUT + I_1 + I_2 + I_S; it += ngw) {
        int r = it; const int lane = fresh_lane();
        if (r < I_IN) { transpose_item(F.w_in + (size_t)l * 1024 * 3104, 1024, 3104, ZW, dWIN, scr, r, lane, true); continue; } r -= I_IN;
        if (r < I_OUT) { transpose_item(F.w_out + (size_t)l * 1024 * 1024, 1024, 1024, 1024, dWOUT, scr, r, lane, false); continue; } r -= I_OUT;
        if (r < I_1) { transpose_item(F.w1 + (size_t)l * 1024 * 4096, 1024, 4096, 4096, dW1, scr, r, lane, false); continue; } r -= I_1;
        if (r < I_2) { transpose_item(F.w2 + (size_t)l * 4096 * 1024, 4096, 1024, 1024, dW2, scr, r, lane, false); continue; } r -= I_2;
        { const float* s = F.w_s + (size_t)l * 65536 + r * 512 + lane * 8; const f32x4 a = *(const f32x4*)s, b = *(const f32x4*)(s + 4);
          v4u o; o.x = pk2(a[0], a[1]); o.y = pk2(a[2], a[3]); o.z = pk2(b[0], b[1]); o.w = pk2(b[2], b[3]); *(v4u*)(dWSP + r * 512 + lane * 8) = o; }
    }
}

__device__ __forceinline__ void phase_norm(const Frame& F, int l, int which, int nrows, int nslab, const float* sgate) {
    const float* nwp = (which == 0 ? F.norm1_w : F.norm2_w) + l * 1024;
    const bool init = (which == 0 && l == 0);
    const int lane = fresh_lane();
    f32x4 nwv[4];
#pragma unroll
    for (int j = 0; j < 4; ++j) nwv[j] = *(const f32x4*)(nwp + 256 * j + 4 * lane);
    int m = F.gw; if (m >= nrows) return;
    f32x4 v[4], vn[4];
    { const bool lat = m < MLAT; const float* src = init ? (lat ? F.x + (size_t)m * 1024 : F.ctx + (size_t)(m - MLAT) * 1024) : (lat ? F.out + (size_t)m * 1024 : F.XC + (size_t)(m - MLAT) * 1024);
#pragma unroll
      for (int j = 0; j < 4; ++j) v[j] = *(const f32x4*)(src + 256 * j + 4 * lane); }
    for (; m < nrows; m += F.NGW) {
        const bool lat = m < MLAT; const int bm = lat ? (m >> 11) : 8;
        float* xrow = lat ? F.out + (size_t)m * 1024 : F.XC + (size_t)(m - MLAT) * 1024;
        const float* mod = F.MOD + (l * 9 + bm) * 6144 + (which == 0 ? 0 : 3 * 1024);
        f32x4 shv[4], scv[4];
#pragma unroll
        for (int j = 0; j < 4; ++j) { const int col = 256 * j + 4 * lane; shv[j] = *(const f32x4*)(mod + col); scv[j] = *(const f32x4*)(mod + 1024 + col); }
        const int mn = m + F.NGW;
        if (mn < nrows) { const bool latn = mn < MLAT; const float* srcn = init ? (latn ? F.x + (size_t)mn * 1024 : F.ctx + (size_t)(mn - MLAT) * 1024) : (latn ? F.out + (size_t)mn * 1024 : F.XC + (size_t)(mn - MLAT) * 1024);
#pragma unroll
            for (int j = 0; j < 4; ++j) vn[j] = *(const f32x4*)(srcn + 256 * j + 4 * lane); }
        const bool red = !lat && nslab > 0;
        if (red) {
#pragma unroll
            for (int j = 0; j < 4; ++j) { f32x4 a = {0.f, 0.f, 0.f, 0.f};
                for (int k = 0; k < nslab; ++k) a += *(const f32x4*)(F.SLAB + ((size_t)k * MCTX + (m - MLAT)) * 1024 + 256 * j + 4 * lane);
                v[j] += a * *(const f32x4*)(sgate + 256 * j + 4 * lane); }
        }
        float s = 0.f;
#pragma unroll
        for (int j = 0; j < 4; ++j) s += (v[j][0] * v[j][0] + v[j][1] * v[j][1]) + (v[j][2] * v[j][2] + v[j][3] * v[j][3]);
        const float rstd = frsq(wave_sum(s) * (1.f / 1024.f) + EPS);
#pragma unroll
        for (int j = 0; j < 4; ++j) {
            const int col = 256 * j + 4 * lane;
            if (init || red) *(f32x4*)(xrow + col) = v[j];
            const f32x4 hh = (v[j] * rstd * nwv[j]) * (scv[j] + 1.0f) + shv[j];
            *(v2u*)(F.H + (size_t)m * 1024 + col) = pack4(hh);
        }
#pragma unroll
        for (int j = 0; j < 4; ++j) v[j] = vn[j];
    }
}
__device__ __forceinline__ void phase_final(const Frame& F, bool poison) {
    for (int m = F.gw; m < MLAT; m += F.NGW) {
        const int lane = fresh_lane();
        float* xrow = F.out + (size_t)m * 1024;
        f32x4 v[4]; float s = 0.f;
#pragma unroll
        for (int j = 0; j < 4; ++j) { v[j] = *(const f32x4*)(xrow + 256 * j + 4 * lane); s += (v[j][0] * v[j][0] + v[j][1] * v[j][1]) + (v[j][2] * v[j][2] + v[j][3] * v[j][3]); }
        float rstd = frsq(wave_sum(s) * (1.f / 1024.f) + EPS);
        if (poison) rstd = __builtin_nanf("");
        f32x4 nwv[4];
#pragma unroll
        for (int j = 0; j < 4; ++j) nwv[j] = *(const f32x4*)(F.final_w + 256 * j + 4 * lane);
#pragma unroll
        for (int j = 0; j < 4; ++j) *(f32x4*)(xrow + 256 * j + 4 * lane) = v[j] * rstd * nwv[j];
    }
}

__device__ __forceinline__ void ew_unit(const Frame& F, int l, int rg) {
    const int r0 = rg * 16;
    const int t_o = F.wave * 64 + fresh_lane();
    const int tid = t_o, lane_ = t_o & 63, wave_ = __builtin_amdgcn_readfirstlane(t_o >> 6);
    unsigned short ra[6], rb[6];
#pragma unroll
    for (int j = 0; j < 6; ++j) { const int idx = tid + 512 * j, rr = idx / 192, pr = idx % 192, hd = pr >> 5, f = pr & 31;
        const bf16_t* p = F.Z + (size_t)(r0 + rr) * ZW + (hd < 4 ? ZC_SQ + hd * 64 : ZC_SK + (hd - 4) * 64) + f; ra[j] = p[0]; rb[j] = p[32]; }
#pragma unroll
    for (int j = 0; j < 6; ++j) {
        const int idx = tid + 512 * j, rr = idx / 192, pr = idx % 192, hd = pr >> 5, f = pr & 31, row = r0 + rr;
        bf16_t* p = F.Z + (size_t)row * ZW + (hd < 4 ? ZC_SQ + hd * 64 : ZC_SK + (hd - 4) * 64) + f;
        const float t1 = bf2f(ra[j]), t2 = bf2f(rb[j]);
        if (row < MLAT) {
            const int t = row & (SEQ - 1); const float pos = (float)(f < 16 ? (t >> 6) : (t & 63));
            const float inv = __builtin_amdgcn_exp2f(-(float)(f & 15) * 0.8304820237218406f);
            const float rev = pos * inv * 0.15915494309189535f; const float cs = __builtin_amdgcn_cosf(rev), sn = __builtin_amdgcn_sinf(rev);
            const float sc = hd < 4 ? 0.125f : 1.0f;
            p[0] = (bf16_t)f2bf((t1 * cs - t2 * sn) * sc); p[32] = (bf16_t)f2bf((t1 * sn + t2 * cs) * sc);
        } else if (hd < 4) {
            p[0] = (bf16_t)f2bf(t1 * 0.125f); p[32] = (bf16_t)f2bf(t2 * 0.125f);
        }
    }
    { v4u gr[2]; bf16_t* gp[2];
#pragma unroll
      for (int j = 0; j < 2; ++j) { const int g = tid + 512 * j, rr = g >> 6, seg = g & 63; gp[j] = F.Z + (size_t)(r0 + rr) * ZW + (seg < 32 ? ZC_GZ + seg * 8 : ZC_LO + (seg - 32) * 8); gr[j] = *(const v4u*)gp[j]; }
#pragma unroll
      for (int j = 0; j < 2; ++j) { const bool isz = ((tid + 512 * j) & 63) < 32; v4u o; unsigned* oi = (unsigned*)&o; const unsigned* gi = (const unsigned*)&gr[j];
#pragma unroll
          for (int e = 0; e < 4; ++e) { const float a = bflo(gi[e]), bb = bfhi(gi[e]); const float sa = sigmoidf_(a), sb = sigmoidf_(bb); oi[e] = isz ? pk2(a * sa, bb * sb) : pk2(sa, sb); }
          *(v4u*)gp[j] = o; } }
    v2u ur[2], vr[2];
#pragma unroll
    for (int j = 0; j < 2; ++j) { const bf16_t* zr = F.Z + (size_t)(r0 + 2 * wave_ + j) * ZW + 4 * lane_; ur[j] = *(const v2u*)(zr + ZC_MU); vr[j] = *(const v2u*)(zr + ZC_MV); }
    const f32x4 gnw = *(const f32x4*)(F.gmlp_norm_w + l * 256 + 4 * lane_);
#pragma unroll
    for (int j = 0; j < 2; ++j) {
        bf16_t* zr = F.Z + (size_t)(r0 + 2 * wave_ + j) * ZW + 4 * lane_;
        f32x4 u = unpack4(ur[j]), v = unpack4(vr[j]); float ss = 0.f;
#pragma unroll
        for (int e = 0; e < 4; ++e) { u[e] = geluf_(u[e]); v[e] = geluf_(v[e]); ss += v[e] * v[e]; }
        const float rs = frsq(wave_sum(ss) * (1.f / 256.f) + EPS);
        *(v2u*)(zr + ZC_MU) = pack4(u); *(v2u*)(zr + ZC_MV) = pack4(v * rs * gnw);
    }
}
__device__ __forceinline__ void chs_unit(const Frame& F, int l, int ck) {
    const int b = ck / 36, cidx = ck % 36, row0 = chunk_row0(b, cidx);
    const int t = F.wave * 64 + fresh_lane();
    LAS float* G = (LAS float*)F.lds;
#pragma unroll
    for (int j = 0; j < 2; ++j) { const int idx = t + 512 * j, p = idx >> 4, c = idx & 15, dh = c & 7;
        const float raw = bf2f(F.Z[(size_t)(row0 + p) * ZW + ZC_LI + c]);
        G[c * 64 + p] = c < 8 ? raw + F.ig_bias[l * 8 + dh] : logsigf_(raw + F.fg_bias[l * 8 + dh]); }
    __syncthreads();
    if (t < 8) { const int d = t >> 2, h = t & 3; float bsum = 0.f, mx = -1e30f;
        for (int i = 0; i < 64; ++i) { const int p = d ? 63 - i : i; bsum += G[(8 + t) * 64 + p]; mx = fmaxf(mx, G[t * 64 + p] - bsum); }
        float* o = F.CHS + ((((b * 4 + h) * 2 + d) * 36) + cidx) * 2; o[0] = bsum; o[1] = bsum + mx; }
    __syncthreads();
}

__device__ __forceinline__ void gdn_prep_unit(const Frame& F, int l, int u, int stop = 99, bf16_t* PGo = nullptr) {
    if (!PGo) PGo = F.PG;
    const int b = u / 144, h = (u / 36) & 3, cidx = u % 36;
    const int row0 = chunk_row0(b, cidx);
    const int seg_lo = cidx < 4 ? MLAT + b * CTXL : b * SEQ, seg_hi = seg_lo + (cidx < 4 ? CTXL : SEQ);
    const int t_o = F.wave * 64 + fresh_lane();
    const int t = t_o, lane = t & 63, w = __builtin_amdgcn_readfirstlane(t >> 6), lr = lane & 15, lq = lane >> 4;
    LAS unsigned char* L = F.lds;
    LAS bf16_t* Qs = (LAS bf16_t*)(L + 0); LAS bf16_t* Ks = (LAS bf16_t*)(L + 9216); LAS bf16_t* Kt = (LAS bf16_t*)(L + 18432); LAS bf16_t* Vt = (LAS bf16_t*)(L + 27648);
    LAS float* gS = (LAS float*)(L + 36864); LAS float* bS = gS + 128; LAS float* gcS = gS + 256; LAS float* totS = gS + 384;
    LAS float* As = (LAS float*)(L + 38912);
    LAS float* CV = (LAS float*)(L + 38912);
    LAS bf16_t* UT = (LAS bf16_t*)(L + 38912); LAS bf16_t* UTd = UT + 4608; LAS bf16_t* WT = UT + 9216; LAS bf16_t* WTd = UT + 13824;
    LAS bf16_t* Tb = (LAS bf16_t*)(L + 75776);
    LAS bf16_t* At = (LAS bf16_t*)(L + 112640);
    if (t < 384) {
        const int pair = t % 96, rg = t / 96, c0 = 2 * pair, part = c0 >> 6, d0 = c0 & 63, zcol = part * 256 + h * 64 + d0;
        float cw[5][2];
#pragma unroll
        for (int j = 0; j < 5; ++j) { const float* wp = F.conv_w + (size_t)(l * 5 + j) * 768 + part * 256 + h * 64 + d0; cw[j][0] = wp[0]; cw[j][1] = wp[1]; }
        float win[20][2];
        unsigned raw[20];
        { const int rbase = row0 + rg * 16 - 2; const bf16_t* zc = F.Z + zcol;
#pragma unroll
          for (int rr = 0; rr < 20; ++rr) { int row = rbase + rr; row = row < seg_lo ? seg_lo : (row >= seg_hi ? seg_hi - 1 : row); raw[rr] = *(const unsigned*)(zc + (size_t)row * ZW); }
          asm volatile("" : "+v"(raw[0]), "+v"(raw[1]), "+v"(raw[2]), "+v"(raw[3]), "+v"(raw[4]), "+v"(raw[5]), "+v"(raw[6]), "+v"(raw[7]), "+v"(raw[8]), "+v"(raw[9]));
          asm volatile("" : "+v"(raw[10]), "+v"(raw[11]), "+v"(raw[12]), "+v"(raw[13]), "+v"(raw[14]), "+v"(raw[15]), "+v"(raw[16]), "+v"(raw[17]), "+v"(raw[18]), "+v"(raw[19]));
#pragma unroll
          for (int rr = 0; rr < 20; ++rr) { const int row = rbase + rr; const unsigned wv = (row >= seg_lo && row < seg_hi) ? raw[rr] : 0u; win[rr][0] = bflo(wv); win[rr][1] = bfhi(wv); } }
#pragma unroll
        for (int i = 0; i < 16; ++i) { float a0 = 0.f, a1 = 0.f;
#pragma unroll
            for (int j = 0; j < 5; ++j) { a0 += cw[j][0] * win[i + j][0]; a1 += cw[j][1] * win[i + j][1]; }
            CV[(rg * 16 + i) * 196 + c0] = siluf_(a0); CV[(rg * 16 + i) * 196 + c0 + 1] = siluf_(a1); }
    } else {
        const int tt = t - 384, d = tt >> 6, p = tt & 63; const bf16_t* zr = F.Z + (size_t)(row0 + p) * ZW;
        const float a = bf2f(zr[ZC_GA + d * 4 + h]), bb = bf2f(zr[ZC_GB + d * 4 + h]);
        gS[d * 64 + p] = -fexp(F.a_log[l * 8 + d * 4 + h]) * softplusf_(a + F.dt_bias[l * 8 + d * 4 + h]);
        bS[d * 64 + p] = sigmoidf_(bb);
    }
    __syncthreads();
    if (stop <= 1) return;
    {
        const int combo = t >> 2, sub = t & 3, row = combo & 63, part = combo >> 6;
        float v[16]; float ss = 0.f;
#pragma unroll
        for (int i = 0; i < 16; ++i) { v[i] = CV[row * 196 + part * 64 + sub * 16 + i]; ss += v[i] * v[i]; }
        ss = quad_sum(ss);
        const float rs = frsq(ss + EPS);
        LAS bf16_t* dst = (part == 0 ? Qs : Ks) + row * 72 + sub * 16;
        v4u o0, o1;
        o0.x = pk2(v[0] * rs, v[1] * rs); o0.y = pk2(v[2] * rs, v[3] * rs); o0.z = pk2(v[4] * rs, v[5] * rs); o0.w = pk2(v[6] * rs, v[7] * rs);
        o1.x = pk2(v[8] * rs, v[9] * rs); o1.y = pk2(v[10] * rs, v[11] * rs); o1.z = pk2(v[12] * rs, v[13] * rs); o1.w = pk2(v[14] * rs, v[15] * rs);
        *(LAS v4u*)dst = o0; *(LAS v4u*)(dst + 8) = o1;
        if (part == 1) {
#pragma unroll
            for (int i = 0; i < 16; ++i) Kt[(sub * 16 + i) * 72 + row] = (bf16_t)f2bf(v[i] * rs);
        }
        const int vrow = t & 63, dg = t >> 6;
#pragma unroll
        for (int i = 0; i < 8; ++i) Vt[(dg * 8 + i) * 72 + vrow] = (bf16_t)f2bf(CV[vrow * 196 + 128 + dg * 8 + i]);
        if (w < 2) { const int d = w, p = d ? 63 - lane : lane; float s = gS[d * 64 + p];
#pragma unroll
            for (int off = 1; off < 64; off <<= 1) { const float y = __shfl_up(s, off); if (lane >= off) s += y; }
            gcS[d * 64 + p] = s; if (lane == 63) totS[d] = s; }
    }
    __syncthreads();
    if (stop <= 2) return;
#pragma unroll
    for (int k2 = 0; k2 < 2; ++k2) {
        const int tt = 2 * w + k2, mt = tt >> 2, nt = tt & 3;
        f32x4 accG = {0.f, 0.f, 0.f, 0.f}, accQ = {0.f, 0.f, 0.f, 0.f};
        accG = mma_ll<2>(Ks + mt * 16 * 72, 72, Ks + nt * 16 * 72, 72, accG, lane);
        accQ = mma_ll<2>(Ks + mt * 16 * 72, 72, Qs + nt * 16 * 72, 72, accQ, lane);
        const int n = nt * 16 + lr, m0 = mt * 16 + 4 * lq;
#pragma unroll
        for (int d = 0; d < 2; ++d) {
            const float gcn = gcS[d * 64 + n], bn = bS[d * 64 + n];
            f32x4 av, tv;
#pragma unroll
            for (int i = 0; i < 4; ++i) { const int m = m0 + i; const float gcm = gcS[d * 64 + m];
                const bool strict = d == 0 ? (m < n) : (m > n); const bool incl = d == 0 ? (m <= n) : (m >= n);
                const float e = fexp(incl ? (gcn - gcm) : 0.f);
                av[i] = strict ? bn * accG[i] * e : 0.f; tv[i] = incl ? 0.125f * accQ[i] * e : 0.f; }
#pragma unroll
            for (int i = 0; i < 4; ++i) { const int si = d ? 63 - n : n, sj = d ? 63 - (m0 + i) : m0 + i; As[d * 4352 + (si >> 1) * 136 + sj * 2 + (si & 1)] = av[i]; }
            *(LAS v2u*)(At + d * 4608 + n * 72 + m0) = pack4(tv);
        }
    }
    __syncthreads();
    if (stop <= 3) return;
    if (w < 2) {
        const int d = w; const LAS float* Ad = As + d * 4352;
        float tr[64]; int lane_o = lane;
#pragma unroll
        for (int ip = 0; ip < 32; ++ip) {
            const int i0 = 2 * ip;
            f32x4 rv[32];
#pragma unroll
            for (int jp = 0; jp <= ip; ++jp) rv[jp] = *(const LAS f32x4*)(Ad + ip * 136 + 4 * jp);
            asm volatile("" : "+v"(lane_o) :: "memory");
            f32x2_ a0 = {0.f, 0.f}, a1 = {0.f, 0.f}, a2 = {0.f, 0.f}, a3 = {0.f, 0.f};
#pragma unroll
            for (int jp = 0; jp < ip; ++jp) {
                const f32x2_ ta = {tr[2 * jp], tr[2 * jp]}, tb = {tr[2 * jp + 1], tr[2 * jp + 1]};
                const f32x2_ va = {rv[jp][0], rv[jp][1]}, vb = {rv[jp][2], rv[jp][3]};
                if (jp & 1) { a2 += va * ta; a3 += vb * tb; } else { a0 += va * ta; a1 += vb * tb; }
            }
            const f32x2_ sum = (a0 + a1) + (a2 + a3);
            const float t0 = (lane_o == i0 ? 1.f : 0.f) - sum[0];
            tr[i0] = t0;
            tr[i0 + 1] = (lane_o == i0 + 1 ? 1.f : 0.f) - sum[1] - rv[ip][1] * t0;
        }
        const int pb = d ? 63 - lane : lane; const float sb = bS[d * 64 + pb], sbe = sb * fexp(gcS[d * 64 + pb]);
        LAS bf16_t* T0 = Tb + d * 9216; LAS bf16_t* T1 = T0 + 4608;
#pragma unroll
        for (int i = 0; i < 64; ++i) { const int pa = d ? 63 - i : i; T0[pa * 72 + pb] = (bf16_t)f2bf(tr[i] * sb); T1[pa * 72 + pb] = (bf16_t)f2bf(tr[i] * sbe); }
    }
    __syncthreads();
    if (stop <= 4) return;
#pragma unroll 1
    for (int d = 0; d < 2; ++d) {
        const int ud = u * 2 + d; const float tot = totS[d];
        const LAS bf16_t* T0 = Tb + d * 9216; const LAS bf16_t* T1 = T0 + 4608; const LAS bf16_t* Ad = At + d * 4608;
        {
            const bool isw = w >= 4; const LAS bf16_t* Aop = isw ? T1 : T0; const LAS bf16_t* Bop = isw ? Kt : Vt;
            LAS bf16_t* o0 = isw ? WT : UT; LAS bf16_t* o1 = isw ? WTd : UTd;
#pragma unroll
            for (int k4 = 0; k4 < 4; ++k4) { const int tt = (w & 3) * 4 + k4, mt = tt >> 2, nt = tt & 3;
                f32x4 acc = {0.f, 0.f, 0.f, 0.f}; acc = mma_ll<2>(Aop + mt * 16 * 72, 72, Bop + nt * 16 * 72, 72, acc, lane);
                const int n = nt * 16 + lr, m0 = mt * 16 + 4 * lq; f32x4 dv;
#pragma unroll
                for (int i = 0; i < 4; ++i) dv[i] = acc[i] * fexp(tot - gcS[d * 64 + m0 + i]);
                *(LAS v2u*)(o0 + n * 72 + m0) = pack4(acc); *(LAS v2u*)(o1 + n * 72 + m0) = pack4(dv); }
        }
        __syncthreads();
        if (stop == 6) { __syncthreads(); continue; }
        {
            const int prod = w >> 1; bf16_t* gout = PGo + (size_t)ud * 16384 + prod * 4096;
            const LAS bf16_t* Aop = prod == 0 ? WTd : prod == 1 ? Kt : prod == 2 ? WT : Ad;
            const LAS bf16_t* Bop = prod == 0 ? Kt : prod == 1 ? UTd : prod == 2 ? Ad : UT;
#pragma unroll
            for (int k8 = 0; k8 < 8; ++k8) { const int tt = (w & 1) * 8 + k8, mt = tt >> 2, nt = tt & 3;
                f32x4 acc = {0.f, 0.f, 0.f, 0.f}; acc = mma_ll<2>(Aop + mt * 16 * 72, 72, Bop + nt * 16 * 72, 72, acc, lane);
                const int n = nt * 16 + lr, m0 = mt * 16 + 4 * lq;
                if (prod == 2) { const f32x4 qv = unpack4(*(const LAS v2u*)(Qs + n * 72 + m0)); const float e = 0.125f * fexp(gcS[d * 64 + n]); acc = qv * e - acc; }
                const int off = (prod == 0 || prod == 2) ? ((nt * 2 + (mt >> 1)) * 64 + ((mt & 1) * 2 + (lq >> 1)) * 16 + lr) * 8 + 4 * (lq & 1) : ((mt * 4 + nt) * 64 + lane) * 4;
                if (stop != 7) *(v2u*)(gout + off) = pack4(acc); else asm volatile("" :: "v"(acc)); }
        }
        if (t == 0 && PGo == F.PG) F.GLG[ud] = fexp(tot);
        __syncthreads();
    }
}

__device__ __forceinline__ void mlstm_prep_unit(const Frame& F, int l, int u) {
    const int b = u / 144, h = (u / 36) & 3, cidx = u % 36;
    const int row0 = chunk_row0(b, cidx);
    const int t_o = F.wave * 64 + fresh_lane();
    const int t = t_o, lane = t & 63, w = __builtin_amdgcn_readfirstlane(t >> 6), lr = lane & 15, lq = lane >> 4;
    LAS unsigned char* L = F.lds;
    LAS bf16_t* Qs = (LAS bf16_t*)(L + 0); LAS bf16_t* Ks = (LAS bf16_t*)(L + 9216); LAS bf16_t* Vta = (LAS bf16_t*)(L + 18432);
    LAS bf16_t* Kte = (LAS bf16_t*)(L + 29952);
    LAS bf16_t* S0 = (LAS bf16_t*)(L + 48384);
    LAS float* igS = (LAS float*)(L + 66816); LAS float* lfS = igS + 128; LAS float* bS = igS + 256; LAS float* dmS = igS + 384; LAS float* rS = igS + 512;
    LAS float* flS = igS + 640; LAS float* eS = igS + 768; LAS float* mpS = igS + 896; LAS float* chS = igS + 904;
    {
        const int r = t >> 3, seg = t & 7; const bf16_t* zr = F.Z + (size_t)(row0 + r) * ZW + h * 64 + seg * 8;
        const v4u q = *(const v4u*)(zr + ZC_LQ), k = *(const v4u*)(zr + ZC_LK), v = *(const v4u*)(zr + ZC_LV);
        *(LAS v4u*)(Qs + r * 72 + seg * 8) = q; *(LAS v4u*)(Ks + r * 72 + seg * 8) = k;
        Vta[(seg * 8 + 0) * 72 + r] = (bf16_t)(v.x & 0xffffu); Vta[(seg * 8 + 1) * 72 + r] = (bf16_t)(v.x >> 16);
        Vta[(seg * 8 + 2) * 72 + r] = (bf16_t)(v.y & 0xffffu); Vta[(seg * 8 + 3) * 72 + r] = (bf16_t)(v.y >> 16);
        Vta[(seg * 8 + 4) * 72 + r] = (bf16_t)(v.z & 0xffffu); Vta[(seg * 8 + 5) * 72 + r] = (bf16_t)(v.z >> 16);
        Vta[(seg * 8 + 6) * 72 + r] = (bf16_t)(v.w & 0xffffu); Vta[(seg * 8 + 7) * 72 + r] = (bf16_t)(v.w >> 16);
#pragma unroll
        for (int j = 0; j < 2; ++j) { const int idx = t + 512 * j, rr = 64 + (idx >> 6), cc = idx & 63; Vta[rr * 72 + cc] = (bf16_t)(rr == 64 ? 0x3F80u : 0u); }
        if (t < 128) { const int d = t >> 6, p = t & 63; const bf16_t* zg = F.Z + (size_t)(row0 + p) * ZW;
            igS[d * 64 + p] = bf2f(zg[ZC_LI + d * 4 + h]) + F.ig_bias[l * 8 + d * 4 + h];
            lfS[d * 64 + p] = logsigf_(bf2f(zg[ZC_LF + d * 4 + h]) + F.fg_bias[l * 8 + d * 4 + h]); }
        if (t >= 128 && t < 272) chS[t - 128] = F.CHS[(size_t)((b * 4 + h) * 2) * 72 + (t - 128)];
    }
    __syncthreads();
    if (w < 2) {
        const int d = w, p = d ? 63 - lane : lane;
        const int step_of = d ? (cidx < 4 ? 3 - cidx : 39 - cidx) : cidx; float mprev = 0.f;
        for (int s = 0; s < step_of; ++s) { const int ci = d ? (s < 4 ? 3 - s : 39 - s) : s; mprev = fmaxf(chS[d * 72 + ci * 2] + mprev, chS[d * 72 + ci * 2 + 1]); }
        const float ig = igS[d * 64 + p]; float bp = lfS[d * 64 + p];
#pragma unroll
        for (int off = 1; off < 64; off <<= 1) { const float y = __shfl_up(bp, off); if (lane >= off) bp += y; }
        float mxp = ig - bp;
#pragma unroll
        for (int off = 1; off < 64; off <<= 1) { const float y = __shfl_up(mxp, off); if (lane >= off) mxp = fmaxf(mxp, y); }
        const float mxall = __shfl(mxp, 63), bl = __shfl(bp, 63);
        const float dmax = bp + mxp, wsmax = bl + mxall;
        const float mnew = fmaxf(bl + mprev, wsmax), cd = fexp(bl + mprev - mnew), e2 = fexp(wsmax - mnew);
        const float mt = fmaxf(bp + mprev, dmax);
        bS[d * 64 + p] = bp; dmS[d * 64 + p] = dmax; rS[d * 64 + p] = fexp(dmax - mt); flS[d * 64 + p] = fexp(-mt);
        eS[d * 64 + p] = fexp(bl - bp + ig - wsmax) * e2;
        const int ud = u * 2 + d; F.WI[ud * 64 + p] = 0.125f * fexp(bp + mprev - mt); if (lane == 0) F.GLM[ud] = cd; }
    __syncthreads();
    {
        const int d = t >> 8, tt = t & 255, p = tt & 63, dg = tt >> 6; const float e = eS[d * 64 + p];
#pragma unroll
        for (int i = 0; i < 16; ++i) Kte[d * 4608 + (dg * 16 + i) * 72 + p] = (bf16_t)f2bf(bf2f(Ks[p * 72 + dg * 16 + i]) * e);
#pragma unroll
        for (int k2 = 0; k2 < 2; ++k2) { const int tl = 2 * w + k2, mt = tl >> 2, nt = tl & 3;
            f32x4 acc = {0.f, 0.f, 0.f, 0.f}; acc = mma_ll<2>(Ks + mt * 16 * 72, 72, Qs + nt * 16 * 72, 72, acc, lane);
            const int n = nt * 16 + lr, m0 = mt * 16 + 4 * lq;
#pragma unroll
            for (int dd = 0; dd < 2; ++dd) { const float bn = bS[dd * 64 + n], dn = dmS[dd * 64 + n], rn = rS[dd * 64 + n]; f32x4 sv;
#pragma unroll
                for (int i = 0; i < 4; ++i) { const int m = m0 + i; const bool incl = dd == 0 ? (m <= n) : (m >= n);
                    const float arg = incl ? (bn - bS[dd * 64 + m] + igS[dd * 64 + m] - dn) : 0.f; sv[i] = incl ? 0.125f * acc[i] * fexp(arg) * rn : 0.f; }
                *(LAS v2u*)(S0 + dd * 4608 + n * 72 + m0) = pack4(sv); } }
    }
    __syncthreads();
    {
        const int d = w >> 2, ud = u * 2 + d; bf16_t* gO = F.PM + (size_t)ud * 10240; bf16_t* gB = gO + 5120;
#pragma unroll 2
        for (int k = 0; k < 10; ++k) { const int tl = (w & 3) * 10 + k; const bool iskv = tl >= 20; const int t2 = iskv ? tl - 20 : tl, mt = t2 / 5, nt = t2 % 5;
            const LAS bf16_t* Aop = (iskv ? Kte : S0) + d * 4608 + mt * 16 * 72;
            f32x4 acc = {0.f, 0.f, 0.f, 0.f}; acc = mma_ll<2>(Aop, 72, Vta + nt * 16 * 72, 72, acc, lane);
            const int n = nt * 16 + lr, m0 = mt * 16 + 4 * lq;
            if (!iskv && n == 65) {
#pragma unroll
                for (int i = 0; i < 4; ++i) acc[i] = flS[d * 64 + m0 + i]; }
            *(v2u*)((iskv ? gB : gO) + ((mt * 5 + nt) * 64 + lane) * 4) = pack4(acc); }
    }
    __syncthreads();
}

__device__ __forceinline__ void l2_touch(const void* gsrc, unsigned lds_dst) {
    unsigned keep;
    asm volatile("s_mov_b32 %0, m0\n\ts_mov_b32 m0, %2\n\ts_nop 0\n\tglobal_load_lds_dword %1, off\n\ts_mov_b32 m0, %0" : "=&s"(keep) : "v"(gsrc), "s"(lds_dst) : "memory");
}
template <int NT> struct ScanOps { bf16x8 Qf[2], Mf[2]; v2u bv[NT], ov[NT]; float gl; f32x4 wi; };
template <bool GDN, int NT> __device__ __forceinline__ void scan_load(const Frame& F, int b, int h, int dir, int wq, int lr, int lq, int s, ScanOps<NT>& o) {
    const int cidx = dir ? (s < 4 ? 3 - s : 39 - s) : s;
    const int ud = ((b * 4 + h) * 36 + cidx) * 2 + dir;
    if (GDN) {
        const bf16_t* gM = F.PG + (size_t)ud * 16384; const bf16_t* gQ = gM + 8192;
#pragma unroll
        for (int ks = 0; ks < 2; ++ks) { o.Mf[ks] = *(const bf16x8*)(gM + ((wq * 2 + ks) * 64 + lq * 16 + lr) * 8); o.Qf[ks] = *(const bf16x8*)(gQ + ((wq * 2 + ks) * 64 + lq * 16 + lr) * 8); }
    } else {
        const bf16_t* zq = F.Z + (size_t)(chunk_row0(b, cidx) + 16 * wq + lr) * ZW + ZC_LQ + h * 64;
#pragma unroll
        for (int ks = 0; ks < 2; ++ks) { o.Qf[ks] = *(const bf16x8*)(zq + 32 * ks + 8 * lq); o.Mf[ks] = o.Qf[ks]; }
    }
    const bf16_t* gB = GDN ? F.PG + (size_t)ud * 16384 + 4096 : F.PM + (size_t)ud * 10240 + 5120;
    const bf16_t* gO = GDN ? F.PG + (size_t)ud * 16384 + 12288 : F.PM + (size_t)ud * 10240;
#pragma unroll
    for (int t = 0; t < NT; ++t) { o.bv[t] = *(const v2u*)(gB + ((wq * NT + t) * 64 + lq * 16 + lr) * 4); o.ov[t] = *(const v2u*)(gO + ((wq * NT + t) * 64 + lq * 16 + lr) * 4); }
    o.gl = GDN ? F.GLG[ud] : F.GLM[ud];
    o.wi = (f32x4){1.f, 1.f, 1.f, 1.f}; if (!GDN) o.wi = *(const f32x4*)(F.WI + ud * 64 + 16 * wq + 4 * lq);
}
struct ScanFin { v2u pend[4]; unsigned short gz[4][4]; };
template <bool GDN> __device__ __forceinline__ void scan_fin_load(const Frame& F, int b, int h, int dir, int wq, int lr, int lq, int s, const float* PEND, ScanFin& f) {
    const int cidx = dir ? (s < 4 ? 3 - s : 39 - s) : s; const int row0 = chunk_row0(b, cidx);
    const float* pp = PEND + (size_t)((b * 4 + h) * 36 + cidx) * 4096 + (wq * 256 + lq * 16 + lr) * 2;
#pragma unroll
    for (int t = 0; t < 4; ++t) { f.pend[t] = *(const v2u*)(pp + t * 128);
#pragma unroll
        for (int i = 0; i < 4; ++i) f.gz[t][i] = F.Z[(size_t)(row0 + 16 * wq + 4 * lq + i) * ZW + (GDN ? ZC_GZ : ZC_LO) + h * 64 + 16 * t + lr]; }
}
__device__ __forceinline__ bool scan_first(int s) { return s < 4 ? (s <= 1) : (s <= 19); }
template <bool GDN> __device__ __forceinline__ void scan_finish(const Frame& F, int b, int h, int dir, int wq, int lr, int lq, int s, float* PEND, const f32x4 (&Oin)[4], const ScanFin& f, const float (&nwv)[4]) {
    const int cidx = dir ? (s < 4 ? 3 - s : 39 - s) : s; const int row0 = chunk_row0(b, cidx);
    float* pp = PEND + (size_t)((b * 4 + h) * 36 + cidx) * 4096 + (wq * 256 + lq * 16 + lr) * 2;
    if (scan_first(s)) {
#pragma unroll
        for (int t = 0; t < 4; ++t) *(v2u*)(pp + t * 128) = pack4(Oin[t]);
    } else {
        f32x4 O[4]; float ss[4] = {0.f, 0.f, 0.f, 0.f};
#pragma unroll
        for (int t = 0; t < 4; ++t)
            { const f32x4 pv = unpack4(f.pend[t]);
#pragma unroll
            for (int i = 0; i < 4; ++i) { O[t][i] = Oin[t][i] + pv[i]; ss[i] += O[t][i] * O[t][i]; } }
#pragma unroll
        for (int i = 0; i < 4; ++i) ss[i] = frsq(row16_sum(ss[i]) * (1.f / 64.f) + EPS);
#pragma unroll
        for (int t = 0; t < 4; ++t) { const int dv = 16 * t + lr;
#pragma unroll
            for (int i = 0; i < 4; ++i) { const int row = row0 + 16 * wq + 4 * lq + i;
                const float g = bf2f(f.gz[t][i]);
                F.MIX[(size_t)row * 1024 + (GDN ? 0 : 768) + h * 64 + dv] = (bf16_t)f2bf(O[t][i] * ss[i] * nwv[t] * g); } }
    }
}
template <bool GDN, int NT> __device__ __forceinline__ bool scan_step(const Frame& F, int b, int h, int dir, int wq, int lane, int s, LAS bf16_t* St, float* PEND, const float (&nwv)[4],
                                                                      f32x4 (&S)[NT], f32x4 (&Oprev)[4], const ScanOps<NT>& use, ScanOps<NT>& ld, ScanFin& fin, bool nofin) {
    const int lr = lane & 15, lq = lane >> 4;
    LAS bf16_t* Sb = St + ((dir * 2 + (s & 1)) * 80) * 72;
    if (s < 36) {
#pragma unroll
        for (int t = 0; t < NT; ++t) *(LAS v2u*)(Sb + (16 * t + lr) * 72 + 16 * wq + 4 * lq) = pack4(S[t]); }
    if (GDN) asm volatile("s_waitcnt vmcnt(33)" ::: "memory"); else asm volatile("s_waitcnt vmcnt(34)" ::: "memory");
    __syncthreads();
    if (s > 0) {
        const int sp = s - 1;
        if (sp == 20 || sp == 2) { asm volatile("s_waitcnt vmcnt(0)" ::: "memory"); scan_fin_load<GDN>(F, b, h, dir, wq, lr, lq, sp, PEND, fin); }
        if (!nofin) scan_finish<GDN>(F, b, h, dir, wq, lr, lq, sp, PEND, Oprev, fin, nwv);
    }
    if (s == 36) return false;
    scan_fin_load<GDN>(F, b, h, dir, wq, lr, lq, s < 35 ? s + 1 : 35, PEND, fin);
    scan_load<GDN, NT>(F, b, h, dir, wq, lr, lq, s < 34 ? s + 2 : 35, ld);
    f32x4 O[NT];
#pragma unroll
    for (int t = 0; t < NT; ++t) {
        const LAS bf16_t* sp2 = Sb + (16 * t + lr) * 72 + 8 * lq;
        const bf16x8 s0 = *(const LAS bf16x8*)sp2, s1 = *(const LAS bf16x8*)(sp2 + 32);
        f32x4 o = {0.f, 0.f, 0.f, 0.f};
        o = __builtin_amdgcn_mfma_f32_16x16x32_bf16(use.Qf[0], s0, o, 0, 0, 0); o = __builtin_amdgcn_mfma_f32_16x16x32_bf16(use.Qf[1], s1, o, 0, 0, 0);
        const f32x4 bv = unpack4(use.bv[t]), ov = unpack4(use.ov[t]);
        if (GDN) {
            f32x4 ms = {0.f, 0.f, 0.f, 0.f};
            ms = __builtin_amdgcn_mfma_f32_16x16x32_bf16(use.Mf[0], s0, ms, 0, 0, 0); ms = __builtin_amdgcn_mfma_f32_16x16x32_bf16(use.Mf[1], s1, ms, 0, 0, 0);
            S[t] = S[t] * use.gl - ms + bv; O[t] = o + ov;
        } else { S[t] = S[t] * use.gl + bv; O[t] = o * use.wi + ov; }
    }
    if (!GDN) {
#pragma unroll
        for (int i = 0; i < 4; ++i) { const float den = row16_bcast<0>(O[NT - 1][i]), fl = row16_bcast<1>(O[NT - 1][i]); const float dv = frcp(fmaxf(fabsf(den), fl));
#pragma unroll
            for (int t = 0; t < 4; ++t) O[t][i] *= dv; }
    }
#pragma unroll
    for (int t = 0; t < 4; ++t) Oprev[t] = O[t];
    return true;
}
template <bool GDN> __device__ __forceinline__ void scan_wg(const Frame& F, int l, int bh, bool nofin = false, int ko = 0) {
    constexpr int NT = GDN ? 4 : 5;
    const int b = bh >> 2, h = bh & 3;
    const int lane = fresh_lane(), dir = F.wave >> 2, wq = F.wave & 3, lr = lane & 15, lq = lane >> 4;
    LAS bf16_t* St = (LAS bf16_t*)F.lds;
    f32x4 S[NT];
#pragma unroll
    for (int t = 0; t < NT; ++t) S[t] = (f32x4){0.f, 0.f, 0.f, 0.f};
    const float* nw = GDN ? F.gdn_norm_w + l * 64 : F.mlstm_norm_w + l * 256 + h * 64;
    float nwv[4];
#pragma unroll
    for (int t = 0; t < 4; ++t) nwv[t] = nw[16 * t + lr];
    float* PEND = F.PEND + (GDN ? (size_t)0 : (size_t)1152 * 4096);
    ScanOps<NT> A0, A1, A2; ScanFin F0, F1;
    f32x4 Oprev[4];
#pragma unroll
    for (int t = 0; t < 4; ++t) { Oprev[t] = (f32x4){0.f, 0.f, 0.f, 0.f}; F0.pend[t] = (v2u){0u, 0u}; F1.pend[t] = (v2u){0u, 0u};
#pragma unroll
        for (int i = 0; i < 4; ++i) { F0.gz[t][i] = 0; F1.gz[t][i] = 0; } }
    scan_load<GDN, NT>(F, b, h, dir, wq, lr, lq, 0, A0);
    scan_load<GDN, NT>(F, b, h, dir, wq, lr, lq, 1, A1);
#pragma unroll 1
    for (int s6 = 0; s6 < 42; s6 += 6) {
        if (!scan_step<GDN, NT>(F, b, h, dir, wq, lane, s6 + 0, St, PEND, nwv, S, Oprev, A0, A2, F1, nofin)) break;
        if (!scan_step<GDN, NT>(F, b, h, dir, wq, lane, s6 + 1, St, PEND, nwv, S, Oprev, A1, A0, F0, nofin)) break;
        if (!scan_step<GDN, NT>(F, b, h, dir, wq, lane, s6 + 2, St, PEND, nwv, S, Oprev, A2, A1, F1, nofin)) break;
        if (!scan_step<GDN, NT>(F, b, h, dir, wq, lane, s6 + 3, St, PEND, nwv, S, Oprev, A0, A2, F0, nofin)) break;
        if (!scan_step<GDN, NT>(F, b, h, dir, wq, lane, s6 + 4, St, PEND, nwv, S, Oprev, A1, A0, F1, nofin)) break;
        if (!scan_step<GDN, NT>(F, b, h, dir, wq, lane, s6 + 5, St, PEND, nwv, S, Oprev, A2, A1, F0, nofin)) break;
    }
    VM_WAIT();
    __syncthreads();
}

__device__ __forceinline__ void swa_unit(const Frame& F, int l, int it, int ko = 0) {
    const bool lat = it < 256; int b, kvh, qb;
    if (lat) { b = it >> 5; kvh = (it >> 4) & 1; qb = it & 15; } else { const int j = it - 256; b = j >> 2; kvh = (j >> 1) & 1; qb = j & 1; }
    const int t_o = F.wave * 64 + fresh_lane();
    const int t = t_o, lane = t & 63, w = __builtin_amdgcn_readfirstlane(t >> 6), lr = lane & 15, lq = lane >> 4;
    const int hq = kvh * 2 + (w >> 2), wrow = (w & 3) * 32;
    const int qrow = (lat ? b * SEQ : MLAT + b * CTXL) + qb * 128 + wrow;
    LAS bf16_t* Ksh = (LAS bf16_t*)F.lds; LAS bf16_t* Vt = Ksh + 4608; LAS bf16_t* Pw = Ksh + 9216 + w * 2304;
    bf16x8 Qf[2][2];
#pragma unroll
    for (int mt = 0; mt < 2; ++mt)
#pragma unroll
        for (int ks = 0; ks < 2; ++ks) Qf[mt][ks] = *(const bf16x8*)(F.Z + (size_t)(qrow + mt * 16 + lr) * ZW + ZC_SQ + hq * 64 + 32 * ks + 8 * lq);
    const float sk = F.sink[l * 4 + hq];
    float mi[2][4], li[2][4]; f32x4 O[2][4];
#pragma unroll
    for (int mt = 0; mt < 2; ++mt)
#pragma unroll
        for (int i = 0; i < 4; ++i) { mi[mt][i] = sk; li[mt][i] = 1.f; O[mt][i] = (f32x4){0.f, 0.f, 0.f, 0.f}; }
    const int lo = lat ? (qb == 0 ? 2 : 0) : 0, nloc = lat ? ((qb == 15 ? 4 : 6) - lo) : 0, ntile = nloc + 4;
    const int sr = t >> 3, sseg = t & 7;
    v4u kreg, vreg;
    { const int krow0 = nloc > 0 ? b * SEQ + (qb - 1) * 128 + lo * 64 : MLAT + b * CTXL;
      const bf16_t* zr = F.Z + (size_t)(krow0 + sr) * ZW + kvh * 64 + sseg * 8; kreg = *(const v4u*)(zr + ZC_SK); vreg = *(const v4u*)(zr + ZC_SV); }
#pragma unroll 1
    for (int j = 0; j < ntile; ++j) {
        const bool masked = j < nloc; const int kpos0 = (qb - 1) * 128 + (lo + j) * 64;
        __syncthreads();
        { *(LAS v4u*)(Ksh + sr * 72 + sseg * 8) = kreg;
          Vt[(sseg * 8 + 0) * 72 + sr] = (bf16_t)(vreg.x & 0xffffu); Vt[(sseg * 8 + 1) * 72 + sr] = (bf16_t)(vreg.x >> 16);
          Vt[(sseg * 8 + 2) * 72 + sr] = (bf16_t)(vreg.y & 0xffffu); Vt[(sseg * 8 + 3) * 72 + sr] = (bf16_t)(vreg.y >> 16);
          Vt[(sseg * 8 + 4) * 72 + sr] = (bf16_t)(vreg.z & 0xffffu); Vt[(sseg * 8 + 5) * 72 + sr] = (bf16_t)(vreg.z >> 16);
          Vt[(sseg * 8 + 6) * 72 + sr] = (bf16_t)(vreg.w & 0xffffu); Vt[(sseg * 8 + 7) * 72 + sr] = (bf16_t)(vreg.w >> 16); }
        if (j + 1 < ntile) { const int jn = j + 1; const int krown = jn < nloc ? b * SEQ + (qb - 1) * 128 + (lo + jn) * 64 : MLAT + b * CTXL + (jn - nloc) * 64;
            const bf16_t* zr = F.Z + (size_t)(krown + sr) * ZW + kvh * 64 + sseg * 8; kreg = *(const v4u*)(zr + ZC_SK); vreg = *(const v4u*)(zr + ZC_SV); }
        __syncthreads();
        if (ko >= 3) continue;
        f32x4 sc[2][4];
#pragma unroll
        for (int nt = 0; nt < 4; ++nt) { const LAS bf16_t* kp = Ksh + (nt * 16 + lr) * 72 + 8 * lq; const bf16x8 k0 = *(const LAS bf16x8*)kp, k1 = *(const LAS bf16x8*)(kp + 32);
#pragma unroll
            for (int mt = 0; mt < 2; ++mt) { f32x4 a = {0.f, 0.f, 0.f, 0.f};
                a = __builtin_amdgcn_mfma_f32_16x16x32_bf16(Qf[mt][0], k0, a, 0, 0, 0); a = __builtin_amdgcn_mfma_f32_16x16x32_bf16(Qf[mt][1], k1, a, 0, 0, 0); sc[mt][nt] = a; } }
        if (ko >= 2) { asm volatile("" :: "v"(sc[0][0]), "v"(sc[0][1]), "v"(sc[0][2]), "v"(sc[0][3]), "v"(sc[1][0]), "v"(sc[1][1]), "v"(sc[1][2]), "v"(sc[1][3])); continue; }
#pragma unroll
        for (int mt = 0; mt < 2; ++mt) {
            float mx[4] = {-1e30f, -1e30f, -1e30f, -1e30f};
#pragma unroll
            for (int nt = 0; nt < 4; ++nt)
#pragma unroll
                for (int i = 0; i < 4; ++i) {
                    if (masked) { const int qpos = qb * 128 + wrow + mt * 16 + 4 * lq + i, kpos = kpos0 + nt * 16 + lr; const int dd = qpos - kpos; if (dd > 128 || dd < -128) sc[mt][nt][i] = -1e30f; }
                    mx[i] = fmaxf(mx[i], sc[mt][nt][i]); }
#pragma unroll
            for (int i = 0; i < 4; ++i) mx[i] = row16_max(mx[i]);
            float al[4], rsum[4];
#pragma unroll
            for (int i = 0; i < 4; ++i) { const float mn = fmaxf(mi[mt][i], mx[i]); al[i] = fexp(mi[mt][i] - mn); mi[mt][i] = mn; rsum[i] = 0.f; }
#pragma unroll
            for (int nt = 0; nt < 4; ++nt)
#pragma unroll
                for (int i = 0; i < 4; ++i) { const float p = fexp(sc[mt][nt][i] - mi[mt][i]); rsum[i] += p; Pw[(mt * 16 + 4 * lq + i) * 72 + nt * 16 + lr] = (bf16_t)f2bf(p); }
#pragma unroll
            for (int i = 0; i < 4; ++i) li[mt][i] = li[mt][i] * al[i] + row16_sum(rsum[i]);
#pragma unroll
            for (int nt = 0; nt < 4; ++nt)
#pragma unroll
                for (int i = 0; i < 4; ++i) O[mt][nt][i] *= al[i];
        }
        LDS_WAIT(); asm volatile("" ::: "memory");
#pragma unroll
        for (int nt = 0; nt < 4; ++nt) { const LAS bf16_t* vp = Vt + (nt * 16 + lr) * 72 + 8 * lq; const bf16x8 v0 = *(const LAS bf16x8*)vp, v1 = *(const LAS bf16x8*)(vp + 32);
#pragma unroll
            for (int mt = 0; mt < 2; ++mt) { const LAS bf16_t* pp = Pw + (mt * 16 + lr) * 72 + 8 * lq; const bf16x8 p0 = *(const LAS bf16x8*)pp, p1 = *(const LAS bf16x8*)(pp + 32);
                O[mt][nt] = __builtin_amdgcn_mfma_f32_16x16x32_bf16(p0, v0, O[mt][nt], 0, 0, 0); O[mt][nt] = __builtin_amdgcn_mfma_f32_16x16x32_bf16(p1, v1, O[mt][nt], 0, 0, 0); } }
    }
    if (ko == 0)
#pragma unroll
    for (int mt = 0; mt < 2; ++mt)
#pragma unroll
        for (int i = 0; i < 4; ++i) { const float inv = frcp(li[mt][i]); bf16_t* orow = F.MIX + (size_t)(qrow + mt * 16 + 4 * lq + i) * 1024 + 256 + hq * 64 + lr;
#pragma unroll
            for (int nt = 0; nt < 4; ++nt) orow[nt * 16] = (bf16_t)f2bf(O[mt][nt][i] * inv); }
    __syncthreads();
}

__device__ __forceinline__ void gmlp_unit(const Frame& F, int l, int it) {
    const int b = it / 72, c = (it >> 2) % 18, g = it & 3;
    const int r0 = c < 16 ? b * SEQ + c * 128 : MLAT + b * CTXL + (c - 16) * 128;
    const int t_o = F.wave * 64 + fresh_lane();
    const int t = t_o, lane = t & 63, w = __builtin_amdgcn_readfirstlane(t >> 6), lr = lane & 15, lq = lane >> 4;
    LAS bf16_t* Vt = (LAS bf16_t*)F.lds;
#pragma unroll
    for (int j = 0; j < 2; ++j) { const int idx = t + 512 * j, q = idx >> 3, seg = idx & 7;
        const v4u v = *(const v4u*)(F.Z + (size_t)(r0 + q) * ZW + ZC_MV + g * 64 + seg * 8);
        Vt[(seg * 8 + 0) * 136 + q] = (bf16_t)(v.x & 0xffffu); Vt[(seg * 8 + 1) * 136 + q] = (bf16_t)(v.x >> 16);
        Vt[(seg * 8 + 2) * 136 + q] = (bf16_t)(v.y & 0xffffu); Vt[(seg * 8 + 3) * 136 + q] = (bf16_t)(v.y >> 16);
        Vt[(seg * 8 + 4) * 136 + q] = (bf16_t)(v.z & 0xffffu); Vt[(seg * 8 + 5) * 136 + q] = (bf16_t)(v.z >> 16);
        Vt[(seg * 8 + 6) * 136 + q] = (bf16_t)(v.w & 0xffffu); Vt[(seg * 8 + 7) * 136 + q] = (bf16_t)(v.w >> 16); }
    __syncthreads();
    bf16x8 Af[4];
#pragma unroll
    for (int ks = 0; ks < 4; ++ks) Af[ks] = *(const bf16x8*)(F.WSP + (size_t)g * 16384 + (16 * w + lr) * 128 + 32 * ks + 8 * lq);
    f32x4 bsv = *(const f32x4*)(F.b_s + (size_t)(l * 4 + g) * 128 + 16 * w + 4 * lq);
    unsigned short uraw[4][4];
#pragma unroll
    for (int nt = 0; nt < 4; ++nt)
#pragma unroll
        for (int i = 0; i < 4; ++i) uraw[nt][i] = F.Z[(size_t)(r0 + 16 * w + 4 * lq + i) * ZW + ZC_MU + g * 64 + nt * 16 + lr];
    f32x4 accs[4];
#pragma unroll
    for (int nt = 0; nt < 4; ++nt) { f32x4 acc = {0.f, 0.f, 0.f, 0.f};
#pragma unroll
        for (int ks = 0; ks < 4; ++ks) { const bf16x8 bfr = *(const LAS bf16x8*)(Vt + (nt * 16 + lr) * 136 + 32 * ks + 8 * lq); acc = __builtin_amdgcn_mfma_f32_16x16x32_bf16(Af[ks], bfr, acc, 0, 0, 0); }
        accs[nt] = acc; }
#pragma unroll
    for (int nt = 0; nt < 4; ++nt)
#pragma unroll
        for (int i = 0; i < 4; ++i) { const int row = r0 + 16 * w + 4 * lq + i, col = g * 64 + nt * 16 + lr;
            F.MIX[(size_t)row * 1024 + 512 + col] = (bf16_t)f2bf(bf2f(uraw[nt][i]) * (accs[nt][i] + bsv[i])); }
    __syncthreads();
}

#ifndef PROBE_KIND
#define PROBE_KIND -1
#endif
#ifndef ONLY_CASE
#define ONLY_CASE -1
#endif
struct Args { const float* in[24]; float* out; unsigned char* ws; int ph_lo, ph_hi; };
constexpr int NPH = 2 + 9 * DEPTH;
__global__ void __launch_bounds__(NWAVES * 64, 2) mk_fwd(Args args) {
    extern __shared__ __attribute__((aligned(16))) unsigned char lds[];
    const int wave_s = __builtin_amdgcn_readfirstlane((int)threadIdx.x >> 6);
    const int tid_ = wave_s * 64 + fresh_lane();
    volatile LAS unsigned* MISC = (volatile LAS unsigned*)((LAS unsigned char*)lds + MISC_OFF);
    if (tid_ < 32) MISC[tid_] = 0u;
    __syncthreads();
    unsigned* barw = (unsigned*)(args.ws + WS_CTL) + CW_BAR;
    XcdBarrier bar; bar.bar = barw; bar.x = 0; bar.st = nullptr;
    const int lo = args.ph_lo, hi = args.ph_hi;
    if (hi - lo > 1) bar = xcd_barrier_post(barw, MISC + 8, tid_);

#pragma unroll 1
    for (int ph = lo; ph < hi; ++ph) {
        int zero; asm volatile("s_mov_b32 %0, 0" : "=s"(zero));
        Frame F;
        F.lds = (LAS unsigned char*)lds;
        F.wave = wave_s;
        F.G = gridDim.x; F.gw = blockIdx.x * NWAVES + F.wave; F.NGW = F.G * NWAVES;
        const float* const* inp = args.in + zero;
        unsigned char* ws = args.ws + zero;
        F.ws = ws;
        int kind, l;
        if (ph == 0) { kind = 0; l = 0; } else if (ph == NPH - 1) { kind = 10; l = DEPTH - 1; } else { l = (ph - 1) / 9; kind = 1 + (ph - 1) % 9; }
        const bool last = (l == DEPTH - 1);
        const int Mrows = last ? MLAT : MALL;
        unsigned char* wb = ws + (size_t)(l & 1) * WSET_STRIDE;
        const int nrep = (kind == PROBE_KIND) ? 2 : 1;
#pragma unroll 1
        for (int rep = 0; rep < nrep; ++rep) {
        if (rep) xcd_barrier(bar, wave_s * 64 + fresh_lane());
        switch (kind) {
        case 0: if (ONLY_CASE >= 0 && ONLY_CASE != 0) break;  F.c = inp[1]; F.cctx = inp[3]; F.ada_w = inp[4]; F.ada_b = inp[5]; F.MOD = (float*)(ws + WS_MOD); phase_mod(F); break;
        case 1: if (ONLY_CASE >= 0 && ONLY_CASE != 1) break;  F.x = inp[0]; F.ctx = inp[2]; F.norm1_w = inp[6]; F.w_in = inp[8]; F.w_out = inp[9]; F.w_s = inp[15]; F.w1 = inp[21]; F.w2 = inp[22]; F.out = args.out + zero; F.MOD = (float*)(ws + WS_MOD); F.XC = (float*)(ws + WS_XC); F.H = (bf16_t*)(ws + WS_H); F.SLAB = (float*)(ws + WS_SLAB); convert_weights(F, l, F.gw, F.NGW); phase_norm(F, l, 0, MALL, (l > 0 && !rep) ? NSPLIT_2 : 0, F.MOD + (size_t)((l > 0 ? l - 1 : 0) * 9 + 8) * 6144 + 5 * 1024); break;
        case 2: if (ONLY_CASE >= 0 && ONLY_CASE != 2) break;  F.H = (bf16_t*)(ws + WS_H); F.WIN = (bf16_t*)(wb + WS_WIN); F.Z = (bf16_t*)(ws + WS_Z); { pg8::Gemm g{F.H, F.WIN, MALL, ZW, D, D, D}; pg8::StaticOrder S; S.init(MALL, ZW, D, F.G, (int)blockIdx.x);
                  pg8::EpiBf16<0> E{F.Z, ZW}; pg8::gemm_phase<pg8::EpiBf16<0>, pg8::StaticOrder, true, true, true>(F.lds, g, S, E, wave_s * 64 + fresh_lane()); } break;
        case 3: if (ONLY_CASE >= 0 && ONLY_CASE != 3) break;  F.Z = (bf16_t*)(ws + WS_Z); F.gmlp_norm_w = inp[17]; F.ig_bias = inp[18]; F.fg_bias = inp[19]; F.CHS = (float*)(ws + WS_CHS); for (int rg = blockIdx.x; rg < MALL / 16 + 288; rg += F.G) { if (rg < MALL / 16) ew_unit(F, l, rg); else chs_unit(F, l, rg - MALL / 16); } break;
        case 4: if (ONLY_CASE >= 0 && ONLY_CASE != 4) break;  F.Z = (bf16_t*)(ws + WS_Z); F.conv_w = inp[10]; F.a_log = inp[11]; F.dt_bias = inp[12]; F.ig_bias = inp[18]; F.fg_bias = inp[19]; F.CHS = (float*)(ws + WS_CHS); F.GLG = (float*)(ws + WS_GLG); F.GLM = F.GLG + 2304; F.WI = F.GLG + 4608; F.PG = (bf16_t*)(ws + WS_PG); F.PM = (bf16_t*)(ws + WS_PM); for (int it = blockIdx.x; it < 2304; it += F.G) { if (it < 1152) { if (!rep) gdn_prep_unit(F, l, it); else if (PROBE_SUB != 2) gdn_prep_unit(F, l, it, PROBE_SUB >= 10 ? PROBE_SUB - 10 : 99, (bf16_t*)(F.ws + WS_H)); } else { if (!rep || PROBE_SUB != 1) mlstm_prep_unit(F, l, it - 1152); } } break;
        case 5: if (ONLY_CASE >= 0 && ONLY_CASE != 5) break;  F.Z = (bf16_t*)(ws + WS_Z); F.PG = (bf16_t*)(ws + WS_PG); F.PM = (bf16_t*)(ws + WS_PM); F.GLG = (float*)(ws + WS_GLG); F.GLM = F.GLG + 2304; F.WI = F.GLG + 4608; F.PEND = (float*)(ws + WS_H); F.MIX = (bf16_t*)(ws + WS_MIX); F.gdn_norm_w = inp[13]; F.mlstm_norm_w = inp[20]; F.sink = inp[14]; F.b_s = inp[16]; F.WSP = (bf16_t*)(wb + WS_WSP); { const int bx = blockIdx.x;
                  if (bx < 32) { if (!rep || PROBE_SUB == 0 || PROBE_SUB == 1 || (PROBE_SUB >= 5 && PROBE_SUB <= 8)) scan_wg<true>(F, l, bx, rep && PROBE_SUB >= 5, rep ? PROBE_SUB - 5 : 0); }
                  else if (bx < 64) { if (!rep || PROBE_SUB == 0 || PROBE_SUB == 1 || PROBE_SUB == 4 || (PROBE_SUB >= 5 && PROBE_SUB <= 8)) scan_wg<false>(F, l, bx - 32, rep && PROBE_SUB >= 5, rep ? PROBE_SUB - 5 : 0); }
                  else if (F.G == 256) {
                      const int k = bx - 64;
                      if (!rep || PROBE_SUB == 0 || PROBE_SUB == 2 || PROBE_SUB >= 9) { swa_unit(F, l, k, rep && PROBE_SUB >= 9 ? PROBE_SUB - 8 : 0); if (k < 96) swa_unit(F, l, k + 192, rep && PROBE_SUB >= 9 ? PROBE_SUB - 8 : 0); }
                      if (!rep || PROBE_SUB == 0 || PROBE_SUB == 3) { if (k < 96) gmlp_unit(F, l, k); else for (int j = 0; j < 5; ++j) gmlp_unit(F, l, 96 + (k - 96) * 5 + j); }
                  } else for (int it = bx - 64; it < 288 + 576; it += F.G - 64) { if (it < 288) swa_unit(F, l, it); else gmlp_unit(F, l, it - 288); } } break;
        case 6: case 9: { if (ONLY_CASE >= 0 && ONLY_CASE != 6) break; F.MIX = (bf16_t*)(ws + WS_MIX); F.HID = (bf16_t*)(ws + WS_HID); F.WOUT = (bf16_t*)(wb + WS_WOUT); F.W2 = (bf16_t*)(wb + WS_W2); F.out = args.out + zero; F.XC = (float*)(ws + WS_XC); F.MOD = (float*)(ws + WS_MOD);  const bool isout = (kind == 6);
                  const int Kd = isout ? D : FF;
                  pg8::Gemm g{isout ? F.MIX : F.HID, isout ? F.WOUT : F.W2, MLAT, D, Kd, Kd, Kd}; pg8::StaticOrder S; S.init(MLAT, D, Kd, F.G, (int)blockIdx.x);
                  if (!last) S.add_split(MCTX / 256, isout ? NSPLIT_OUT : NSPLIT_2, Kd);
                  pg8::EpiResid E{rep ? (float*)(F.ws + WS_H) : F.out, rep ? (float*)(F.ws + WS_H) + (size_t)MLAT * 1024 : F.XC, F.MOD + (size_t)l * 9 * 6144 + (isout ? 2 : 5) * 1024, (float*)(F.ws + WS_SLAB)};
                  pg8::gemm_phase<pg8::EpiResid, pg8::StaticOrder, true, true>(F.lds, g, S, E, wave_s * 64 + fresh_lane()); } break;
        case 7: if (ONLY_CASE >= 0 && ONLY_CASE != 7) break;  F.norm2_w = inp[7]; F.out = args.out + zero; F.MOD = (float*)(ws + WS_MOD); F.XC = (float*)(ws + WS_XC); F.H = (bf16_t*)(ws + WS_H); F.SLAB = (float*)(ws + WS_SLAB); phase_norm(F, l, 1, Mrows, (!last && !rep) ? NSPLIT_OUT : 0, F.MOD + (size_t)(l * 9 + 8) * 6144 + 2 * 1024); break;
        case 8: if (ONLY_CASE >= 0 && ONLY_CASE != 8) break;  F.H = (bf16_t*)(ws + WS_H); F.W1 = (bf16_t*)(wb + WS_W1); F.HID = (bf16_t*)(ws + WS_HID); { pg8::Gemm g{F.H, F.W1, Mrows, FF, D, D, D}; pg8::StaticOrder S; S.init(Mrows, FF, D, F.G, (int)blockIdx.x);
                  pg8::EpiBf16<1> E{F.HID, FF}; pg8::gemm_phase<pg8::EpiBf16<1>, pg8::StaticOrder, true, true, true>(F.lds, g, S, E, wave_s * 64 + fresh_lane()); } break;
        default: { F.out = args.out + zero; F.final_w = inp[23]; const bool poison = (hi - lo > 1) && (__hip_atomic_load(barw + XB_TMO, __ATOMIC_RELAXED, __HIP_MEMORY_SCOPE_AGENT) != 0u); phase_final(F, poison); } break;
        }
        }
        if (ph + 1 < hi) xcd_barrier(bar, wave_s * 64 + fresh_lane());
    }
}

extern "C" void kernel_launch(void* const* d_in, const int* in_sizes, int n_in, void* d_out, int out_size, void* d_ws, size_t ws_size, hipStream_t stream) {
    static int grid = 0;
    if (grid == 0) {
        if (n_in != 24 || out_size != MLAT * D || ws_size < WS_END) { fprintf(stderr, "kernel_launch: unexpected shapes: n_in %d out %d ws %zu (need %zu)\n", n_in, out_size, ws_size, (size_t)WS_END); grid = -1; return; }
        int dev = 0, cus = 0, per_cu = 0;
        if (hipGetDevice(&dev) != hipSuccess || hipDeviceGetAttribute(&cus, hipDeviceAttributeMultiprocessorCount, dev) != hipSuccess) { grid = -1; return; }
        if (hipFuncSetAttribute((const void*)mk_fwd, hipFuncAttributeMaxDynamicSharedMemorySize, LDS_BYTES) != hipSuccess) { fprintf(stderr, "kernel_launch: hipFuncSetAttribute failed\n"); grid = -1; return; }
        if (hipOccupancyMaxActiveBlocksPerMultiprocessor(&per_cu, (const void*)mk_fwd, NWAVES * 64, LDS_BYTES) != hipSuccess || per_cu < 1) { fprintf(stderr, "kernel_launch: occupancy query says %d\n", per_cu); grid = -1; return; }
        (void)hipGetLastError();
        grid = cus;
        if (grid < 128) { fprintf(stderr, "kernel_launch: device too small (%d CUs)\n", grid); grid = -1; return; }
    }
    if (grid < 0) return;
    (void)hipMemsetAsync((char*)d_ws + WS_CTL, 0, CTL_ZERO_BYTES, stream);
    Args a{};
    for (int i = 0; i < 24; ++i) a.in[i] = (const float*)d_in[i];
    a.out = (float*)d_out; a.ws = (unsigned char*)d_ws;
#if MK_PER_PHASE
    for (int p = 0; p < NPH; ++p) { a.ph_lo = p; a.ph_hi = p + 1; hipLaunchKernelGGL(mk_fwd, dim3(grid), dim3(NWAVES * 64), LDS_BYTES, stream, a); }
#else
    a.ph_lo = 0; a.ph_hi = NPH;
    void* kargs[] = {&a};
    hipError_t e = hipLaunchCooperativeKernel((const void*)mk_fwd, dim3(grid), dim3(NWAVES * 64), kargs, LDS_BYTES, stream);
    if (e != hipSuccess) fprintf(stderr, "kernel_launch: cooperative launch failed: %s (grid %d)\n", hipGetErrorString(e), grid);
#endif
}
```

```cpp
#include <hip/hip_runtime.h>
#include <cstdio>
#include <cstdint>
#ifndef MK_PER_PHASE
#define MK_PER_PHASE 0
#endif
#define PROBE_KIND -1
#define PROBE_SUB 0
namespace pg8 {
#define PG8_LAS __attribute__((address_space(3)))
typedef unsigned short bf16_t;
typedef short bf16x8 __attribute__((ext_vector_type(8)));
typedef float f32x4 __attribute__((ext_vector_type(4)));
typedef unsigned u32x4 __attribute__((ext_vector_type(4)));
constexpr int BM = 256, BK = 64, HALF = 128, HTB = HALF * BK * 2  , STAGE_BYTES = 8 * HTB, NXCD = 8, WGM = 8;

__host__ __device__ __forceinline__ int lds_byte(int r, int c) { const int st = (r >> 4) * 2 + (c >> 5), rr = r & 15, cc = c & 31, ob = rr * 64 + cc * 2; return st * 1024 + (ob ^ (((ob >> 9) & 1) << 5)); }
__host__ __device__ __forceinline__ void stage_rc(int b, int& R, int& C) { const int st = b / 1024, sb = b % 1024, swz = sb ^ (((sb >> 9) & 1) << 5); R = (st >> 1) * 16 + swz / 64; C = (st & 1) * 32 + (swz % 64) / 2; }
__host__ __device__ __forceinline__ int perm32(int rho) { const int n = rho >> 4, i = rho & 15; return 8 * (i >> 2) + 4 * n + (i & 3); }

struct Unit { int pm, pn, kofs, nt, slab; };
struct Gemm { const bf16_t* A; const bf16_t* Bt; int M, N, K, lda, ldb; };

struct StaticOrder {
    int nM, nN, nwg, G, c, ntk, nsp, nsplit, kslice, pm0;
    __host__ __device__ void init(int M, int N, int K, int G_, int c_) { nM = M / BM; nN = N / BM; nwg = nM * nN; G = G_; c = c_; ntk = K / BK; nsp = 0; nsplit = 1; kslice = K; pm0 = nM; }
    __host__ __device__ void add_split(int npanels, int nsplit_, int K) { nsplit = nsplit_; kslice = K / nsplit_; nsp = npanels * nN * nsplit_; }
    __host__ __device__ void map(long L, Unit& u) const {
        int wgid = (int)L; { const int q = nwg / NXCD, r = nwg % NXCD, xcd = wgid % NXCD, off = wgid / NXCD; wgid = (xcd < r ? xcd * (q + 1) : r * (q + 1) + (xcd - r) * q) + off; }
        const int nig = WGM * nN, gid = wgid / nig, fm = gid * WGM, gsz = (nM - fm) < WGM ? (nM - fm) : WGM;
        u.pm = fm + ((wgid % nig) % gsz); u.pn = (wgid % nig) / gsz; u.kofs = 0; u.nt = ntk; u.slab = 0;
    }
    __host__ __device__ bool next(int i, Unit& u) const {
        const long L = (long)i * G + c;
        if (L < nwg) { map(L, u); return true; }
        const long J = L - nwg; if (J >= nsp) return false;
        const int ks = (int)(J % nsplit), tile = (int)(J / nsplit);
        u.pn = tile % nN; u.pm = pm0 + tile / nN; u.kofs = ks * kslice; u.nt = kslice / BK; u.slab = ks + 1; return true;
    }
    __device__ __forceinline__ void a_ready(const Unit&) const {}
    __device__ __forceinline__ void done(const Unit&) const {}
};

__device__ __forceinline__ unsigned cvt_pk_bf16(float lo, float hi) { unsigned r; asm volatile("v_cvt_pk_bf16_f32 %0, %1, %2" : "=v"(r) : "v"(lo), "v"(hi)); return r; }

template <int ACT  > struct EpiBf16 {
    static constexpr bool PERM = true, AFTER_DRAIN = false;
    bf16_t* O; int ldc;
    __device__ __forceinline__ void operator()(const f32x4 (&acc)[2][2][4][2], const Unit& u, int wr, int wc, int fr, int fq) const {
        const int row0 = u.pm * BM + wr * 64 + fr; const int col0 = u.pn * BM + wc * 32 + 8 * fq;
#pragma unroll
        for (int ai = 0; ai < 2; ++ai)
#pragma unroll
            for (int m = 0; m < 4; ++m) { bf16_t* rowp = O + (size_t)(row0 + ai * HALF + m * 16) * ldc + col0;
#pragma unroll
                for (int bj = 0; bj < 2; ++bj) { f32x4 v0 = acc[ai][bj][m][0], v1 = acc[ai][bj][m][1];
                    if (ACT == 1) {
#pragma unroll
                        for (int e = 0; e < 4; ++e) { float a = fmaxf(v0[e], 0.f), b = fmaxf(v1[e], 0.f); v0[e] = a * a; v1[e] = b * b; } }
                    u32x4 w; w.x = cvt_pk_bf16(v0[0], v0[1]); w.y = cvt_pk_bf16(v0[2], v0[3]); w.z = cvt_pk_bf16(v1[0], v1[1]); w.w = cvt_pk_bf16(v1[2], v1[3]);
                    *(u32x4*)(rowp + bj * HALF) = w; } }
    }
};

struct EpiResid {
    static constexpr bool PERM = false, AFTER_DRAIN = false;
    float* xlat; float* xctx; const float* gmod; float* slab;
    __device__ __forceinline__ void operator()(const f32x4 (&acc)[2][2][4][2], const Unit& u, int wr, int wc, int fr, int fq) const {
        if (u.slab) {
            float* sb = slab + (size_t)(u.slab - 1) * 2048 * 1024 + (size_t)(u.pm - 64) * BM * 1024 + u.pn * BM + wc * 32 + 4 * fq;
#pragma unroll
            for (int ai = 0; ai < 2; ++ai)
#pragma unroll
                for (int m = 0; m < 4; ++m) { float* rowp = sb + (size_t)(ai * HALF + wr * 64 + m * 16 + fr) * 1024;
#pragma unroll
                    for (int bj = 0; bj < 2; ++bj)
#pragma unroll
                        for (int n = 0; n < 2; ++n) *(f32x4*)(rowp + bj * HALF + n * 16) = acc[ai][bj][m][n]; }
            return;
        }
        const int bm = u.pm < 64 ? (u.pm >> 3) : 8;
        float* base = u.pm < 64 ? xlat + (size_t)u.pm * BM * 1024 : xctx + (size_t)(u.pm - 64) * BM * 1024;
        const float* g = gmod + bm * 6144;
        const int col0 = u.pn * BM + wc * 32 + 4 * fq;
        f32x4 gv[2][2];
#pragma unroll
        for (int bj = 0; bj < 2; ++bj)
#pragma unroll
            for (int n = 0; n < 2; ++n) gv[bj][n] = *(const f32x4*)(g + col0 + bj * HALF + n * 16);
#pragma unroll
        for (int ai = 0; ai < 2; ++ai)
#pragma unroll
            for (int m = 0; m < 4; ++m) { float* rowp = base + (size_t)(ai * HALF + wr * 64 + m * 16 + fr) * 1024 + col0;
                f32x4 xv[2][2];
#pragma unroll
                for (int bj = 0; bj < 2; ++bj)
#pragma unroll
                    for (int n = 0; n < 2; ++n) xv[bj][n] = *(const f32x4*)(rowp + bj * HALF + n * 16);
#pragma unroll
                for (int bj = 0; bj < 2; ++bj)
#pragma unroll
                    for (int n = 0; n < 2; ++n) *(f32x4*)(rowp + bj * HALF + n * 16) = xv[bj][n] + gv[bj][n] * acc[ai][bj][m][n];
                if (m & 1) asm volatile("" ::: "memory"); }
    }
};

template <class Epi, class Sched, bool ALIGN_EPI = false, bool SP2 = false, bool UNIFORM_NT = false>
__device__ __forceinline__ void gemm_phase(PG8_LAS unsigned char* lds, const Gemm g, const Sched& S, const Epi& E, int tid_in) {
    int tid_o = tid_in; asm volatile("" : "+v"(tid_o)); const int tid = tid_o, wid = __builtin_amdgcn_readfirstlane(tid >> 6), lane = tid & 63, wr = wid >> 2, wc = wid & 3, fr = lane & 15, fq = lane >> 4;
    const int lda = g.lda, ldb = g.ldb; const int nt_uniform = g.K / BK;
    unsigned voffA[2], voffB[2];
#pragma unroll
    for (int i = 0; i < 2; ++i) { int R, C; stage_rc(tid * 16 + i * 8192, R, C); const int Rb = Epi::PERM ? ((R & ~31) + perm32(R & 31)) : R;
        voffA[i] = (unsigned)(R * lda + C) * 2u; voffB[i] = (unsigned)(Rb * ldb + C) * 2u; }
    const size_t kstep = (size_t)(BK * 2);
    const size_t hstepA = (size_t)HALF * lda * 2, hstepB = (size_t)HALF * ldb * 2;
    const size_t tstepA = 2 * hstepA, tstepB = 2 * hstepB;
    const unsigned ldsw = (unsigned)wid * 1024u;
    const int aoff = lds_byte(wr * 64 + fr, fq * 8), boff = lds_byte(wc * 32 + fr, fq * 8);
#define PG8_SA(b, h) (((b) * 2 + (h)) * HTB)
#define PG8_SB(b, h) ((4 + (b) * 2 + (h)) * HTB)
#define PG8_STAGE(bufoff, gbase, voff) do { _Pragma("unroll") for (int _i = 0; _i < 2; ++_i) \
        __builtin_amdgcn_global_load_lds((const unsigned*)((const char*)(gbase) + (voff)[_i]), (PG8_LAS unsigned*)(lds + (bufoff) + ldsw + _i * 8192), 16, 0, 0); } while (0)
#define PG8_LDA(dst, b, h) do { _Pragma("unroll") for (int m = 0; m < 4; ++m) _Pragma("unroll") for (int k = 0; k < 2; ++k) dst[m][k] = *(const PG8_LAS bf16x8*)(lds + PG8_SA(b, h) + aoff + m * 2048 + k * 1024); } while (0)
#define PG8_LDB(dst, b, h) do { _Pragma("unroll") for (int n = 0; n < 2; ++n) _Pragma("unroll") for (int k = 0; k < 2; ++k) dst[n][k] = *(const PG8_LAS bf16x8*)(lds + PG8_SB(b, h) + boff + n * 2048 + k * 1024); } while (0)
#define PG8_MMA(ai, bj, At, Bt) do { __builtin_amdgcn_s_setprio(1); _Pragma("unroll") for (int m = 0; m < 4; ++m) _Pragma("unroll") for (int n = 0; n < 2; ++n) _Pragma("unroll") for (int k = 0; k < 2; ++k) \
        acc[ai][bj][m][n] = __builtin_amdgcn_mfma_f32_16x16x32_bf16(Bt[n][k], At[m][k], acc[ai][bj][m][n], 0, 0, 0); __builtin_amdgcn_s_setprio(0); } while (0)
#define PG8_WAIT_V(n) asm volatile("s_waitcnt vmcnt(" #n ")" ::: "memory")
#define PG8_WAIT_L(n) asm volatile("s_waitcnt lgkmcnt(" #n ")" ::: "memory")
#define PG8_BAR __builtin_amdgcn_s_barrier()
#define PG8_SCHED __builtin_amdgcn_sched_barrier(0)
    Unit cur, nxt; int ui = 0;
    if (!S.next(0, cur)) return;
    f32x4 acc[2][2][4][2];
#pragma unroll
    for (int a = 0; a < 2; ++a)
#pragma unroll
        for (int b = 0; b < 2; ++b)
#pragma unroll
            for (int m = 0; m < 4; ++m)
#pragma unroll
                for (int n = 0; n < 2; ++n) acc[a][b][m][n] = (f32x4){0.f, 0.f, 0.f, 0.f};
    bf16x8 At[4][2], B0[2][2], B1[2][2];
    const char* cA = (const char*)g.A + (size_t)cur.pm * tstepA + (size_t)cur.kofs * 2; const char* cB = (const char*)g.Bt + (size_t)cur.pn * tstepB + (size_t)cur.kofs * 2;
    S.a_ready(cur);
    if constexpr (SP2) {
        PG8_STAGE(PG8_SB(0, 0), cB, voffB); PG8_STAGE(PG8_SB(0, 1), cB + hstepB, voffB); PG8_STAGE(PG8_SA(0, 0), cA, voffA); PG8_STAGE(PG8_SA(0, 1), cA + hstepA, voffA);
        if (wr == 1) PG8_BAR;
        PG8_WAIT_V(2); PG8_BAR;
        PG8_STAGE(PG8_SB(1, 0), cB + kstep, voffB); PG8_STAGE(PG8_SA(1, 0), cA + kstep, voffA); PG8_STAGE(PG8_SB(1, 1), cB + hstepB + kstep, voffB);
        PG8_WAIT_V(6); PG8_BAR;
    } else {
        PG8_STAGE(PG8_SB(0, 0), cB, voffB); PG8_STAGE(PG8_SA(0, 0), cA, voffA); PG8_STAGE(PG8_SB(0, 1), cB + hstepB, voffB); PG8_STAGE(PG8_SA(0, 1), cA + hstepA, voffA);
        if (wr == 1) PG8_BAR;
        PG8_WAIT_V(4); PG8_BAR;
        PG8_STAGE(PG8_SB(1, 0), cB + kstep, voffB); PG8_STAGE(PG8_SA(1, 0), cA + kstep, voffA); PG8_STAGE(PG8_SB(1, 1), cB + hstepB + kstep, voffB);
        PG8_WAIT_V(6); PG8_BAR;
    }
    for (;;) {
        const bool has_next = S.next(ui + 1, nxt);
        const char* nA = has_next ? (const char*)g.A + (size_t)nxt.pm * tstepA + (size_t)nxt.kofs * 2 : cA; const char* nB = has_next ? (const char*)g.Bt + (size_t)nxt.pn * tstepB + (size_t)nxt.kofs * 2 : cB;
        const int nt = UNIFORM_NT ? nt_uniform : cur.nt;
        for (int t = 0; t < nt; t += 2) {
            const bool last = (t == nt - 2);
            const char* a1 = cA + (size_t)(t + 1) * kstep;
            const char* a2 = last ? nA : cA + (size_t)(t + 2) * kstep; const char* b2 = last ? nB : cB + (size_t)(t + 2) * kstep;
            const char* a3 = a2 + kstep; const char* b3 = b2 + kstep;
            if (last && has_next) S.a_ready(nxt);
            if constexpr (SP2) {
            PG8_LDB(B0, 0, 0); PG8_LDB(B1, 0, 1); PG8_SCHED; PG8_LDA(At, 0, 0); PG8_STAGE(PG8_SA(1, 1), a1 + hstepA, voffA);
            PG8_WAIT_V(8); PG8_WAIT_L(0); PG8_BAR; PG8_MMA(0, 0, At, B0); PG8_MMA(0, 1, At, B1); PG8_BAR; PG8_SCHED;
            PG8_LDA(At, 0, 1); PG8_STAGE(PG8_SB(0, 0), b2, voffB); PG8_STAGE(PG8_SB(0, 1), b2 + hstepB, voffB); PG8_STAGE(PG8_SA(0, 0), a2, voffA);
            PG8_WAIT_V(8); PG8_WAIT_L(0); PG8_BAR; PG8_MMA(1, 0, At, B0); PG8_MMA(1, 1, At, B1); PG8_BAR; PG8_SCHED;
            PG8_LDB(B0, 1, 0); PG8_LDB(B1, 1, 1); PG8_SCHED; PG8_LDA(At, 1, 0); PG8_STAGE(PG8_SA(0, 1), a2 + hstepA, voffA);
            PG8_WAIT_V(8); PG8_WAIT_L(0); PG8_BAR; PG8_MMA(0, 0, At, B0); PG8_MMA(0, 1, At, B1); PG8_BAR; PG8_SCHED;
            PG8_LDA(At, 1, 1); PG8_STAGE(PG8_SB(1, 0), b3, voffB); PG8_STAGE(PG8_SB(1, 1), b3 + hstepB, voffB); PG8_STAGE(PG8_SA(1, 0), a3, voffA);
            PG8_WAIT_V(8); PG8_WAIT_L(0); PG8_BAR; PG8_MMA(1, 0, At, B0); PG8_MMA(1, 1, At, B1); PG8_BAR; PG8_SCHED;
            } else {
            PG8_LDB(B0, 0, 0); PG8_SCHED; PG8_LDA(At, 0, 0); PG8_STAGE(PG8_SA(1, 1), a1 + hstepA, voffA);
            PG8_WAIT_L(8); PG8_BAR; PG8_WAIT_L(0); PG8_MMA(0, 0, At, B0); PG8_BAR; PG8_SCHED;
            PG8_LDB(B1, 0, 1); PG8_STAGE(PG8_SB(0, 0), b2, voffB);
            PG8_BAR; PG8_WAIT_L(0); PG8_MMA(0, 1, At, B1); PG8_BAR;
            PG8_LDA(At, 0, 1); PG8_STAGE(PG8_SA(0, 0), a2, voffA);
            PG8_BAR; PG8_WAIT_L(0); PG8_MMA(1, 0, At, B0); PG8_BAR; PG8_SCHED;
            PG8_STAGE(PG8_SB(0, 1), b2 + hstepB, voffB);
            PG8_WAIT_V(6); PG8_BAR; PG8_MMA(1, 1, At, B1); PG8_BAR;
            PG8_LDB(B0, 1, 0); PG8_SCHED; PG8_LDA(At, 1, 0); PG8_STAGE(PG8_SA(0, 1), a2 + hstepA, voffA);
            PG8_WAIT_L(8); PG8_BAR; PG8_WAIT_L(0); PG8_MMA(0, 0, At, B0); PG8_BAR; PG8_SCHED;
            PG8_LDB(B1, 1, 1); PG8_STAGE(PG8_SB(1, 0), b3, voffB);
            PG8_BAR; PG8_WAIT_L(0); PG8_MMA(0, 1, At, B1); PG8_BAR;
            PG8_LDA(At, 1, 1); PG8_STAGE(PG8_SA(1, 0), a3, voffA);
            PG8_BAR; PG8_WAIT_L(0); PG8_MMA(1, 0, At, B0); PG8_BAR; PG8_SCHED;
            PG8_STAGE(PG8_SB(1, 1), b3 + hstepB, voffB);
            PG8_WAIT_V(6); PG8_BAR; PG8_MMA(1, 1, At, B1); PG8_BAR;
            }
        }
        if constexpr (ALIGN_EPI) { if (wr == 0) PG8_BAR; }
        if constexpr (!Epi::AFTER_DRAIN) { E(acc, cur, wr, wc, fr, fq); S.done(cur); }
        if (!has_next) break;
#pragma unroll
        for (int a = 0; a < 2; ++a)
#pragma unroll
            for (int b = 0; b < 2; ++b)
#pragma unroll
                for (int m = 0; m < 4; ++m)
#pragma unroll
                    for (int n = 0; n < 2; ++n) acc[a][b][m][n] = (f32x4){0.f, 0.f, 0.f, 0.f};
        cur = nxt; cA = nA; cB = nB; ++ui;
        if constexpr (ALIGN_EPI) { if (wr == 1) PG8_BAR; }
    }
    PG8_WAIT_V(0);
    if constexpr (!ALIGN_EPI) { if (wr == 0) PG8_BAR; }
    PG8_BAR;
    if constexpr (Epi::AFTER_DRAIN) { E.fused(acc, cur, wr, wc, fr, fq, lds, wid, lane); S.done(cur); }
#undef PG8_SA
#undef PG8_SB
#undef PG8_STAGE
#undef PG8_LDA
#undef PG8_LDB
#undef PG8_MMA
#undef PG8_WAIT_V
#undef PG8_WAIT_L
#undef PG8_BAR
#undef PG8_SCHED
}
}
constexpr int NWAVES = 8;
constexpr int NB = 8, SEQ = 2048, CTXL = 256, D = 1024, DEPTH = 4, FF = 4096;
constexpr int MLAT = NB * SEQ, MCTX = NB * CTXL, MALL = MLAT + MCTX;
constexpr int ZW = 3328;
constexpr int ZC_GQ = 0, ZC_GK = 256, ZC_GV = 512, ZC_GZ = 768, ZC_SQ = 1024, ZC_SK = 1280, ZC_SV = 1408, ZC_MU = 1536, ZC_MV = 1792,
              ZC_LQ = 2048, ZC_LK = 2304, ZC_LV = 2560, ZC_LO = 2816, ZC_GA = 3072, ZC_GB = 3080, ZC_LI = 3088, ZC_LF = 3096;
constexpr float EPS = 1e-6f;
constexpr size_t MiB = 1u << 20;
constexpr size_t WS_CTL = 0, CTL_ZERO_BYTES = 65536;
constexpr size_t WS_MOD = 1 * MiB;
constexpr size_t WS_WIN = 2 * MiB, WS_WOUT = 9 * MiB, WS_W1 = 11 * MiB, WS_W2 = 19 * MiB, WS_WSP = 27 * MiB;
constexpr size_t WS_CHS = 27 * MiB + 512 * 1024;
constexpr size_t WS_GLG = 27 * MiB + 768 * 1024;
constexpr size_t WS_XC = 29 * MiB;
constexpr size_t WS_H = 37 * MiB;
constexpr size_t WS_MIX = 73 * MiB;
constexpr size_t WS_Z = 109 * MiB;
constexpr size_t WS_PG = 226 * MiB;
constexpr size_t WS_PM = 298 * MiB;
constexpr size_t WS_HID = 109 * MiB;
constexpr size_t WS_SLAB = 254 * MiB;
constexpr size_t WS_WSET2 = 343 * MiB;
constexpr size_t WSET_STRIDE = WS_WSET2 - 2 * MiB;
constexpr size_t WS_END = 369 * MiB;
constexpr int NSPLIT_OUT = 2, NSPLIT_2 = 4;
constexpr int CONV_SPLIT0 = 0, CONV_SPLIT = 3000;
constexpr int CW_BAR = 1024;
constexpr int LDS_BYTES = 147456;
constexpr int MISC_OFF = 131072 + 8192;

#define LAS __attribute__((address_space(3)))
typedef unsigned short bf16_t;
typedef unsigned v4u __attribute__((ext_vector_type(4)));
typedef unsigned v2u __attribute__((ext_vector_type(2)));
typedef float f32x4 __attribute__((ext_vector_type(4)));
typedef short bf16x8 __attribute__((ext_vector_type(8)));
#define LDS_WAIT() asm volatile("s_waitcnt lgkmcnt(0)" ::: "memory")
#define VM_WAIT() asm volatile("s_waitcnt vmcnt(0)" ::: "memory")
typedef float f32x2_ __attribute__((ext_vector_type(2)));
typedef __bf16 bf16x2_ __attribute__((ext_vector_type(2)));
__device__ __forceinline__ unsigned pk2(float lo, float hi) { const f32x2_ v = {lo, hi}; const bf16x2_ r = __builtin_convertvector(v, bf16x2_); return __builtin_bit_cast(unsigned, r); }
__device__ __forceinline__ unsigned f2bf(float f) { return pk2(f, 0.f) & 0xffffu; }
__device__ __forceinline__ float bf2f(unsigned v) { return __builtin_bit_cast(float, v << 16); }
__device__ __forceinline__ float bflo(unsigned w) { return __builtin_bit_cast(float, w << 16); }
__device__ __forceinline__ float bfhi(unsigned w) { return __builtin_bit_cast(float, w & 0xffff0000u); }
template <int CTRL> __device__ __forceinline__ float dppf(float x) { return __builtin_bit_cast(float, __builtin_amdgcn_update_dpp(0, __builtin_bit_cast(int, x), CTRL, 0xF, 0xF, true)); }
__device__ __forceinline__ float row16_sum(float v) { v += dppf<0xB1>(v); v += dppf<0x4E>(v); v += dppf<0x141>(v); v += dppf<0x140>(v); return v; }
__device__ __forceinline__ float row16_max(float v) { v = fmaxf(v, dppf<0xB1>(v)); v = fmaxf(v, dppf<0x4E>(v)); v = fmaxf(v, dppf<0x141>(v)); v = fmaxf(v, dppf<0x140>(v)); return v; }
__device__ __forceinline__ float quad_sum(float v) { v += dppf<0xB1>(v); v += dppf<0x4E>(v); return v; }
template <int N> __device__ __forceinline__ float row16_bcast(float v) { return dppf<0x150 + N>(v); }
__device__ __forceinline__ float wave_sum(float v) { v = row16_sum(v); v += __shfl_xor(v, 16); v += __shfl_xor(v, 32); return v; }
__device__ __forceinline__ float frcp(float x) { return __builtin_amdgcn_rcpf(x); }
__device__ __forceinline__ float frsq(float x) { return __builtin_amdgcn_rsqf(x); }
__device__ __forceinline__ float fexp(float x) { return __builtin_amdgcn_exp2f(x * 1.4426950408889634f); }
__device__ __forceinline__ float flog1p(float y) { return y < 0.02f ? y * (1.0f - y * (0.5f - y * (0.33333333f - 0.25f * y))) : __builtin_amdgcn_logf(1.0f + y) * 0.6931471805599453f; }
__device__ __forceinline__ float sigmoidf_(float x) { return frcp(1.f + fexp(-x)); }
__device__ __forceinline__ float siluf_(float x) { return x * frcp(1.f + fexp(-x)); }
__device__ __forceinline__ float softplusf_(float x) { return x > 20.f ? x : flog1p(fexp(x)); }
__device__ __forceinline__ float logsigf_(float x) { return x >= 0.f ? -flog1p(fexp(-x)) : x - flog1p(fexp(x)); }
__device__ __forceinline__ float geluf_(float x) { const float u = 0.7978845608028654f * (x + 0.044715f * x * x * x); const float th = 1.0f - 2.0f * frcp(1.0f + fexp(2.0f * u)); return 0.5f * x * (1.f + th); }
template <int KS> __device__ __forceinline__ f32x4 mma_ll(const LAS bf16_t* A, int lda, const LAS bf16_t* Bt, int ldb, f32x4 acc, int lane) {
    const LAS bf16_t* ap = A + (lane & 15) * lda + 8 * (lane >> 4);
    const LAS bf16_t* bp = Bt + (lane & 15) * ldb + 8 * (lane >> 4);
#pragma unroll
    for (int ks = 0; ks < KS; ++ks) {
        const bf16x8 a = *(const LAS bf16x8*)(ap + 32 * ks); const bf16x8 b = *(const LAS bf16x8*)(bp + 32 * ks);
        acc = __builtin_amdgcn_mfma_f32_16x16x32_bf16(a, b, acc, 0, 0, 0);
    }
    return acc;
}
__device__ __forceinline__ v2u pack4(const f32x4 v) { v2u r; r.x = pk2(v[0], v[1]); r.y = pk2(v[2], v[3]); return r; }
__device__ __forceinline__ f32x4 unpack4(const v2u w) { f32x4 r; r[0] = bflo(w.x); r[1] = bfhi(w.x); r[2] = bflo(w.y); r[3] = bfhi(w.y); return r; }
__device__ __forceinline__ int chunk_row0(int b, int cidx) { return cidx < 4 ? MLAT + b * CTXL + cidx * 64 : b * SEQ + (cidx - 4) * 64; }

#define XB_TMO      128
#define XB_XCNT(j)  (256  + 64 * (j))
#define XB_XSUB(j)  (1280 + 64 * (j))
#define XB_XGEN(j)  (2304 + 64 * (j))
#define XB_TOP      3328
#define XB_TOPGEN   3392
#define XCD_BAR_WORDS 3456
#define XB_SPIN_CAP (1u << 18)

__device__ __forceinline__ unsigned xb_ld(unsigned* p)              { return __hip_atomic_load(p, __ATOMIC_RELAXED, __HIP_MEMORY_SCOPE_AGENT); }
__device__ __forceinline__ unsigned xb_add(unsigned* p, unsigned v) { return __hip_atomic_fetch_add(p, v, __ATOMIC_RELAXED, __HIP_MEMORY_SCOPE_AGENT); }
__device__ __forceinline__ unsigned xb_xcc_id() { return (unsigned)__builtin_amdgcn_s_getreg((3 << 11) | 20) & 0xFu; }
#define XB_SPIN(cond, bar) do { unsigned _sp = 0; while (cond) { __builtin_amdgcn_s_sleep(1); \
    if ((++_sp & 255u) == 0u) { if (xb_ld(&(bar)[XB_TMO])) break; if (_sp > XB_SPIN_CAP) { atomicAdd(&(bar)[XB_TMO], 1u); break; } } } } while (0)

struct XcdBarrier {
    unsigned* bar; unsigned x;
    volatile LAS unsigned* st;
};

__device__ __forceinline__ XcdBarrier xcd_barrier_post(unsigned* bar, volatile LAS unsigned* st, int tid) {
    XcdBarrier b; b.bar = bar; b.x = xb_xcc_id(); b.st = st;
    if (tid == 0) (void)xb_add(&bar[XB_XCNT(b.x)], 1u);
    return b;
}
__device__ __forceinline__ void xcd_barrier_complete(unsigned* bar, unsigned x, unsigned& nloc, unsigned& nx) {
    const unsigned G = gridDim.x * gridDim.y * gridDim.z;
    unsigned sum, cnt, mine, sp = 0u;
    for (;;) {
        sum = 0u; cnt = 0u; mine = 0u;
#pragma unroll
        for (unsigned j = 0; j < 16; ++j) { const unsigned c = xb_ld(&bar[XB_XCNT(j)]); sum += c; cnt += (c > 0u) ? 1u : 0u; mine = (j == x) ? c : mine; }
        if (sum == G) break;
        __builtin_amdgcn_s_sleep(1);
        if ((++sp & 255u) == 0u) { if (xb_ld(&bar[XB_TMO])) break; if (sp > XB_SPIN_CAP) { atomicAdd(&bar[XB_TMO], 1u); break; } }
    }
    nloc = mine > 0u ? mine : 1u; nx = cnt > 0u ? cnt : 1u;
}

__device__ __forceinline__ void xcd_barrier(const XcdBarrier& b, int tid) {
    asm volatile("s_waitcnt vmcnt(0)" ::: "memory");
    __syncthreads();
    if (tid == 0) {
        unsigned* bar = b.bar;
        __builtin_amdgcn_s_waitcnt(0);
        unsigned nloc = b.st[0], nx = b.st[1];
        if (nloc == 0u) { xcd_barrier_complete(bar, b.x, nloc, nx); b.st[0] = nloc; b.st[1] = nx; }
        const unsigned old = xb_add(&bar[XB_XSUB(b.x)], 1u);
        const unsigned gen = old / nloc;
        if (old + 1u == (gen + 1u) * nloc) {
            __builtin_amdgcn_fence(__ATOMIC_RELEASE, "agent");
            asm volatile("s_waitcnt vmcnt(0)" ::: "memory");
            const unsigned og = xb_add(&bar[XB_TOP], 1u);
            const unsigned tg = og / nx;
            if (og + 1u == (tg + 1u) * nx) xb_add(&bar[XB_TOPGEN], 1u);
            else XB_SPIN(xb_ld(&bar[XB_TOPGEN]) == tg, bar);
            __builtin_amdgcn_fence(__ATOMIC_ACQUIRE, "agent");
            xb_add(&bar[XB_XGEN(b.x)], 1u);
            asm volatile("s_waitcnt vmcnt(0)" ::: "memory");
        } else {
            XB_SPIN(xb_ld(&bar[XB_XGEN(b.x)]) == gen, bar);
            __builtin_amdgcn_fence(__ATOMIC_ACQUIRE, "agent");
            asm volatile("s_waitcnt vmcnt(0)" ::: "memory");
        }
    }
    __syncthreads();
}

struct Frame {
    LAS unsigned char* lds;
    int wave, G, gw, NGW;
    const float *x, *c, *ctx, *cctx, *ada_w, *ada_b, *norm1_w, *norm2_w, *w_in, *w_out, *conv_w, *a_log, *dt_bias, *gdn_norm_w, *sink, *w_s, *b_s,
                *gmlp_norm_w, *ig_bias, *fg_bias, *mlstm_norm_w, *w1, *w2, *final_w;
    float* out; unsigned char* ws;
    float *MOD, *XC, *CHS, *GLG, *GLM, *WI, *PEND, *SLAB;
    bf16_t *WIN, *WOUT, *W1, *W2, *WSP, *H, *MIX, *Z, *PG, *PM, *HID;
};

__device__ __forceinline__ int fresh_lane() { int t; asm volatile("v_mbcnt_lo_u32_b32 %0, -1, 0\n\tv_mbcnt_hi_u32_b32 %0, -1, %0" : "=v"(t)); return t; }
__device__ __forceinline__ void phase_mod(const Frame& F) {
    LAS float* sact = (LAS float*)F.lds;
    LAS float* part = sact + 9 * 1024;
    const int lane0 = fresh_lane(), tid0 = F.wave * 64 + lane0;
    for (int i = tid0; i < 9 * 1024; i += NWAVES * 64) { const float v = i < 8192 ? F.c[i] : F.cctx[i - 8192]; sact[i] = v * frcp(1.f + fexp(-v)); }
    __syncthreads();
    for (int task = blockIdx.x; task < DEPTH * 48; task += F.G) {
        const int lane = fresh_lane(), tid = F.wave * 64 + lane;
        const int l = task / 48, cg = task % 48, col = cg * 128 + 2 * lane, k0 = F.wave * 128;
        const float* w = F.ada_w + (size_t)l * 1024 * 6144 + (size_t)k0 * 6144 + col;
        float a0[9], a1[9];
#pragma unroll
        for (int b = 0; b < 9; ++b) { a0[b] = 0.f; a1[b] = 0.f; }
#pragma unroll 8
        for (int k = 0; k < 128; ++k) { const f32x2_ wv = *(const f32x2_*)(w + (size_t)k * 6144);
#pragma unroll
            for (int b = 0; b < 9; ++b) { const float sv = sact[b * 1024 + k0 + k]; a0[b] += sv * wv[0]; a1[b] += sv * wv[1]; } }
#pragma unroll
        for (int b = 0; b < 9; ++b) { part[(F.wave * 9 + b) * 128 + 2 * lane] = a0[b]; part[(F.wave * 9 + b) * 128 + 2 * lane + 1] = a1[b]; }
        __syncthreads();
        for (int o = tid; o < 9 * 128; o += NWAVES * 64) { const int b = o >> 7, cc = o & 127; float s = F.ada_b[l * 6144 + cg * 128 + cc];
#pragma unroll
            for (int wv = 0; wv < 8; ++wv) s += part[(wv * 9 + b) * 128 + cc];
            F.MOD[(l * 9 + b) * 6144 + cg * 128 + cc] = s; }
        __syncthreads();
    }
}

__device__ __forceinline__ void transpose_item(const float* W, int K, int N, int Ndst, bf16_t* WT, LAS float* scr, int item, int lane, bool remap) {
    const int nblk = Ndst / 32, kb = item / nblk, nb = item % nblk, k0 = 64 * kb, n0 = 32 * nb;
    const int n = n0 + (lane & 31);
    const int src = remap ? (n < 1024 ? n : n < 3072 ? n + 16 : n < 3088 ? n - 2048 : n < 3104 ? n : -1) : n;
    float wv[32]; const int srcc = src >= 0 ? src : 0;
#pragma unroll
    for (int i = 0; i < 32; ++i) wv[i] = W[(size_t)(k0 + 2 * i + (lane >> 5)) * N + srcc];
#pragma unroll
    for (int i = 0; i < 32; ++i) scr[(2 * i + (lane >> 5)) * 33 + (lane & 31)] = src >= 0 ? wv[i] : 0.f;
    LDS_WAIT(); asm volatile("" ::: "memory");
    const int c = lane & 7;
#pragma unroll
    for (int j = 0; j < 4; ++j) { const int nn = (lane >> 3) + 8 * j; const LAS float* s = scr + (8 * c) * 33 + nn;
        v4u o; o.x = pk2(s[0 * 33], s[1 * 33]); o.y = pk2(s[2 * 33], s[3 * 33]); o.z = pk2(s[4 * 33], s[5 * 33]); o.w = pk2(s[6 * 33], s[7 * 33]);
        *(v4u*)(WT + (size_t)(n0 + nn) * K + k0 + 8 * c) = o; }
    LDS_WAIT(); asm volatile("" ::: "memory");
}
__device__ __forceinline__ void convert_weights(const Frame& F, int l, int gw, int ngw, int item_lo, int item_hi) {
    LAS float* scr = (LAS float*)(F.lds + F.wave * 16384);
    unsigned char* wb = F.ws + (size_t)(l & 1) * WSET_STRIDE;
    bf16_t* dWIN = (bf16_t*)(wb + WS_WIN); bf16_t* dWOUT = (bf16_t*)(wb + WS_WOUT); bf16_t* dW1 = (bf16_t*)(wb + WS_W1); bf16_t* dW2 = (bf16_t*)(wb + WS_W2); bf16_t* dWSP = (bf16_t*)(wb + WS_WSP);
    constexpr int I_IN = 16 * (ZW / 32), I_OUT = 16 * 32, I_1 = 16 * 128, I_2 = 64 * 32, I_S = 128;
    for (int it = item_lo + gw; it < item_hi; it += ngw) {
        int r = it; const int lane = fresh_lane();
        if (r < I_IN) { transpose_item(F.w_in + (size_t)l * 1024 * 3104, 1024, 3104, ZW, dWIN, scr, r, lane, true); continue; } r -= I_IN;
        if (r < I_OUT) { transpose_item(F.w_out + (size_t)l * 1024 * 1024, 1024, 1024, 1024, dWOUT, scr, r, lane, false); continue; } r -= I_OUT;
        if (r < I_1) { transpose_item(F.w1 + (size_t)l * 1024 * 4096, 1024, 4096, 4096, dW1, scr, r, lane, false); continue; } r -= I_1;
        if (r < I_2) { transpose_item(F.w2 + (size_t)l * 4096 * 1024, 4096, 1024, 1024, dW2, scr, r, lane, false); continue; } r -= I_2;
        { const float* s = F.w_s + (size_t)l * 65536 + r * 512 + lane * 8; const f32x4 a = *(const f32x4*)s, b = *(const f32x4*)(s + 4);
          v4u o; o.x = pk2(a[0], a[1]); o.y = pk2(a[2], a[3]); o.z = pk2(b[0], b[1]); o.w = pk2(b[2], b[3]); *(v4u*)(dWSP + r * 512 + lane * 8) = o; }
    }
}

__device__ __forceinline__ void phase_norm(const Frame& F, int l, int which, int nrows, int nslab, const float* sgate) {
    const float* nwp = (which == 0 ? F.norm1_w : F.norm2_w) + l * 1024;
    const bool init = (which == 0 && l == 0);
    const int lane = fresh_lane();
    f32x4 nwv[4];
#pragma unroll
    for (int j = 0; j < 4; ++j) nwv[j] = *(const f32x4*)(nwp + 256 * j + 4 * lane);
    int m = F.gw; if (m >= nrows) return;
    f32x4 v[4], vn[4];
    { const bool lat = m < MLAT; const float* src = init ? (lat ? F.x + (size_t)m * 1024 : F.ctx + (size_t)(m - MLAT) * 1024) : (lat ? F.out + (size_t)m * 1024 : F.XC + (size_t)(m - MLAT) * 1024);
#pragma unroll
      for (int j = 0; j < 4; ++j) v[j] = *(const f32x4*)(src + 256 * j + 4 * lane); }
    for (; m < nrows; m += F.NGW) {
        const bool lat = m < MLAT; const int bm = lat ? (m >> 11) : 8;
        float* xrow = lat ? F.out + (size_t)m * 1024 : F.XC + (size_t)(m - MLAT) * 1024;
        const float* mod = F.MOD + (l * 9 + bm) * 6144 + (which == 0 ? 0 : 3 * 1024);
        f32x4 shv[4], scv[4];
#pragma unroll
        for (int j = 0; j < 4; ++j) { const int col = 256 * j + 4 * lane; shv[j] = *(const f32x4*)(mod + col); scv[j] = *(const f32x4*)(mod + 1024 + col); }
        const int mn = m + F.NGW;
        if (mn < nrows) { const bool latn = mn < MLAT; const float* srcn = init ? (latn ? F.x + (size_t)mn * 1024 : F.ctx + (size_t)(mn - MLAT) * 1024) : (latn ? F.out + (size_t)mn * 1024 : F.XC + (size_t)(mn - MLAT) * 1024);
#pragma unroll
            for (int j = 0; j < 4; ++j) vn[j] = *(const f32x4*)(srcn + 256 * j + 4 * lane); }
        const bool red = !lat && nslab > 0;
        if (red) {
#pragma unroll
            for (int j = 0; j < 4; ++j) { f32x4 a = {0.f, 0.f, 0.f, 0.f};
                for (int k = 0; k < nslab; ++k) a += *(const f32x4*)(F.SLAB + ((size_t)k * MCTX + (m - MLAT)) * 1024 + 256 * j + 4 * lane);
                v[j] += a * *(const f32x4*)(sgate + 256 * j + 4 * lane); }
        }
        float s = 0.f;
#pragma unroll
        for (int j = 0; j < 4; ++j) s += (v[j][0] * v[j][0] + v[j][1] * v[j][1]) + (v[j][2] * v[j][2] + v[j][3] * v[j][3]);
        const float rstd = frsq(wave_sum(s) * (1.f / 1024.f) + EPS);
#pragma unroll
        for (int j = 0; j < 4; ++j) {
            const int col = 256 * j + 4 * lane;
            if (init || red) *(f32x4*)(xrow + col) = v[j];
            const f32x4 hh = (v[j] * rstd * nwv[j]) * (scv[j] + 1.0f) + shv[j];
            *(v2u*)(F.H + (size_t)m * 1024 + col) = pack4(hh);
        }
#pragma unroll
        for (int j = 0; j < 4; ++j) v[j] = vn[j];
    }
}
__device__ __forceinline__ void phase_final(const Frame& F, bool poison) {
    for (int m = F.gw; m < MLAT; m += F.NGW) {
        const int lane = fresh_lane();
        float* xrow = F.out + (size_t)m * 1024;
        f32x4 v[4]; float s = 0.f;
#pragma unroll
        for (int j = 0; j < 4; ++j) { v[j] = *(const f32x4*)(xrow + 256 * j + 4 * lane); s += (v[j][0] * v[j][0] + v[j][1] * v[j][1]) + (v[j][2] * v[j][2] + v[j][3] * v[j][3]); }
        float rstd = frsq(wave_sum(s) * (1.f / 1024.f) + EPS);
        if (poison) rstd = __builtin_nanf("");
        f32x4 nwv[4];
#pragma unroll
        for (int j = 0; j < 4; ++j) nwv[j] = *(const f32x4*)(F.final_w + 256 * j + 4 * lane);
#pragma unroll
        for (int j = 0; j < 4; ++j) *(f32x4*)(xrow + 256 * j + 4 * lane) = v[j] * rstd * nwv[j];
    }
}

__device__ __forceinline__ void ew_unit(const Frame& F, int l, int rg) {
    const int r0 = rg * 16;
    const int t_o = F.wave * 64 + fresh_lane();
    const int tid = t_o, lane_ = t_o & 63, wave_ = __builtin_amdgcn_readfirstlane(t_o >> 6);
    unsigned short ra[6], rb[6];
#pragma unroll
    for (int j = 0; j < 6; ++j) { const int idx = tid + 512 * j, rr = idx / 192, pr = idx % 192, hd = pr >> 5, f = pr & 31;
        const bf16_t* p = F.Z + (size_t)(r0 + rr) * ZW + (hd < 4 ? ZC_SQ + hd * 64 : ZC_SK + (hd - 4) * 64) + f; ra[j] = p[0]; rb[j] = p[32]; }
#pragma unroll
    for (int j = 0; j < 6; ++j) {
        const int idx = tid + 512 * j, rr = idx / 192, pr = idx % 192, hd = pr >> 5, f = pr & 31, row = r0 + rr;
        bf16_t* p = F.Z + (size_t)row * ZW + (hd < 4 ? ZC_SQ + hd * 64 : ZC_SK + (hd - 4) * 64) + f;
        const float t1 = bf2f(ra[j]), t2 = bf2f(rb[j]);
        if (row < MLAT) {
            const int t = row & (SEQ - 1); const float pos = (float)(f < 16 ? (t >> 6) : (t & 63));
            const float inv = __builtin_amdgcn_exp2f(-(float)(f & 15) * 0.8304820237218406f);
            const float rev = pos * inv * 0.15915494309189535f; const float cs = __builtin_amdgcn_cosf(rev), sn = __builtin_amdgcn_sinf(rev);
            const float sc = hd < 4 ? 0.125f : 1.0f;
            p[0] = (bf16_t)f2bf((t1 * cs - t2 * sn) * sc); p[32] = (bf16_t)f2bf((t1 * sn + t2 * cs) * sc);
        } else if (hd < 4) {
            p[0] = (bf16_t)f2bf(t1 * 0.125f); p[32] = (bf16_t)f2bf(t2 * 0.125f);
        }
    }
    { v4u gr[2]; bf16_t* gp[2];
#pragma unroll
      for (int j = 0; j < 2; ++j) { const int g = tid + 512 * j, rr = g >> 6, seg = g & 63; gp[j] = F.Z + (size_t)(r0 + rr) * ZW + (seg < 32 ? ZC_GZ + seg * 8 : ZC_LO + (seg - 32) * 8); gr[j] = *(const v4u*)gp[j]; }
#pragma unroll
      for (int j = 0; j < 2; ++j) { const bool isz = ((tid + 512 * j) & 63) < 32; v4u o; unsigned* oi = (unsigned*)&o; const unsigned* gi = (const unsigned*)&gr[j];
#pragma unroll
          for (int e = 0; e < 4; ++e) { const float a = bflo(gi[e]), bb = bfhi(gi[e]); const float sa = sigmoidf_(a), sb = sigmoidf_(bb); oi[e] = isz ? pk2(a * sa, bb * sb) : pk2(sa, sb); }
          *(v4u*)gp[j] = o; } }
    v2u ur[2], vr[2];
#pragma unroll
    for (int j = 0; j < 2; ++j) { const bf16_t* zr = F.Z + (size_t)(r0 + 2 * wave_ + j) * ZW + 4 * lane_; ur[j] = *(const v2u*)(zr + ZC_MU); vr[j] = *(const v2u*)(zr + ZC_MV); }
    const f32x4 gnw = *(const f32x4*)(F.gmlp_norm_w + l * 256 + 4 * lane_);
#pragma unroll
    for (int j = 0; j < 2; ++j) {
        bf16_t* zr = F.Z + (size_t)(r0 + 2 * wave_ + j) * ZW + 4 * lane_;
        f32x4 u = unpack4(ur[j]), v = unpack4(vr[j]); float ss = 0.f;
#pragma unroll
        for (int e = 0; e < 4; ++e) { u[e] = geluf_(u[e]); v[e] = geluf_(v[e]); ss += v[e] * v[e]; }
        const float rs = frsq(wave_sum(ss) * (1.f / 256.f) + EPS);
        *(v2u*)(zr + ZC_MU) = pack4(u); *(v2u*)(zr + ZC_MV) = pack4(v * rs * gnw);
    }
}
__device__ __forceinline__ void chs_unit(const Frame& F, int l, int ck) {
    const int b = ck / 36, cidx = ck % 36, row0 = chunk_row0(b, cidx);
    const int t = F.wave * 64 + fresh_lane();
    LAS float* G = (LAS float*)F.lds;
#pragma unroll
    for (int j = 0; j < 2; ++j) { const int idx = t + 512 * j, p = idx >> 4, c = idx & 15, dh = c & 7;
        const float raw = bf2f(F.Z[(size_t)(row0 + p) * ZW + ZC_LI + c]);
        G[c * 64 + p] = c < 8 ? raw + F.ig_bias[l * 8 + dh] : logsigf_(raw + F.fg_bias[l * 8 + dh]); }
    __syncthreads();
    if (t < 8) { const int d = t >> 2, h = t & 3; float bsum = 0.f, mx = -1e30f;
        for (int i = 0; i < 64; ++i) { const int p = d ? 63 - i : i; bsum += G[(8 + t) * 64 + p]; mx = fmaxf(mx, G[t * 64 + p] - bsum); }
        float* o = F.CHS + ((((b * 4 + h) * 2 + d) * 36) + cidx) * 2; o[0] = bsum; o[1] = bsum + mx; }
    __syncthreads();
}

__device__ __forceinline__ void gdn_prep_unit(const Frame& F, int l, int u, int stop = 99, bf16_t* PGo = nullptr) {
    if (!PGo) PGo = F.PG;
    const int b = u / 144, h = (u / 36) & 3, cidx = u % 36;
    const int row0 = chunk_row0(b, cidx);
    const int seg_lo = cidx < 4 ? MLAT + b * CTXL : b * SEQ, seg_hi = seg_lo + (cidx < 4 ? CTXL : SEQ);
    const int t_o = F.wave * 64 + fresh_lane();
    const int t = t_o, lane = t & 63, w = __builtin_amdgcn_readfirstlane(t >> 6), lr = lane & 15, lq = lane >> 4;
    LAS unsigned char* L = F.lds;
    LAS bf16_t* Qs = (LAS bf16_t*)(L + 0); LAS bf16_t* Ks = (LAS bf16_t*)(L + 9216); LAS bf16_t* Kt = (LAS bf16_t*)(L + 18432); LAS bf16_t* Vt = (LAS bf16_t*)(L + 27648);
    LAS float* gS = (LAS float*)(L + 36864); LAS float* bS = gS + 128; LAS float* gcS = gS + 256; LAS float* totS = gS + 384;
    LAS float* As = (LAS float*)(L + 38912);
    LAS float* CV = (LAS float*)(L + 38912);
    LAS bf16_t* UT = (LAS bf16_t*)(L + 38912); LAS bf16_t* UTd = UT + 4608; LAS bf16_t* WT = UT + 9216; LAS bf16_t* WTd = UT + 13824;
    LAS bf16_t* Tb = (LAS bf16_t*)(L + 75776);
    LAS bf16_t* At = (LAS bf16_t*)(L + 112640);
    if (t < 384) {
        const int pair = t % 96, rg = t / 96, c0 = 2 * pair, part = c0 >> 6, d0 = c0 & 63, zcol = part * 256 + h * 64 + d0;
        float cw[5][2];
#pragma unroll
        for (int j = 0; j < 5; ++j) { const float* wp = F.conv_w + (size_t)(l * 5 + j) * 768 + part * 256 + h * 64 + d0; cw[j][0] = wp[0]; cw[j][1] = wp[1]; }
        float win[20][2];
        unsigned raw[20];
        { const int rbase = row0 + rg * 16 - 2; const bf16_t* zc = F.Z + zcol;
#pragma unroll
          for (int rr = 0; rr < 20; ++rr) { int row = rbase + rr; row = row < seg_lo ? seg_lo : (row >= seg_hi ? seg_hi - 1 : row); raw[rr] = *(const unsigned*)(zc + (size_t)row * ZW); }
          asm volatile("" : "+v"(raw[0]), "+v"(raw[1]), "+v"(raw[2]), "+v"(raw[3]), "+v"(raw[4]), "+v"(raw[5]), "+v"(raw[6]), "+v"(raw[7]), "+v"(raw[8]), "+v"(raw[9]));
          asm volatile("" : "+v"(raw[10]), "+v"(raw[11]), "+v"(raw[12]), "+v"(raw[13]), "+v"(raw[14]), "+v"(raw[15]), "+v"(raw[16]), "+v"(raw[17]), "+v"(raw[18]), "+v"(raw[19]));
#pragma unroll
          for (int rr = 0; rr < 20; ++rr) { const int row = rbase + rr; const unsigned wv = (row >= seg_lo && row < seg_hi) ? raw[rr] : 0u; win[rr][0] = bflo(wv); win[rr][1] = bfhi(wv); } }
#pragma unroll
        for (int i = 0; i < 16; ++i) { float a0 = 0.f, a1 = 0.f;
#pragma unroll
            for (int j = 0; j < 5; ++j) { a0 += cw[j][0] * win[i + j][0]; a1 += cw[j][1] * win[i + j][1]; }
            CV[(rg * 16 + i) * 196 + c0] = siluf_(a0); CV[(rg * 16 + i) * 196 + c0 + 1] = siluf_(a1); }
    } else {
        const int tt = t - 384, d = tt >> 6, p = tt & 63; const bf16_t* zr = F.Z + (size_t)(row0 + p) * ZW;
        const float a = bf2f(zr[ZC_GA + d * 4 + h]), bb = bf2f(zr[ZC_GB + d * 4 + h]);
        gS[d * 64 + p] = -fexp(F.a_log[l * 8 + d * 4 + h]) * softplusf_(a + F.dt_bias[l * 8 + d * 4 + h]);
        bS[d * 64 + p] = sigmoidf_(bb);
    }
    __syncthreads();
    if (stop <= 1) return;
    {
        const int combo = t >> 2, sub = t & 3, row = combo & 63, part = combo >> 6;
        float v[16]; float ss = 0.f;
#pragma unroll
        for (int i = 0; i < 16; ++i) { v[i] = CV[row * 196 + part * 64 + sub * 16 + i]; ss += v[i] * v[i]; }
        ss = quad_sum(ss);
        const float rs = frsq(ss + EPS);
        LAS bf16_t* dst = (part == 0 ? Qs : Ks) + row * 72 + sub * 16;
        v4u o0, o1;
        o0.x = pk2(v[0] * rs, v[1] * rs); o0.y = pk2(v[2] * rs, v[3] * rs); o0.z = pk2(v[4] * rs, v[5] * rs); o0.w = pk2(v[6] * rs, v[7] * rs);
        o1.x = pk2(v[8] * rs, v[9] * rs); o1.y = pk2(v[10] * rs, v[11] * rs); o1.z = pk2(v[12] * rs, v[13] * rs); o1.w = pk2(v[14] * rs, v[15] * rs);
        *(LAS v4u*)dst = o0; *(LAS v4u*)(dst + 8) = o1;
        if (part == 1) {
#pragma unroll
            for (int i = 0; i < 16; ++i) Kt[(sub * 16 + i) * 72 + row] = (bf16_t)f2bf(v[i] * rs);
        }
        const int vrow = t & 63, dg = t >> 6;
#pragma unroll
        for (int i = 0; i < 8; ++i) Vt[(dg * 8 + i) * 72 + vrow] = (bf16_t)f2bf(CV[vrow * 196 + 128 + dg * 8 + i]);
        if (w < 2) { const int d = w, p = d ? 63 - lane : lane; float s = gS[d * 64 + p];
#pragma unroll
            for (int off = 1; off < 64; off <<= 1) { const float y = __shfl_up(s, off); if (lane >= off) s += y; }
            gcS[d * 64 + p] = s; if (lane == 63) totS[d] = s; }
    }
    __syncthreads();
    if (stop <= 2) return;
#pragma unroll
    for (int k2 = 0; k2 < 2; ++k2) {
        const int tt = 2 * w + k2, mt = tt >> 2, nt = tt & 3;
        f32x4 accG = {0.f, 0.f, 0.f, 0.f}, accQ = {0.f, 0.f, 0.f, 0.f};
        accG = mma_ll<2>(Ks + mt * 16 * 72, 72, Ks + nt * 16 * 72, 72, accG, lane);
        accQ = mma_ll<2>(Ks + mt * 16 * 72, 72, Qs + nt * 16 * 72, 72, accQ, lane);
        const int n = nt * 16 + lr, m0 = mt * 16 + 4 * lq;
#pragma unroll
        for (int d = 0; d < 2; ++d) {
            const float gcn = gcS[d * 64 + n], bn = bS[d * 64 + n];
            f32x4 av, tv;
#pragma unroll
            for (int i = 0; i < 4; ++i) { const int m = m0 + i; const float gcm = gcS[d * 64 + m];
                const bool strict = d == 0 ? (m < n) : (m > n); const bool incl = d == 0 ? (m <= n) : (m >= n);
                const float e = fexp(incl ? (gcn - gcm) : 0.f);
                av[i] = strict ? bn * accG[i] * e : 0.f; tv[i] = incl ? 0.125f * accQ[i] * e : 0.f; }
#pragma unroll
            for (int i = 0; i < 4; ++i) { const int si = d ? 63 - n : n, sj = d ? 63 - (m0 + i) : m0 + i; As[d * 4352 + (si >> 1) * 136 + sj * 2 + (si & 1)] = av[i]; }
            *(LAS v2u*)(At + d * 4608 + n * 72 + m0) = pack4(tv);
        }
    }
    __syncthreads();
    if (stop <= 3) return;
    if (w < 2) {
        const int d = w; const LAS float* Ad = As + d * 4352;
        float tr[64]; int lane_o = lane;
#pragma unroll
        for (int ip = 0; ip < 32; ++ip) {
            const int i0 = 2 * ip;
            f32x4 rv[32];
#pragma unroll
            for (int jp = 0; jp <= ip; ++jp) rv[jp] = *(const LAS f32x4*)(Ad + ip * 136 + 4 * jp);
            asm volatile("" : "+v"(lane_o) :: "memory");
            f32x2_ a0 = {0.f, 0.f}, a1 = {0.f, 0.f}, a2 = {0.f, 0.f}, a3 = {0.f, 0.f};
#pragma unroll
            for (int jp = 0; jp < ip; ++jp) {
                const f32x2_ ta = {tr[2 * jp], tr[2 * jp]}, tb = {tr[2 * jp + 1], tr[2 * jp + 1]};
                const f32x2_ va = {rv[jp][0], rv[jp][1]}, vb = {rv[jp][2], rv[jp][3]};
                if (jp & 1) { a2 += va * ta; a3 += vb * tb; } else { a0 += va * ta; a1 += vb * tb; }
            }
            const f32x2_ sum = (a0 + a1) + (a2 + a3);
            const float t0 = (lane_o == i0 ? 1.f : 0.f) - sum[0];
            tr[i0] = t0;
            tr[i0 + 1] = (lane_o == i0 + 1 ? 1.f : 0.f) - sum[1] - rv[ip][1] * t0;
        }
        const int pb = d ? 63 - lane : lane; const float sb = bS[d * 64 + pb], sbe = sb * fexp(gcS[d * 64 + pb]);
        LAS bf16_t* T0 = Tb + d * 9216; LAS bf16_t* T1 = T0 + 4608;
#pragma unroll
        for (int i = 0; i < 64; ++i) { const int pa = d ? 63 - i : i; T0[pa * 72 + pb] = (bf16_t)f2bf(tr[i] * sb); T1[pa * 72 + pb] = (bf16_t)f2bf(tr[i] * sbe); }
    }
    __syncthreads();
    if (stop <= 4) return;
#pragma unroll 1
    for (int d = 0; d < 2; ++d) {
        const int ud = u * 2 + d; const float tot = totS[d];
        const LAS bf16_t* T0 = Tb + d * 9216; const LAS bf16_t* T1 = T0 + 4608; const LAS bf16_t* Ad = At + d * 4608;
        {
            const bool isw = w >= 4; const LAS bf16_t* Aop = isw ? T1 : T0; const LAS bf16_t* Bop = isw ? Kt : Vt;
            LAS bf16_t* o0 = isw ? WT : UT; LAS bf16_t* o1 = isw ? WTd : UTd;
#pragma unroll
            for (int k4 = 0; k4 < 4; ++k4) { const int tt = (w & 3) * 4 + k4, mt = tt >> 2, nt = tt & 3;
                f32x4 acc = {0.f, 0.f, 0.f, 0.f}; acc = mma_ll<2>(Aop + mt * 16 * 72, 72, Bop + nt * 16 * 72, 72, acc, lane);
                const int n = nt * 16 + lr, m0 = mt * 16 + 4 * lq; f32x4 dv;
#pragma unroll
                for (int i = 0; i < 4; ++i) dv[i] = acc[i] * fexp(tot - gcS[d * 64 + m0 + i]);
                *(LAS v2u*)(o0 + n * 72 + m0) = pack4(acc); *(LAS v2u*)(o1 + n * 72 + m0) = pack4(dv); }
        }
        __syncthreads();
        if (stop == 6) { __syncthreads(); continue; }
        {
            const int prod = w >> 1; bf16_t* gout = PGo + (size_t)ud * 16384 + prod * 4096;
            const LAS bf16_t* Aop = prod == 0 ? WTd : prod == 1 ? Kt : prod == 2 ? WT : Ad;
            const LAS bf16_t* Bop = prod == 0 ? Kt : prod == 1 ? UTd : prod == 2 ? Ad : UT;
#pragma unroll
            for (int k8 = 0; k8 < 8; ++k8) { const int tt = (w & 1) * 8 + k8, mt = tt >> 2, nt = tt & 3;
                f32x4 acc = {0.f, 0.f, 0.f, 0.f}; acc = mma_ll<2>(Aop + mt * 16 * 72, 72, Bop + nt * 16 * 72, 72, acc, lane);
                const int n = nt * 16 + lr, m0 = mt * 16 + 4 * lq;
                if (prod == 2) { const f32x4 qv = unpack4(*(const LAS v2u*)(Qs + n * 72 + m0)); const float e = 0.125f * fexp(gcS[d * 64 + n]); acc = qv * e - acc; }
                const int off = (prod == 0 || prod == 2) ? ((nt * 2 + (mt >> 1)) * 64 + ((mt & 1) * 2 + (lq >> 1)) * 16 + lr) * 8 + 4 * (lq & 1) : ((mt * 4 + nt) * 64 + lane) * 4;
                if (stop != 7) *(v2u*)(gout + off) = pack4(acc); else asm volatile("" :: "v"(acc)); }
        }
        if (t == 0 && PGo == F.PG) F.GLG[ud] = fexp(tot);
        __syncthreads();
    }
}

__device__ __forceinline__ void mlstm_prep_unit(const Frame& F, int l, int u) {
    const int b = u / 144, h = (u / 36) & 3, cidx = u % 36;
    const int row0 = chunk_row0(b, cidx);
    const int t_o = F.wave * 64 + fresh_lane();
    const int t = t_o, lane = t & 63, w = __builtin_amdgcn_readfirstlane(t >> 6), lr = lane & 15, lq = lane >> 4;
    LAS unsigned char* L = F.lds;
    LAS bf16_t* Qs = (LAS bf16_t*)(L + 0); LAS bf16_t* Ks = (LAS bf16_t*)(L + 9216); LAS bf16_t* Vta = (LAS bf16_t*)(L + 18432);
    LAS bf16_t* Kte = (LAS bf16_t*)(L + 29952);
    LAS bf16_t* S0 = (LAS bf16_t*)(L + 48384);
    LAS float* igS = (LAS float*)(L + 66816); LAS float* lfS = igS + 128; LAS float* bS = igS + 256; LAS float* dmS = igS + 384; LAS float* rS = igS + 512;
    LAS float* flS = igS + 640; LAS float* eS = igS + 768; LAS float* mpS = igS + 896; LAS float* chS = igS + 904;
    {
        const int r = t >> 3, seg = t & 7; const bf16_t* zr = F.Z + (size_t)(row0 + r) * ZW + h * 64 + seg * 8;
        const v4u q = *(const v4u*)(zr + ZC_LQ), k = *(const v4u*)(zr + ZC_LK), v = *(const v4u*)(zr + ZC_LV);
        *(LAS v4u*)(Qs + r * 72 + seg * 8) = q; *(LAS v4u*)(Ks + r * 72 + seg * 8) = k;
        Vta[(seg * 8 + 0) * 72 + r] = (bf16_t)(v.x & 0xffffu); Vta[(seg * 8 + 1) * 72 + r] = (bf16_t)(v.x >> 16);
        Vta[(seg * 8 + 2) * 72 + r] = (bf16_t)(v.y & 0xffffu); Vta[(seg * 8 + 3) * 72 + r] = (bf16_t)(v.y >> 16);
        Vta[(seg * 8 + 4) * 72 + r] = (bf16_t)(v.z & 0xffffu); Vta[(seg * 8 + 5) * 72 + r] = (bf16_t)(v.z >> 16);
        Vta[(seg * 8 + 6) * 72 + r] = (bf16_t)(v.w & 0xffffu); Vta[(seg * 8 + 7) * 72 + r] = (bf16_t)(v.w >> 16);
#pragma unroll
        for (int j = 0; j < 2; ++j) { const int idx = t + 512 * j, rr = 64 + (idx >> 6), cc = idx & 63; Vta[rr * 72 + cc] = (bf16_t)(rr == 64 ? 0x3F80u : 0u); }
        if (t < 128) { const int d = t >> 6, p = t & 63; const bf16_t* zg = F.Z + (size_t)(row0 + p) * ZW;
            igS[d * 64 + p] = bf2f(zg[ZC_LI + d * 4 + h]) + F.ig_bias[l * 8 + d * 4 + h];
            lfS[d * 64 + p] = logsigf_(bf2f(zg[ZC_LF + d * 4 + h]) + F.fg_bias[l * 8 + d * 4 + h]); }
        if (t >= 128 && t < 272) chS[t - 128] = F.CHS[(size_t)((b * 4 + h) * 2) * 72 + (t - 128)];
    }
    __syncthreads();
    if (w < 2) {
        const int d = w, p = d ? 63 - lane : lane;
        const int step_of = d ? (cidx < 4 ? 3 - cidx : 39 - cidx) : cidx; float mprev = 0.f;
        for (int s = 0; s < step_of; ++s) { const int ci = d ? (s < 4 ? 3 - s : 39 - s) : s; mprev = fmaxf(chS[d * 72 + ci * 2] + mprev, chS[d * 72 + ci * 2 + 1]); }
        const float ig = igS[d * 64 + p]; float bp = lfS[d * 64 + p];
#pragma unroll
        for (int off = 1; off < 64; off <<= 1) { const float y = __shfl_up(bp, off); if (lane >= off) bp += y; }
        float mxp = ig - bp;
#pragma unroll
        for (int off = 1; off < 64; off <<= 1) { const float y = __shfl_up(mxp, off); if (lane >= off) mxp = fmaxf(mxp, y); }
        const float mxall = __shfl(mxp, 63), bl = __shfl(bp, 63);
        const float dmax = bp + mxp, wsmax = bl + mxall;
        const float mnew = fmaxf(bl + mprev, wsmax), cd = fexp(bl + mprev - mnew), e2 = fexp(wsmax - mnew);
        const float mt = fmaxf(bp + mprev, dmax);
        bS[d * 64 + p] = bp; dmS[d * 64 + p] = dmax; rS[d * 64 + p] = fexp(dmax - mt); flS[d * 64 + p] = fexp(-mt);
        eS[d * 64 + p] = fexp(bl - bp + ig - wsmax) * e2;
        const int ud = u * 2 + d; F.WI[ud * 64 + p] = 0.125f * fexp(bp + mprev - mt); if (lane == 0) F.GLM[ud] = cd; }
    __syncthreads();
    {
        const int d = t >> 8, tt = t & 255, p = tt & 63, dg = tt >> 6; const float e = eS[d * 64 + p];
#pragma unroll
        for (int i = 0; i < 16; ++i) Kte[d * 4608 + (dg * 16 + i) * 72 + p] = (bf16_t)f2bf(bf2f(Ks[p * 72 + dg * 16 + i]) * e);
#pragma unroll
        for (int k2 = 0; k2 < 2; ++k2) { const int tl = 2 * w + k2, mt = tl >> 2, nt = tl & 3;
            f32x4 acc = {0.f, 0.f, 0.f, 0.f}; acc = mma_ll<2>(Ks + mt * 16 * 72, 72, Qs + nt * 16 * 72, 72, acc, lane);
            const int n = nt * 16 + lr, m0 = mt * 16 + 4 * lq;
#pragma unroll
            for (int dd = 0; dd < 2; ++dd) { const float bn = bS[dd * 64 + n], dn = dmS[dd * 64 + n], rn = rS[dd * 64 + n]; f32x4 sv;
#pragma unroll
                for (int i = 0; i < 4; ++i) { const int m = m0 + i; const bool incl = dd == 0 ? (m <= n) : (m >= n);
                    const float arg = incl ? (bn - bS[dd * 64 + m] + igS[dd * 64 + m] - dn) : 0.f; sv[i] = incl ? 0.125f * acc[i] * fexp(arg) * rn : 0.f; }
                *(LAS v2u*)(S0 + dd * 4608 + n * 72 + m0) = pack4(sv); } }
    }
    __syncthreads();
    {
        const int d = w >> 2, ud = u * 2 + d; bf16_t* gO = F.PM + (size_t)ud * 10240; bf16_t* gB = gO + 5120;
#pragma unroll 2
        for (int k = 0; k < 10; ++k) { const int tl = (w & 3) * 10 + k; const bool iskv = tl >= 20; const int t2 = iskv ? tl - 20 : tl, mt = t2 / 5, nt = t2 % 5;
            const LAS bf16_t* Aop = (iskv ? Kte : S0) + d * 4608 + mt * 16 * 72;
            f32x4 acc = {0.f, 0.f, 0.f, 0.f}; acc = mma_ll<2>(Aop, 72, Vta + nt * 16 * 72, 72, acc, lane);
            const int n = nt * 16 + lr, m0 = mt * 16 + 4 * lq;
            if (!iskv && n == 65) {
#pragma unroll
                for (int i = 0; i < 4; ++i) acc[i] = flS[d * 64 + m0 + i]; }
            *(v2u*)((iskv ? gB : gO) + ((mt * 5 + nt) * 64 + lane) * 4) = pack4(acc); }
    }
    __syncthreads();
}

__device__ __forceinline__ void l2_touch(const void* gsrc, unsigned lds_dst) {
    unsigned keep;
    asm volatile("s_mov_b32 %0, m0\n\ts_mov_b32 m0, %2\n\ts_nop 0\n\tglobal_load_lds_dword %1, off\n\ts_mov_b32 m0, %0" : "=&s"(keep) : "v"(gsrc), "s"(lds_dst) : "memory");
}
template <int NT> struct ScanOps { bf16x8 Qf[2], Mf[2]; v2u bv[NT], ov[NT]; float gl; f32x4 wi; };
template <bool GDN, int NT> __device__ __forceinline__ void scan_load(const Frame& F, int b, int h, int dir, int wq, int lr, int lq, int s, ScanOps<NT>& o) {
    const int cidx = dir ? (s < 4 ? 3 - s : 39 - s) : s;
    const int ud = ((b * 4 + h) * 36 + cidx) * 2 + dir;
    if (GDN) {
        const bf16_t* gM = F.PG + (size_t)ud * 16384; const bf16_t* gQ = gM + 8192;
#pragma unroll
        for (int ks = 0; ks < 2; ++ks) { o.Mf[ks] = *(const bf16x8*)(gM + ((wq * 2 + ks) * 64 + lq * 16 + lr) * 8); o.Qf[ks] = *(const bf16x8*)(gQ + ((wq * 2 + ks) * 64 + lq * 16 + lr) * 8); }
    } else {
        const bf16_t* zq = F.Z + (size_t)(chunk_row0(b, cidx) + 16 * wq + lr) * ZW + ZC_LQ + h * 64;
#pragma unroll
        for (int ks = 0; ks < 2; ++ks) { o.Qf[ks] = *(const bf16x8*)(zq + 32 * ks + 8 * lq); o.Mf[ks] = o.Qf[ks]; }
    }
    const bf16_t* gB = GDN ? F.PG + (size_t)ud * 16384 + 4096 : F.PM + (size_t)ud * 10240 + 5120;
    const bf16_t* gO = GDN ? F.PG + (size_t)ud * 16384 + 12288 : F.PM + (size_t)ud * 10240;
#pragma unroll
    for (int t = 0; t < NT; ++t) { o.bv[t] = *(const v2u*)(gB + ((wq * NT + t) * 64 + lq * 16 + lr) * 4); o.ov[t] = *(const v2u*)(gO + ((wq * NT + t) * 64 + lq * 16 + lr) * 4); }
    o.gl = GDN ? F.GLG[ud] : F.GLM[ud];
    o.wi = (f32x4){1.f, 1.f, 1.f, 1.f}; if (!GDN) o.wi = *(const f32x4*)(F.WI + ud * 64 + 16 * wq + 4 * lq);
}
struct ScanFin { v2u pend[4]; unsigned short gz[4][4]; };
template <bool GDN> __device__ __forceinline__ void scan_fin_load(const Frame& F, int b, int h, int dir, int wq, int lr, int lq, int s, const float* PEND, ScanFin& f) {
    const int cidx = dir ? (s < 4 ? 3 - s : 39 - s) : s; const int row0 = chunk_row0(b, cidx);
    const float* pp = PEND + (size_t)((b * 4 + h) * 36 + cidx) * 4096 + (wq * 256 + lq * 16 + lr) * 2;
#pragma unroll
    for (int t = 0; t < 4; ++t) { f.pend[t] = *(const v2u*)(pp + t * 128);
#pragma unroll
        for (int i = 0; i < 4; ++i) f.gz[t][i] = F.Z[(size_t)(row0 + 16 * wq + 4 * lq + i) * ZW + (GDN ? ZC_GZ : ZC_LO) + h * 64 + 16 * t + lr]; }
}
__device__ __forceinline__ bool scan_first(int s) { return s < 4 ? (s <= 1) : (s <= 19); }
template <bool GDN> __device__ __forceinline__ void scan_finish(const Frame& F, int b, int h, int dir, int wq, int lr, int lq, int s, float* PEND, const f32x4 (&Oin)[4], const ScanFin& f, const float (&nwv)[4]) {
    const int cidx = dir ? (s < 4 ? 3 - s : 39 - s) : s; const int row0 = chunk_row0(b, cidx);
    float* pp = PEND + (size_t)((b * 4 + h) * 36 + cidx) * 4096 + (wq * 256 + lq * 16 + lr) * 2;
    if (scan_first(s)) {
#pragma unroll
        for (int t = 0; t < 4; ++t) *(v2u*)(pp + t * 128) = pack4(Oin[t]);
    } else {
        f32x4 O[4]; float ss[4] = {0.f, 0.f, 0.f, 0.f};
#pragma unroll
        for (int t = 0; t < 4; ++t)
            { const f32x4 pv = unpack4(f.pend[t]);
#pragma unroll
            for (int i = 0; i < 4; ++i) { O[t][i] = Oin[t][i] + pv[i]; ss[i] += O[t][i] * O[t][i]; } }
#pragma unroll
        for (int i = 0; i < 4; ++i) ss[i] = frsq(row16_sum(ss[i]) * (1.f / 64.f) + EPS);
#pragma unroll
        for (int t = 0; t < 4; ++t) { const int dv = 16 * t + lr;
#pragma unroll
            for (int i = 0; i < 4; ++i) { const int row = row0 + 16 * wq + 4 * lq + i;
                const float g = bf2f(f.gz[t][i]);
                F.MIX[(size_t)row * 1024 + (GDN ? 0 : 768) + h * 64 + dv] = (bf16_t)f2bf(O[t][i] * ss[i] * nwv[t] * g); } }
    }
}
template <bool GDN, int NT> __device__ __forceinline__ bool scan_step(const Frame& F, int b, int h, int dir, int wq, int lane, int s, LAS bf16_t* St, float* PEND, const float (&nwv)[4],
                                                                      f32x4 (&S)[NT], f32x4 (&Oprev)[4], const ScanOps<NT>& use, ScanOps<NT>& ld, ScanFin& fin, bool nofin) {
    const int lr = lane & 15, lq = lane >> 4;
    LAS bf16_t* Sb = St + ((dir * 2 + (s & 1)) * 80) * 72;
    if (s < 36) {
#pragma unroll
        for (int t = 0; t < NT; ++t) *(LAS v2u*)(Sb + (16 * t + lr) * 72 + 16 * wq + 4 * lq) = pack4(S[t]); }
    if (GDN) asm volatile("s_waitcnt vmcnt(33)" ::: "memory"); else asm volatile("s_waitcnt vmcnt(34)" ::: "memory");
    __syncthreads();
    if (s > 0) {
        const int sp = s - 1;
        if (sp == 20 || sp == 2) { asm volatile("s_waitcnt vmcnt(0)" ::: "memory"); scan_fin_load<GDN>(F, b, h, dir, wq, lr, lq, sp, PEND, fin); }
        if (!nofin) scan_finish<GDN>(F, b, h, dir, wq, lr, lq, sp, PEND, Oprev, fin, nwv);
    }
    if (s == 36) return false;
    scan_fin_load<GDN>(F, b, h, dir, wq, lr, lq, s < 35 ? s + 1 : 35, PEND, fin);
    scan_load<GDN, NT>(F, b, h, dir, wq, lr, lq, s < 34 ? s + 2 : 35, ld);
    f32x4 O[NT];
#pragma unroll
    for (int t = 0; t < NT; ++t) {
        const LAS bf16_t* sp2 = Sb + (16 * t + lr) * 72 + 8 * lq;
        const bf16x8 s0 = *(const LAS bf16x8*)sp2, s1 = *(const LAS bf16x8*)(sp2 + 32);
        f32x4 o = {0.f, 0.f, 0.f, 0.f};
        o = __builtin_amdgcn_mfma_f32_16x16x32_bf16(use.Qf[0], s0, o, 0, 0, 0); o = __builtin_amdgcn_mfma_f32_16x16x32_bf16(use.Qf[1], s1, o, 0, 0, 0);
        const f32x4 bv = unpack4(use.bv[t]), ov = unpack4(use.ov[t]);
        if (GDN) {
            f32x4 ms = {0.f, 0.f, 0.f, 0.f};
            ms = __builtin_amdgcn_mfma_f32_16x16x32_bf16(use.Mf[0], s0, ms, 0, 0, 0); ms = __builtin_amdgcn_mfma_f32_16x16x32_bf16(use.Mf[1], s1, ms, 0, 0, 0);
            S[t] = S[t] * use.gl - ms + bv; O[t] = o + ov;
        } else { S[t] = S[t] * use.gl + bv; O[t] = o * use.wi + ov; }
    }
    if (!GDN) {
#pragma unroll
        for (int i = 0; i < 4; ++i) { const float den = row16_bcast<0>(O[NT - 1][i]), fl = row16_bcast<1>(O[NT - 1][i]); const float dv = frcp(fmaxf(fabsf(den), fl));
#pragma unroll
            for (int t = 0; t < 4; ++t) O[t][i] *= dv; }
    }
#pragma unroll
    for (int t = 0; t < 4; ++t) Oprev[t] = O[t];
    return true;
}
template <bool GDN> __device__ __forceinline__ void scan_wg(const Frame& F, int l, int bh, bool nofin = false, int ko = 0) {
    constexpr int NT = GDN ? 4 : 5;
    const int b = bh >> 2, h = bh & 3;
    const int lane = fresh_lane(), dir = F.wave >> 2, wq = F.wave & 3, lr = lane & 15, lq = lane >> 4;
    LAS bf16_t* St = (LAS bf16_t*)F.lds;
    f32x4 S[NT];
#pragma unroll
    for (int t = 0; t < NT; ++t) S[t] = (f32x4){0.f, 0.f, 0.f, 0.f};
    const float* nw = GDN ? F.gdn_norm_w + l * 64 : F.mlstm_norm_w + l * 256 + h * 64;
    float nwv[4];
#pragma unroll
    for (int t = 0; t < 4; ++t) nwv[t] = nw[16 * t + lr];
    float* PEND = F.PEND + (GDN ? (size_t)0 : (size_t)1152 * 4096);
    ScanOps<NT> A0, A1, A2; ScanFin F0, F1;
    f32x4 Oprev[4];
#pragma unroll
    for (int t = 0; t < 4; ++t) { Oprev[t] = (f32x4){0.f, 0.f, 0.f, 0.f}; F0.pend[t] = (v2u){0u, 0u}; F1.pend[t] = (v2u){0u, 0u};
#pragma unroll
        for (int i = 0; i < 4; ++i) { F0.gz[t][i] = 0; F1.gz[t][i] = 0; } }
    scan_load<GDN, NT>(F, b, h, dir, wq, lr, lq, 0, A0);
    scan_load<GDN, NT>(F, b, h, dir, wq, lr, lq, 1, A1);
#pragma unroll 1
    for (int s6 = 0; s6 < 42; s6 += 6) {
        if (!scan_step<GDN, NT>(F, b, h, dir, wq, lane, s6 + 0, St, PEND, nwv, S, Oprev, A0, A2, F1, nofin)) break;
        if (!scan_step<GDN, NT>(F, b, h, dir, wq, lane, s6 + 1, St, PEND, nwv, S, Oprev, A1, A0, F0, nofin)) break;
        if (!scan_step<GDN, NT>(F, b, h, dir, wq, lane, s6 + 2, St, PEND, nwv, S, Oprev, A2, A1, F1, nofin)) break;
        if (!scan_step<GDN, NT>(F, b, h, dir, wq, lane, s6 + 3, St, PEND, nwv, S, Oprev, A0, A2, F0, nofin)) break;
        if (!scan_step<GDN, NT>(F, b, h, dir, wq, lane, s6 + 4, St, PEND, nwv, S, Oprev, A1, A0, F1, nofin)) break;
        if (!scan_step<GDN, NT>(F, b, h, dir, wq, lane, s6 + 5, St, PEND, nwv, S, Oprev, A2, A1, F0, nofin)) break;
    }
    VM_WAIT();
    __syncthreads();
}

__device__ __forceinline__ void swa_unit(const Frame& F, int l, int it, int ko = 0) {
    const bool lat = it < 256; int b, kvh, qb;
    if (lat) { b = it >> 5; kvh = (it >> 4) & 1; qb = it & 15; } else { const int j = it - 256; b = j >> 2; kvh = (j >> 1) & 1; qb = j & 1; }
    const int t_o = F.wave * 64 + fresh_lane();
    const int t = t_o, lane = t & 63, w = __builtin_amdgcn_readfirstlane(t >> 6), lr = lane & 15, lq = lane >> 4;
    const int hq = kvh * 2 + (w >> 2), wrow = (w & 3) * 32;
    const int qrow = (lat ? b * SEQ : MLAT + b * CTXL) + qb * 128 + wrow;
    LAS bf16_t* Ksh = (LAS bf16_t*)F.lds; LAS bf16_t* Vt = Ksh + 4608; LAS bf16_t* Pw = Ksh + 9216 + w * 2304;
    bf16x8 Qf[2][2];
#pragma unroll
    for (int mt = 0; mt < 2; ++mt)
#pragma unroll
        for (int ks = 0; ks < 2; ++ks) Qf[mt][ks] = *(const bf16x8*)(F.Z + (size_t)(qrow + mt * 16 + lr) * ZW + ZC_SQ + hq * 64 + 32 * ks + 8 * lq);
    const float sk = F.sink[l * 4 + hq];
    float mi[2][4], li[2][4]; f32x4 O[2][4];
#pragma unroll
    for (int mt = 0; mt < 2; ++mt)
#pragma unroll
        for (int i = 0; i < 4; ++i) { mi[mt][i] = sk; li[mt][i] = 1.f; O[mt][i] = (f32x4){0.f, 0.f, 0.f, 0.f}; }
    const int lo = lat ? (qb == 0 ? 2 : 0) : 0, nloc = lat ? ((qb == 15 ? 4 : 6) - lo) : 0, ntile = nloc + 4;
    const int sr = t >> 3, sseg = t & 7;
    v4u kreg, vreg;
    { const int krow0 = nloc > 0 ? b * SEQ + (qb - 1) * 128 + lo * 64 : MLAT + b * CTXL;
      const bf16_t* zr = F.Z + (size_t)(krow0 + sr) * ZW + kvh * 64 + sseg * 8; kreg = *(const v4u*)(zr + ZC_SK); vreg = *(const v4u*)(zr + ZC_SV); }
#pragma unroll 1
    for (int j = 0; j < ntile; ++j) {
        const bool masked = j < nloc; const int kpos0 = (qb - 1) * 128 + (lo + j) * 64;
        __syncthreads();
        { *(LAS v4u*)(Ksh + sr * 72 + sseg * 8) = kreg;
          Vt[(sseg * 8 + 0) * 72 + sr] = (bf16_t)(vreg.x & 0xffffu); Vt[(sseg * 8 + 1) * 72 + sr] = (bf16_t)(vreg.x >> 16);
          Vt[(sseg * 8 + 2) * 72 + sr] = (bf16_t)(vreg.y & 0xffffu); Vt[(sseg * 8 + 3) * 72 + sr] = (bf16_t)(vreg.y >> 16);
          Vt[(sseg * 8 + 4) * 72 + sr] = (bf16_t)(vreg.z & 0xffffu); Vt[(sseg * 8 + 5) * 72 + sr] = (bf16_t)(vreg.z >> 16);
          Vt[(sseg * 8 + 6) * 72 + sr] = (bf16_t)(vreg.w & 0xffffu); Vt[(sseg * 8 + 7) * 72 + sr] = (bf16_t)(vreg.w >> 16); }
        if (j + 1 < ntile) { const int jn = j + 1; const int krown = jn < nloc ? b * SEQ + (qb - 1) * 128 + (lo + jn) * 64 : MLAT + b * CTXL + (jn - nloc) * 64;
            const bf16_t* zr = F.Z + (size_t)(krown + sr) * ZW + kvh * 64 + sseg * 8; kreg = *(const v4u*)(zr + ZC_SK); vreg = *(const v4u*)(zr + ZC_SV); }
        __syncthreads();
        if (ko >= 3) continue;
        f32x4 sc[2][4];
#pragma unroll
        for (int nt = 0; nt < 4; ++nt) { const LAS bf16_t* kp = Ksh + (nt * 16 + lr) * 72 + 8 * lq; const bf16x8 k0 = *(const LAS bf16x8*)kp, k1 = *(const LAS bf16x8*)(kp + 32);
#pragma unroll
            for (int mt = 0; mt < 2; ++mt) { f32x4 a = {0.f, 0.f, 0.f, 0.f};
                a = __builtin_amdgcn_mfma_f32_16x16x32_bf16(Qf[mt][0], k0, a, 0, 0, 0); a = __builtin_amdgcn_mfma_f32_16x16x32_bf16(Qf[mt][1], k1, a, 0, 0, 0); sc[mt][nt] = a; } }
        if (ko >= 2) { asm volatile("" :: "v"(sc[0][0]), "v"(sc[0][1]), "v"(sc[0][2]), "v"(sc[0][3]), "v"(sc[1][0]), "v"(sc[1][1]), "v"(sc[1][2]), "v"(sc[1][3])); continue; }
#pragma unroll
        for (int mt = 0; mt < 2; ++mt) {
            float mx[4] = {-1e30f, -1e30f, -1e30f, -1e30f};
#pragma unroll
            for (int nt = 0; nt < 4; ++nt)
#pragma unroll
                for (int i = 0; i < 4; ++i) {
                    if (masked) { const int qpos = qb * 128 + wrow + mt * 16 + 4 * lq + i, kpos = kpos0 + nt * 16 + lr; const int dd = qpos - kpos; if (dd > 128 || dd < -128) sc[mt][nt][i] = -1e30f; }
                    mx[i] = fmaxf(mx[i], sc[mt][nt][i]); }
#pragma unroll
            for (int i = 0; i < 4; ++i) mx[i] = row16_max(mx[i]);
            float al[4], rsum[4];
#pragma unroll
            for (int i = 0; i < 4; ++i) { const float mn = fmaxf(mi[mt][i], mx[i]); al[i] = fexp(mi[mt][i] - mn); mi[mt][i] = mn; rsum[i] = 0.f; }
#pragma unroll
            for (int nt = 0; nt < 4; ++nt)
#pragma unroll
                for (int i = 0; i < 4; ++i) { const float p = fexp(sc[mt][nt][i] - mi[mt][i]); rsum[i] += p; Pw[(mt * 16 + 4 * lq + i) * 72 + nt * 16 + lr] = (bf16_t)f2bf(p); }
#pragma unroll
            for (int i = 0; i < 4; ++i) li[mt][i] = li[mt][i] * al[i] + row16_sum(rsum[i]);
#pragma unroll
            for (int nt = 0; nt < 4; ++nt)
#pragma unroll
                for (int i = 0; i < 4; ++i) O[mt][nt][i] *= al[i];
        }
        LDS_WAIT(); asm volatile("" ::: "memory");
#pragma unroll
        for (int nt = 0; nt < 4; ++nt) { const LAS bf16_t* vp = Vt + (nt * 16 + lr) * 72 + 8 * lq; const bf16x8 v0 = *(const LAS bf16x8*)vp, v1 = *(const LAS bf16x8*)(vp + 32);
#pragma unroll
            for (int mt = 0; mt < 2; ++mt) { const LAS bf16_t* pp = Pw + (mt * 16 + lr) * 72 + 8 * lq; const bf16x8 p0 = *(const LAS bf16x8*)pp, p1 = *(const LAS bf16x8*)(pp + 32);
                O[mt][nt] = __builtin_amdgcn_mfma_f32_16x16x32_bf16(p0, v0, O[mt][nt], 0, 0, 0); O[mt][nt] = __builtin_amdgcn_mfma_f32_16x16x32_bf16(p1, v1, O[mt][nt], 0, 0, 0); } }
    }
    if (ko == 0)
#pragma unroll
    for (int mt = 0; mt < 2; ++mt)
#pragma unroll
        for (int i = 0; i < 4; ++i) { const float inv = frcp(li[mt][i]); bf16_t* orow = F.MIX + (size_t)(qrow + mt * 16 + 4 * lq + i) * 1024 + 256 + hq * 64 + lr;
#pragma unroll
            for (int nt = 0; nt < 4; ++nt) orow[nt * 16] = (bf16_t)f2bf(O[mt][nt][i] * inv); }
    __syncthreads();
}

__device__ __forceinline__ void gmlp_unit(const Frame& F, int l, int it) {
    const int b = it / 72, c = (it >> 2) % 18, g = it & 3;
    const int r0 = c < 16 ? b * SEQ + c * 128 : MLAT + b * CTXL + (c - 16) * 128;
    const int t_o = F.wave * 64 + fresh_lane();
    const int t = t_o, lane = t & 63, w = __builtin_amdgcn_readfirstlane(t >> 6), lr = lane & 15, lq = lane >> 4;
    LAS bf16_t* Vt = (LAS bf16_t*)F.lds;
#pragma unroll
    for (int j = 0; j < 2; ++j) { const int idx = t + 512 * j, q = idx >> 3, seg = idx & 7;
        const v4u v = *(const v4u*)(F.Z + (size_t)(r0 + q) * ZW + ZC_MV + g * 64 + seg * 8);
        Vt[(seg * 8 + 0) * 136 + q] = (bf16_t)(v.x & 0xffffu); Vt[(seg * 8 + 1) * 136 + q] = (bf16_t)(v.x >> 16);
        Vt[(seg * 8 + 2) * 136 + q] = (bf16_t)(v.y & 0xffffu); Vt[(seg * 8 + 3) * 136 + q] = (bf16_t)(v.y >> 16);
        Vt[(seg * 8 + 4) * 136 + q] = (bf16_t)(v.z & 0xffffu); Vt[(seg * 8 + 5) * 136 + q] = (bf16_t)(v.z >> 16);
        Vt[(seg * 8 + 6) * 136 + q] = (bf16_t)(v.w & 0xffffu); Vt[(seg * 8 + 7) * 136 + q] = (bf16_t)(v.w >> 16); }
    __syncthreads();
    bf16x8 Af[4];
#pragma unroll
    for (int ks = 0; ks < 4; ++ks) Af[ks] = *(const bf16x8*)(F.WSP + (size_t)g * 16384 + (16 * w + lr) * 128 + 32 * ks + 8 * lq);
    f32x4 bsv = *(const f32x4*)(F.b_s + (size_t)(l * 4 + g) * 128 + 16 * w + 4 * lq);
    unsigned short uraw[4][4];
#pragma unroll
    for (int nt = 0; nt < 4; ++nt)
#pragma unroll
        for (int i = 0; i < 4; ++i) uraw[nt][i] = F.Z[(size_t)(r0 + 16 * w + 4 * lq + i) * ZW + ZC_MU + g * 64 + nt * 16 + lr];
    f32x4 accs[4];
#pragma unroll
    for (int nt = 0; nt < 4; ++nt) { f32x4 acc = {0.f, 0.f, 0.f, 0.f};
#pragma unroll
        for (int ks = 0; ks < 4; ++ks) { const bf16x8 bfr = *(const LAS bf16x8*)(Vt + (nt * 16 + lr) * 136 + 32 * ks + 8 * lq); acc = __builtin_amdgcn_mfma_f32_16x16x32_bf16(Af[ks], bfr, acc, 0, 0, 0); }
        accs[nt] = acc; }
#pragma unroll
    for (int nt = 0; nt < 4; ++nt)
#pragma unroll
        for (int i = 0; i < 4; ++i) { const int row = r0 + 16 * w + 4 * lq + i, col = g * 64 + nt * 16 + lr;
            F.MIX[(size_t)row * 1024 + 512 + col] = (bf16_t)f2bf(bf2f(uraw[nt][i]) * (accs[nt][i] + bsv[i])); }
    __syncthreads();
}

#ifndef PROBE_KIND
#define PROBE_KIND -1
#endif
#ifndef ONLY_CASE
#define ONLY_CASE -1
#endif
struct Args { const float* in[24]; float* out; unsigned char* ws; int ph_lo, ph_hi; };
constexpr int NPH = 2 + 9 * DEPTH;
__global__ void __launch_bounds__(NWAVES * 64, 2) mk_fwd(Args args) {
    extern __shared__ __attribute__((aligned(16))) unsigned char lds[];
    const int wave_s = __builtin_amdgcn_readfirstlane((int)threadIdx.x >> 6);
    const int tid_ = wave_s * 64 + fresh_lane();
    volatile LAS unsigned* MISC = (volatile LAS unsigned*)((LAS unsigned char*)lds + MISC_OFF);
    if (tid_ < 32) MISC[tid_] = 0u;
    __syncthreads();
    unsigned* barw = (unsigned*)(args.ws + WS_CTL) + CW_BAR;
    XcdBarrier bar; bar.bar = barw; bar.x = 0; bar.st = nullptr;
    const int lo = args.ph_lo, hi = args.ph_hi;
    if (hi - lo > 1) bar = xcd_barrier_post(barw, MISC + 8, tid_);

#pragma unroll 1
    for (int ph = lo; ph < hi; ++ph) {
        int zero; asm volatile("s_mov_b32 %0, 0" : "=s"(zero));
        Frame F;
        F.lds = (LAS unsigned char*)lds;
        F.wave = wave_s;
        F.G = gridDim.x; F.gw = blockIdx.x * NWAVES + F.wave; F.NGW = F.G * NWAVES;
        const float* const* inp = args.in + zero;
        unsigned char* ws = args.ws + zero;
        F.ws = ws;
        int kind, l;
        if (ph == 0) { kind = 0; l = 0; } else if (ph == NPH - 1) { kind = 10; l = DEPTH - 1; } else { l = (ph - 1) / 9; kind = 1 + (ph - 1) % 9; }
        const bool last = (l == DEPTH - 1);
        const int Mrows = last ? MLAT : MALL;
        unsigned char* wb = ws + (size_t)(l & 1) * WSET_STRIDE;
        const int nrep = (kind == PROBE_KIND) ? 2 : 1;
#pragma unroll 1
        for (int rep = 0; rep < nrep; ++rep) {
        if (rep) xcd_barrier(bar, wave_s * 64 + fresh_lane());
        switch (kind) {
        case 0: if (ONLY_CASE >= 0 && ONLY_CASE != 0) break;  F.c = inp[1]; F.cctx = inp[3]; F.ada_w = inp[4]; F.ada_b = inp[5]; F.MOD = (float*)(ws + WS_MOD); phase_mod(F); break;
        case 1: if (ONLY_CASE >= 0 && ONLY_CASE != 1) break;  F.x = inp[0]; F.ctx = inp[2]; F.norm1_w = inp[6]; F.w_in = inp[8]; F.w_out = inp[9]; F.w_s = inp[15]; F.w1 = inp[21]; F.w2 = inp[22]; F.out = args.out + zero; F.MOD = (float*)(ws + WS_MOD); F.XC = (float*)(ws + WS_XC); F.H = (bf16_t*)(ws + WS_H); F.SLAB = (float*)(ws + WS_SLAB); if (l == 0 || F.G != 256) convert_weights(F, l, F.gw, F.NGW, 0, 6400); phase_norm(F, l, 0, MALL, (l > 0 && !rep) ? NSPLIT_2 : 0, F.MOD + (size_t)((l > 0 ? l - 1 : 0) * 9 + 8) * 6144 + 5 * 1024); break;
        case 2: if (ONLY_CASE >= 0 && ONLY_CASE != 2) break;  F.H = (bf16_t*)(ws + WS_H); F.WIN = (bf16_t*)(wb + WS_WIN); F.Z = (bf16_t*)(ws + WS_Z); { pg8::Gemm g{F.H, F.WIN, MALL, ZW, D, D, D}; pg8::StaticOrder S; S.init(MALL, ZW, D, F.G, (int)blockIdx.x);
                  pg8::EpiBf16<0> E{F.Z, ZW}; pg8::gemm_phase<pg8::EpiBf16<0>, pg8::StaticOrder, true, true, true>(F.lds, g, S, E, wave_s * 64 + fresh_lane()); } break;
        case 3: if (ONLY_CASE >= 0 && ONLY_CASE != 3) break;  F.Z = (bf16_t*)(ws + WS_Z); F.gmlp_norm_w = inp[17]; F.ig_bias = inp[18]; F.fg_bias = inp[19]; F.CHS = (float*)(ws + WS_CHS); for (int rg = blockIdx.x; rg < MALL / 16 + 288; rg += F.G) { if (rg < MALL / 16) ew_unit(F, l, rg); else chs_unit(F, l, rg - MALL / 16); } break;
        case 4: if (ONLY_CASE >= 0 && ONLY_CASE != 4) break;  F.Z = (bf16_t*)(ws + WS_Z); F.conv_w = inp[10]; F.a_log = inp[11]; F.dt_bias = inp[12]; F.ig_bias = inp[18]; F.fg_bias = inp[19]; F.CHS = (float*)(ws + WS_CHS); F.GLG = (float*)(ws + WS_GLG); F.GLM = F.GLG + 2304; F.WI = F.GLG + 4608; F.PG = (bf16_t*)(ws + WS_PG); F.PM = (bf16_t*)(ws + WS_PM); for (int it = blockIdx.x; it < 2304; it += F.G) { if (it < 1152) { if (!rep) gdn_prep_unit(F, l, it); else if (PROBE_SUB != 2) gdn_prep_unit(F, l, it, PROBE_SUB >= 10 ? PROBE_SUB - 10 : 99, (bf16_t*)(F.ws + WS_H)); } else { if (!rep || PROBE_SUB != 1) mlstm_prep_unit(F, l, it - 1152); } } break;
        case 5: if (ONLY_CASE >= 0 && ONLY_CASE != 5) break;  F.Z = (bf16_t*)(ws + WS_Z); F.PG = (bf16_t*)(ws + WS_PG); F.PM = (bf16_t*)(ws + WS_PM); F.GLG = (float*)(ws + WS_GLG); F.GLM = F.GLG + 2304; F.WI = F.GLG + 4608; F.PEND = (float*)(ws + WS_H); F.MIX = (bf16_t*)(ws + WS_MIX); F.gdn_norm_w = inp[13]; F.mlstm_norm_w = inp[20]; F.sink = inp[14]; F.b_s = inp[16]; F.WSP = (bf16_t*)(wb + WS_WSP); { const int bx = blockIdx.x;
                  if (bx < 32) { if (!rep || PROBE_SUB == 0 || PROBE_SUB == 1 || (PROBE_SUB >= 5 && PROBE_SUB <= 8)) scan_wg<true>(F, l, bx, rep && PROBE_SUB >= 5, rep ? PROBE_SUB - 5 : 0); }
                  else if (bx < 64) { if (!rep || PROBE_SUB == 0 || PROBE_SUB == 1 || PROBE_SUB == 4 || (PROBE_SUB >= 5 && PROBE_SUB <= 8)) scan_wg<false>(F, l, bx - 32, rep && PROBE_SUB >= 5, rep ? PROBE_SUB - 5 : 0); }
                  else if (F.G == 256) {
                      const int k = bx - 64;
                      if (!rep || PROBE_SUB == 0 || PROBE_SUB == 2 || PROBE_SUB >= 9) { swa_unit(F, l, k, rep && PROBE_SUB >= 9 ? PROBE_SUB - 8 : 0); if (k < 96) swa_unit(F, l, k + 192, rep && PROBE_SUB >= 9 ? PROBE_SUB - 8 : 0); }
                      if (!rep || PROBE_SUB == 0 || PROBE_SUB == 3) { if (k < 96) gmlp_unit(F, l, k); else for (int j = 0; j < 5; ++j) gmlp_unit(F, l, 96 + (k - 96) * 5 + j); }
                  } else for (int it = bx - 64; it < 288 + 576; it += F.G - 64) { if (it < 288) swa_unit(F, l, it); else gmlp_unit(F, l, it - 288); } } break;
        case 6: case 9: { if (ONLY_CASE >= 0 && ONLY_CASE != 6) break; F.MIX = (bf16_t*)(ws + WS_MIX); F.HID = (bf16_t*)(ws + WS_HID); F.WOUT = (bf16_t*)(wb + WS_WOUT); F.W2 = (bf16_t*)(wb + WS_W2); F.out = args.out + zero; F.XC = (float*)(ws + WS_XC); F.MOD = (float*)(ws + WS_MOD);  const bool isout = (kind == 6);
                  const int Kd = isout ? D : FF;
                  pg8::Gemm g{isout ? F.MIX : F.HID, isout ? F.WOUT : F.W2, MLAT, D, Kd, Kd, Kd}; pg8::StaticOrder S; S.init(MLAT, D, Kd, F.G, (int)blockIdx.x);
                  if (!last) S.add_split(MCTX / 256, isout ? NSPLIT_OUT : NSPLIT_2, Kd);
                  pg8::EpiResid E{rep ? (float*)(F.ws + WS_H) : F.out, rep ? (float*)(F.ws + WS_H) + (size_t)MLAT * 1024 : F.XC, F.MOD + (size_t)l * 9 * 6144 + (isout ? 2 : 5) * 1024, (float*)(F.ws + WS_SLAB)};
                  pg8::gemm_phase<pg8::EpiResid, pg8::StaticOrder, true, true>(F.lds, g, S, E, wave_s * 64 + fresh_lane());
                  if (!isout && !last && !rep && F.G == 256 && blockIdx.x >= 128) { F.w_in = inp[8]; F.w_out = inp[9]; F.w_s = inp[15]; F.w1 = inp[21]; F.w2 = inp[22]; convert_weights(F, l + 1, ((int)blockIdx.x - 128) * NWAVES + F.wave, 128 * NWAVES, CONV_SPLIT, 6400); } } break;
        case 7: if (ONLY_CASE >= 0 && ONLY_CASE != 7) break;  F.norm2_w = inp[7]; F.out = args.out + zero; F.MOD = (float*)(ws + WS_MOD); F.XC = (float*)(ws + WS_XC); F.H = (bf16_t*)(ws + WS_H); F.SLAB = (float*)(ws + WS_SLAB); phase_norm(F, l, 1, Mrows, (!last && !rep) ? NSPLIT_OUT : 0, F.MOD + (size_t)(l * 9 + 8) * 6144 + 2 * 1024); break;
        case 8: if (ONLY_CASE >= 0 && ONLY_CASE != 8) break;  F.H = (bf16_t*)(ws + WS_H); F.W1 = (bf16_t*)(wb + WS_W1); F.HID = (bf16_t*)(ws + WS_HID); { pg8::Gemm g{F.H, F.W1, Mrows, FF, D, D, D}; pg8::StaticOrder S; S.init(Mrows, FF, D, F.G, (int)blockIdx.x);
                  pg8::EpiBf16<1> E{F.HID, FF}; pg8::gemm_phase<pg8::EpiBf16<1>, pg8::StaticOrder, true, true, true>(F.lds, g, S, E, wave_s * 64 + fresh_lane()); }
                if (!last && !rep && F.G == 256 && blockIdx.x >= 128) { F.w_in = inp[8]; F.w_out = inp[9]; F.w_s = inp[15]; F.w1 = inp[21]; F.w2 = inp[22]; convert_weights(F, l + 1, ((int)blockIdx.x - 128) * NWAVES + F.wave, 128 * NWAVES, CONV_SPLIT0, CONV_SPLIT); }
                break;
        default: { F.out = args.out + zero; F.final_w = inp[23]; const bool poison = (hi - lo > 1) && (__hip_atomic_load(barw + XB_TMO, __ATOMIC_RELAXED, __HIP_MEMORY_SCOPE_AGENT) != 0u); phase_final(F, poison); } break;
        }
        }
        if (ph + 1 < hi) xcd_barrier(bar, wave_s * 64 + fresh_lane());
    }
}

extern "C" void kernel_launch(void* const* d_in, const int* in_sizes, int n_in, void* d_out, int out_size, void* d_ws, size_t ws_size, hipStream_t stream) {
    static int grid = 0;
    if (grid == 0) {
        if (n_in != 24 || out_size != MLAT * D || ws_size < WS_END) { fprintf(stderr, "kernel_launch: unexpected shapes: n_in %d out %d ws %zu (need %zu)\n", n_in, out_size, ws_size, (size_t)WS_END); grid = -1; return; }
        int dev = 0, cus = 0, per_cu = 0;
        if (hipGetDevice(&dev) != hipSuccess || hipDeviceGetAttribute(&cus, hipDeviceAttributeMultiprocessorCount, dev) != hipSuccess) { grid = -1; return; }
        if (hipFuncSetAttribute((const void*)mk_fwd, hipFuncAttributeMaxDynamicSharedMemorySize, LDS_BYTES) != hipSuccess) { fprintf(stderr, "kernel_launch: hipFuncSetAttribute failed\n"); grid = -1; return; }
        if (hipOccupancyMaxActiveBlocksPerMultiprocessor(&per_cu, (const void*)mk_fwd, NWAVES * 64, LDS_BYTES) != hipSuccess || per_cu < 1) { fprintf(stderr, "kernel_launch: occupancy query says %d\n", per_cu); grid = -1; return; }
        (void)hipGetLastError();
        grid = cus;
        if (grid < 128) { fprintf(stderr, "kernel_launch: device too small (%d CUs)\n", grid); grid = -1; return; }
    }
    if (grid < 0) return;
    (void)hipMemsetAsync((char*)d_ws + WS_CTL, 0, CTL_ZERO_BYTES, stream);
    Args a{};
    for (int i = 0; i < 24; ++i) a.in[i] = (const float*)d_in[i];
    a.out = (float*)d_out; a.ws = (unsigned char*)d_ws;
#if MK_PER_PHASE
    for (int p = 0; p < NPH; ++p) { a.ph_lo = p; a.ph_hi = p + 1; hipLaunchKernelGGL(mk_fwd, dim3(grid), dim3(NWAVES * 64), LDS_BYTES, stream, a); }
#else
    a.ph_lo = 0; a.ph_hi = NPH;
    void* kargs[] = {&a};
    hipError_t e = hipLaunchCooperativeKernel((const void*)mk_fwd, dim3(grid), dim3(NWAVES * 64), kargs, LDS_BYTES, stream);
    if (e != hipSuccess) fprintf(stderr, "kernel_launch: cooperative launch failed: %s (grid %d)\n", hipGetErrorString(e), grid);
#endif
}
```

```cpp
#include <hip/hip_runtime.h>
#include <cstdio>
#include <cstdint>
#ifndef MK_PER_PHASE
#define MK_PER_PHASE 0
#endif
#define PROBE_KIND -1
#define PROBE_SUB 0
namespace pg8 {
#define PG8_LAS __attribute__((address_space(3)))
typedef unsigned short bf16_t;
typedef short bf16x8 __attribute__((ext_vector_type(8)));
typedef float f32x4 __attribute__((ext_vector_type(4)));
typedef unsigned u32x4 __attribute__((ext_vector_type(4)));
constexpr int BM = 256, BK = 64, HALF = 128, HTB = HALF * BK * 2  , STAGE_BYTES = 8 * HTB, NXCD = 8, WGM = 8;

__host__ __device__ __forceinline__ int lds_byte(int r, int c) { const int st = (r >> 4) * 2 + (c >> 5), rr = r & 15, cc = c & 31, ob = rr * 64 + cc * 2; return st * 1024 + (ob ^ (((ob >> 9) & 1) << 5)); }
__host__ __device__ __forceinline__ void stage_rc(int b, int& R, int& C) { const int st = b / 1024, sb = b % 1024, swz = sb ^ (((sb >> 9) & 1) << 5); R = (st >> 1) * 16 + swz / 64; C = (st & 1) * 32 + (swz % 64) / 2; }
__host__ __device__ __forceinline__ int perm32(int rho) { const int n = rho >> 4, i = rho & 15; return 8 * (i >> 2) + 4 * n + (i & 3); }

struct Unit { int pm, pn, kofs, nt, slab; };
struct Gemm { const bf16_t* A; const bf16_t* Bt; int M, N, K, lda, ldb; };

struct StaticOrder {
    int nM, nN, nwg, G, c, ntk, nsp, nsplit, kslice, pm0;
    __host__ __device__ void init(int M, int N, int K, int G_, int c_) { nM = M / BM; nN = N / BM; nwg = nM * nN; G = G_; c = c_; ntk = K / BK; nsp = 0; nsplit = 1; kslice = K; pm0 = nM; }
    __host__ __device__ void add_split(int npanels, int nsplit_, int K) { nsplit = nsplit_; kslice = K / nsplit_; nsp = npanels * nN * nsplit_; }
    __host__ __device__ void map(long L, Unit& u) const {
        int wgid = (int)L; { const int q = nwg / NXCD, r = nwg % NXCD, xcd = wgid % NXCD, off = wgid / NXCD; wgid = (xcd < r ? xcd * (q + 1) : r * (q + 1) + (xcd - r) * q) + off; }
        const int nig = WGM * nN, gid = wgid / nig, fm = gid * WGM, gsz = (nM - fm) < WGM ? (nM - fm) : WGM;
        u.pm = fm + ((wgid % nig) % gsz); u.pn = (wgid % nig) / gsz; u.kofs = 0; u.nt = ntk; u.slab = 0;
    }
    __host__ __device__ bool next(int i, Unit& u) const {
        const long L = (long)i * G + c;
        if (L < nwg) { map(L, u); return true; }
        const long J = L - nwg; if (J >= nsp) return false;
        const int ks = (int)(J % nsplit), tile = (int)(J / nsplit);
        u.pn = tile % nN; u.pm = pm0 + tile / nN; u.kofs = ks * kslice; u.nt = kslice / BK; u.slab = ks + 1; return true;
    }
    __device__ __forceinline__ void a_ready(const Unit&) const {}
    __device__ __forceinline__ void done(const Unit&) const {}
};

__device__ __forceinline__ unsigned cvt_pk_bf16(float lo, float hi) { unsigned r; asm volatile("v_cvt_pk_bf16_f32 %0, %1, %2" : "=v"(r) : "v"(lo), "v"(hi)); return r; }

template <int ACT  > struct EpiBf16 {
    static constexpr bool PERM = true, AFTER_DRAIN = false;
    bf16_t* O; int ldc;
    __device__ __forceinline__ void operator()(const f32x4 (&acc)[2][2][4][2], const Unit& u, int wr, int wc, int fr, int fq) const {
        const int row0 = u.pm * BM + wr * 64 + fr; const int col0 = u.pn * BM + wc * 32 + 8 * fq;
#pragma unroll
        for (int ai = 0; ai < 2; ++ai)
#pragma unroll
            for (int m = 0; m < 4; ++m) { bf16_t* rowp = O + (size_t)(row0 + ai * HALF + m * 16) * ldc + col0;
#pragma unroll
                for (int bj = 0; bj < 2; ++bj) { f32x4 v0 = acc[ai][bj][m][0], v1 = acc[ai][bj][m][1];
                    if (ACT == 1) {
#pragma unroll
                        for (int e = 0; e < 4; ++e) { float a = fmaxf(v0[e], 0.f), b = fmaxf(v1[e], 0.f); v0[e] = a * a; v1[e] = b * b; } }
                    u32x4 w; w.x = cvt_pk_bf16(v0[0], v0[1]); w.y = cvt_pk_bf16(v0[2], v0[3]); w.z = cvt_pk_bf16(v1[0], v1[1]); w.w = cvt_pk_bf16(v1[2], v1[3]);
                    *(u32x4*)(rowp + bj * HALF) = w; } }
    }
};

struct EpiResid {
    static constexpr bool PERM = false, AFTER_DRAIN = false;
    float* xlat; float* xctx; const float* gmod; float* slab;
    __device__ __forceinline__ void operator()(const f32x4 (&acc)[2][2][4][2], const Unit& u, int wr, int wc, int fr, int fq) const {
        if (u.slab) {
            float* sb = slab + (size_t)(u.slab - 1) * 2048 * 1024 + (size_t)(u.pm - 64) * BM * 1024 + u.pn * BM + wc * 32 + 4 * fq;
#pragma unroll
            for (int ai = 0; ai < 2; ++ai)
#pragma unroll
                for (int m = 0; m < 4; ++m) { float* rowp = sb + (size_t)(ai * HALF + wr * 64 + m * 16 + fr) * 1024;
#pragma unroll
                    for (int bj = 0; bj < 2; ++bj)
#pragma unroll
                        for (int n = 0; n < 2; ++n) *(f32x4*)(rowp + bj * HALF + n * 16) = acc[ai][bj][m][n]; }
            return;
        }
        const int bm = u.pm < 64 ? (u.pm >> 3) : 8;
        float* base = u.pm < 64 ? xlat + (size_t)u.pm * BM * 1024 : xctx + (size_t)(u.pm - 64) * BM * 1024;
        const float* g = gmod + bm * 6144;
        const int col0 = u.pn * BM + wc * 32 + 4 * fq;
        f32x4 gv[2][2];
#pragma unroll
        for (int bj = 0; bj < 2; ++bj)
#pragma unroll
            for (int n = 0; n < 2; ++n) gv[bj][n] = *(const f32x4*)(g + col0 + bj * HALF + n * 16);
#pragma unroll
        for (int ai = 0; ai < 2; ++ai)
#pragma unroll
            for (int m = 0; m < 4; ++m) { float* rowp = base + (size_t)(ai * HALF + wr * 64 + m * 16 + fr) * 1024 + col0;
                f32x4 xv[2][2];
#pragma unroll
                for (int bj = 0; bj < 2; ++bj)
#pragma unroll
                    for (int n = 0; n < 2; ++n) xv[bj][n] = *(const f32x4*)(rowp + bj * HALF + n * 16);
#pragma unroll
                for (int bj = 0; bj < 2; ++bj)
#pragma unroll
                    for (int n = 0; n < 2; ++n) *(f32x4*)(rowp + bj * HALF + n * 16) = xv[bj][n] + gv[bj][n] * acc[ai][bj][m][n];
                if (m & 1) asm volatile("" ::: "memory"); }
    }
};

template <class Epi, class Sched, bool ALIGN_EPI = false, bool SP2 = false, bool UNIFORM_NT = false>
__device__ __forceinline__ void gemm_phase(PG8_LAS unsigned char* lds, const Gemm g, const Sched& S, const Epi& E, int tid_in) {
    int tid_o = tid_in; asm volatile("" : "+v"(tid_o)); const int tid = tid_o, wid = __builtin_amdgcn_readfirstlane(tid >> 6), lane = tid & 63, wr = wid >> 2, wc = wid & 3, fr = lane & 15, fq = lane >> 4;
    const int lda = g.lda, ldb = g.ldb; const int nt_uniform = g.K / BK;
    unsigned voffA[2], voffB[2];
#pragma unroll
    for (int i = 0; i < 2; ++i) { int R, C; stage_rc(tid * 16 + i * 8192, R, C); const int Rb = Epi::PERM ? ((R & ~31) + perm32(R & 31)) : R;
        voffA[i] = (unsigned)(R * lda + C) * 2u; voffB[i] = (unsigned)(Rb * ldb + C) * 2u; }
    const size_t kstep = (size_t)(BK * 2);
    const size_t hstepA = (size_t)HALF * lda * 2, hstepB = (size_t)HALF * ldb * 2;
    const size_t tstepA = 2 * hstepA, tstepB = 2 * hstepB;
    const unsigned ldsw = (unsigned)wid * 1024u;
    const int aoff = lds_byte(wr * 64 + fr, fq * 8), boff = lds_byte(wc * 32 + fr, fq * 8);
#define PG8_SA(b, h) (((b) * 2 + (h)) * HTB)
#define PG8_SB(b, h) ((4 + (b) * 2 + (h)) * HTB)
#define PG8_STAGE(bufoff, gbase, voff) do { _Pragma("unroll") for (int _i = 0; _i < 2; ++_i) \
        __builtin_amdgcn_global_load_lds((const unsigned*)((const char*)(gbase) + (voff)[_i]), (PG8_LAS unsigned*)(lds + (bufoff) + ldsw + _i * 8192), 16, 0, 0); } while (0)
#define PG8_LDA(dst, b, h) do { _Pragma("unroll") for (int m = 0; m < 4; ++m) _Pragma("unroll") for (int k = 0; k < 2; ++k) dst[m][k] = *(const PG8_LAS bf16x8*)(lds + PG8_SA(b, h) + aoff + m * 2048 + k * 1024); } while (0)
#define PG8_LDB(dst, b, h) do { _Pragma("unroll") for (int n = 0; n < 2; ++n) _Pragma("unroll") for (int k = 0; k < 2; ++k) dst[n][k] = *(const PG8_LAS bf16x8*)(lds + PG8_SB(b, h) + boff + n * 2048 + k * 1024); } while (0)
#define PG8_MMA(ai, bj, At, Bt) do { __builtin_amdgcn_s_setprio(1); _Pragma("unroll") for (int m = 0; m < 4; ++m) _Pragma("unroll") for (int n = 0; n < 2; ++n) _Pragma("unroll") for (int k = 0; k < 2; ++k) \
        acc[ai][bj][m][n] = __builtin_amdgcn_mfma_f32_16x16x32_bf16(Bt[n][k], At[m][k], acc[ai][bj][m][n], 0, 0, 0); __builtin_amdgcn_s_setprio(0); } while (0)
#define PG8_WAIT_V(n) asm volatile("s_waitcnt vmcnt(" #n ")" ::: "memory")
#define PG8_WAIT_L(n) asm volatile("s_waitcnt lgkmcnt(" #n ")" ::: "memory")
#define PG8_BAR __builtin_amdgcn_s_barrier()
#define PG8_SCHED __builtin_amdgcn_sched_barrier(0)
    Unit cur, nxt; int ui = 0;
    if (!S.next(0, cur)) return;
    f32x4 acc[2][2][4][2];
#pragma unroll
    for (int a = 0; a < 2; ++a)
#pragma unroll
        for (int b = 0; b < 2; ++b)
#pragma unroll
            for (int m = 0; m < 4; ++m)
#pragma unroll
                for (int n = 0; n < 2; ++n) acc[a][b][m][n] = (f32x4){0.f, 0.f, 0.f, 0.f};
    bf16x8 At[4][2], B0[2][2], B1[2][2];
    const char* cA = (const char*)g.A + (size_t)cur.pm * tstepA + (size_t)cur.kofs * 2; const char* cB = (const char*)g.Bt + (size_t)cur.pn * tstepB + (size_t)cur.kofs * 2;
    S.a_ready(cur);
    if constexpr (SP2) {
        PG8_STAGE(PG8_SB(0, 0), cB, voffB); PG8_STAGE(PG8_SB(0, 1), cB + hstepB, voffB); PG8_STAGE(PG8_SA(0, 0), cA, voffA); PG8_STAGE(PG8_SA(0, 1), cA + hstepA, voffA);
        if (wr == 1) PG8_BAR;
        PG8_WAIT_V(2); PG8_BAR;
        PG8_STAGE(PG8_SB(1, 0), cB + kstep, voffB); PG8_STAGE(PG8_SA(1, 0), cA + kstep, voffA); PG8_STAGE(PG8_SB(1, 1), cB + hstepB + kstep, voffB);
        PG8_WAIT_V(6); PG8_BAR;
    } else {
        PG8_STAGE(PG8_SB(0, 0), cB, voffB); PG8_STAGE(PG8_SA(0, 0), cA, voffA); PG8_STAGE(PG8_SB(0, 1), cB + hstepB, voffB); PG8_STAGE(PG8_SA(0, 1), cA + hstepA, voffA);
        if (wr == 1) PG8_BAR;
        PG8_WAIT_V(4); PG8_BAR;
        PG8_STAGE(PG8_SB(1, 0), cB + kstep, voffB); PG8_STAGE(PG8_SA(1, 0), cA + kstep, voffA); PG8_STAGE(PG8_SB(1, 1), cB + hstepB + kstep, voffB);
        PG8_WAIT_V(6); PG8_BAR;
    }
    for (;;) {
        const bool has_next = S.next(ui + 1, nxt);
        const char* nA = has_next ? (const char*)g.A + (size_t)nxt.pm * tstepA + (size_t)nxt.kofs * 2 : cA; const char* nB = has_next ? (const char*)g.Bt + (size_t)nxt.pn * tstepB + (size_t)nxt.kofs * 2 : cB;
        const int nt = UNIFORM_NT ? nt_uniform : cur.nt;
        for (int t = 0; t < nt; t += 2) {
            const bool last = (t == nt - 2);
            const char* a1 = cA + (size_t)(t + 1) * kstep;
            const char* a2 = last ? nA : cA + (size_t)(t + 2) * kstep; const char* b2 = last ? nB : cB + (size_t)(t + 2) * kstep;
            const char* a3 = a2 + kstep; const char* b3 = b2 + kstep;
            if (last && has_next) S.a_ready(nxt);
            if constexpr (SP2) {
            PG8_LDB(B0, 0, 0); PG8_LDB(B1, 0, 1); PG8_SCHED; PG8_LDA(At, 0, 0); PG8_STAGE(PG8_SA(1, 1), a1 + hstepA, voffA);
            PG8_WAIT_V(8); PG8_WAIT_L(0); PG8_BAR; PG8_MMA(0, 0, At, B0); PG8_MMA(0, 1, At, B1); PG8_BAR; PG8_SCHED;
            PG8_LDA(At, 0, 1); PG8_STAGE(PG8_SB(0, 0), b2, voffB); PG8_STAGE(PG8_SB(0, 1), b2 + hstepB, voffB); PG8_STAGE(PG8_SA(0, 0), a2, voffA);
            PG8_WAIT_V(8); PG8_WAIT_L(0); PG8_BAR; PG8_MMA(1, 0, At, B0); PG8_MMA(1, 1, At, B1); PG8_BAR; PG8_SCHED;
            PG8_LDB(B0, 1, 0); PG8_LDB(B1, 1, 1); PG8_SCHED; PG8_LDA(At, 1, 0); PG8_STAGE(PG8_SA(0, 1), a2 + hstepA, voffA);
            PG8_WAIT_V(8); PG8_WAIT_L(0); PG8_BAR; PG8_MMA(0, 0, At, B0); PG8_MMA(0, 1, At, B1); PG8_BAR; PG8_SCHED;
            PG8_LDA(At, 1, 1); PG8_STAGE(PG8_SB(1, 0), b3, voffB); PG8_STAGE(PG8_SB(1, 1), b3 + hstepB, voffB); PG8_STAGE(PG8_SA(1, 0), a3, voffA);
            PG8_WAIT_V(8); PG8_WAIT_L(0); PG8_BAR; PG8_MMA(1, 0, At, B0); PG8_MMA(1, 1, At, B1); PG8_BAR; PG8_SCHED;
            } else {
            PG8_LDB(B0, 0, 0); PG8_SCHED; PG8_LDA(At, 0, 0); PG8_STAGE(PG8_SA(1, 1), a1 + hstepA, voffA);
            PG8_WAIT_L(8); PG8_BAR; PG8_WAIT_L(0); PG8_MMA(0, 0, At, B0); PG8_BAR; PG8_SCHED;
            PG8_LDB(B1, 0, 1); PG8_STAGE(PG8_SB(0, 0), b2, voffB);
            PG8_BAR; PG8_WAIT_L(0); PG8_MMA(0, 1, At, B1); PG8_BAR;
            PG8_LDA(At, 0, 1); PG8_STAGE(PG8_SA(0, 0), a2, voffA);
            PG8_BAR; PG8_WAIT_L(0); PG8_MMA(1, 0, At, B0); PG8_BAR; PG8_SCHED;
            PG8_STAGE(PG8_SB(0, 1), b2 + hstepB, voffB);
            PG8_WAIT_V(6); PG8_BAR; PG8_MMA(1, 1, At, B1); PG8_BAR;
            PG8_LDB(B0, 1, 0); PG8_SCHED; PG8_LDA(At, 1, 0); PG8_STAGE(PG8_SA(0, 1), a2 + hstepA, voffA);
            PG8_WAIT_L(8); PG8_BAR; PG8_WAIT_L(0); PG8_MMA(0, 0, At, B0); PG8_BAR; PG8_SCHED;
            PG8_LDB(B1, 1, 1); PG8_STAGE(PG8_SB(1, 0), b3, voffB);
            PG8_BAR; PG8_WAIT_L(0); PG8_MMA(0, 1, At, B1); PG8_BAR;
            PG8_LDA(At, 1, 1); PG8_STAGE(PG8_SA(1, 0), a3, voffA);
            PG8_BAR; PG8_WAIT_L(0); PG8_MMA(1, 0, At, B0); PG8_BAR; PG8_SCHED;
            PG8_STAGE(PG8_SB(1, 1), b3 + hstepB, voffB);
            PG8_WAIT_V(6); PG8_BAR; PG8_MMA(1, 1, At, B1); PG8_BAR;
            }
        }
        if constexpr (ALIGN_EPI) { if (wr == 0) PG8_BAR; }
        if constexpr (!Epi::AFTER_DRAIN) { E(acc, cur, wr, wc, fr, fq); S.done(cur); }
        if (!has_next) break;
#pragma unroll
        for (int a = 0; a < 2; ++a)
#pragma unroll
            for (int b = 0; b < 2; ++b)
#pragma unroll
                for (int m = 0; m < 4; ++m)
#pragma unroll
                    for (int n = 0; n < 2; ++n) acc[a][b][m][n] = (f32x4){0.f, 0.f, 0.f, 0.f};
        cur = nxt; cA = nA; cB = nB; ++ui;
        if constexpr (ALIGN_EPI) { if (wr == 1) PG8_BAR; }
    }
    PG8_WAIT_V(0);
    if constexpr (!ALIGN_EPI) { if (wr == 0) PG8_BAR; }
    PG8_BAR;
    if constexpr (Epi::AFTER_DRAIN) { E.fused(acc, cur, wr, wc, fr, fq, lds, wid, lane); S.done(cur); }
#undef PG8_SA
#undef PG8_SB
#undef PG8_STAGE
#undef PG8_LDA
#undef PG8_LDB
#undef PG8_MMA
#undef PG8_WAIT_V
#undef PG8_WAIT_L
#undef PG8_BAR
#undef PG8_SCHED
}
}
constexpr int NWAVES = 8;
constexpr int NB = 8, SEQ = 2048, CTXL = 256, D = 1024, DEPTH = 4, FF = 4096;
constexpr int MLAT = NB * SEQ, MCTX = NB * CTXL, MALL = MLAT + MCTX;
constexpr int ZW = 3328;
constexpr int ZC_GQ = 0, ZC_GK = 256, ZC_GV = 512, ZC_GZ = 768, ZC_SQ = 1024, ZC_SK = 1280, ZC_SV = 1408, ZC_MU = 1536, ZC_MV = 1792,
              ZC_LQ = 2048, ZC_LK = 2304, ZC_LV = 2560, ZC_LO = 2816, ZC_GA = 3072, ZC_GB = 3080, ZC_LI = 3088, ZC_LF = 3096;
constexpr float EPS = 1e-6f;
constexpr size_t MiB = 1u << 20;
constexpr size_t WS_CTL = 0, CTL_ZERO_BYTES = 65536;
constexpr size_t WS_MOD = 1 * MiB;
constexpr size_t WS_WIN = 2 * MiB, WS_WOUT = 9 * MiB, WS_W1 = 11 * MiB, WS_W2 = 19 * MiB, WS_WSP = 27 * MiB;
constexpr size_t WS_CHS = 27 * MiB + 512 * 1024;
constexpr size_t WS_GLG = 27 * MiB + 768 * 1024;
constexpr size_t WS_XC = 29 * MiB;
constexpr size_t WS_H = 37 * MiB;
constexpr size_t WS_MIX = 73 * MiB;
constexpr size_t WS_Z = 109 * MiB;
constexpr size_t WS_PG = 226 * MiB;
constexpr size_t WS_PM = 298 * MiB;
constexpr size_t WS_HID = 109 * MiB;
constexpr size_t WS_SLAB = 254 * MiB;
constexpr size_t WS_WSET2 = 343 * MiB;
constexpr size_t WSET_STRIDE = WS_WSET2 - 2 * MiB;
constexpr size_t WS_END = 369 * MiB;
constexpr int NSPLIT_OUT = 2, NSPLIT_2 = 4;
constexpr int CONV_SPLIT0 = 0, CONV_SPLIT = 3000;
constexpr int CW_BAR = 1024;
constexpr int LDS_BYTES = 147456;
constexpr int MISC_OFF = 131072 + 8192;

#define LAS __attribute__((address_space(3)))
typedef unsigned short bf16_t;
typedef unsigned v4u __attribute__((ext_vector_type(4)));
typedef unsigned v2u __attribute__((ext_vector_type(2)));
typedef float f32x4 __attribute__((ext_vector_type(4)));
typedef short bf16x8 __attribute__((ext_vector_type(8)));
#define LDS_WAIT() asm volatile("s_waitcnt lgkmcnt(0)" ::: "memory")
#define VM_WAIT() asm volatile("s_waitcnt vmcnt(0)" ::: "memory")
typedef float f32x2_ __attribute__((ext_vector_type(2)));
typedef __bf16 bf16x2_ __attribute__((ext_vector_type(2)));
__device__ __forceinline__ unsigned pk2(float lo, float hi) { const f32x2_ v = {lo, hi}; const bf16x2_ r = __builtin_convertvector(v, bf16x2_); return __builtin_bit_cast(unsigned, r); }
__device__ __forceinline__ unsigned f2bf(float f) { return pk2(f, 0.f) & 0xffffu; }
__device__ __forceinline__ float bf2f(unsigned v) { return __builtin_bit_cast(float, v << 16); }
__device__ __forceinline__ float bflo(unsigned w) { return __builtin_bit_cast(float, w << 16); }
__device__ __forceinline__ float bfhi(unsigned w) { return __builtin_bit_cast(float, w & 0xffff0000u); }
template <int CTRL> __device__ __forceinline__ float dppf(float x) { return __builtin_bit_cast(float, __builtin_amdgcn_update_dpp(0, __builtin_bit_cast(int, x), CTRL, 0xF, 0xF, true)); }
__device__ __forceinline__ float row16_sum(float v) { v += dppf<0xB1>(v); v += dppf<0x4E>(v); v += dppf<0x141>(v); v += dppf<0x140>(v); return v; }
__device__ __forceinline__ float row16_max(float v) { v = fmaxf(v, dppf<0xB1>(v)); v = fmaxf(v, dppf<0x4E>(v)); v = fmaxf(v, dppf<0x141>(v)); v = fmaxf(v, dppf<0x140>(v)); return v; }
__device__ __forceinline__ float quad_sum(float v) { v += dppf<0xB1>(v); v += dppf<0x4E>(v); return v; }
template <int N> __device__ __forceinline__ float row16_bcast(float v) { return dppf<0x150 + N>(v); }
__device__ __forceinline__ float wave_sum(float v) { v = row16_sum(v); v += __shfl_xor(v, 16); v += __shfl_xor(v, 32); return v; }
__device__ __forceinline__ float frcp(float x) { return __builtin_amdgcn_rcpf(x); }
__device__ __forceinline__ float frsq(float x) { return __builtin_amdgcn_rsqf(x); }
__device__ __forceinline__ float fexp(float x) { return __builtin_amdgcn_exp2f(x * 1.4426950408889634f); }
__device__ __forceinline__ float flog1p(float y) { return y < 0.02f ? y * (1.0f - y * (0.5f - y * (0.33333333f - 0.25f * y))) : __builtin_amdgcn_logf(1.0f + y) * 0.6931471805599453f; }
__device__ __forceinline__ float sigmoidf_(float x) { return frcp(1.f + fexp(-x)); }
__device__ __forceinline__ float siluf_(float x) { return x * frcp(1.f + fexp(-x)); }
__device__ __forceinline__ float softplusf_(float x) { return x > 20.f ? x : flog1p(fexp(x)); }
__device__ __forceinline__ float logsigf_(float x) { return x >= 0.f ? -flog1p(fexp(-x)) : x - flog1p(fexp(x)); }
__device__ __forceinline__ float geluf_(float x) { const float u = 0.7978845608028654f * (x + 0.044715f * x * x * x); const float th = 1.0f - 2.0f * frcp(1.0f + fexp(2.0f * u)); return 0.5f * x * (1.f + th); }
template <int KS> __device__ __forceinline__ f32x4 mma_ll(const LAS bf16_t* A, int lda, const LAS bf16_t* Bt, int ldb, f32x4 acc, int lane) {
    const LAS bf16_t* ap = A + (lane & 15) * lda + 8 * (lane >> 4);
    const LAS bf16_t* bp = Bt + (lane & 15) * ldb + 8 * (lane >> 4);
#pragma unroll
    for (int ks = 0; ks < KS; ++ks) {
        const bf16x8 a = *(const LAS bf16x8*)(ap + 32 * ks); const bf16x8 b = *(const LAS bf16x8*)(bp + 32 * ks);
        acc = __builtin_amdgcn_mfma_f32_16x16x32_bf16(a, b, acc, 0, 0, 0);
    }
    return acc;
}
__device__ __forceinline__ v2u pack4(const f32x4 v) { v2u r; r.x = pk2(v[0], v[1]); r.y = pk2(v[2], v[3]); return r; }
__device__ __forceinline__ f32x4 unpack4(const v2u w) { f32x4 r; r[0] = bflo(w.x); r[1] = bfhi(w.x); r[2] = bflo(w.y); r[3] = bfhi(w.y); return r; }
__device__ __forceinline__ int chunk_row0(int b, int cidx) { return cidx < 4 ? MLAT + b * CTXL + cidx * 64 : b * SEQ + (cidx - 4) * 64; }

#define XB_TMO      128
#define XB_XCNT(j)  (256  + 64 * (j))
#define XB_XSUB(j)  (1280 + 64 * (j))
#define XB_XGEN(j)  (2304 + 64 * (j))
#define XB_TOP      3328
#define XB_TOPGEN   3392
#define XCD_BAR_WORDS 3456
#define XB_SPIN_CAP (1u << 18)

__device__ __forceinline__ unsigned xb_ld(unsigned* p)              { return __hip_atomic_load(p, __ATOMIC_RELAXED, __HIP_MEMORY_SCOPE_AGENT); }
__device__ __forceinline__ unsigned xb_add(unsigned* p, unsigned v) { return __hip_atomic_fetch_add(p, v, __ATOMIC_RELAXED, __HIP_MEMORY_SCOPE_AGENT); }
__device__ __forceinline__ unsigned xb_xcc_id() { return (unsigned)__builtin_amdgcn_s_getreg((3 << 11) | 20) & 0xFu; }
#define XB_SPIN(cond, bar) do { unsigned _sp = 0; while (cond) { __builtin_amdgcn_s_sleep(1); \
    if ((++_sp & 255u) == 0u) { if (xb_ld(&(bar)[XB_TMO])) break; if (_sp > XB_SPIN_CAP) { atomicAdd(&(bar)[XB_TMO], 1u); break; } } } } while (0)

struct XcdBarrier {
    unsigned* bar; unsigned x;
    volatile LAS unsigned* st;
};

__device__ __forceinline__ XcdBarrier xcd_barrier_post(unsigned* bar, volatile LAS unsigned* st, int tid) {
    XcdBarrier b; b.bar = bar; b.x = xb_xcc_id(); b.st = st;
    if (tid == 0) (void)xb_add(&bar[XB_XCNT(b.x)], 1u);
    return b;
}
__device__ __forceinline__ void xcd_barrier_complete(unsigned* bar, unsigned x, unsigned& nloc, unsigned& nx) {
    const unsigned G = gridDim.x * gridDim.y * gridDim.z;
    unsigned sum, cnt, mine, sp = 0u;
    for (;;) {
        sum = 0u; cnt = 0u; mine = 0u;
#pragma unroll
        for (unsigned j = 0; j < 16; ++j) { const unsigned c = xb_ld(&bar[XB_XCNT(j)]); sum += c; cnt += (c > 0u) ? 1u : 0u; mine = (j == x) ? c : mine; }
        if (sum == G) break;
        __builtin_amdgcn_s_sleep(1);
        if ((++sp & 255u) == 0u) { if (xb_ld(&bar[XB_TMO])) break; if (sp > XB_SPIN_CAP) { atomicAdd(&bar[XB_TMO], 1u); break; } }
    }
    nloc = mine > 0u ? mine : 1u; nx = cnt > 0u ? cnt : 1u;
}

__device__ __forceinline__ void xcd_barrier(const XcdBarrier& b, int tid) {
    asm volatile("s_waitcnt vmcnt(0)" ::: "memory");
    __syncthreads();
    if (tid == 0) {
        unsigned* bar = b.bar;
        __builtin_amdgcn_s_waitcnt(0);
        unsigned nloc = b.st[0], nx = b.st[1];
        if (nloc == 0u) { xcd_barrier_complete(bar, b.x, nloc, nx); b.st[0] = nloc; b.st[1] = nx; }
        const unsigned old = xb_add(&bar[XB_XSUB(b.x)], 1u);
        const unsigned gen = old / nloc;
        if (old + 1u == (gen + 1u) * nloc) {
            __builtin_amdgcn_fence(__ATOMIC_RELEASE, "agent");
            asm volatile("s_waitcnt vmcnt(0)" ::: "memory");
            const unsigned og = xb_add(&bar[XB_TOP], 1u);
            const unsigned tg = og / nx;
            if (og + 1u == (tg + 1u) * nx) xb_add(&bar[XB_TOPGEN], 1u);
            else XB_SPIN(xb_ld(&bar[XB_TOPGEN]) == tg, bar);
            __builtin_amdgcn_fence(__ATOMIC_ACQUIRE, "agent");
            xb_add(&bar[XB_XGEN(b.x)], 1u);
            asm volatile("s_waitcnt vmcnt(0)" ::: "memory");
        } else {
            XB_SPIN(xb_ld(&bar[XB_XGEN(b.x)]) == gen, bar);
            __builtin_amdgcn_fence(__ATOMIC_ACQUIRE, "agent");
            asm volatile("s_waitcnt vmcnt(0)" ::: "memory");
        }
    }
    __syncthreads();
}

struct Frame {
    LAS unsigned char* lds;
    int wave, G, gw, NGW;
    const float *x, *c, *ctx, *cctx, *ada_w, *ada_b, *norm1_w, *norm2_w, *w_in, *w_out, *conv_w, *a_log, *dt_bias, *gdn_norm_w, *sink, *w_s, *b_s,
                *gmlp_norm_w, *ig_bias, *fg_bias, *mlstm_norm_w, *w1, *w2, *final_w;
    float* out; unsigned char* ws;
    float *MOD, *XC, *CHS, *GLG, *GLM, *WI, *PEND, *SLAB;
    bf16_t *WIN, *WOUT, *W1, *W2, *WSP, *H, *MIX, *Z, *PG, *PM, *HID;
};

__device__ __forceinline__ int fresh_lane() { int t; asm volatile("v_mbcnt_lo_u32_b32 %0, -1, 0\n\tv_mbcnt_hi_u32_b32 %0, -1, %0" : "=v"(t)); return t; }
__device__ __forceinline__ void phase_mod(const Frame& F) {
    LAS float* sact = (LAS float*)F.lds;
    LAS float* part = sact + 9 * 1024;
    const int lane0 = fresh_lane(), tid0 = F.wave * 64 + lane0;
    for (int i = tid0; i < 9 * 1024; i += NWAVES * 64) { const float v = i < 8192 ? F.c[i] : F.cctx[i - 8192]; sact[i] = v * frcp(1.f + fexp(-v)); }
    __syncthreads();
    for (int task = blockIdx.x; task < DEPTH * 48; task += F.G) {
        const int lane = fresh_lane(), tid = F.wave * 64 + lane;
        const int l = task / 48, cg = task % 48, col = cg * 128 + 2 * lane, k0 = F.wave * 128;
        const float* w = F.ada_w + (size_t)l * 1024 * 6144 + (size_t)k0 * 6144 + col;
        float a0[9], a1[9];
#pragma unroll
        for (int b = 0; b < 9; ++b) { a0[b] = 0.f; a1[b] = 0.f; }
#pragma unroll 8
        for (int k = 0; k < 128; ++k) { const f32x2_ wv = *(const f32x2_*)(w + (size_t)k * 6144);
#pragma unroll
            for (int b = 0; b < 9; ++b) { const float sv = sact[b * 1024 + k0 + k]; a0[b] += sv * wv[0]; a1[b] += sv * wv[1]; } }
#pragma unroll
        for (int b = 0; b < 9; ++b) { part[(F.wave * 9 + b) * 128 + 2 * lane] = a0[b]; part[(F.wave * 9 + b) * 128 + 2 * lane + 1] = a1[b]; }
        __syncthreads();
        for (int o = tid; o < 9 * 128; o += NWAVES * 64) { const int b = o >> 7, cc = o & 127; float s = F.ada_b[l * 6144 + cg * 128 + cc];
#pragma unroll
            for (int wv = 0; wv < 8; ++wv) s += part[(wv * 9 + b) * 128 + cc];
            F.MOD[(l * 9 + b) * 6144 + cg * 128 + cc] = s; }
        __syncthreads();
    }
}

__device__ __forceinline__ void transpose_item(const float* W, int K, int N, int Ndst, bf16_t* WT, LAS float* scr, int item, int lane, bool remap) {
    const int nblk = Ndst / 32, kb = item / nblk, nb = item % nblk, k0 = 64 * kb, n0 = 32 * nb;
    const int n = n0 + (lane & 31);
    const int src = remap ? (n < 1024 ? n : n < 3072 ? n + 16 : n < 3088 ? n - 2048 : n < 3104 ? n : -1) : n;
    float wv[32]; const int srcc = src >= 0 ? src : 0;
#pragma unroll
    for (int i = 0; i < 32; ++i) wv[i] = W[(size_t)(k0 + 2 * i + (lane >> 5)) * N + srcc];
#pragma unroll
    for (int i = 0; i < 32; ++i) scr[(2 * i + (lane >> 5)) * 33 + (lane & 31)] = src >= 0 ? wv[i] : 0.f;
    LDS_WAIT(); asm volatile("" ::: "memory");
    const int c = lane & 7;
#pragma unroll
    for (int j = 0; j < 4; ++j) { const int nn = (lane >> 3) + 8 * j; const LAS float* s = scr + (8 * c) * 33 + nn;
        v4u o; o.x = pk2(s[0 * 33], s[1 * 33]); o.y = pk2(s[2 * 33], s[3 * 33]); o.z = pk2(s[4 * 33], s[5 * 33]); o.w = pk2(s[6 * 33], s[7 * 33]);
        *(v4u*)(WT + (size_t)(n0 + nn) * K + k0 + 8 * c) = o; }
    LDS_WAIT(); asm volatile("" ::: "memory");
}
__device__ __forceinline__ void convert_weights(const Frame& F, int l, int gw, int ngw, int item_lo, int item_hi) {
    LAS float* scr = (LAS float*)(F.lds + F.wave * 16384);
    unsigned char* wb = F.ws + (size_t)(l & 1) * WSET_STRIDE;
    bf16_t* dWIN = (bf16_t*)(wb + WS_WIN); bf16_t* dWOUT = (bf16_t*)(wb + WS_WOUT); bf16_t* dW1 = (bf16_t*)(wb + WS_W1); bf16_t* dW2 = (bf16_t*)(wb + WS_W2); bf16_t* dWSP = (bf16_t*)(wb + WS_WSP);
    constexpr int I_IN = 16 * (ZW / 32), I_OUT = 16 * 32, I_1 = 16 * 128, I_2 = 64 * 32, I_S = 128;
    for (int it = item_lo + gw; it < item_hi; it += ngw) {
        int r = it; const int lane = fresh_lane();
        if (r < I_IN) { transpose_item(F.w_in + (size_t)l * 1024 * 3104, 1024, 3104, ZW, dWIN, scr, r, lane, true); continue; } r -= I_IN;
        if (r < I_OUT) { transpose_item(F.w_out + (size_t)l * 1024 * 1024, 1024, 1024, 1024, dWOUT, scr, r, lane, false); continue; } r -= I_OUT;
        if (r < I_1) { transpose_item(F.w1 + (size_t)l * 1024 * 4096, 1024, 4096, 4096, dW1, scr, r, lane, false); continue; } r -= I_1;
        if (r < I_2) { transpose_item(F.w2 + (size_t)l * 4096 * 1024, 4096, 1024, 1024, dW2, scr, r, lane, false); continue; } r -= I_2;
        { const float* s = F.w_s + (size_t)l * 65536 + r * 512 + lane * 8; const f32x4 a = *(const f32x4*)s, b = *(const f32x4*)(s + 4);
          v4u o; o.x = pk2(a[0], a[1]); o.y = pk2(a[2], a[3]); o.z = pk2(b[0], b[1]); o.w = pk2(b[2], b[3]); *(v4u*)(dWSP + r * 512 + lane * 8) = o; }
    }
}

__device__ __forceinline__ void phase_norm(const Frame& F, int l, int which, int nrows, int nslab, const float* sgate) {
    const float* nwp = (which == 0 ? F.norm1_w : F.norm2_w) + l * 1024;
    const bool init = (which == 0 && l == 0);
    const int lane = fresh_lane();
    f32x4 nwv[4];
#pragma unroll
    for (int j = 0; j < 4; ++j) nwv[j] = *(const f32x4*)(nwp + 256 * j + 4 * lane);
    int m = F.gw; if (m >= nrows) return;
    f32x4 v[4], vn[4];
    { const bool lat = m < MLAT; const float* src = init ? (lat ? F.x + (size_t)m * 1024 : F.ctx + (size_t)(m - MLAT) * 1024) : (lat ? F.out + (size_t)m * 1024 : F.XC + (size_t)(m - MLAT) * 1024);
#pragma unroll
      for (int j = 0; j < 4; ++j) v[j] = *(const f32x4*)(src + 256 * j + 4 * lane); }
    for (; m < nrows; m += F.NGW) {
        const bool lat = m < MLAT; const int bm = lat ? (m >> 11) : 8;
        float* xrow = lat ? F.out + (size_t)m * 1024 : F.XC + (size_t)(m - MLAT) * 1024;
        const float* mod = F.MOD + (l * 9 + bm) * 6144 + (which == 0 ? 0 : 3 * 1024);
        f32x4 shv[4], scv[4];
#pragma unroll
        for (int j = 0; j < 4; ++j) { const int col = 256 * j + 4 * lane; shv[j] = *(const f32x4*)(mod + col); scv[j] = *(const f32x4*)(mod + 1024 + col); }
        const int mn = m + F.NGW;
        if (mn < nrows) { const bool latn = mn < MLAT; const float* srcn = init ? (latn ? F.x + (size_t)mn * 1024 : F.ctx + (size_t)(mn - MLAT) * 1024) : (latn ? F.out + (size_t)mn * 1024 : F.XC + (size_t)(mn - MLAT) * 1024);
#pragma unroll
            for (int j = 0; j < 4; ++j) vn[j] = *(const f32x4*)(srcn + 256 * j + 4 * lane); }
        const bool red = !lat && nslab > 0;
        if (red) {
#pragma unroll
            for (int j = 0; j < 4; ++j) { f32x4 a = {0.f, 0.f, 0.f, 0.f};
                for (int k = 0; k < nslab; ++k) a += *(const f32x4*)(F.SLAB + ((size_t)k * MCTX + (m - MLAT)) * 1024 + 256 * j + 4 * lane);
                v[j] += a * *(const f32x4*)(sgate + 256 * j + 4 * lane); }
        }
        float s = 0.f;
#pragma unroll
        for (int j = 0; j < 4; ++j) s += (v[j][0] * v[j][0] + v[j][1] * v[j][1]) + (v[j][2] * v[j][2] + v[j][3] * v[j][3]);
        const float rstd = frsq(wave_sum(s) * (1.f / 1024.f) + EPS);
#pragma unroll
        for (int j = 0; j < 4; ++j) {
            const int col = 256 * j + 4 * lane;
            if (init || red) *(f32x4*)(xrow + col) = v[j];
            const f32x4 hh = (v[j] * rstd * nwv[j]) * (scv[j] + 1.0f) + shv[j];
            *(v2u*)(F.H + (size_t)m * 1024 + col) = pack4(hh);
        }
#pragma unroll
        for (int j = 0; j < 4; ++j) v[j] = vn[j];
    }
}
__device__ __forceinline__ void phase_final(const Frame& F, bool poison) {
    for (int m = F.gw; m < MLAT; m += F.NGW) {
        const int lane = fresh_lane();
        float* xrow = F.out + (size_t)m * 1024;
        f32x4 v[4]; float s = 0.f;
#pragma unroll
        for (int j = 0; j < 4; ++j) { v[j] = *(const f32x4*)(xrow + 256 * j + 4 * lane); s += (v[j][0] * v[j][0] + v[j][1] * v[j][1]) + (v[j][2] * v[j][2] + v[j][3] * v[j][3]); }
        float rstd = frsq(wave_sum(s) * (1.f / 1024.f) + EPS);
        if (poison) rstd = __builtin_nanf("");
        f32x4 nwv[4];
#pragma unroll
        for (int j = 0; j < 4; ++j) nwv[j] = *(const f32x4*)(F.final_w + 256 * j + 4 * lane);
#pragma unroll
        for (int j = 0; j < 4; ++j) *(f32x4*)(xrow + 256 * j + 4 * lane) = v[j] * rstd * nwv[j];
    }
}

__device__ __forceinline__ void ew_unit(const Frame& F, int l, int rg) {
    const int r0 = rg * 16;
    const int t_o = F.wave * 64 + fresh_lane();
    const int tid = t_o, lane_ = t_o & 63, wave_ = __builtin_amdgcn_readfirstlane(t_o >> 6);
    unsigned short ra[6], rb[6];
#pragma unroll
    for (int j = 0; j < 6; ++j) { const int idx = tid + 512 * j, rr = idx / 192, pr = idx % 192, hd = pr >> 5, f = pr & 31;
        const bf16_t* p = F.Z + (size_t)(r0 + rr) * ZW + (hd < 4 ? ZC_SQ + hd * 64 : ZC_SK + (hd - 4) * 64) + f; ra[j] = p[0]; rb[j] = p[32]; }
#pragma unroll
    for (int j = 0; j < 6; ++j) {
        const int idx = tid + 512 * j, rr = idx / 192, pr = idx % 192, hd = pr >> 5, f = pr & 31, row = r0 + rr;
        bf16_t* p = F.Z + (size_t)row * ZW + (hd < 4 ? ZC_SQ + hd * 64 : ZC_SK + (hd - 4) * 64) + f;
        const float t1 = bf2f(ra[j]), t2 = bf2f(rb[j]);
        if (row < MLAT) {
            const int t = row & (SEQ - 1); const float pos = (float)(f < 16 ? (t >> 6) : (t & 63));
            const float inv = __builtin_amdgcn_exp2f(-(float)(f & 15) * 0.8304820237218406f);
            const float rev = pos * inv * 0.15915494309189535f; const float cs = __builtin_amdgcn_cosf(rev), sn = __builtin_amdgcn_sinf(rev);
            const float sc = hd < 4 ? 0.125f : 1.0f;
            p[0] = (bf16_t)f2bf((t1 * cs - t2 * sn) * sc); p[32] = (bf16_t)f2bf((t1 * sn + t2 * cs) * sc);
        } else if (hd < 4) {
            p[0] = (bf16_t)f2bf(t1 * 0.125f); p[32] = (bf16_t)f2bf(t2 * 0.125f);
        }
    }
    { v4u gr[2]; bf16_t* gp[2];
#pragma unroll
      for (int j = 0; j < 2; ++j) { const int g = tid + 512 * j, rr = g >> 6, seg = g & 63; gp[j] = F.Z + (size_t)(r0 + rr) * ZW + (seg < 32 ? ZC_GZ + seg * 8 : ZC_LO + (seg - 32) * 8); gr[j] = *(const v4u*)gp[j]; }
#pragma unroll
      for (int j = 0; j < 2; ++j) { const bool isz = ((tid + 512 * j) & 63) < 32; v4u o; unsigned* oi = (unsigned*)&o; const unsigned* gi = (const unsigned*)&gr[j];
#pragma unroll
          for (int e = 0; e < 4; ++e) { const float a = bflo(gi[e]), bb = bfhi(gi[e]); const float sa = sigmoidf_(a), sb = sigmoidf_(bb); oi[e] = isz ? pk2(a * sa, bb * sb) : pk2(sa, sb); }
          *(v4u*)gp[j] = o; } }
    v2u ur[2], vr[2];
#pragma unroll
    for (int j = 0; j < 2; ++j) { const bf16_t* zr = F.Z + (size_t)(r0 + 2 * wave_ + j) * ZW + 4 * lane_; ur[j] = *(const v2u*)(zr + ZC_MU); vr[j] = *(const v2u*)(zr + ZC_MV); }
    const f32x4 gnw = *(const f32x4*)(F.gmlp_norm_w + l * 256 + 4 * lane_);
#pragma unroll
    for (int j = 0; j < 2; ++j) {
        bf16_t* zr = F.Z + (size_t)(r0 + 2 * wave_ + j) * ZW + 4 * lane_;
        f32x4 u = unpack4(ur[j]), v = unpack4(vr[j]); float ss = 0.f;
#pragma unroll
        for (int e = 0; e < 4; ++e) { u[e] = geluf_(u[e]); v[e] = geluf_(v[e]); ss += v[e] * v[e]; }
        const float rs = frsq(wave_sum(ss) * (1.f / 256.f) + EPS);
        *(v2u*)(zr + ZC_MU) = pack4(u); *(v2u*)(zr + ZC_MV) = pack4(v * rs * gnw);
    }
}
__device__ __forceinline__ void chs_unit(const Frame& F, int l, int ck) {
    const int b = ck / 36, cidx = ck % 36, row0 = chunk_row0(b, cidx);
    const int t = F.wave * 64 + fresh_lane();
    LAS float* G = (LAS float*)F.lds;
#pragma unroll
    for (int j = 0; j < 2; ++j) { const int idx = t + 512 * j, p = idx >> 4, c = idx & 15, dh = c & 7;
        const float raw = bf2f(F.Z[(size_t)(row0 + p) * ZW + ZC_LI + c]);
        G[c * 64 + p] = c < 8 ? raw + F.ig_bias[l * 8 + dh] : logsigf_(raw + F.fg_bias[l * 8 + dh]); }
    __syncthreads();
    if (t < 8) { const int d = t >> 2, h = t & 3; float bsum = 0.f, mx = -1e30f;
        for (int i = 0; i < 64; ++i) { const int p = d ? 63 - i : i; bsum += G[(8 + t) * 64 + p]; mx = fmaxf(mx, G[t * 64 + p] - bsum); }
        float* o = F.CHS + ((((b * 4 + h) * 2 + d) * 36) + cidx) * 2; o[0] = bsum; o[1] = bsum + mx; }
    __syncthreads();
}

__device__ __forceinline__ void gdn_prep_unit(const Frame& F, int l, int u, int stop = 99, bf16_t* PGo = nullptr) {
    if (!PGo) PGo = F.PG;
    const int b = u / 144, h = (u / 36) & 3, cidx = u % 36;
    const int row0 = chunk_row0(b, cidx);
    const int seg_lo = cidx < 4 ? MLAT + b * CTXL : b * SEQ, seg_hi = seg_lo + (cidx < 4 ? CTXL : SEQ);
    const int t_o = F.wave * 64 + fresh_lane();
    const int t = t_o, lane = t & 63, w = __builtin_amdgcn_readfirstlane(t >> 6), lr = lane & 15, lq = lane >> 4;
    LAS unsigned char* L = F.lds;
    LAS bf16_t* Qs = (LAS bf16_t*)(L + 0); LAS bf16_t* Ks = (LAS bf16_t*)(L + 9216); LAS bf16_t* Kt = (LAS bf16_t*)(L + 18432); LAS bf16_t* Vt = (LAS bf16_t*)(L + 27648);
    LAS float* gS = (LAS float*)(L + 36864); LAS float* bS = gS + 128; LAS float* gcS = gS + 256; LAS float* totS = gS + 384;
    LAS float* As = (LAS float*)(L + 38912);
    LAS float* CV = (LAS float*)(L + 38912);
    LAS bf16_t* UT = (LAS bf16_t*)(L + 38912); LAS bf16_t* UTd = UT + 4608; LAS bf16_t* WT = UT + 9216; LAS bf16_t* WTd = UT + 13824;
    LAS bf16_t* Tb = (LAS bf16_t*)(L + 75776);
    LAS bf16_t* At = (LAS bf16_t*)(L + 112640);
    if (t < 384) {
        const int pair = t % 96, rg = t / 96, c0 = 2 * pair, part = c0 >> 6, d0 = c0 & 63, zcol = part * 256 + h * 64 + d0;
        float cw[5][2];
#pragma unroll
        for (int j = 0; j < 5; ++j) { const float* wp = F.conv_w + (size_t)(l * 5 + j) * 768 + part * 256 + h * 64 + d0; cw[j][0] = wp[0]; cw[j][1] = wp[1]; }
        float win[20][2];
        unsigned raw[20];
        { const int rbase = row0 + rg * 16 - 2; const bf16_t* zc = F.Z + zcol;
#pragma unroll
          for (int rr = 0; rr < 20; ++rr) { int row = rbase + rr; row = row < seg_lo ? seg_lo : (row >= seg_hi ? seg_hi - 1 : row); raw[rr] = *(const unsigned*)(zc + (size_t)row * ZW); }
          asm volatile("" : "+v"(raw[0]), "+v"(raw[1]), "+v"(raw[2]), "+v"(raw[3]), "+v"(raw[4]), "+v"(raw[5]), "+v"(raw[6]), "+v"(raw[7]), "+v"(raw[8]), "+v"(raw[9]));
          asm volatile("" : "+v"(raw[10]), "+v"(raw[11]), "+v"(raw[12]), "+v"(raw[13]), "+v"(raw[14]), "+v"(raw[15]), "+v"(raw[16]), "+v"(raw[17]), "+v"(raw[18]), "+v"(raw[19]));
#pragma unroll
          for (int rr = 0; rr < 20; ++rr) { const int row = rbase + rr; const unsigned wv = (row >= seg_lo && row < seg_hi) ? raw[rr] : 0u; win[rr][0] = bflo(wv); win[rr][1] = bfhi(wv); } }
#pragma unroll
        for (int i = 0; i < 16; ++i) { float a0 = 0.f, a1 = 0.f;
#pragma unroll
            for (int j = 0; j < 5; ++j) { a0 += cw[j][0] * win[i + j][0]; a1 += cw[j][1] * win[i + j][1]; }
            CV[(rg * 16 + i) * 196 + c0] = siluf_(a0); CV[(rg * 16 + i) * 196 + c0 + 1] = siluf_(a1); }
    } else {
        const int tt = t - 384, d = tt >> 6, p = tt & 63; const bf16_t* zr = F.Z + (size_t)(row0 + p) * ZW;
        const float a = bf2f(zr[ZC_GA + d * 4 + h]), bb = bf2f(zr[ZC_GB + d * 4 + h]);
        gS[d * 64 + p] = -fexp(F.a_log[l * 8 + d * 4 + h]) * softplusf_(a + F.dt_bias[l * 8 + d * 4 + h]);
        bS[d * 64 + p] = sigmoidf_(bb);
    }
    __syncthreads();
    if (stop <= 1) return;
    {
        const int combo = t >> 2, sub = t & 3, row = combo & 63, part = combo >> 6;
        float v[16]; float ss = 0.f;
#pragma unroll
        for (int i = 0; i < 16; ++i) { v[i] = CV[row * 196 + part * 64 + sub * 16 + i]; ss += v[i] * v[i]; }
        ss = quad_sum(ss);
        const float rs = frsq(ss + EPS);
        LAS bf16_t* dst = (part == 0 ? Qs : Ks) + row * 72 + sub * 16;
        v4u o0, o1;
        o0.x = pk2(v[0] * rs, v[1] * rs); o0.y = pk2(v[2] * rs, v[3] * rs); o0.z = pk2(v[4] * rs, v[5] * rs); o0.w = pk2(v[6] * rs, v[7] * rs);
        o1.x = pk2(v[8] * rs, v[9] * rs); o1.y = pk2(v[10] * rs, v[11] * rs); o1.z = pk2(v[12] * rs, v[13] * rs); o1.w = pk2(v[14] * rs, v[15] * rs);
        *(LAS v4u*)dst = o0; *(LAS v4u*)(dst + 8) = o1;
        if (part == 1) {
#pragma unroll
            for (int i = 0; i < 16; ++i) Kt[(sub * 16 + i) * 72 + row] = (bf16_t)f2bf(v[i] * rs);
        }
        const int vrow = t & 63, dg = t >> 6;
#pragma unroll
        for (int i = 0; i < 8; ++i) Vt[(dg * 8 + i) * 72 + vrow] = (bf16_t)f2bf(CV[vrow * 196 + 128 + dg * 8 + i]);
        if (w < 2) { const int d = w, p = d ? 63 - lane : lane; float s = gS[d * 64 + p];
#pragma unroll
            for (int off = 1; off < 64; off <<= 1) { const float y = __shfl_up(s, off); if (lane >= off) s += y; }
            gcS[d * 64 + p] = s; if (lane == 63) totS[d] = s; }
    }
    __syncthreads();
    if (stop <= 2) return;
#pragma unroll
    for (int k2 = 0; k2 < 2; ++k2) {
        const int tt = 2 * w + k2, mt = tt >> 2, nt = tt & 3;
        f32x4 accG = {0.f, 0.f, 0.f, 0.f}, accQ = {0.f, 0.f, 0.f, 0.f};
        accG = mma_ll<2>(Ks + mt * 16 * 72, 72, Ks + nt * 16 * 72, 72, accG, lane);
        accQ = mma_ll<2>(Ks + mt * 16 * 72, 72, Qs + nt * 16 * 72, 72, accQ, lane);
        const int n = nt * 16 + lr, m0 = mt * 16 + 4 * lq;
#pragma unroll
        for (int d = 0; d < 2; ++d) {
            const float gcn = gcS[d * 64 + n], bn = bS[d * 64 + n];
            f32x4 av, tv;
#pragma unroll
            for (int i = 0; i < 4; ++i) { const int m = m0 + i; const float gcm = gcS[d * 64 + m];
                const bool strict = d == 0 ? (m < n) : (m > n); const bool incl = d == 0 ? (m <= n) : (m >= n);
                const float e = fexp(incl ? (gcn - gcm) : 0.f);
                av[i] = strict ? bn * accG[i] * e : 0.f; tv[i] = incl ? 0.125f * accQ[i] * e : 0.f; }
#pragma unroll
            for (int i = 0; i < 4; ++i) { const int si = d ? 63 - n : n, sj = d ? 63 - (m0 + i) : m0 + i; As[d * 4352 + (si >> 1) * 136 + sj * 2 + (si & 1)] = av[i]; }
            *(LAS v2u*)(At + d * 4608 + n * 72 + m0) = pack4(tv);
        }
    }
    __syncthreads();
    if (stop <= 3) return;
    if (w < 2) {
        const int d = w; const LAS float* Ad = As + d * 4352;
        float tr[64]; int lane_o = lane;
#pragma unroll
        for (int ip = 0; ip < 32; ++ip) {
            const int i0 = 2 * ip;
            f32x4 rv[32];
#pragma unroll
            for (int jp = 0; jp <= ip; ++jp) rv[jp] = *(const LAS f32x4*)(Ad + ip * 136 + 4 * jp);
            asm volatile("" : "+v"(lane_o) :: "memory");
            f32x2_ a0 = {0.f, 0.f}, a1 = {0.f, 0.f}, a2 = {0.f, 0.f}, a3 = {0.f, 0.f};
#pragma unroll
            for (int jp = 0; jp < ip; ++jp) {
                const f32x2_ ta = {tr[2 * jp], tr[2 * jp]}, tb = {tr[2 * jp + 1], tr[2 * jp + 1]};
                const f32x2_ va = {rv[jp][0], rv[jp][1]}, vb = {rv[jp][2], rv[jp][3]};
                if (jp & 1) { a2 += va * ta; a3 += vb * tb; } else { a0 += va * ta; a1 += vb * tb; }
            }
            const f32x2_ sum = (a0 + a1) + (a2 + a3);
            const float t0 = (lane_o == i0 ? 1.f : 0.f) - sum[0];
            tr[i0] = t0;
            tr[i0 + 1] = (lane_o == i0 + 1 ? 1.f : 0.f) - sum[1] - rv[ip][1] * t0;
        }
        const int pb = d ? 63 - lane : lane; const float sb = bS[d * 64 + pb], sbe = sb * fexp(gcS[d * 64 + pb]);
        LAS bf16_t* T0 = Tb + d * 9216; LAS bf16_t* T1 = T0 + 4608;
#pragma unroll
        for (int i = 0; i < 64; ++i) { const int pa = d ? 63 - i : i; T0[pa * 72 + pb] = (bf16_t)f2bf(tr[i] * sb); T1[pa * 72 + pb] = (bf16_t)f2bf(tr[i] * sbe); }
    }
    __syncthreads();
    if (stop <= 4) return;
#pragma unroll 1
    for (int d = 0; d < 2; ++d) {
        const int ud = u * 2 + d; const float tot = totS[d];
        const LAS bf16_t* T0 = Tb + d * 9216; const LAS bf16_t* T1 = T0 + 4608; const LAS bf16_t* Ad = At + d * 4608;
        {
            const bool isw = w >= 4; const LAS bf16_t* Aop = isw ? T1 : T0; const LAS bf16_t* Bop = isw ? Kt : Vt;
            LAS bf16_t* o0 = isw ? WT : UT; LAS bf16_t* o1 = isw ? WTd : UTd;
#pragma unroll
            for (int k4 = 0; k4 < 4; ++k4) { const int tt = (w & 3) * 4 + k4, mt = tt >> 2, nt = tt & 3;
                f32x4 acc = {0.f, 0.f, 0.f, 0.f}; acc = mma_ll<2>(Aop + mt * 16 * 72, 72, Bop + nt * 16 * 72, 72, acc, lane);
                const int n = nt * 16 + lr, m0 = mt * 16 + 4 * lq; f32x4 dv;
#pragma unroll
                for (int i = 0; i < 4; ++i) dv[i] = acc[i] * fexp(tot - gcS[d * 64 + m0 + i]);
                *(LAS v2u*)(o0 + n * 72 + m0) = pack4(acc); *(LAS v2u*)(o1 + n * 72 + m0) = pack4(dv); }
        }
        __syncthreads();
        if (stop == 6) { __syncthreads(); continue; }
        {
            const int prod = w >> 1; bf16_t* gout = PGo + (size_t)ud * 16384 + prod * 4096;
            const LAS bf16_t* Aop = prod == 0 ? WTd : prod == 1 ? Kt : prod == 2 ? WT : Ad;
            const LAS bf16_t* Bop = prod == 0 ? Kt : prod == 1 ? UTd : prod == 2 ? Ad : UT;
#pragma unroll
            for (int k8 = 0; k8 < 8; ++k8) { const int tt = (w & 1) * 8 + k8, mt = tt >> 2, nt = tt & 3;
                f32x4 acc = {0.f, 0.f, 0.f, 0.f}; acc = mma_ll<2>(Aop + mt * 16 * 72, 72, Bop + nt * 16 * 72, 72, acc, lane);
                const int n = nt * 16 + lr, m0 = mt * 16 + 4 * lq;
                if (prod == 2) { const f32x4 qv = unpack4(*(const LAS v2u*)(Qs + n * 72 + m0)); const float e = 0.125f * fexp(gcS[d * 64 + n]); acc = qv * e - acc; }
                const int off = (prod == 0 || prod == 2) ? ((nt * 2 + (mt >> 1)) * 64 + ((mt & 1) * 2 + (lq >> 1)) * 16 + lr) * 8 + 4 * (lq & 1) : ((mt * 4 + nt) * 64 + lane) * 4;
                if (stop != 7) *(v2u*)(gout + off) = pack4(acc); else asm volatile("" :: "v"(acc)); }
        }
        if (t == 0 && PGo == F.PG) F.GLG[ud] = fexp(tot);
        __syncthreads();
    }
}

__device__ __forceinline__ void mlstm_prep_unit(const Frame& F, int l, int u) {
    const int b = u / 144, h = (u / 36) & 3, cidx = u % 36;
    const int row0 = chunk_row0(b, cidx);
    const int t_o = F.wave * 64 + fresh_lane();
    const int t = t_o, lane = t & 63, w = __builtin_amdgcn_readfirstlane(t >> 6), lr = lane & 15, lq = lane >> 4;
    LAS unsigned char* L = F.lds;
    LAS bf16_t* Qs = (LAS bf16_t*)(L + 0); LAS bf16_t* Ks = (LAS bf16_t*)(L + 9216); LAS bf16_t* Vta = (LAS bf16_t*)(L + 18432);
    LAS bf16_t* Kte = (LAS bf16_t*)(L + 29952);
    LAS bf16_t* S0 = (LAS bf16_t*)(L + 48384);
    LAS float* igS = (LAS float*)(L + 66816); LAS float* lfS = igS + 128; LAS float* bS = igS + 256; LAS float* dmS = igS + 384; LAS float* rS = igS + 512;
    LAS float* flS = igS + 640; LAS float* eS = igS + 768; LAS float* mpS = igS + 896; LAS float* chS = igS + 904;
    {
        const int r = t >> 3, seg = t & 7; const bf16_t* zr = F.Z + (size_t)(row0 + r) * ZW + h * 64 + seg * 8;
        const v4u q = *(const v4u*)(zr + ZC_LQ), k = *(const v4u*)(zr + ZC_LK), v = *(const v4u*)(zr + ZC_LV);
        *(LAS v4u*)(Qs + r * 72 + seg * 8) = q; *(LAS v4u*)(Ks + r * 72 + seg * 8) = k;
        Vta[(seg * 8 + 0) * 72 + r] = (bf16_t)(v.x & 0xffffu); Vta[(seg * 8 + 1) * 72 + r] = (bf16_t)(v.x >> 16);
        Vta[(seg * 8 + 2) * 72 + r] = (bf16_t)(v.y & 0xffffu); Vta[(seg * 8 + 3) * 72 + r] = (bf16_t)(v.y >> 16);
        Vta[(seg * 8 + 4) * 72 + r] = (bf16_t)(v.z & 0xffffu); Vta[(seg * 8 + 5) * 72 + r] = (bf16_t)(v.z >> 16);
        Vta[(seg * 8 + 6) * 72 + r] = (bf16_t)(v.w & 0xffffu); Vta[(seg * 8 + 7) * 72 + r] = (bf16_t)(v.w >> 16);
#pragma unroll
        for (int j = 0; j < 2; ++j) { const int idx = t + 512 * j, rr = 64 + (idx >> 6), cc = idx & 63; Vta[rr * 72 + cc] = (bf16_t)(rr == 64 ? 0x3F80u : 0u); }
        if (t < 128) { const int d = t >> 6, p = t & 63; const bf16_t* zg = F.Z + (size_t)(row0 + p) * ZW;
            igS[d * 64 + p] = bf2f(zg[ZC_LI + d * 4 + h]) + F.ig_bias[l * 8 + d * 4 + h];
            lfS[d * 64 + p] = logsigf_(bf2f(zg[ZC_LF + d * 4 + h]) + F.fg_bias[l * 8 + d * 4 + h]); }
        if (t >= 128 && t < 272) chS[t - 128] = F.CHS[(size_t)((b * 4 + h) * 2) * 72 + (t - 128)];
    }
    __syncthreads();
    if (w < 2) {
        const int d = w, p = d ? 63 - lane : lane;
        const int step_of = d ? (cidx < 4 ? 3 - cidx : 39 - cidx) : cidx; float mprev = 0.f;
        for (int s = 0; s < step_of; ++s) { const int ci = d ? (s < 4 ? 3 - s : 39 - s) : s; mprev = fmaxf(chS[d * 72 + ci * 2] + mprev, chS[d * 72 + ci * 2 + 1]); }
        const float ig = igS[d * 64 + p]; float bp = lfS[d * 64 + p];
#pragma unroll
        for (int off = 1; off < 64; off <<= 1) { const float y = __shfl_up(bp, off); if (lane >= off) bp += y; }
        float mxp = ig - bp;
#pragma unroll
        for (int off = 1; off < 64; off <<= 1) { const float y = __shfl_up(mxp, off); if (lane >= off) mxp = fmaxf(mxp, y); }
        const float mxall = __shfl(mxp, 63), bl = __shfl(bp, 63);
        const float dmax = bp + mxp, wsmax = bl + mxall;
        const float mnew = fmaxf(bl + mprev, wsmax), cd = fexp(bl + mprev - mnew), e2 = fexp(wsmax - mnew);
        const float mt = fmaxf(bp + mprev, dmax);
        bS[d * 64 + p] = bp; dmS[d * 64 + p] = dmax; rS[d * 64 + p] = fexp(dmax - mt); flS[d * 64 + p] = fexp(-mt);
        eS[d * 64 + p] = fexp(bl - bp + ig - wsmax) * e2;
        const int ud = u * 2 + d; F.WI[ud * 64 + p] = 0.125f * fexp(bp + mprev - mt); if (lane == 0) F.GLM[ud] = cd; }
    __syncthreads();
    {
        const int d = t >> 8, tt = t & 255, p = tt & 63, dg = tt >> 6; const float e = eS[d * 64 + p];
#pragma unroll
        for (int i = 0; i < 16; ++i) Kte[d * 4608 + (dg * 16 + i) * 72 + p] = (bf16_t)f2bf(bf2f(Ks[p * 72 + dg * 16 + i]) * e);
#pragma unroll
        for (int k2 = 0; k2 < 2; ++k2) { const int tl = 2 * w + k2, mt = tl >> 2, nt = tl & 3;
            f32x4 acc = {0.f, 0.f, 0.f, 0.f}; acc = mma_ll<2>(Ks + mt * 16 * 72, 72, Qs + nt * 16 * 72, 72, acc, lane);
            const int n = nt * 16 + lr, m0 = mt * 16 + 4 * lq;
#pragma unroll
            for (int dd = 0; dd < 2; ++dd) { const float bn = bS[dd * 64 + n], dn = dmS[dd * 64 + n], rn = rS[dd * 64 + n]; f32x4 sv;
#pragma unroll
                for (int i = 0; i < 4; ++i) { const int m = m0 + i; const bool incl = dd == 0 ? (m <= n) : (m >= n);
                    const float arg = incl ? (bn - bS[dd * 64 + m] + igS[dd * 64 + m] - dn) : 0.f; sv[i] = incl ? 0.125f * acc[i] * fexp(arg) * rn : 0.f; }
                *(LAS v2u*)(S0 + dd * 4608 + n * 72 + m0) = pack4(sv); } }
    }
    __syncthreads();
    {
        const int d = w >> 2, ud = u * 2 + d; bf16_t* gO = F.PM + (size_t)ud * 10240; bf16_t* gB = gO + 5120;
#pragma unroll 2
        for (int k = 0; k < 10; ++k) { const int tl = (w & 3) * 10 + k; const bool iskv = tl >= 20; const int t2 = iskv ? tl - 20 : tl, mt = t2 / 5, nt = t2 % 5;
            const LAS bf16_t* Aop = (iskv ? Kte : S0) + d * 4608 + mt * 16 * 72;
            f32x4 acc = {0.f, 0.f, 0.f, 0.f}; acc = mma_ll<2>(Aop, 72, Vta + nt * 16 * 72, 72, acc, lane);
            const int n = nt * 16 + lr, m0 = mt * 16 + 4 * lq;
            if (!iskv && n == 65) {
#pragma unroll
                for (int i = 0; i < 4; ++i) acc[i] = flS[d * 64 + m0 + i]; }
            *(v2u*)((iskv ? gB : gO) + ((mt * 5 + nt) * 64 + lane) * 4) = pack4(acc); }
    }
    __syncthreads();
}

__device__ __forceinline__ void l2_touch(const void* gsrc, unsigned lds_dst) {
    unsigned keep;
    asm volatile("s_mov_b32 %0, m0\n\ts_mov_b32 m0, %2\n\ts_nop 0\n\tglobal_load_lds_dword %1, off\n\ts_mov_b32 m0, %0" : "=&s"(keep) : "v"(gsrc), "s"(lds_dst) : "memory");
}
template <int NT> struct ScanOps { bf16x8 Qf[2], Mf[2]; v2u bv[NT], ov[NT]; float gl; f32x4 wi; };
template <bool GDN, int NT> __device__ __forceinline__ void scan_load(const Frame& F, int b, int h, int dir, int wq, int lr, int lq, int s, ScanOps<NT>& o) {
    const int cidx = dir ? (s < 4 ? 3 - s : 39 - s) : s;
    const int ud = ((b * 4 + h) * 36 + cidx) * 2 + dir;
    if (GDN) {
        const bf16_t* gM = F.PG + (size_t)ud * 16384; const bf16_t* gQ = gM + 8192;
#pragma unroll
        for (int ks = 0; ks < 2; ++ks) { o.Mf[ks] = *(const bf16x8*)(gM + ((wq * 2 + ks) * 64 + lq * 16 + lr) * 8); o.Qf[ks] = *(const bf16x8*)(gQ + ((wq * 2 + ks) * 64 + lq * 16 + lr) * 8); }
    } else {
        const bf16_t* zq = F.Z + (size_t)(chunk_row0(b, cidx) + 16 * wq + lr) * ZW + ZC_LQ + h * 64;
#pragma unroll
        for (int ks = 0; ks < 2; ++ks) { o.Qf[ks] = *(const bf16x8*)(zq + 32 * ks + 8 * lq); o.Mf[ks] = o.Qf[ks]; }
    }
    const bf16_t* gB = GDN ? F.PG + (size_t)ud * 16384 + 4096 : F.PM + (size_t)ud * 10240 + 5120;
    const bf16_t* gO = GDN ? F.PG + (size_t)ud * 16384 + 12288 : F.PM + (size_t)ud * 10240;
#pragma unroll
    for (int t = 0; t < NT; ++t) { o.bv[t] = *(const v2u*)(gB + ((wq * NT + t) * 64 + lq * 16 + lr) * 4); o.ov[t] = *(const v2u*)(gO + ((wq * NT + t) * 64 + lq * 16 + lr) * 4); }
    o.gl = GDN ? F.GLG[ud] : F.GLM[ud];
    o.wi = (f32x4){1.f, 1.f, 1.f, 1.f}; if (!GDN) o.wi = *(const f32x4*)(F.WI + ud * 64 + 16 * wq + 4 * lq);
}
struct ScanFin { v2u pend[4]; unsigned short gz[4][4]; };
template <bool GDN> __device__ __forceinline__ void scan_fin_load(const Frame& F, int b, int h, int dir, int wq, int lr, int lq, int s, const float* PEND, ScanFin& f) {
    const int cidx = dir ? (s < 4 ? 3 - s : 39 - s) : s; const int row0 = chunk_row0(b, cidx);
    const float* pp = PEND + (size_t)((b * 4 + h) * 36 + cidx) * 4096 + (wq * 256 + lq * 16 + lr) * 2;
#pragma unroll
    for (int t = 0; t < 4; ++t) { f.pend[t] = *(const v2u*)(pp + t * 128);
#pragma unroll
        for (int i = 0; i < 4; ++i) f.gz[t][i] = F.Z[(size_t)(row0 + 16 * wq + 4 * lq + i) * ZW + (GDN ? ZC_GZ : ZC_LO) + h * 64 + 16 * t + lr]; }
}
__device__ __forceinline__ bool scan_first(int s) { return s < 4 ? (s <= 1) : (s <= 19); }
template <bool GDN> __device__ __forceinline__ void scan_finish(const Frame& F, int b, int h, int dir, int wq, int lr, int lq, int s, float* PEND, const f32x4 (&Oin)[4], const ScanFin& f, const float (&nwv)[4]) {
    const int cidx = dir ? (s < 4 ? 3 - s : 39 - s) : s; const int row0 = chunk_row0(b, cidx);
    float* pp = PEND + (size_t)((b * 4 + h) * 36 + cidx) * 4096 + (wq * 256 + lq * 16 + lr) * 2;
    if (scan_first(s)) {
#pragma unroll
        for (int t = 0; t < 4; ++t) *(v2u*)(pp + t * 128) = pack4(Oin[t]);
    } else {
        f32x4 O[4]; float ss[4] = {0.f, 0.f, 0.f, 0.f};
#pragma unroll
        for (int t = 0; t < 4; ++t)
            { const f32x4 pv = unpack4(f.pend[t]);
#pragma unroll
            for (int i = 0; i < 4; ++i) { O[t][i] = Oin[t][i] + pv[i]; ss[i] += O[t][i] * O[t][i]; } }
#pragma unroll
        for (int i = 0; i < 4; ++i) ss[i] = frsq(row16_sum(ss[i]) * (1.f / 64.f) + EPS);
#pragma unroll
        for (int t = 0; t < 4; ++t) { const int dv = 16 * t + lr;
#pragma unroll
            for (int i = 0; i < 4; ++i) { const int row = row0 + 16 * wq + 4 * lq + i;
                const float g = bf2f(f.gz[t][i]);
                F.MIX[(size_t)row * 1024 + (GDN ? 0 : 768) + h * 64 + dv] = (bf16_t)f2bf(O[t][i] * ss[i] * nwv[t] * g); } }
    }
}
template <bool GDN, int NT> __device__ __forceinline__ bool scan_step(const Frame& F, int b, int h, int dir, int wq, int lane, int s, LAS bf16_t* St, float* PEND, const float (&nwv)[4],
                                                                      f32x4 (&S)[NT], f32x4 (&Oprev)[4], const ScanOps<NT>& use, ScanOps<NT>& ld, ScanFin& fin, bool nofin) {
    const int lr = lane & 15, lq = lane >> 4;
    LAS bf16_t* Sb = St + ((dir * 2 + (s & 1)) * 80) * 72;
    if (s < 36) {
#pragma unroll
        for (int t = 0; t < NT; ++t) *(LAS v2u*)(Sb + (16 * t + lr) * 72 + 16 * wq + 4 * lq) = pack4(S[t]); }
    if (GDN) asm volatile("s_waitcnt vmcnt(33)" ::: "memory"); else asm volatile("s_waitcnt vmcnt(34)" ::: "memory");
    __syncthreads();
    if (s > 0) {
        const int sp = s - 1;
        if (sp == 20 || sp == 2) { asm volatile("s_waitcnt vmcnt(0)" ::: "memory"); scan_fin_load<GDN>(F, b, h, dir, wq, lr, lq, sp, PEND, fin); }
        if (!nofin) scan_finish<GDN>(F, b, h, dir, wq, lr, lq, sp, PEND, Oprev, fin, nwv);
    }
    if (s == 36) return false;
    scan_fin_load<GDN>(F, b, h, dir, wq, lr, lq, s < 35 ? s + 1 : 35, PEND, fin);
    scan_load<GDN, NT>(F, b, h, dir, wq, lr, lq, s < 34 ? s + 2 : 35, ld);
    f32x4 O[NT];
#pragma unroll
    for (int t = 0; t < NT; ++t) {
        const LAS bf16_t* sp2 = Sb + (16 * t + lr) * 72 + 8 * lq;
        const bf16x8 s0 = *(const LAS bf16x8*)sp2, s1 = *(const LAS bf16x8*)(sp2 + 32);
        f32x4 o = {0.f, 0.f, 0.f, 0.f};
        o = __builtin_amdgcn_mfma_f32_16x16x32_bf16(use.Qf[0], s0, o, 0, 0, 0); o = __builtin_amdgcn_mfma_f32_16x16x32_bf16(use.Qf[1], s1, o, 0, 0, 0);
        const f32x4 bv = unpack4(use.bv[t]), ov = unpack4(use.ov[t]);
        if (GDN) {
            f32x4 ms = {0.f, 0.f, 0.f, 0.f};
            ms = __builtin_amdgcn_mfma_f32_16x16x32_bf16(use.Mf[0], s0, ms, 0, 0, 0); ms = __builtin_amdgcn_mfma_f32_16x16x32_bf16(use.Mf[1], s1, ms, 0, 0, 0);
            S[t] = S[t] * use.gl - ms + bv; O[t] = o + ov;
        } else { S[t] = S[t] * use.gl + bv; O[t] = o * use.wi + ov; }
    }
    if (!GDN) {
#pragma unroll
        for (int i = 0; i < 4; ++i) { const float den = row16_bcast<0>(O[NT - 1][i]), fl = row16_bcast<1>(O[NT - 1][i]); const float dv = frcp(fmaxf(fabsf(den), fl));
#pragma unroll
            for (int t = 0; t < 4; ++t) O[t][i] *= dv; }
    }
#pragma unroll
    for (int t = 0; t < 4; ++t) Oprev[t] = O[t];
    return true;
}
template <bool GDN> __device__ __forceinline__ void scan_wg(const Frame& F, int l, int bh, bool nofin = false, int ko = 0) {
    constexpr int NT = GDN ? 4 : 5;
    const int b = bh >> 2, h = bh & 3;
    const int lane = fresh_lane(), dir = F.wave >> 2, wq = F.wave & 3, lr = lane & 15, lq = lane >> 4;
    LAS bf16_t* St = (LAS bf16_t*)F.lds;
    f32x4 S[NT];
#pragma unroll
    for (int t = 0; t < NT; ++t) S[t] = (f32x4){0.f, 0.f, 0.f, 0.f};
    const float* nw = GDN ? F.gdn_norm_w + l * 64 : F.mlstm_norm_w + l * 256 + h * 64;
    float nwv[4];
#pragma unroll
    for (int t = 0; t < 4; ++t) nwv[t] = nw[16 * t + lr];
    float* PEND = F.PEND + (GDN ? (size_t)0 : (size_t)1152 * 4096);
    ScanOps<NT> A0, A1, A2; ScanFin F0, F1;
    f32x4 Oprev[4];
#pragma unroll
    for (int t = 0; t < 4; ++t) { Oprev[t] = (f32x4){0.f, 0.f, 0.f, 0.f}; F0.pend[t] = (v2u){0u, 0u}; F1.pend[t] = (v2u){0u, 0u};
#pragma unroll
        for (int i = 0; i < 4; ++i) { F0.gz[t][i] = 0; F1.gz[t][i] = 0; } }
    scan_load<GDN, NT>(F, b, h, dir, wq, lr, lq, 0, A0);
    scan_load<GDN, NT>(F, b, h, dir, wq, lr, lq, 1, A1);
#pragma unroll 1
    for (int s6 = 0; s6 < 42; s6 += 6) {
        if (!scan_step<GDN, NT>(F, b, h, dir, wq, lane, s6 + 0, St, PEND, nwv, S, Oprev, A0, A2, F1, nofin)) break;
        if (!scan_step<GDN, NT>(F, b, h, dir, wq, lane, s6 + 1, St, PEND, nwv, S, Oprev, A1, A0, F0, nofin)) break;
        if (!scan_step<GDN, NT>(F, b, h, dir, wq, lane, s6 + 2, St, PEND, nwv, S, Oprev, A2, A1, F1, nofin)) break;
        if (!scan_step<GDN, NT>(F, b, h, dir, wq, lane, s6 + 3, St, PEND, nwv, S, Oprev, A0, A2, F0, nofin)) break;
        if (!scan_step<GDN, NT>(F, b, h, dir, wq, lane, s6 + 4, St, PEND, nwv, S, Oprev, A1, A0, F1, nofin)) break;
        if (!scan_step<GDN, NT>(F, b, h, dir, wq, lane, s6 + 5, St, PEND, nwv, S, Oprev, A2, A1, F0, nofin)) break;
    }
    VM_WAIT();
    __syncthreads();
}

__device__ __forceinline__ void swa_unit(const Frame& F, int l, int it, int ko = 0) {
    const bool lat = it < 256; int b, kvh, qb;
    if (lat) { b = it >> 5; kvh = (it >> 4) & 1; qb = it & 15; } else { const int j = it - 256; b = j >> 2; kvh = (j >> 1) & 1; qb = j & 1; }
    const int t_o = F.wave * 64 + fresh_lane();
    const int t = t_o, lane = t & 63, w = __builtin_amdgcn_readfirstlane(t >> 6), lr = lane & 15, lq = lane >> 4;
    const int hq = kvh * 2 + (w >> 2), wrow = (w & 3) * 32;
    const int qrow = (lat ? b * SEQ : MLAT + b * CTXL) + qb * 128 + wrow;
    LAS bf16_t* Ksh = (LAS bf16_t*)F.lds; LAS bf16_t* Vt = Ksh + 4608; LAS bf16_t* Pw = Ksh + 9216 + w * 2304;
    bf16x8 Qf[2][2];
#pragma unroll
    for (int mt = 0; mt < 2; ++mt)
#pragma unroll
        for (int ks = 0; ks < 2; ++ks) Qf[mt][ks] = *(const bf16x8*)(F.Z + (size_t)(qrow + mt * 16 + lr) * ZW + ZC_SQ + hq * 64 + 32 * ks + 8 * lq);
    const float sk = F.sink[l * 4 + hq];
    float mi[2][4], li[2][4]; f32x4 O[2][4];
#pragma unroll
    for (int mt = 0; mt < 2; ++mt)
#pragma unroll
        for (int i = 0; i < 4; ++i) { mi[mt][i] = sk; li[mt][i] = 1.f; O[mt][i] = (f32x4){0.f, 0.f, 0.f, 0.f}; }
    const int lo = lat ? (qb == 0 ? 2 : 0) : 0, nloc = lat ? ((qb == 15 ? 4 : 6) - lo) : 0, ntile = nloc + 4;
    const int sr = t >> 3, sseg = t & 7;
    v4u kreg, vreg;
    { const int krow0 = nloc > 0 ? b * SEQ + (qb - 1) * 128 + lo * 64 : MLAT + b * CTXL;
      const bf16_t* zr = F.Z + (size_t)(krow0 + sr) * ZW + kvh * 64 + sseg * 8; kreg = *(const v4u*)(zr + ZC_SK); vreg = *(const v4u*)(zr + ZC_SV); }
#pragma unroll 1
    for (int j = 0; j < ntile; ++j) {
        const bool masked = j < nloc; const int kpos0 = (qb - 1) * 128 + (lo + j) * 64;
        __syncthreads();
        { *(LAS v4u*)(Ksh + sr * 72 + sseg * 8) = kreg;
          Vt[(sseg * 8 + 0) * 72 + sr] = (bf16_t)(vreg.x & 0xffffu); Vt[(sseg * 8 + 1) * 72 + sr] = (bf16_t)(vreg.x >> 16);
          Vt[(sseg * 8 + 2) * 72 + sr] = (bf16_t)(vreg.y & 0xffffu); Vt[(sseg * 8 + 3) * 72 + sr] = (bf16_t)(vreg.y >> 16);
          Vt[(sseg * 8 + 4) * 72 + sr] = (bf16_t)(vreg.z & 0xffffu); Vt[(sseg * 8 + 5) * 72 + sr] = (bf16_t)(vreg.z >> 16);
          Vt[(sseg * 8 + 6) * 72 + sr] = (bf16_t)(vreg.w & 0xffffu); Vt[(sseg * 8 + 7) * 72 + sr] = (bf16_t)(vreg.w >> 16); }
        if (j + 1 < ntile) { const int jn = j + 1; const int krown = jn < nloc ? b * SEQ + (qb - 1) * 128 + (lo + jn) * 64 : MLAT + b * CTXL + (jn - nloc) * 64;
            const bf16_t* zr = F.Z + (size_t)(krown + sr) * ZW + kvh * 64 + sseg * 8; kreg = *(const v4u*)(zr + ZC_SK); vreg = *(const v4u*)(zr + ZC_SV); }
        __syncthreads();
        if (ko >= 3) continue;
        f32x4 sc[2][4];
#pragma unroll
        for (int nt = 0; nt < 4; ++nt) { const LAS bf16_t* kp = Ksh + (nt * 16 + lr) * 72 + 8 * lq; const bf16x8 k0 = *(const LAS bf16x8*)kp, k1 = *(const LAS bf16x8*)(kp + 32);
#pragma unroll
            for (int mt = 0; mt < 2; ++mt) { f32x4 a = {0.f, 0.f, 0.f, 0.f};
                a = __builtin_amdgcn_mfma_f32_16x16x32_bf16(Qf[mt][0], k0, a, 0, 0, 0); a = __builtin_amdgcn_mfma_f32_16x16x32_bf16(Qf[mt][1], k1, a, 0, 0, 0); sc[mt][nt] = a; } }
        if (ko >= 2) { asm volatile("" :: "v"(sc[0][0]), "v"(sc[0][1]), "v"(sc[0][2]), "v"(sc[0][3]), "v"(sc[1][0]), "v"(sc[1][1]), "v"(sc[1][2]), "v"(sc[1][3])); continue; }
#pragma unroll
        for (int mt = 0; mt < 2; ++mt) {
            float mx[4] = {-1e30f, -1e30f, -1e30f, -1e30f};
#pragma unroll
            for (int nt = 0; nt < 4; ++nt)
#pragma unroll
                for (int i = 0; i < 4; ++i) {
                    if (masked) { const int qpos = qb * 128 + wrow + mt * 16 + 4 * lq + i, kpos = kpos0 + nt * 16 + lr; const int dd = qpos - kpos; if (dd > 128 || dd < -128) sc[mt][nt][i] = -1e30f; }
                    mx[i] = fmaxf(mx[i], sc[mt][nt][i]); }
#pragma unroll
            for (int i = 0; i < 4; ++i) mx[i] = row16_max(mx[i]);
            float al[4], rsum[4];
#pragma unroll
            for (int i = 0; i < 4; ++i) { const float mn = fmaxf(mi[mt][i], mx[i]); al[i] = fexp(mi[mt][i] - mn); mi[mt][i] = mn; rsum[i] = 0.f; }
#pragma unroll
            for (int nt = 0; nt < 4; ++nt)
#pragma unroll
                for (int i = 0; i < 4; ++i) { const float p = fexp(sc[mt][nt][i] - mi[mt][i]); rsum[i] += p; Pw[(mt * 16 + 4 * lq + i) * 72 + nt * 16 + lr] = (bf16_t)f2bf(p); }
#pragma unroll
            for (int i = 0; i < 4; ++i) li[mt][i] = li[mt][i] * al[i] + row16_sum(rsum[i]);
#pragma unroll
            for (int nt = 0; nt < 4; ++nt)
#pragma unroll
                for (int i = 0; i < 4; ++i) O[mt][nt][i] *= al[i];
        }
        LDS_WAIT(); asm volatile("" ::: "memory");
#pragma unroll
        for (int nt = 0; nt < 4; ++nt) { const LAS bf16_t* vp = Vt + (nt * 16 + lr) * 72 + 8 * lq; const bf16x8 v0 = *(const LAS bf16x8*)vp, v1 = *(const LAS bf16x8*)(vp + 32);
#pragma unroll
            for (int mt = 0; mt < 2; ++mt) { const LAS bf16_t* pp = Pw + (mt * 16 + lr) * 72 + 8 * lq; const bf16x8 p0 = *(const LAS bf16x8*)pp, p1 = *(const LAS bf16x8*)(pp + 32);
                O[mt][nt] = __builtin_amdgcn_mfma_f32_16x16x32_bf16(p0, v0, O[mt][nt], 0, 0, 0); O[mt][nt] = __builtin_amdgcn_mfma_f32_16x16x32_bf16(p1, v1, O[mt][nt], 0, 0, 0); } }
    }
    if (ko == 0)
#pragma unroll
    for (int mt = 0; mt < 2; ++mt)
#pragma unroll
        for (int i = 0; i < 4; ++i) { const float inv = frcp(li[mt][i]); bf16_t* orow = F.MIX + (size_t)(qrow + mt * 16 + 4 * lq + i) * 1024 + 256 + hq * 64 + lr;
#pragma unroll
            for (int nt = 0; nt < 4; ++nt) orow[nt * 16] = (bf16_t)f2bf(O[mt][nt][i] * inv); }
    __syncthreads();
}

__device__ __forceinline__ void gmlp_unit(const Frame& F, int l, int it) {
    const int b = it / 72, c = (it >> 2) % 18, g = it & 3;
    const int r0 = c < 16 ? b * SEQ + c * 128 : MLAT + b * CTXL + (c - 16) * 128;
    const int t_o = F.wave * 64 + fresh_lane();
    const int t = t_o, lane = t & 63, w = __builtin_amdgcn_readfirstlane(t >> 6), lr = lane & 15, lq = lane >> 4;
    LAS bf16_t* Vt = (LAS bf16_t*)F.lds;
#pragma unroll
    for (int j = 0; j < 2; ++j) { const int idx = t + 512 * j, q = idx >> 3, seg = idx & 7;
        const v4u v = *(const v4u*)(F.Z + (size_t)(r0 + q) * ZW + ZC_MV + g * 64 + seg * 8);
        Vt[(seg * 8 + 0) * 136 + q] = (bf16_t)(v.x & 0xffffu); Vt[(seg * 8 + 1) * 136 + q] = (bf16_t)(v.x >> 16);
        Vt[(seg * 8 + 2) * 136 + q] = (bf16_t)(v.y & 0xffffu); Vt[(seg * 8 + 3) * 136 + q] = (bf16_t)(v.y >> 16);
        Vt[(seg * 8 + 4) * 136 + q] = (bf16_t)(v.z & 0xffffu); Vt[(seg * 8 + 5) * 136 + q] = (bf16_t)(v.z >> 16);
        Vt[(seg * 8 + 6) * 136 + q] = (bf16_t)(v.w & 0xffffu); Vt[(seg * 8 + 7) * 136 + q] = (bf16_t)(v.w >> 16); }
    __syncthreads();
    bf16x8 Af[4];
#pragma unroll
    for (int ks = 0; ks < 4; ++ks) Af[ks] = *(const bf16x8*)(F.WSP + (size_t)g * 16384 + (16 * w + lr) * 128 + 32 * ks + 8 * lq);
    f32x4 bsv = *(const f32x4*)(F.b_s + (size_t)(l * 4 + g) * 128 + 16 * w + 4 * lq);
    unsigned short uraw[4][4];
#pragma unroll
    for (int nt = 0; nt < 4; ++nt)
#pragma unroll
        for (int i = 0; i < 4; ++i) uraw[nt][i] = F.Z[(size_t)(r0 + 16 * w + 4 * lq + i) * ZW + ZC_MU + g * 64 + nt * 16 + lr];
    f32x4 accs[4];
#pragma unroll
    for (int nt = 0; nt < 4; ++nt) { f32x4 acc = {0.f, 0.f, 0.f, 0.f};
#pragma unroll
        for (int ks = 0; ks < 4; ++ks) { const bf16x8 bfr = *(const LAS bf16x8*)(Vt + (nt * 16 + lr) * 136 + 32 * ks + 8 * lq); acc = __builtin_amdgcn_mfma_f32_16x16x32_bf16(Af[ks], bfr, acc, 0, 0, 0); }
        accs[nt] = acc; }
#pragma unroll
    for (int nt = 0; nt < 4; ++nt)
#pragma unroll
        for (int i = 0; i < 4; ++i) { const int row = r0 + 16 * w + 4 * lq + i, col = g * 64 + nt * 16 + lr;
            F.MIX[(size_t)row * 1024 + 512 + col] = (bf16_t)f2bf(bf2f(uraw[nt][i]) * (accs[nt][i] + bsv[i])); }
    __syncthreads();
}

#ifndef PROBE_KIND
#define PROBE_KIND -1
#endif
#ifndef ONLY_CASE
#define ONLY_CASE -1
#endif
struct Args { const float* in[24]; float* out; unsigned char* ws; int ph_lo, ph_hi; };
constexpr int NPH = 2 + 9 * DEPTH;
__global__ void __launch_bounds__(NWAVES * 64, 2) mk_fwd(Args args) {
    extern __shared__ __attribute__((aligned(16))) unsigned char lds[];
    const int wave_s = __builtin_amdgcn_readfirstlane((int)threadIdx.x >> 6);
    const int tid_ = wave_s * 64 + fresh_lane();
    volatile LAS unsigned* MISC = (volatile LAS unsigned*)((LAS unsigned char*)lds + MISC_OFF);
    if (tid_ < 32) MISC[tid_] = 0u;
    __syncthreads();
    unsigned* barw = (unsigned*)(args.ws + WS_CTL) + CW_BAR;
    XcdBarrier bar; bar.bar = barw; bar.x = 0; bar.st = nullptr;
    const int lo = args.ph_lo, hi = args.ph_hi;
    if (hi - lo > 1) bar = xcd_barrier_post(barw, MISC + 8, tid_);

#pragma unroll 1
    for (int ph = lo; ph < hi; ++ph) {
        int zero; asm volatile("s_mov_b32 %0, 0" : "=s"(zero));
        Frame F;
        F.lds = (LAS unsigned char*)lds;
        F.wave = wave_s;
        F.G = gridDim.x; F.gw = blockIdx.x * NWAVES + F.wave; F.NGW = F.G * NWAVES;
        const float* const* inp = args.in + zero;
        unsigned char* ws = args.ws + zero;
        F.ws = ws;
        int kind, l;
        if (ph == 0) { kind = 0; l = 0; } else if (ph == NPH - 1) { kind = 10; l = DEPTH - 1; } else { l = (ph - 1) / 9; kind = 1 + (ph - 1) % 9; }
        const bool last = (l == DEPTH - 1);
        const int Mrows = last ? MLAT : MALL;
        unsigned char* wb = ws + (size_t)(l & 1) * WSET_STRIDE;
        const int nrep = (kind == PROBE_KIND) ? 2 : 1;
#pragma unroll 1
        for (int rep = 0; rep < nrep; ++rep) {
        if (rep) xcd_barrier(bar, wave_s * 64 + fresh_lane());
        switch (kind) {
        case 0: if (ONLY_CASE >= 0 && ONLY_CASE != 0) break;  F.c = inp[1]; F.cctx = inp[3]; F.ada_w = inp[4]; F.ada_b = inp[5]; F.MOD = (float*)(ws + WS_MOD); phase_mod(F); break;
        case 1: if (ONLY_CASE >= 0 && ONLY_CASE != 1) break;  F.x = inp[0]; F.ctx = inp[2]; F.norm1_w = inp[6]; F.w_in = inp[8]; F.w_out = inp[9]; F.w_s = inp[15]; F.w1 = inp[21]; F.w2 = inp[22]; F.out = args.out + zero; F.MOD = (float*)(ws + WS_MOD); F.XC = (float*)(ws + WS_XC); F.H = (bf16_t*)(ws + WS_H); F.SLAB = (float*)(ws + WS_SLAB); if (l == 0 || F.G != 256) convert_weights(F, l, F.gw, F.NGW, 0, 6400); phase_norm(F, l, 0, MALL, (l > 0 && !rep) ? NSPLIT_2 : 0, F.MOD + (size_t)((l > 0 ? l - 1 : 0) * 9 + 8) * 6144 + 5 * 1024); break;
        case 2: if (ONLY_CASE >= 0 && ONLY_CASE != 2) break;  F.H = (bf16_t*)(ws + WS_H); F.WIN = (bf16_t*)(wb + WS_WIN); F.Z = (bf16_t*)(ws + WS_Z); { pg8::Gemm g{F.H, F.WIN, MALL, ZW, D, D, D}; pg8::StaticOrder S; S.init(MALL, ZW, D, F.G, (int)blockIdx.x);
                  pg8::EpiBf16<0> E{F.Z, ZW}; pg8::gemm_phase<pg8::EpiBf16<0>, pg8::StaticOrder, true, true, true>(F.lds, g, S, E, wave_s * 64 + fresh_lane()); } break;
        case 3: if (ONLY_CASE >= 0 && ONLY_CASE != 3) break;  F.Z = (bf16_t*)(ws + WS_Z); F.gmlp_norm_w = inp[17]; F.ig_bias = inp[18]; F.fg_bias = inp[19]; F.CHS = (float*)(ws + WS_CHS); for (int rg = blockIdx.x; rg < MALL / 16 + 288; rg += F.G) { if (rg < MALL / 16) ew_unit(F, l, rg); else chs_unit(F, l, rg - MALL / 16); } break;
        case 4: if (ONLY_CASE >= 0 && ONLY_CASE != 4) break;  F.Z = (bf16_t*)(ws + WS_Z); F.conv_w = inp[10]; F.a_log = inp[11]; F.dt_bias = inp[12]; F.ig_bias = inp[18]; F.fg_bias = inp[19]; F.CHS = (float*)(ws + WS_CHS); F.GLG = (float*)(ws + WS_GLG); F.GLM = F.GLG + 2304; F.WI = F.GLG + 4608; F.PG = (bf16_t*)(ws + WS_PG); F.PM = (bf16_t*)(ws + WS_PM); {
                  for (int it = blockIdx.x; it < 1152; it += F.G) { if (!rep) gdn_prep_unit(F, l, it); else if (PROBE_SUB != 2) gdn_prep_unit(F, l, it, PROBE_SUB >= 10 ? PROBE_SUB - 10 : 99, (bf16_t*)(F.ws + WS_H)); }
                  if (!rep || PROBE_SUB != 1) {
                      if (F.G == 256) {
                          const int bx = blockIdx.x; const int n = bx < 128 ? 3 : 6, first = bx < 128 ? bx * 3 : 384 + (bx - 128) * 6;
                          for (int j = 0; j < n; ++j) mlstm_prep_unit(F, l, first + j);
                      } else for (int it = blockIdx.x; it < 1152; it += F.G) mlstm_prep_unit(F, l, it);
                  } } break;
        case 5: if (ONLY_CASE >= 0 && ONLY_CASE != 5) break;  F.Z = (bf16_t*)(ws + WS_Z); F.PG = (bf16_t*)(ws + WS_PG); F.PM = (bf16_t*)(ws + WS_PM); F.GLG = (float*)(ws + WS_GLG); F.GLM = F.GLG + 2304; F.WI = F.GLG + 4608; F.PEND = (float*)(ws + WS_H); F.MIX = (bf16_t*)(ws + WS_MIX); F.gdn_norm_w = inp[13]; F.mlstm_norm_w = inp[20]; F.sink = inp[14]; F.b_s = inp[16]; F.WSP = (bf16_t*)(wb + WS_WSP); { const int bx = blockIdx.x;
                  if (bx < 32) { if (!rep || PROBE_SUB == 0 || PROBE_SUB == 1 || (PROBE_SUB >= 5 && PROBE_SUB <= 8)) scan_wg<true>(F, l, bx, rep && PROBE_SUB >= 5, rep ? PROBE_SUB - 5 : 0); }
                  else if (bx < 64) { if (!rep || PROBE_SUB == 0 || PROBE_SUB == 1 || PROBE_SUB == 4 || (PROBE_SUB >= 5 && PROBE_SUB <= 8)) scan_wg<false>(F, l, bx - 32, rep && PROBE_SUB >= 5, rep ? PROBE_SUB - 5 : 0); }
                  else if (F.G == 256) {
                      const int k = bx - 64;
                      if (!rep || PROBE_SUB == 0 || PROBE_SUB == 2 || PROBE_SUB >= 9) { swa_unit(F, l, k, rep && PROBE_SUB >= 9 ? PROBE_SUB - 8 : 0); if (k < 96) swa_unit(F, l, k + 192, rep && PROBE_SUB >= 9 ? PROBE_SUB - 8 : 0); }
                      if (!rep || PROBE_SUB == 0 || PROBE_SUB == 3) { if (k < 96) gmlp_unit(F, l, k); else for (int j = 0; j < 5; ++j) gmlp_unit(F, l, 96 + (k - 96) * 5 + j); }
                  } else for (int it = bx - 64; it < 288 + 576; it += F.G - 64) { if (it < 288) swa_unit(F, l, it); else gmlp_unit(F, l, it - 288); } } break;
        case 6: case 9: { if (ONLY_CASE >= 0 && ONLY_CASE != 6) break; F.MIX = (bf16_t*)(ws + WS_MIX); F.HID = (bf16_t*)(ws + WS_HID); F.WOUT = (bf16_t*)(wb + WS_WOUT); F.W2 = (bf16_t*)(wb + WS_W2); F.out = args.out + zero; F.XC = (float*)(ws + WS_XC); F.MOD = (float*)(ws + WS_MOD);  const bool isout = (kind == 6);
                  const int Kd = isout ? D : FF;
                  pg8::Gemm g{isout ? F.MIX : F.HID, isout ? F.WOUT : F.W2, MLAT, D, Kd, Kd, Kd}; pg8::StaticOrder S; S.init(MLAT, D, Kd, F.G, (int)blockIdx.x);
                  if (!last) S.add_split(MCTX / 256, isout ? NSPLIT_OUT : NSPLIT_2, Kd);
                  pg8::EpiResid E{rep ? (float*)(F.ws + WS_H) : F.out, rep ? (float*)(F.ws + WS_H) + (size_t)MLAT * 1024 : F.XC, F.MOD + (size_t)l * 9 * 6144 + (isout ? 2 : 5) * 1024, (float*)(F.ws + WS_SLAB)};
                  pg8::gemm_phase<pg8::EpiResid, pg8::StaticOrder, true, true>(F.lds, g, S, E, wave_s * 64 + fresh_lane());
                  if (!isout && !last && !rep && F.G == 256 && blockIdx.x >= 128) { F.w_in = inp[8]; F.w_out = inp[9]; F.w_s = inp[15]; F.w1 = inp[21]; F.w2 = inp[22]; convert_weights(F, l + 1, ((int)blockIdx.x - 128) * NWAVES + F.wave, 128 * NWAVES, CONV_SPLIT, 6400); } } break;
        case 7: if (ONLY_CASE >= 0 && ONLY_CASE != 7) break;  F.norm2_w = inp[7]; F.out = args.out + zero; F.MOD = (float*)(ws + WS_MOD); F.XC = (float*)(ws + WS_XC); F.H = (bf16_t*)(ws + WS_H); F.SLAB = (float*)(ws + WS_SLAB); phase_norm(F, l, 1, Mrows, (!last && !rep) ? NSPLIT_OUT : 0, F.MOD + (size_t)(l * 9 + 8) * 6144 + 2 * 1024); break;
        case 8: if (ONLY_CASE >= 0 && ONLY_CASE != 8) break;  F.H = (bf16_t*)(ws + WS_H); F.W1 = (bf16_t*)(wb + WS_W1); F.HID = (bf16_t*)(ws + WS_HID); { pg8::Gemm g{F.H, F.W1, Mrows, FF, D, D, D}; pg8::StaticOrder S; S.init(Mrows, FF, D, F.G, (int)blockIdx.x);
                  pg8::EpiBf16<1> E{F.HID, FF}; pg8::gemm_phase<pg8::EpiBf16<1>, pg8::StaticOrder, true, true, true>(F.lds, g, S, E, wave_s * 64 + fresh_lane()); }
                if (!last && !rep && F.G == 256 && blockIdx.x >= 128) { F.w_in = inp[8]; F.w_out = inp[9]; F.w_s = inp[15]; F.w1 = inp[21]; F.w2 = inp[22]; convert_weights(F, l + 1, ((int)blockIdx.x - 128) * NWAVES + F.wave, 128 * NWAVES, CONV_SPLIT0, CONV_SPLIT); }
                break;
        default: { F.out = args.out + zero; F.final_w = inp[23]; const bool poison = (hi - lo > 1) && (__hip_atomic_load(barw + XB_TMO, __ATOMIC_RELAXED, __HIP_MEMORY_SCOPE_AGENT) != 0u); phase_final(F, poison); } break;
        }
        }
        if (ph + 1 < hi) xcd_barrier(bar, wave_s * 64 + fresh_lane());
    }
}

extern "C" void kernel_launch(void* const* d_in, const int* in_sizes, int n_in, void* d_out, int out_size, void* d_ws, size_t ws_size, hipStream_t stream) {
    static int grid = 0;
    if (grid == 0) {
        if (n_in != 24 || out_size != MLAT * D || ws_size < WS_END) { fprintf(stderr, "kernel_launch: unexpected shapes: n_in %d out %d ws %zu (need %zu)\n", n_in, out_size, ws_size, (size_t)WS_END); grid = -1; return; }
        int dev = 0, cus = 0, per_cu = 0;
        if (hipGetDevice(&dev) != hipSuccess || hipDeviceGetAttribute(&cus, hipDeviceAttributeMultiprocessorCount, dev) != hipSuccess) { grid = -1; return; }
        if (hipFuncSetAttribute((const void*)mk_fwd, hipFuncAttributeMaxDynamicSharedMemorySize, LDS_BYTES) != hipSuccess) { fprintf(stderr, "kernel_launch: hipFuncSetAttribute failed\n"); grid = -1; return; }
        if (hipOccupancyMaxActiveBlocksPerMultiprocessor(&per_cu, (const void*)mk_fwd, NWAVES * 64, LDS_BYTES) != hipSuccess || per_cu < 1) { fprintf(stderr, "kernel_launch: occupancy query says %d\n", per_cu); grid = -1; return; }
        (void)hipGetLastError();
        grid = cus;
        if (grid < 128) { fprintf(stderr, "kernel_launch: device too small (%d CUs)\n", grid); grid = -1; return; }
    }
    if (grid < 0) return;
    (void)hipMemsetAsync((char*)d_ws + WS_CTL, 0, CTL_ZERO_BYTES, stream);
    Args a{};
    for (int i = 0; i < 24; ++i) a.in[i] = (const float*)d_in[i];
    a.out = (float*)d_out; a.ws = (unsigned char*)d_ws;
#if MK_PER_PHASE
    for (int p = 0; p < NPH; ++p) { a.ph_lo = p; a.ph_hi = p + 1; hipLaunchKernelGGL(mk_fwd, dim3(grid), dim3(NWAVES * 64), LDS_BYTES, stream, a); }
#else
    a.ph_lo = 0; a.ph_hi = NPH;
    void* kargs[] = {&a};
    hipError_t e = hipLaunchCooperativeKernel((const void*)mk_fwd, dim3(grid), dim3(NWAVES * 64), kargs, LDS_BYTES, stream);
    if (e != hipSuccess) fprintf(stderr, "kernel_launch: cooperative launch failed: %s (grid %d)\n", hipGetErrorString(e), grid);
#endif
}
```
